# Optimizing an MI355X kernel written in HIP

```python
import jax, jax.numpy as jnp
from jax import lax
import numpy as np

D_MODEL = 2048
BATCH = 1
SEQ = 8192
DEPTH = 1

HEAD_DIM = 128
DILATED_GROUPS = ((128, 1), (512, 4), (2048, 16))
HEADS_PER_GROUP = 8
N_HEADS_A = HEADS_PER_GROUP * len(DILATED_GROUPS)
A_OUT_WIDTH = HEADS_PER_GROUP * HEAD_DIM
ATTN_BLOCK = 128
NUM_BUCKETS = 32
MAX_DISTANCE = 2048
NEG_INF = -1e30
RET_HEADS = 8
RET_QK_DIM = 128
RET_V_DIM = 256
RET_V_WIDTH = RET_HEADS * RET_V_DIM
RET_CHUNK = 128
ROPE_BASE = 10000.0
GN_EPS = 1e-5
N_EXPERTS = 64
N_GROUPS = 8
TOPK_GROUPS = 4
TOP_K = 8
EXPERT_DIM = 512
SHARED_DIM = 512
ROUTED_SCALE = 2.5
MOE_BLOCK = 128
RMS_EPS = 1e-6
A_QKV = N_HEADS_A * HEAD_DIM
R_QK = RET_HEADS * RET_QK_DIM
IN_WIDTH = 3 * A_QKV + 2 * R_QK + 2 * RET_V_WIDTH + 2 * D_MODEL

kernel_name = 'hybrid_dilated_retention_moe_block'


def _rmsnorm(x, g):
    xf = x.astype(jnp.float32)
    y = xf * lax.rsqrt(jnp.mean(xf * xf, axis=-1, keepdims=True) + RMS_EPS)
    return (y * g.astype(jnp.float32)).astype(x.dtype)


def _t5_bucket(dist):
    max_exact = NUM_BUCKETS // 2
    safe = np.maximum(dist, 1).astype(np.float32)
    large = max_exact + (np.log(safe / max_exact) / np.log(MAX_DISTANCE / max_exact)
                         * (NUM_BUCKETS - max_exact)).astype(np.int32)
    return np.where(dist < max_exact, dist, np.minimum(large, NUM_BUCKETS - 1)).astype(np.int32)


def _dilated_group(q, k, v, bias_tab, w_steps, dilation):
    B, S, H, E = q.shape
    L = S // dilation
    nb = -(-L // ATTN_BLOCK)
    Lp = nb * ATTN_BLOCK

    def to_res(t):
        t = t.reshape(B, L, dilation, H, E).transpose(0, 2, 3, 1, 4)
        return jnp.pad(t, ((0, 0), (0, 0), (0, 0), (0, Lp - L), (0, 0)))

    def key_blocks(t):
        t = jnp.pad(to_res(t), ((0, 0), (0, 0), (0, 0), (ATTN_BLOCK, 0), (0, 0)))
        t = t.reshape(B, dilation, H, nb + 1, ATTN_BLOCK, E)
        return jnp.concatenate([t[:, :, :, :-1], t[:, :, :, 1:]], axis=4)

    qb = to_res(q).reshape(B, dilation, H, nb, ATTN_BLOCK, E)
    kb, vb = key_blocks(k), key_blocks(v)
    a = np.arange(ATTN_BLOCK)[:, None]
    cc = np.arange(2 * ATTN_BLOCK)[None, :]
    delta = ATTN_BLOCK + a - cc
    band = (delta >= 0) & (delta <= w_steps)
    key_ok = ((np.arange(nb)[:, None] - 1) * ATTN_BLOCK + np.arange(2 * ATTN_BLOCK)[None, :]) >= 0
    mask = band[None] & key_ok[:, None, :]
    bucket = _t5_bucket(np.maximum(delta, 0) * dilation)
    bias = jnp.transpose(bias_tab.astype(jnp.float32)[bucket], (2, 0, 1))
    s = jnp.einsum('bdhnqe,bdhnke->bdhnqk', qb, kb, preferred_element_type=jnp.float32)
    s = jnp.where(mask, s + bias[None, None, :, None], NEG_INF)
    m = jnp.max(s, axis=-1, keepdims=True)
    p = jnp.exp(s - m)
    l = jnp.sum(p, axis=-1, keepdims=True)
    o = jnp.einsum('bdhnqk,bdhnke->bdhnqe', p.astype(v.dtype), vb,
                   preferred_element_type=jnp.float32) / l
    lse = (m + jnp.log(l))[..., 0]

    def from_res(t):
        rest = t.shape[5:]
        t = t.reshape((B, dilation, H, Lp) + rest)[:, :, :, :L]
        perm = (0, 3, 1, 2) + tuple(range(4, t.ndim))
        return t.transpose(perm).reshape((B, S, H) + rest)

    return from_res(o), from_res(lse)


def _rotary(t):
    S, E = t.shape[1], t.shape[3]
    inv = ROPE_BASE ** (-jnp.arange(0, E, 2, dtype=jnp.float32) / E)
    ang = jnp.arange(S, dtype=jnp.float32)[:, None] * inv[None, :]
    cos, sin = jnp.cos(ang)[None, :, None, :], jnp.sin(ang)[None, :, None, :]
    tf = t.astype(jnp.float32)
    t1, t2 = tf[..., :E // 2], tf[..., E // 2:]
    return jnp.concatenate([t1 * cos - t2 * sin, t1 * sin + t2 * cos], axis=-1).astype(t.dtype)


def _retention(q, k, v):
    B, S, H, DK = q.shape
    DV = v.shape[-1]
    C = RET_CHUNK
    N = S // C
    log_g = jnp.log1p(-jnp.exp2(-5.0 - jnp.arange(H, dtype=jnp.float32)))

    def chunk(t):
        return t.astype(jnp.float32).reshape(B, N, C, H, t.shape[-1]).transpose(0, 3, 1, 2, 4)

    qc, kc, vc = chunk(q), chunk(k), chunk(v)
    idx = jnp.arange(C, dtype=jnp.float32)
    diff = idx[:, None] - idx[None, :]
    dmat = jnp.where(diff >= 0, jnp.exp(log_g[:, None, None] * jnp.maximum(diff, 0.0)), 0.0)
    inner = jnp.einsum('bhnqd,bhnkd->bhnqk', qc, kc) * dmat[None, :, None]
    inner = jnp.einsum('bhnqk,bhnke->bhnqe', inner, vc)
    zeta = jnp.exp(log_g[:, None] * (C - 1 - idx))
    upd = jnp.einsum('bhnkd,bhnke->bhnde', kc, vc * zeta[None, :, None, :, None])
    g_chunk = jnp.exp(log_g * C)[None, :, None, None]

    def step(state, u):
        return g_chunk * state + u, state

    _, prev = lax.scan(step, jnp.zeros((B, H, DK, DV), jnp.float32), jnp.moveaxis(upd, 2, 0))
    prev = jnp.moveaxis(prev, 0, 2)
    xi = jnp.exp(log_g[:, None] * (idx + 1.0))
    cross = jnp.einsum('bhnqd,bhnde->bhnqe', qc, prev) * xi[None, :, None, :, None]
    return (inner + cross).transpose(0, 2, 3, 1, 4).reshape(B, S, H, DV)


def _moe(h, router_w, router_bias, w_gate_e, w_up_e, w_down_e):
    T, D = h.shape
    E = N_EXPERTS
    scores = jax.nn.sigmoid(jnp.dot(h.astype(jnp.float32), router_w.astype(jnp.float32)))
    sel = scores + router_bias.astype(jnp.float32)
    grp_score = lax.top_k(sel.reshape(T, N_GROUPS, E // N_GROUPS), 2)[0].sum(-1)
    _, grp_idx = lax.top_k(grp_score, TOPK_GROUPS)
    grp_mask = jax.nn.one_hot(grp_idx, N_GROUPS, dtype=jnp.float32).sum(1)
    exp_mask = jnp.repeat(grp_mask, E // N_GROUPS, axis=1) > 0
    _, top_idx = lax.top_k(jnp.where(exp_mask, sel, -jnp.inf), TOP_K)
    top_w = jnp.take_along_axis(scores, top_idx, axis=1)
    top_w = top_w / jnp.sum(top_w, axis=-1, keepdims=True) * ROUTED_SCALE
    TK = T * TOP_K
    flat_e = top_idx.reshape(TK)
    flat_w = top_w.reshape(TK)
    order = jnp.argsort(flat_e)
    sorted_e = flat_e[order]
    counts = jnp.bincount(flat_e, length=E)
    padded = (counts + MOE_BLOCK - 1) // MOE_BLOCK * MOE_BLOCK
    pad_end = jnp.cumsum(padded)
    pad_start = pad_end - padded
    start = jnp.cumsum(counts) - counts
    dest = pad_start[sorted_e] + jnp.arange(TK, dtype=jnp.int32) - start[sorted_e]
    n_blocks = (TK + E * (MOE_BLOCK - 1) + MOE_BLOCK - 1) // MOE_BLOCK
    P = n_blocks * MOE_BLOCK
    tok_buf = jnp.full((P,), T, jnp.int32).at[dest].set((order // TOP_K).astype(jnp.int32))
    w_buf = jnp.zeros((P,), jnp.float32).at[dest].set(flat_w[order])
    block_e = jnp.minimum(jnp.searchsorted(pad_end, jnp.arange(n_blocks) * MOE_BLOCK, side='right'), E - 1)
    h_pad = jnp.concatenate([h, jnp.zeros((1, D), h.dtype)], axis=0)

    def body(out, blk):
        tok, wt, e = blk
        xb = h_pad[tok]
        y = (jax.nn.silu(xb @ w_gate_e[e]) * (xb @ w_up_e[e])) @ w_down_e[e]
        return out.at[tok].add(y.astype(jnp.float32) * wt[:, None]), None

    out, _ = lax.scan(body, jnp.zeros((T + 1, D), jnp.float32),
                      (tok_buf.reshape(n_blocks, MOE_BLOCK), w_buf.reshape(n_blocks, MOE_BLOCK), block_e))
    return out[:T].astype(h.dtype)


def setup_inputs(seed: int = 0) -> dict:
    key = jax.random.key(seed)
    ks = jax.random.split(key, 22)
    f32 = jnp.float32

    def nrm(k, shape, scale):
        return jax.random.normal(k, shape, f32) * scale

    L = DEPTH
    return {
        'x': nrm(ks[0], (BATCH, SEQ, D_MODEL), 1.0),
        'c': nrm(ks[1], (BATCH, D_MODEL), 1.0),
        'rel_bias': nrm(ks[2], (NUM_BUCKETS, N_HEADS_A), 0.5),
        'w_ada': nrm(ks[3], (L, D_MODEL, 6 * D_MODEL), 0.5 * D_MODEL ** -0.5),
        'b_ada': nrm(ks[4], (L, 6 * D_MODEL), 0.02),
        'ln1_g': 1.0 + nrm(ks[5], (L, D_MODEL), 0.02),
        'w_in': nrm(ks[6], (L, D_MODEL, IN_WIDTH), D_MODEL ** -0.5),
        'q_norm_g': 1.0 + nrm(ks[7], (L, HEAD_DIM), 0.02),
        'k_norm_g': 1.0 + nrm(ks[8], (L, HEAD_DIM), 0.02),
        'ret_gn_g': 1.0 + nrm(ks[9], (L, RET_V_WIDTH), 0.02),
        'p_a': nrm(ks[10], (L, A_OUT_WIDTH, D_MODEL), A_OUT_WIDTH ** -0.5),
        'p_b': nrm(ks[11], (L, RET_V_WIDTH, D_MODEL), RET_V_WIDTH ** -0.5),
        'w_o': nrm(ks[12], (L, D_MODEL, D_MODEL), D_MODEL ** -0.5),
        'ln2_g': 1.0 + nrm(ks[13], (L, D_MODEL), 0.02),
        'router_w': nrm(ks[14], (L, D_MODEL, N_EXPERTS), D_MODEL ** -0.5),
        'router_bias': nrm(ks[15], (L, N_EXPERTS), 0.01),
        'w_gate_e': nrm(ks[16], (L, N_EXPERTS, D_MODEL, EXPERT_DIM), D_MODEL ** -0.5),
        'w_up_e': nrm(ks[17], (L, N_EXPERTS, D_MODEL, EXPERT_DIM), D_MODEL ** -0.5),
        'w_down_e': nrm(ks[18], (L, N_EXPERTS, EXPERT_DIM, D_MODEL), EXPERT_DIM ** -0.5),
        'w_gate_s': nrm(ks[19], (L, D_MODEL, SHARED_DIM), D_MODEL ** -0.5),
        'w_up_s': nrm(ks[20], (L, D_MODEL, SHARED_DIM), D_MODEL ** -0.5),
        'w_down_s': nrm(ks[21], (L, SHARED_DIM, D_MODEL), SHARED_DIM ** -0.5),
    }


def reference(x, c, rel_bias, w_ada, b_ada, ln1_g, w_in, q_norm_g, k_norm_g, ret_gn_g,
              p_a, p_b, w_o, ln2_g, router_w, router_bias, w_gate_e, w_up_e, w_down_e,
              w_gate_s, w_up_s, w_down_s):
    B, S, D = x.shape
    sizes = [A_QKV, A_QKV, A_QKV, R_QK, R_QK, RET_V_WIDTH, RET_V_WIDTH, D_MODEL, D_MODEL]
    cuts = [int(v) for v in np.cumsum(sizes)[:-1]]
    for l in range(DEPTH):
        mod = jax.nn.silu(c) @ w_ada[l] + b_ada[l]
        sh1, sc1, g1, sh2, sc2, g2 = jnp.split(mod[:, None, :], 6, axis=-1)
        h = _rmsnorm(x, ln1_g[l]) * (1.0 + sc1) + sh1
        proj = h @ w_in[l]
        qa, ka, va, qr, kr, vr, gr, gate_a, gate_b = jnp.split(proj, cuts, axis=-1)
        qa = _rmsnorm(qa.reshape(B, S, N_HEADS_A, HEAD_DIM), q_norm_g[l]) * (HEAD_DIM ** -0.5)
        ka = _rmsnorm(ka.reshape(B, S, N_HEADS_A, HEAD_DIM), k_norm_g[l])
        va = va.reshape(B, S, N_HEADS_A, HEAD_DIM)
        outs, lses = [], []
        for gi, (win, dil) in enumerate(DILATED_GROUPS):
            hs = slice(gi * HEADS_PER_GROUP, (gi + 1) * HEADS_PER_GROUP)
            o, lse = _dilated_group(qa[:, :, hs], ka[:, :, hs], va[:, :, hs], rel_bias[:, hs], win // dil, dil)
            outs.append(o)
            lses.append(lse)
        alpha = jax.nn.softmax(jnp.stack(lses, axis=0), axis=0)
        y_a = jnp.sum(alpha[..., None] * jnp.stack(outs, axis=0), axis=0)
        y_a = y_a.reshape(B, S, A_OUT_WIDTH).astype(x.dtype)
        qr = _rotary(qr.reshape(B, S, RET_HEADS, RET_QK_DIM))
        kr = _rotary(kr.reshape(B, S, RET_HEADS, RET_QK_DIM)) * (RET_QK_DIM ** -0.5)
        ret = _retention(qr, kr, vr.reshape(B, S, RET_HEADS, RET_V_DIM))
        mu = jnp.mean(ret, axis=-1, keepdims=True)
        var = jnp.mean(jnp.square(ret - mu), axis=-1, keepdims=True)
        ret = ((ret - mu) * lax.rsqrt(var + GN_EPS)).reshape(B, S, RET_V_WIDTH) * ret_gn_g[l].astype(jnp.float32)
        y_b = (ret * jax.nn.silu(gr.astype(jnp.float32))).astype(x.dtype)
        merged = jax.nn.sigmoid(gate_a) * (y_a @ p_a[l]) + jax.nn.sigmoid(gate_b) * (y_b @ p_b[l])
        x = x + g1 * (merged @ w_o[l])
        h2 = _rmsnorm(x, ln2_g[l]) * (1.0 + sc2) + sh2
        hf = h2.reshape(B * S, D)
        routed = _moe(hf, router_w[l], router_bias[l], w_gate_e[l], w_up_e[l], w_down_e[l])
        shared = (jax.nn.silu(hf @ w_gate_s[l]) * (hf @ w_up_s[l])) @ w_down_s[l]
        x = x + g2 * (routed + shared).reshape(B, S, D)
    return x
```

```cpp
#include <hip/hip_runtime.h>
#include <cstdio>
#include <cstdint>

#define LAS __attribute__((address_space(3)))
#define GAS __attribute__((address_space(1)))
typedef unsigned short bf16_t;
typedef short bf16x8 __attribute__((ext_vector_type(8)));
typedef short bf16x4 __attribute__((ext_vector_type(4)));
typedef float f32x4 __attribute__((ext_vector_type(4)));
typedef float f32x2 __attribute__((ext_vector_type(2)));
typedef float f32x16 __attribute__((ext_vector_type(16)));
typedef unsigned u32x4 __attribute__((ext_vector_type(4)));
typedef unsigned u32x2 __attribute__((ext_vector_type(2)));
typedef GAS unsigned gu32;

#ifndef DUP2_MASK
#define DUP2_MASK 0
#endif
#ifndef MK_PER_PHASE
#define MK_PER_PHASE 0
#endif

constexpr int S = 8192, D = 2048, INW = 19456;
constexpr int C_QA = 0, C_KA = 3072, C_VA = 6144, C_QR = 9216, C_KR = 10240, C_VR = 11264, C_GR = 13312, C_GA = 15360, C_GB = 17408;
constexpr int NE = 64, ED = 512, TOPK = 8;
constexpr int MAXT_R = 320;
constexpr int SH_ROW0 = MAXT_R * 256;
constexpr int NROWS_Y = SH_ROW0 + S;
constexpr int NPH = 13;

constexpr size_t MiB = 1u << 20;
constexpr size_t WS_CTL = 0, CTL_ZERO_BYTES = 1 * MiB;
constexpr size_t WS_MODP = 1 * MiB;
constexpr size_t WS_MODF = 1 * MiB + 512 * 1024;
constexpr size_t WS_LSE = 2 * MiB;
constexpr size_t WS_ROPE = 3 * MiB;
constexpr size_t WS_EOF = 7 * MiB;
constexpr size_t WS_TOKS = 8 * MiB;
constexpr size_t WS_PA = 10 * MiB, WS_PB = 14 * MiB, WS_WO = 22 * MiB;
constexpr size_t WS_H = 32 * MiB;
constexpr size_t WS_E1 = 64 * MiB;
constexpr size_t WS_E2 = 324 * MiB;
constexpr size_t WS_PREV = 454 * MiB;
constexpr size_t WS_YB = 486 * MiB;
constexpr size_t WS_MERGED = 518 * MiB;
constexpr size_t WS_R1 = 550 * MiB;
constexpr size_t WS_OG = WS_R1, WS_YA = WS_R1 + 48 * MiB, WS_UPD = WS_R1 + 64 * MiB, WS_ACT = WS_R1;
constexpr size_t WS_R2 = 678 * MiB;
constexpr size_t WS_WINT = WS_R2, WS_PROJ = WS_R2 + 76 * MiB, WS_Y = WS_R2;
constexpr size_t WS_END = 1058 * MiB;
constexpr int CW_TMO = 0, CW_CODE = 1, CW_BAR = 4096, CW_CNT = 8192;

constexpr int RING_BYTES = 131072;
constexpr int LDS_TAB = 131072;
constexpr int LDS_MISC = 163840 - 256;
constexpr int LDS_BYTES = 163840;

__device__ __forceinline__ float bf2f(unsigned b) { return __uint_as_float(b << 16); }
__device__ __forceinline__ unsigned cvt_pk_bf16(float lo, float hi) { unsigned r; asm("v_cvt_pk_bf16_f32 %0, %1, %2" : "=v"(r) : "v"(lo), "v"(hi)); return r; }
__device__ __forceinline__ float fsilu(float v) { return v / (1.f + __expf(-v)); }
__device__ __forceinline__ float fsigm(float v) { return 1.f / (1.f + __expf(-v)); }
#define TR_READ(dst, base, OFF) asm volatile("ds_read_b64_tr_b16 %0, %1 offset:%2" : "=&v"(dst) : "v"(base), "i"(OFF) : "memory")
#define TR_WAIT2(a, b) asm volatile("s_waitcnt lgkmcnt(0)" : "+v"(a), "+v"(b) :: "memory")
#define TR_WAIT4(a, b, c, d) asm volatile("s_waitcnt lgkmcnt(0)" : "+v"(a), "+v"(b), "+v"(c), "+v"(d) :: "memory")
#define LDS_WAIT() asm volatile("s_waitcnt lgkmcnt(0)" ::: "memory")
#define VM_WAIT() asm volatile("s_waitcnt vmcnt(0)" ::: "memory")

namespace pg8 {
constexpr int BM = 256, BK = 64, HALF = 128, HTB = HALF * BK * 2, STAGE_BYTES = 8 * HTB, NXCD = 8, WGM = 8;
__host__ __device__ __forceinline__ int lds_byte(int r, int c) { const int st = (r >> 4) * 2 + (c >> 5), rr = r & 15, cc = c & 31, ob = rr * 64 + cc * 2; return st * 1024 + (ob ^ (((ob >> 9) & 1) << 5)); }
__host__ __device__ __forceinline__ void stage_rc(int b, int& R, int& C) { const int st = b / 1024, sb = b % 1024, swz = sb ^ (((sb >> 9) & 1) << 5); R = (st >> 1) * 16 + swz / 64; C = (st & 1) * 32 + (swz % 64) / 2; }
__host__ __device__ __forceinline__ int perm32(int rho) { const int n = rho >> 4, i = rho & 15; return 8 * (i >> 2) + 4 * n + (i & 3); }

struct Unit { int row0, pn, e, nvalid; };

struct DenseSched {
    static constexpr bool RAGGED = false;
    const char* A; const char* Bt; int lda, K; int nM, nN, nwg, G, c, i_lo, i_hi;
    __device__ __forceinline__ void init(const void* A_, int lda_, const void* Bt_, int M, int N, int K_, int G_, int c_) { A = (const char*)A_; Bt = (const char*)Bt_; lda = lda_; K = K_; nM = M / BM; nN = N / BM; nwg = nM * nN; G = G_; c = c_; i_lo = 0; i_hi = 0x7fffffff; }
    __device__ __forceinline__ bool next(int i, Unit& u) const {
        if (i_lo + i >= i_hi) return false;
        const long L = (long)(i_lo + i) * G + c; if (L >= nwg) return false;
        int wgid = (int)L; { const int q = nwg / NXCD, r = nwg % NXCD, xcd = wgid % NXCD, off = wgid / NXCD; wgid = (xcd < r ? xcd * (q + 1) : r * (q + 1) + (xcd - r) * q) + off; }
        const int nig = WGM * nN, gid = wgid / nig, fm = gid * WGM, gsz = (nM - fm) < WGM ? (nM - fm) : WGM;
        u.row0 = (fm + ((wgid % nig) % gsz)) * BM; u.pn = (wgid % nig) / gsz; u.e = 0; u.nvalid = 256; return true;
    }
    __device__ __forceinline__ const char* a_base() const { return A; }
    __device__ __forceinline__ const char* b_ptr(const Unit& u) const { return Bt + (size_t)u.pn * BM * K * 2; }
    __device__ __forceinline__ void a_off(const Unit& u, int tid, unsigned (&off)[2][2]) const {
#pragma unroll
        for (int i = 0; i < 2; ++i) { int R, C; stage_rc(tid * 16 + i * 8192, R, C);
            off[0][i] = (unsigned)((u.row0 + R) * lda + C) * 2u; off[1][i] = (unsigned)((u.row0 + HALF + R) * lda + C) * 2u; }
    }
};

template <class Epi, class Sched, bool ALIGN_EPI>
__device__ __forceinline__ void gemm_phase(LAS unsigned char* lds, const int K, const Sched& S, const Epi& E) {
    const int tid = threadIdx.x, wid = __builtin_amdgcn_readfirstlane(tid >> 6), lane = tid & 63, wr = wid >> 2, wc = wid & 3, fr = lane & 15, fq = lane >> 4;
    const int nt = K / BK;
    unsigned voffB[2];
#pragma unroll
    for (int i = 0; i < 2; ++i) { int R, C; stage_rc(tid * 16 + i * 8192, R, C); const int Rb = Epi::PERM ? ((R & ~31) + perm32(R & 31)) : R; voffB[i] = (unsigned)(Rb * K + C) * 2u; }
    const size_t kstep = (size_t)(BK * 2);
    const size_t hstepB = (size_t)HALF * K * 2;
    const unsigned ldsw = (unsigned)wid * 1024u;
    const int aoff = lds_byte(wr * 64 + fr, fq * 8), boff = lds_byte(wc * 32 + fr, fq * 8);
#define PG8_SA(b, h) (((b) * 2 + (h)) * HTB)
#define PG8_SB(b, h) ((4 + (b) * 2 + (h)) * HTB)
#define PG8_STAGE(bufoff, gbase, voff) do { _Pragma("unroll") for (int _i = 0; _i < 2; ++_i) \
        __builtin_amdgcn_global_load_lds((const unsigned*)((const char*)(gbase) + (voff)[_i]), (LAS unsigned*)(lds + (bufoff) + ldsw + _i * 8192), 16, 0, 0); } while (0)
#define PG8_LDA(dst, b, h) do { _Pragma("unroll") for (int m = 0; m < 4; ++m) _Pragma("unroll") for (int k = 0; k < 2; ++k) dst[m][k] = *(const LAS bf16x8*)(lds + PG8_SA(b, h) + aoff + m * 2048 + k * 1024); } while (0)
#define PG8_LDB(dst, b, h) do { _Pragma("unroll") for (int n = 0; n < 2; ++n) _Pragma("unroll") for (int k = 0; k < 2; ++k) dst[n][k] = *(const LAS bf16x8*)(lds + PG8_SB(b, h) + boff + n * 2048 + k * 1024); } while (0)
#define PG8_MMA(ai, bj, At, Bt) do { __builtin_amdgcn_s_setprio(1); _Pragma("unroll") for (int m = 0; m < 4; ++m) _Pragma("unroll") for (int n = 0; n < 2; ++n) _Pragma("unroll") for (int k = 0; k < 2; ++k) \
        acc[ai][bj][m][n] = __builtin_amdgcn_mfma_f32_16x16x32_bf16(Bt[n][k], At[m][k], acc[ai][bj][m][n], 0, 0, 0); __builtin_amdgcn_s_setprio(0); } while (0)
#define PG8_WAIT_V(n) asm volatile("s_waitcnt vmcnt(" #n ")" ::: "memory")
#define PG8_WAIT_L(n) asm volatile("s_waitcnt lgkmcnt(" #n ")" ::: "memory")
#define PG8_BAR __builtin_amdgcn_s_barrier()
#define PG8_SCHED __builtin_amdgcn_sched_barrier(0)
    Unit cur, nxt; int ui = 0;
    if (!S.next(0, cur)) return;
    f32x4 acc[2][2][4][2];
#pragma unroll
    for (int a = 0; a < 2; ++a)
#pragma unroll
        for (int b = 0; b < 2; ++b)
#pragma unroll
            for (int m = 0; m < 4; ++m)
#pragma unroll
                for (int n = 0; n < 2; ++n) acc[a][b][m][n] = (f32x4){0.f, 0.f, 0.f, 0.f};
    bf16x8 At[4][2], B0[2][2], B1[2][2];
    unsigned coff[2][2], noff[2][2];
    S.a_off(cur, tid, coff);
    const char* const Ab = S.a_base();
    const char* cB = S.b_ptr(cur);
    PG8_STAGE(PG8_SB(0, 0), cB, voffB); PG8_STAGE(PG8_SB(0, 1), cB + hstepB, voffB); PG8_STAGE(PG8_SA(0, 0), Ab, coff[0]); PG8_STAGE(PG8_SA(0, 1), Ab, coff[1]);
    if (wr == 1) PG8_BAR;
    PG8_WAIT_V(2); PG8_BAR;
    PG8_STAGE(PG8_SB(1, 0), cB + kstep, voffB); PG8_STAGE(PG8_SA(1, 0), Ab + kstep, coff[0]); PG8_STAGE(PG8_SB(1, 1), cB + hstepB + kstep, voffB);
    PG8_WAIT_V(6); PG8_BAR;
    for (;;) {
        const bool has_next = S.next(ui + 1, nxt);
        const char* nB = has_next ? S.b_ptr(nxt) : cB;
        for (int t = 0; t < nt; t += 2) {
            const bool last = (t == nt - 2);
            const char* a1 = Ab + (size_t)(t + 1) * kstep;
            const char* a2 = last ? Ab : Ab + (size_t)(t + 2) * kstep; const char* b2 = last ? nB : cB + (size_t)(t + 2) * kstep;
            const char* a3 = a2 + kstep; const char* b3 = b2 + kstep;
            if (last && has_next) S.a_off(nxt, tid, noff);
            PG8_LDB(B0, 0, 0); PG8_LDB(B1, 0, 1); PG8_SCHED; PG8_LDA(At, 0, 0); PG8_STAGE(PG8_SA(1, 1), a1, coff[1]);
            PG8_WAIT_V(8); PG8_WAIT_L(0); PG8_BAR; PG8_MMA(0, 0, At, B0); PG8_MMA(0, 1, At, B1); PG8_BAR; PG8_SCHED;
            if (last && has_next) { coff[0][0] = noff[0][0]; coff[0][1] = noff[0][1]; coff[1][0] = noff[1][0]; coff[1][1] = noff[1][1]; }
            PG8_LDA(At, 0, 1); PG8_STAGE(PG8_SB(0, 0), b2, voffB); PG8_STAGE(PG8_SB(0, 1), b2 + hstepB, voffB); PG8_STAGE(PG8_SA(0, 0), a2, coff[0]);
            PG8_WAIT_V(8); PG8_WAIT_L(0); PG8_BAR; if (!Sched::RAGGED || cur.nvalid > HALF) { PG8_MMA(1, 0, At, B0); PG8_MMA(1, 1, At, B1); } PG8_BAR; PG8_SCHED;
            PG8_LDB(B0, 1, 0); PG8_LDB(B1, 1, 1); PG8_SCHED; PG8_LDA(At, 1, 0); PG8_STAGE(PG8_SA(0, 1), a2, coff[1]);
            PG8_WAIT_V(8); PG8_WAIT_L(0); PG8_BAR; PG8_MMA(0, 0, At, B0); PG8_MMA(0, 1, At, B1); PG8_BAR; PG8_SCHED;
            PG8_LDA(At, 1, 1); PG8_STAGE(PG8_SB(1, 0), b3, voffB); PG8_STAGE(PG8_SB(1, 1), b3 + hstepB, voffB); PG8_STAGE(PG8_SA(1, 0), a3, coff[0]);
            PG8_WAIT_V(8); PG8_WAIT_L(0); PG8_BAR; if (!Sched::RAGGED || cur.nvalid > HALF) { PG8_MMA(1, 0, At, B0); PG8_MMA(1, 1, At, B1); } PG8_BAR; PG8_SCHED;
        }
        if constexpr (ALIGN_EPI) { if (wr == 0) PG8_BAR; }
        E(acc, cur, wr, wc, fr, fq);
        if (!has_next) break;
#pragma unroll
        for (int a = 0; a < 2; ++a)
#pragma unroll
            for (int b = 0; b < 2; ++b)
#pragma unroll
                for (int m = 0; m < 4; ++m)
#pragma unroll
                    for (int n = 0; n < 2; ++n) acc[a][b][m][n] = (f32x4){0.f, 0.f, 0.f, 0.f};
        cur = nxt; cB = nB; ++ui;
        if constexpr (ALIGN_EPI) { if (wr == 1) PG8_BAR; }
    }
    PG8_WAIT_V(0);
    if constexpr (!ALIGN_EPI) { if (wr == 0) PG8_BAR; }
    PG8_BAR;
#undef PG8_SA
#undef PG8_SB
#undef PG8_STAGE
#undef PG8_LDA
#undef PG8_LDB
#undef PG8_MMA
#undef PG8_WAIT_V
#undef PG8_WAIT_L
#undef PG8_BAR
#undef PG8_SCHED
}
}
using pg8::Unit;

struct EpiBf16 {
    static constexpr bool PERM = true;
    bf16_t* O; int ldc; int nostore;
    __device__ __forceinline__ void operator()(const f32x4 (&acc)[2][2][4][2], const Unit& u, int wr, int wc, int fr, int fq) const {
        const int row0 = u.row0 + wr * 64 + fr, col0 = u.pn * 256 + wc * 32 + 8 * fq;
#pragma unroll
        for (int ai = 0; ai < 2; ++ai)
#pragma unroll
            for (int m = 0; m < 4; ++m) { bf16_t* rowp = O + (size_t)(row0 + ai * 128 + m * 16) * ldc + col0;
#pragma unroll
                for (int bj = 0; bj < 2; ++bj) { const f32x4 v0 = acc[ai][bj][m][0], v1 = acc[ai][bj][m][1];
                    u32x4 w; w.x = cvt_pk_bf16(v0[0], v0[1]); w.y = cvt_pk_bf16(v0[2], v0[3]); w.z = cvt_pk_bf16(v1[0], v1[1]); w.w = cvt_pk_bf16(v1[2], v1[3]);
                    if (!nostore) *(u32x4*)(rowp + bj * 128) = w; else asm volatile("" :: "v"(w)); } }
    }
};
template <bool ADD> struct EpiGate {
    static constexpr bool PERM = true;
    bf16_t* O; int ldc; const bf16_t* gate; int ldg;
    __device__ __forceinline__ void operator()(const f32x4 (&acc)[2][2][4][2], const Unit& u, int wr, int wc, int fr, int fq) const {
        const int row0 = u.row0 + wr * 64 + fr, col0 = u.pn * 256 + wc * 32 + 8 * fq;
#pragma unroll
        for (int ai = 0; ai < 2; ++ai)
#pragma unroll
            for (int m = 0; m < 4; ++m) { const size_t r = (size_t)(row0 + ai * 128 + m * 16); bf16_t* rowp = O + r * ldc + col0; const bf16_t* gp = gate + r * ldg + col0;
#pragma unroll
                for (int bj = 0; bj < 2; ++bj) { const f32x4 v0 = acc[ai][bj][m][0], v1 = acc[ai][bj][m][1];
                    const u32x4 g = *(const u32x4*)(gp + bj * 128);
                    float o[8];
                    o[0] = fsigm(bf2f(g.x & 0xffffu)) * v0[0]; o[1] = fsigm(bf2f(g.x >> 16)) * v0[1]; o[2] = fsigm(bf2f(g.y & 0xffffu)) * v0[2]; o[3] = fsigm(bf2f(g.y >> 16)) * v0[3];
                    o[4] = fsigm(bf2f(g.z & 0xffffu)) * v1[0]; o[5] = fsigm(bf2f(g.z >> 16)) * v1[1]; o[6] = fsigm(bf2f(g.w & 0xffffu)) * v1[2]; o[7] = fsigm(bf2f(g.w >> 16)) * v1[3];
                    if (ADD) { const u32x4 p = *(const u32x4*)(rowp + bj * 128);
                        o[0] += bf2f(p.x & 0xffffu); o[1] += bf2f(p.x >> 16); o[2] += bf2f(p.y & 0xffffu); o[3] += bf2f(p.y >> 16);
                        o[4] += bf2f(p.z & 0xffffu); o[5] += bf2f(p.z >> 16); o[6] += bf2f(p.w & 0xffffu); o[7] += bf2f(p.w >> 16); }
                    u32x4 w; w.x = cvt_pk_bf16(o[0], o[1]); w.y = cvt_pk_bf16(o[2], o[3]); w.z = cvt_pk_bf16(o[4], o[5]); w.w = cvt_pk_bf16(o[6], o[7]);
                    *(u32x4*)(rowp + bj * 128) = w; } }
    }
};
struct EpiResid {
    static constexpr bool PERM = false;
    const float* base; float* out; int ldc; const float* gvec;
    __device__ __forceinline__ void operator()(const f32x4 (&acc)[2][2][4][2], const Unit& u, int wr, int wc, int fr, int fq) const {
        const int row0 = u.row0 + wr * 64 + fr, col0 = u.pn * 256 + wc * 32 + 4 * fq;
        f32x4 gv[2][2];
#pragma unroll
        for (int bj = 0; bj < 2; ++bj)
#pragma unroll
            for (int n = 0; n < 2; ++n) gv[bj][n] = *(const f32x4*)(gvec + col0 + bj * 128 + n * 16);
#pragma unroll
        for (int ai = 0; ai < 2; ++ai)
#pragma unroll
            for (int m = 0; m < 4; ++m) { const size_t off = (size_t)(row0 + ai * 128 + m * 16) * ldc + col0;
#pragma unroll
                for (int bj = 0; bj < 2; ++bj)
#pragma unroll
                    for (int n = 0; n < 2; ++n) { const f32x4 bs = *(const f32x4*)(base + off + bj * 128 + n * 16); *(f32x4*)(out + off + bj * 128 + n * 16) = bs + gv[bj][n] * acc[ai][bj][m][n]; } }
    }
};
struct EpiGateUp {
    static constexpr bool PERM = true;
    bf16_t* ACT;
    __device__ __forceinline__ void operator()(const f32x4 (&acc)[2][2][4][2], const Unit& u, int wr, int wc, int fr, int fq) const {
        const int row0 = u.row0 + wr * 64 + fr, col0 = u.pn * 128 + wc * 32 + 8 * fq;
#pragma unroll
        for (int ai = 0; ai < 2; ++ai)
#pragma unroll
            for (int m = 0; m < 4; ++m) { bf16_t* rowp = ACT + (size_t)(row0 + ai * 128 + m * 16) * ED + col0;
                const f32x4 g0 = acc[ai][0][m][0], g1 = acc[ai][0][m][1], u0 = acc[ai][1][m][0], u1 = acc[ai][1][m][1];
                u32x4 w; w.x = cvt_pk_bf16(fsilu(g0[0]) * u0[0], fsilu(g0[1]) * u0[1]); w.y = cvt_pk_bf16(fsilu(g0[2]) * u0[2], fsilu(g0[3]) * u0[3]);
                w.z = cvt_pk_bf16(fsilu(g1[0]) * u1[0], fsilu(g1[1]) * u1[1]); w.w = cvt_pk_bf16(fsilu(g1[2]) * u1[2], fsilu(g1[3]) * u1[3]);
                *(u32x4*)rowp = w; }
    }
};
struct EpiDown {
    static constexpr bool PERM = true;
    bf16_t* Y; const float* wsorted;
    __device__ __forceinline__ void operator()(const f32x4 (&acc)[2][2][4][2], const Unit& u, int wr, int wc, int fr, int fq) const {
        const int rl0 = wr * 64 + fr, col0 = u.pn * 256 + wc * 32 + 8 * fq;
#pragma unroll
        for (int ai = 0; ai < 2; ++ai)
#pragma unroll
            for (int m = 0; m < 4; ++m) { const int rl = rl0 + ai * 128 + m * 16; const int row = u.row0 + rl;
                float wv = 1.f; if (u.e < NE) wv = (rl < u.nvalid) ? wsorted[row] : 0.f;
                bf16_t* rowp = Y + (size_t)row * D + col0;
#pragma unroll
                for (int bj = 0; bj < 2; ++bj) { const f32x4 v0 = acc[ai][bj][m][0] * wv, v1 = acc[ai][bj][m][1] * wv;
                    u32x4 w; w.x = cvt_pk_bf16(v0[0], v0[1]); w.y = cvt_pk_bf16(v0[2], v0[3]); w.z = cvt_pk_bf16(v1[0], v1[1]); w.w = cvt_pk_bf16(v1[2], v1[3]);
                    *(u32x4*)(rowp + bj * 128) = w; } }
    }
};

struct MoeTab { LAS int* te; LAS int* tn; LAS int* misc; };
__device__ __forceinline__ MoeTab moe_tab(LAS unsigned char* lds) { MoeTab t; t.te = (LAS int*)(lds + LDS_TAB); t.tn = t.te + 352; t.misc = t.tn + 352; return t; }
struct MoeSched1 {
    static constexpr bool RAGGED = true;
    const char* H2; const char* E1; const int* toks; MoeTab tab; int G, vcu;
    __device__ __forceinline__ bool next(int i, Unit& u) const {
        const int ntr = tab.misc[0]; const int L = i * G + vcu; if (L >= 4 * (ntr + 32)) return false;
        const int t = L >> 2; u.pn = L & 3;
        if (t < ntr) { u.row0 = t * 256; u.e = tab.te[t]; u.nvalid = tab.tn[t]; } else { u.row0 = SH_ROW0 + (t - ntr) * 256; u.e = NE; u.nvalid = 256; }
        return true;
    }
    __device__ __forceinline__ const char* a_base() const { return H2; }
    __device__ __forceinline__ const char* b_ptr(const Unit& u) const { return E1 + ((size_t)u.e * 1024 + (size_t)u.pn * 256) * (D * 2); }
    __device__ __forceinline__ void a_off(const Unit& u, int tid, unsigned (&off)[2][2]) const {
#pragma unroll
        for (int i = 0; i < 2; ++i) { int R, C; pg8::stage_rc(tid * 16 + i * 8192, R, C);
#pragma unroll
            for (int h = 0; h < 2; ++h) { const int r = h * 128 + R; int tok;
                if (u.e < NE) tok = (r < u.nvalid) ? toks[u.row0 + r] : 0; else tok = u.row0 - SH_ROW0 + r;
                off[h][i] = (unsigned)(tok * D + C) * 2u; } }
    }
};
struct MoeSched2 {
    static constexpr bool RAGGED = true;
    const char* ACT; const char* E2; MoeTab tab; int G, vcu;
    __device__ __forceinline__ bool next(int i, Unit& u) const {
        const int ntr = tab.misc[0]; const int L = i * G + vcu; if (L >= 8 * (ntr + 32)) return false;
        const int t = L >> 3; u.pn = L & 7;
        if (t < ntr) { u.row0 = t * 256; u.e = tab.te[t]; u.nvalid = tab.tn[t]; } else { u.row0 = SH_ROW0 + (t - ntr) * 256; u.e = NE; u.nvalid = 256; }
        return true;
    }
    __device__ __forceinline__ const char* a_base() const { return ACT; }
    __device__ __forceinline__ const char* b_ptr(const Unit& u) const { return E2 + ((size_t)u.e * 2048 + (size_t)u.pn * 256) * (ED * 2); }
    __device__ __forceinline__ void a_off(const Unit& u, int tid, unsigned (&off)[2][2]) const {
#pragma unroll
        for (int i = 0; i < 2; ++i) { int R, C; pg8::stage_rc(tid * 16 + i * 8192, R, C);
            off[0][i] = (unsigned)((u.row0 + R) * ED + C) * 2u; off[1][i] = (unsigned)((u.row0 + 128 + R) * ED + C) * 2u; }
    }
};

#define XB_TMO      128
#define XB_XCNT(j)  (256  + 64 * (j))
#define XB_XSUB(j)  (1280 + 64 * (j))
#define XB_XGEN(j)  (2304 + 64 * (j))
#define XB_TOP      3328
#define XB_TOPGEN   3392
#define XCD_BAR_WORDS 3456
#define XB_SPIN_CAP (1u << 18)
__device__ __forceinline__ unsigned xb_ld(unsigned* p)              { return __hip_atomic_load(p, __ATOMIC_RELAXED, __HIP_MEMORY_SCOPE_AGENT); }
__device__ __forceinline__ unsigned xb_add(unsigned* p, unsigned v) { return __hip_atomic_fetch_add(p, v, __ATOMIC_RELAXED, __HIP_MEMORY_SCOPE_AGENT); }
__device__ __forceinline__ unsigned xb_xcc_id() { return (unsigned)__builtin_amdgcn_s_getreg((3 << 11) | 20) & 0xFu; }
#define XB_SPIN(cond, bar) do { unsigned _sp = 0; while (cond) { __builtin_amdgcn_s_sleep(1); \
    if ((++_sp & 255u) == 0u) { if (xb_ld(&(bar)[XB_TMO])) break; if (_sp > XB_SPIN_CAP) { atomicAdd(&(bar)[XB_TMO], 1u); break; } } } } while (0)
struct XcdBarrier { unsigned* bar; unsigned x; volatile LAS unsigned* st; };
__device__ __forceinline__ XcdBarrier xcd_barrier_post(unsigned* bar, volatile LAS unsigned* st) {
    XcdBarrier b; b.bar = bar; b.x = xb_xcc_id(); b.st = st;
    if (threadIdx.x == 0) (void)xb_add(&bar[XB_XCNT(b.x)], 1u);
    return b;
}
__device__ __forceinline__ void xcd_barrier_complete(unsigned* bar, unsigned x, unsigned& nloc, unsigned& nx) {
    const unsigned G = gridDim.x * gridDim.y * gridDim.z;
    unsigned sum, cnt, mine, sp = 0u;
    for (;;) {
        sum = 0u; cnt = 0u; mine = 0u;
#pragma unroll
        for (unsigned j = 0; j < 16; ++j) { const unsigned c = xb_ld(&bar[XB_XCNT(j)]); sum += c; cnt += (c > 0u) ? 1u : 0u; mine = (j == x) ? c : mine; }
        if (sum == G) break;
        __builtin_amdgcn_s_sleep(1);
        if ((++sp & 255u) == 0u) { if (xb_ld(&bar[XB_TMO])) break; if (sp > XB_SPIN_CAP) { atomicAdd(&bar[XB_TMO], 1u); break; } }
    }
    nloc = mine > 0u ? mine : 1u; nx = cnt > 0u ? cnt : 1u;
}
__device__ __forceinline__ void xcd_barrier(const XcdBarrier& b) {
    asm volatile("s_waitcnt vmcnt(0)" ::: "memory");
    __syncthreads();
    if (threadIdx.x == 0) {
        unsigned* bar = b.bar;
        __builtin_amdgcn_s_waitcnt(0);
        unsigned nloc = b.st[0], nx = b.st[1];
        if (nloc == 0u) { xcd_barrier_complete(bar, b.x, nloc, nx); b.st[0] = nloc; b.st[1] = nx; }
        const unsigned old = xb_add(&bar[XB_XSUB(b.x)], 1u);
        const unsigned gen = old / nloc;
        if (old + 1u == (gen + 1u) * nloc) {
            __builtin_amdgcn_fence(__ATOMIC_RELEASE, "agent");
            asm volatile("s_waitcnt vmcnt(0)" ::: "memory");
            const unsigned og = xb_add(&bar[XB_TOP], 1u);
            const unsigned tg = og / nx;
            if (og + 1u == (tg + 1u) * nx) xb_add(&bar[XB_TOPGEN], 1u);
            else XB_SPIN(xb_ld(&bar[XB_TOPGEN]) == tg, bar);
            __builtin_amdgcn_fence(__ATOMIC_ACQUIRE, "agent");
            xb_add(&bar[XB_XGEN(b.x)], 1u);
            asm volatile("s_waitcnt vmcnt(0)" ::: "memory");
        } else {
            XB_SPIN(xb_ld(&bar[XB_XGEN(b.x)]) == gen, bar);
            __builtin_amdgcn_fence(__ATOMIC_ACQUIRE, "agent");
            asm volatile("s_waitcnt vmcnt(0)" ::: "memory");
        }
    }
    __syncthreads();
}

struct Ctx {
    LAS unsigned char* lds;
    int tid, lane, wave, G, vcu, bx;
    float* out; unsigned char* ws;
};
constexpr int LDS_PTRS = 163840 - 512;
__device__ __forceinline__ const float* inp(const Ctx& F, int i) {
    const LAS unsigned* p = (const LAS unsigned*)(F.lds + LDS_PTRS) + 2 * i;
    const unsigned lo = __builtin_amdgcn_readfirstlane(p[0]), hi = __builtin_amdgcn_readfirstlane(p[1]);
    return (const float*)(const GAS float*)(((unsigned long long)hi << 32) | lo);
}
#define IN_X 0
#define IN_C 1
#define IN_RELB 2
#define IN_WADA 3
#define IN_BADA 4
#define IN_LN1 5
#define IN_WIN 6
#define IN_QNG 7
#define IN_KNG 8
#define IN_GNG 9
#define IN_PA 10
#define IN_PB 11
#define IN_WO 12
#define IN_LN2 13
#define IN_RW 14
#define IN_RB 15
#define IN_WG 16
#define IN_WU 17
#define IN_WD 18
#define IN_WGS 19
#define IN_WUS 20
#define IN_WDS 21

struct CvItem { const float* src; bf16_t* dst; int ldw, ldt; };
constexpr int CV_WIN = 32 * 304, CV_PA = 16 * 32, CV_PB = 32 * 32, CV_WO = 32 * 32, CV_EX = 768;
constexpr int CV_DENSE = CV_WIN + CV_PA + CV_PB + CV_WO, CV_ALL = CV_DENSE + 65 * CV_EX;
#ifndef CV_BG_FROM
#define CV_BG_FROM CV_DENSE
#endif
__device__ __forceinline__ void cv_kn(int q, int nbg_count, int& kb, int& nb) {
    const int super = q >> 3, sub = q & 7; kb = (super / nbg_count) * 4 + (sub >> 1); nb = (super % nbg_count) * 2 + (sub & 1);
}
__device__ __forceinline__ CvItem cv_decode(const Ctx& F, int it) {
    CvItem c; int r = it; int kb, nb;
    if (r < CV_WIN) { cv_kn(r, 152, kb, nb); c.ldw = INW; c.ldt = D; c.src = inp(F, IN_WIN) + (size_t)(64 * kb) * INW + 64 * nb; c.dst = (bf16_t*)(F.ws + WS_WINT) + (size_t)(64 * nb) * D + 64 * kb; return c; } r -= CV_WIN;
    if (r < CV_PA) { cv_kn(r, 16, kb, nb); c.ldw = D; c.ldt = 1024; c.src = inp(F, IN_PA) + (size_t)(64 * kb) * D + 64 * nb; c.dst = (bf16_t*)(F.ws + WS_PA) + (size_t)(64 * nb) * 1024 + 64 * kb; return c; } r -= CV_PA;
    if (r < CV_PB) { cv_kn(r, 16, kb, nb); c.ldw = D; c.ldt = D; c.src = inp(F, IN_PB) + (size_t)(64 * kb) * D + 64 * nb; c.dst = (bf16_t*)(F.ws + WS_PB) + (size_t)(64 * nb) * D + 64 * kb; return c; } r -= CV_PB;
    if (r < CV_WO) { cv_kn(r, 16, kb, nb); c.ldw = D; c.ldt = D; c.src = inp(F, IN_WO) + (size_t)(64 * kb) * D + 64 * nb; c.dst = (bf16_t*)(F.ws + WS_WO) + (size_t)(64 * nb) * D + 64 * kb; return c; } r -= CV_WO;
    const int e = r / CV_EX; int q = r % CV_EX;
    if (q < 512) {
        const int isup = q >> 8; q &= 255; cv_kn(q, 4, kb, nb); const int n0 = 64 * nb;
        const float* w = (e < NE) ? inp(F, isup ? IN_WU : IN_WG) + (size_t)e * D * ED : inp(F, isup ? IN_WUS : IN_WGS);
        c.ldw = ED; c.ldt = D; c.src = w + (size_t)(64 * kb) * ED + n0;
        c.dst = (bf16_t*)(F.ws + WS_E1) + (size_t)e * 1024 * D + (size_t)((n0 >> 7) * 256 + (n0 & 127) + isup * 128) * D + 64 * kb;
    } else {
        q -= 512; cv_kn(q, 16, kb, nb);
        const float* w = (e < NE) ? inp(F, IN_WD) + (size_t)e * ED * D : inp(F, IN_WDS);
        c.ldw = D; c.ldt = ED; c.src = w + (size_t)(64 * kb) * D + 64 * nb;
        c.dst = (bf16_t*)(F.ws + WS_E2) + (size_t)e * D * ED + (size_t)(64 * nb) * ED + 64 * kb;
    }
    return c;
}
__device__ __forceinline__ void cv_load(const CvItem& c, int lane, f32x4 (&v)[16]) {
    const int r4 = lane >> 4, c16 = lane & 15;
#pragma unroll
    for (int i = 0; i < 16; ++i) v[i] = *(const f32x4*)(c.src + (size_t)(4 * i + r4) * c.ldw + 4 * c16);
}
__device__ __forceinline__ void cv_store(const CvItem& c, int lane, const f32x4 (&v)[16], LAS float* scr) {
    const int r4 = lane >> 4, c16 = lane & 15;
#pragma unroll
    for (int i = 0; i < 16; ++i) { LAS float* d = scr + (4 * i + r4) * 65 + 4 * c16; d[0] = v[i].x; d[1] = v[i].y; d[2] = v[i].z; d[3] = v[i].w; }
    LDS_WAIT(); asm volatile("" ::: "memory");
    const int cc = lane & 7;
#pragma unroll
    for (int j = 0; j < 8; ++j) { const int n = (lane >> 3) + 8 * j; const LAS float* s = scr + (8 * cc) * 65 + n;
        u32x4 o; o.x = cvt_pk_bf16(s[0 * 65], s[1 * 65]); o.y = cvt_pk_bf16(s[2 * 65], s[3 * 65]); o.z = cvt_pk_bf16(s[4 * 65], s[5 * 65]); o.w = cvt_pk_bf16(s[6 * 65], s[7 * 65]);
        *(GAS u32x4*)(c.dst + (size_t)n * c.ldt + 8 * cc) = o; }
    LDS_WAIT(); asm volatile("" ::: "memory");
}
__device__ __forceinline__ void convert_items(const Ctx& F, int lo, int hi, int gw, int NGW) {
    LAS float* scr = (LAS float*)(F.lds + 16384 + F.wave * 16640);
    int it = lo + gw;
    if (it >= hi) return;
    f32x4 va[16], vb[16];
    CvItem ca = cv_decode(F, it), cb = ca;
    cv_load(ca, F.lane, va);
    for (;;) {
        int nx = it + NGW; const bool hb = nx < hi;
        if (hb) { cb = cv_decode(F, nx); cv_load(cb, F.lane, vb); }
        cv_store(ca, F.lane, va, scr);
        if (!hb) break;
        it = nx; nx = it + NGW; const bool ha = nx < hi;
        if (ha) { ca = cv_decode(F, nx); cv_load(ca, F.lane, va); }
        cv_store(cb, F.lane, vb, scr);
        if (!ha) break;
        it = nx;
    }
}
__device__ __forceinline__ void p0_prologue(const Ctx& F) {
    {
        const float* cvec = inp(F, IN_C); const float* wada = inp(F, IN_WADA); float* modp = (float*)(F.ws + WS_MODP);
        LAS float* red = (LAS float*)F.lds;
        for (int it = F.bx; it < 384; it += F.G) {
            const int cc = it % 48, ks = it / 48; const int col = cc * 256 + F.lane * 4; const int k0 = ks * 256 + F.wave * 32;
            f32x4 a = (f32x4){0.f, 0.f, 0.f, 0.f};
#pragma unroll 8
            for (int r = 0; r < 32; ++r) { const int k = k0 + r; const float s = fsilu(cvec[k]); const f32x4 w = *(const f32x4*)(wada + (size_t)k * 12288 + col); a += w * s; }
            *(LAS f32x4*)(red + F.wave * 256 + F.lane * 4) = a;
            __syncthreads();
            if (F.tid < 256) { float s = 0.f;
#pragma unroll
                for (int w = 0; w < 8; ++w) s += red[w * 256 + F.tid];
                modp[ks * 12288 + cc * 256 + F.tid] = s; }
            __syncthreads();
        }
    }
    {
        float* rc = (float*)(F.ws + WS_ROPE); float* rs = rc + S * 64;
        for (int idx = F.bx * 512 + F.tid; idx < S * 64; idx += F.G * 512) {
            const int pos = idx >> 6, i = idx & 63;
            double inv = 1.0; const double r = 0.86596432336006535;
            for (int q = 0; q < i; ++q) inv *= r;
            const double ang = (double)pos * inv;
            const double n = __builtin_rint(ang * 0.15915494309189535);
            const float red = (float)(ang - n * 6.283185307179586);
            rc[idx] = __cosf(red); rs[idx] = __sinf(red);
        }
    }
    convert_items(F, 0, CV_BG_FROM, F.vcu * 8 + F.wave, F.G * 8);
}

__device__ __forceinline__ float mod_sum(const Ctx& F, int n) {
    const float* modp = (const float*)(F.ws + WS_MODP); float s = inp(F, IN_BADA)[n];
#pragma unroll
    for (int k = 0; k < 8; ++k) s += modp[k * 12288 + n];
    return s;
}
__device__ __forceinline__ void norm_rows(const Ctx& F, const float* X, const LAS float* gs, const LAS float* sh, bf16_t* O) {
    const int gw = F.vcu * 8 + F.wave, NGW = F.G * 8;
    for (int m = gw; m < S; m += NGW) {
        const GAS f32x4* xr = (const GAS f32x4*)(X + (size_t)m * D) + F.lane;
        f32x4 v[8]; float ss = 0.f;
#pragma unroll
        for (int j = 0; j < 8; ++j) { v[j] = xr[64 * j]; ss += (v[j].x * v[j].x + v[j].y * v[j].y) + (v[j].z * v[j].z + v[j].w * v[j].w); }
#pragma unroll
        for (int o = 1; o < 64; o <<= 1) ss += __shfl_xor(ss, o);
        const float rstd = 1.0f / sqrtf(ss * (1.f / D) + 1e-6f);
        GAS u32x2* o8 = (GAS u32x2*)(O + (size_t)m * D) + F.lane;
#pragma unroll
        for (int j = 0; j < 8; ++j) { const f32x4 g = *(const LAS f32x4*)(gs + 256 * j + 4 * F.lane), s = *(const LAS f32x4*)(sh + 256 * j + 4 * F.lane);
            const f32x4 y = v[j] * rstd * g + s; u32x2 w; w.x = cvt_pk_bf16(y.x, y.y); w.y = cvt_pk_bf16(y.z, y.w); o8[64 * j] = w; }
    }
}
__device__ __forceinline__ void p1_norm1(const Ctx& F) {
    LAS float* gs = (LAS float*)F.lds; LAS float* sh = gs + D;
    for (int k = F.tid; k < D; k += 512) { const float shv = mod_sum(F, k), scv = mod_sum(F, D + k); gs[k] = inp(F, IN_LN1)[k] * (1.f + scv); sh[k] = shv; }
    float* modf = (float*)(F.ws + WS_MODF);
    for (int n = F.bx * 512 + F.tid; n < 12288; n += F.G * 512) modf[n] = mod_sum(F, n);
    __syncthreads();
    norm_rows(F, inp(F, IN_X), gs, sh, (bf16_t*)(F.ws + WS_H));
}


__device__ __forceinline__ bf16x8 pk_frag(u32x2 lo, u32x2 hi) { u32x4 v; v.x = lo.x; v.y = lo.y; v.z = hi.x; v.w = hi.y; return __builtin_bit_cast(bf16x8, v); }
__device__ __forceinline__ f32x4 mfma16(bf16x8 a, bf16x8 b, f32x4 c) { return __builtin_amdgcn_mfma_f32_16x16x32_bf16(a, b, c, 0, 0, 0); }
__device__ __forceinline__ float gamma_log2(int h) { return log2f(1.0f - exp2f(-5.0f - (float)h)); }

struct AttnU { int g, hh, d, r, nb, head; };
__device__ __forceinline__ AttnU attn_decode(int u) {
    AttnU U; U.g = u >> 9; const int rem = u & 511; U.hh = rem >> 6; const int rem2 = rem & 63;
    const int dsh = 2 * U.g; U.d = 1 << dsh; const int nblk = 64 >> dsh;
    U.r = rem2 / nblk; U.nb = rem2 % nblk; U.head = U.g * 8 + U.hh; return U;
}
__device__ __forceinline__ void attn_issue(const bf16_t* proj, const AttnU& U, int tid, int w, int lane, u32x4 (&kr)[8], u32x4 (&vr)[8], u32x4 (&qr)[4]) {
    const int rowi = tid >> 4, ch = tid & 15;
#pragma unroll
    for (int p = 0; p < 8; ++p) { const int cc = p * 32 + rowi; const int jk = (U.nb - 1) * 128 + cc;
        if (jk >= 0) { const unsigned off = (unsigned)(jk * U.d + U.r) * INW + U.head * 128 + ch * 8; kr[p] = *(const u32x4*)(proj + off + C_KA); vr[p] = *(const u32x4*)(proj + off + C_VA); }
        else { kr[p] = (u32x4){0u, 0u, 0u, 0u}; vr[p] = (u32x4){0u, 0u, 0u, 0u}; } }
    const int ql = lane & 15, g4 = lane >> 4; const unsigned tq = (unsigned)((U.nb * 128 + 16 * w + ql) * U.d + U.r);
#pragma unroll
    for (int ds = 0; ds < 4; ++ds) qr[ds] = *(const u32x4*)(proj + tq * INW + C_QA + U.head * 128 + 32 * ds + 8 * g4);
}
__device__ __forceinline__ void p3_attn(const Ctx& F) {
    const bf16_t* proj = (const bf16_t*)(F.ws + WS_PROJ);
    LAS bf16_t* KS = (LAS bf16_t*)F.lds;
    LAS bf16_t* VS = (LAS bf16_t*)(F.lds + 69632);
    LAS float* BT = (LAS float*)(F.lds + 139264);
    const int lane = F.lane, w = F.wave, ql = lane & 15, g4 = lane >> 4;
    const int rowi = F.tid >> 4, ch = F.tid & 15;
    u32x4 kr[8], vr[8], qr[4];
    int it = F.bx;
    if (it < 1536) { const AttnU U0 = attn_decode(it); attn_issue(proj, U0, F.tid, w, lane, kr, vr, qr); }
    for (; it < 1536; it += F.G) {
        const AttnU U = attn_decode(it);
        const int d = U.d, nb = U.nb;
        if (F.tid <= 128) { const int dist = F.tid * d; int b;
            if (dist < 16) b = dist; else { b = 16 + (int)floorf(log2f((float)dist * 0.0625f) * (16.0f / 7.0f)); b = b > 31 ? 31 : b; }
            BT[F.tid] = inp(F, IN_RELB)[b * 24 + U.head]; }
        {
            const float* kg = inp(F, IN_KNG) + ch * 8;
            const f32x4 kg0 = *(const f32x4*)kg, kg1 = *(const f32x4*)(kg + 4);
#pragma unroll
            for (int p = 0; p < 8; ++p) { const int cc = p * 32 + rowi;
                float f[8]; f[0] = bf2f(kr[p].x & 0xffffu); f[1] = bf2f(kr[p].x >> 16); f[2] = bf2f(kr[p].y & 0xffffu); f[3] = bf2f(kr[p].y >> 16);
                f[4] = bf2f(kr[p].z & 0xffffu); f[5] = bf2f(kr[p].z >> 16); f[6] = bf2f(kr[p].w & 0xffffu); f[7] = bf2f(kr[p].w >> 16);
                float ss = 0.f;
#pragma unroll
                for (int e = 0; e < 8; ++e) ss += f[e] * f[e];
                ss += __shfl_xor(ss, 1); ss += __shfl_xor(ss, 2); ss += __shfl_xor(ss, 4); ss += __shfl_xor(ss, 8);
                const float rstd = 1.0f / sqrtf(ss * (1.f / 128.f) + 1e-6f);
                u32x4 o; o.x = cvt_pk_bf16(f[0] * rstd * kg0.x, f[1] * rstd * kg0.y); o.y = cvt_pk_bf16(f[2] * rstd * kg0.z, f[3] * rstd * kg0.w);
                o.z = cvt_pk_bf16(f[4] * rstd * kg1.x, f[5] * rstd * kg1.y); o.w = cvt_pk_bf16(f[6] * rstd * kg1.z, f[7] * rstd * kg1.w);
                *(LAS u32x4*)(KS + cc * 136 + ch * 8) = o;
                *(LAS u32x4*)(VS + cc * 136 + ch * 8) = vr[p]; }
        }
        const int a = 16 * w + ql;
        const unsigned tq = (unsigned)((nb * 128 + a) * d + U.r);
        bf16x8 qf[4];
        {
            float f[4][8]; float ss = 0.f;
#pragma unroll
            for (int ds = 0; ds < 4; ++ds) { f[ds][0] = bf2f(qr[ds].x & 0xffffu); f[ds][1] = bf2f(qr[ds].x >> 16); f[ds][2] = bf2f(qr[ds].y & 0xffffu); f[ds][3] = bf2f(qr[ds].y >> 16);
                f[ds][4] = bf2f(qr[ds].z & 0xffffu); f[ds][5] = bf2f(qr[ds].z >> 16); f[ds][6] = bf2f(qr[ds].w & 0xffffu); f[ds][7] = bf2f(qr[ds].w >> 16);
#pragma unroll
                for (int e = 0; e < 8; ++e) ss += f[ds][e] * f[ds][e]; }
            ss += __shfl_xor(ss, 16); ss += __shfl_xor(ss, 32);
            const float rs = (1.0f / sqrtf(ss * (1.f / 128.f) + 1e-6f)) * 0.08838834764831845f;
#pragma unroll
            for (int ds = 0; ds < 4; ++ds) { const float* qg = inp(F, IN_QNG) + 32 * ds + 8 * g4; const f32x4 q0 = *(const f32x4*)qg, q1 = *(const f32x4*)(qg + 4); u32x4 o;
                o.x = cvt_pk_bf16(f[ds][0] * rs * q0.x, f[ds][1] * rs * q0.y); o.y = cvt_pk_bf16(f[ds][2] * rs * q0.z, f[ds][3] * rs * q0.w);
                o.z = cvt_pk_bf16(f[ds][4] * rs * q1.x, f[ds][5] * rs * q1.y); o.w = cvt_pk_bf16(f[ds][6] * rs * q1.z, f[ds][7] * rs * q1.w);
                qf[ds] = __builtin_bit_cast(bf16x8, o); }
        }
        __syncthreads();
        { const int nx = it + F.G; if (nx < 1536) { const AttnU Un = attn_decode(nx); attn_issue(proj, Un, F.tid, w, lane, kr, vr, qr); } }
        const int kbase = 32 * (w >> 1);
        f32x4 sc[10];
#pragma unroll
        for (int ti = 0; ti < 10; ++ti) { f32x4 acc = (f32x4){0.f, 0.f, 0.f, 0.f};
#pragma unroll
            for (int ds = 0; ds < 4; ++ds) { const bf16x8 kf = *(const LAS bf16x8*)(KS + (kbase + 16 * ti + ql) * 136 + 32 * ds + 8 * g4); acc = mfma16(kf, qf[ds], acc); }
            sc[ti] = acc; }
        float mx = -1e30f;
#pragma unroll
        for (int ti = 0; ti < 10; ++ti)
#pragma unroll
            for (int i = 0; i < 4; ++i) { const int cc = kbase + 16 * ti + 4 * g4 + i; const int delta = 128 + a - cc;
                const bool ok = (delta >= 0) && (delta <= 128) && (nb > 0 || cc >= 128);
                const float sv = ok ? sc[ti][i] + BT[ok ? delta : 0] : -1e30f; sc[ti][i] = sv; mx = fmaxf(mx, sv); }
        mx = fmaxf(mx, __shfl_xor(mx, 16)); mx = fmaxf(mx, __shfl_xor(mx, 32));
        float lsum = 0.f;
#pragma unroll
        for (int ti = 0; ti < 10; ++ti)
#pragma unroll
            for (int i = 0; i < 4; ++i) { const float p = __expf(sc[ti][i] - mx); sc[ti][i] = p; lsum += p; }
        lsum += __shfl_xor(lsum, 16); lsum += __shfl_xor(lsum, 32);
        bf16x8 pf[5];
#pragma unroll
        for (int s = 0; s < 5; ++s) { u32x4 o; o.x = cvt_pk_bf16(sc[2 * s][0], sc[2 * s][1]); o.y = cvt_pk_bf16(sc[2 * s][2], sc[2 * s][3]);
            o.z = cvt_pk_bf16(sc[2 * s + 1][0], sc[2 * s + 1][1]); o.w = cvt_pk_bf16(sc[2 * s + 1][2], sc[2 * s + 1][3]); pf[s] = __builtin_bit_cast(bf16x8, o); }
        const float rl = 1.0f / lsum;
        bf16_t* og = (bf16_t*)(F.ws + WS_OG) + ((unsigned)(U.g * S) + tq) * 1024u + U.hh * 128;
        const unsigned vbase = (unsigned)(size_t)VS + (unsigned)(((kbase + 4 * g4 + (ql >> 2)) * 136 + 4 * (ql & 3)) * 2);
#pragma unroll
        for (int dt = 0; dt < 8; ++dt) { f32x4 acc = (f32x4){0.f, 0.f, 0.f, 0.f};
            u32x2 lo[5], hi[5];
#pragma unroll
            for (int s = 0; s < 5; ++s) { TR_READ(lo[s], vbase, (32 * s * 136 + dt * 16) * 2); TR_READ(hi[s], vbase, ((32 * s + 16) * 136 + dt * 16) * 2); }
            TR_WAIT4(lo[0], hi[0], lo[1], hi[1]); TR_WAIT4(lo[2], hi[2], lo[3], hi[3]); TR_WAIT2(lo[4], hi[4]);
#pragma unroll
            for (int s = 0; s < 5; ++s) acc = mfma16(pk_frag(lo[s], hi[s]), pf[s], acc);
            u32x2 o; o.x = cvt_pk_bf16(acc[0] * rl, acc[1] * rl); o.y = cvt_pk_bf16(acc[2] * rl, acc[3] * rl);
            *(u32x2*)(og + dt * 16 + 4 * g4) = o; }
        if (g4 == 0) ((float*)(F.ws + WS_LSE))[((unsigned)(U.g * S) + tq) * 8u + U.hh] = mx + __logf(lsum);
        __syncthreads();
    }
}

__device__ __forceinline__ void rot8v(const u32x4 own, const u32x4 par, int ch, const f32x4 c0, const f32x4 c1, const f32x4 s0, const f32x4 s1, float scale, float (&o)[8]) {
    float a[8], b[8];
    a[0] = bf2f(own.x & 0xffffu); a[1] = bf2f(own.x >> 16); a[2] = bf2f(own.y & 0xffffu); a[3] = bf2f(own.y >> 16); a[4] = bf2f(own.z & 0xffffu); a[5] = bf2f(own.z >> 16); a[6] = bf2f(own.w & 0xffffu); a[7] = bf2f(own.w >> 16);
    b[0] = bf2f(par.x & 0xffffu); b[1] = bf2f(par.x >> 16); b[2] = bf2f(par.y & 0xffffu); b[3] = bf2f(par.y >> 16); b[4] = bf2f(par.z & 0xffffu); b[5] = bf2f(par.z >> 16); b[6] = bf2f(par.w & 0xffffu); b[7] = bf2f(par.w >> 16);
    const float cv[8] = {c0.x, c0.y, c0.z, c0.w, c1.x, c1.y, c1.z, c1.w}, sv[8] = {s0.x, s0.y, s0.z, s0.w, s1.x, s1.y, s1.z, s1.w};
#pragma unroll
    for (int e = 0; e < 8; ++e) o[e] = ((ch < 8) ? (a[e] * cv[e] - b[e] * sv[e]) : (b[e] * sv[e] + a[e] * cv[e])) * scale;
}

__device__ __forceinline__ void upd_unit(const Ctx& F, int u) {
    const int n = u >> 3, h = u & 7;
    const bf16_t* proj = (const bf16_t*)(F.ws + WS_PROJ);
    const float* rc = (const float*)(F.ws + WS_ROPE); const float* rsn = rc + S * 64;
    LAS bf16_t* KS = (LAS bf16_t*)F.lds;
    LAS bf16_t* VS = (LAS bf16_t*)(F.lds + 34816);
    const int lane = F.lane, w = F.wave;
    const float lg2 = gamma_log2(h);
    {
        const int rowi = F.tid >> 4, ch = F.tid & 15;
        u32x4 kown[4], kpar[4], vv[8]; f32x4 c0[4], c1[4], s0[4], s1[4];
#pragma unroll
        for (int p = 0; p < 4; ++p) { const int j = p * 32 + rowi; const unsigned tok = (unsigned)(n * 128 + j);
            const bf16_t* kp = proj + tok * INW + C_KR + h * 128;
            kown[p] = *(const u32x4*)(kp + ch * 8); kpar[p] = *(const u32x4*)(kp + (ch ^ 8) * 8);
            const float* cp = rc + tok * 64 + (ch & 7) * 8; const float* sp = rsn + tok * 64 + (ch & 7) * 8;
            c0[p] = *(const f32x4*)cp; c1[p] = *(const f32x4*)(cp + 4); s0[p] = *(const f32x4*)sp; s1[p] = *(const f32x4*)(sp + 4);
            vv[2 * p] = *(const u32x4*)(proj + tok * INW + C_VR + h * 256 + ch * 8); vv[2 * p + 1] = *(const u32x4*)(proj + tok * INW + C_VR + h * 256 + (ch + 16) * 8); }
#pragma unroll
        for (int p = 0; p < 4; ++p) { const int j = p * 32 + rowi;
            float o[8]; rot8v(kown[p], kpar[p], ch, c0[p], c1[p], s0[p], s1[p], 0.08838834764831845f, o);
            u32x4 ov; ov.x = cvt_pk_bf16(o[0], o[1]); ov.y = cvt_pk_bf16(o[2], o[3]); ov.z = cvt_pk_bf16(o[4], o[5]); ov.w = cvt_pk_bf16(o[6], o[7]);
            *(LAS u32x4*)(KS + j * 136 + ch * 8) = ov; }
#pragma unroll
        for (int p = 0; p < 4; ++p) { const int j = p * 32 + rowi; const float z = exp2f(lg2 * (float)(127 - j));
#pragma unroll
            for (int c2 = 0; c2 < 2; ++c2) { const int chv = ch + 16 * c2; const u32x4 x = vv[2 * p + c2];
                u32x4 ov; ov.x = cvt_pk_bf16(bf2f(x.x & 0xffffu) * z, bf2f(x.x >> 16) * z); ov.y = cvt_pk_bf16(bf2f(x.y & 0xffffu) * z, bf2f(x.y >> 16) * z);
                ov.z = cvt_pk_bf16(bf2f(x.z & 0xffffu) * z, bf2f(x.z >> 16) * z); ov.w = cvt_pk_bf16(bf2f(x.w & 0xffffu) * z, bf2f(x.w >> 16) * z);
                *(LAS u32x4*)(VS + j * 264 + chv * 8) = ov; } }
    }
    __syncthreads();
    const int ql = lane & 15, g4 = lane >> 4;
    const unsigned kb = (unsigned)(size_t)KS + (unsigned)(((8 * g4 + (ql >> 2)) * 136 + 4 * (ql & 3)) * 2);
    const unsigned vbw = (unsigned)(size_t)VS + (unsigned)(((8 * g4 + (ql >> 2)) * 264 + 4 * (ql & 3) + 32 * w) * 2);
    f32x4 acc[2][8];
#pragma unroll
    for (int a = 0; a < 2; ++a)
#pragma unroll
        for (int b = 0; b < 8; ++b) acc[a][b] = (f32x4){0.f, 0.f, 0.f, 0.f};
#pragma unroll
    for (int ks = 0; ks < 4; ++ks) {
        u32x2 vl[2], vh[2];
#pragma unroll
        for (int a = 0; a < 2; ++a) { TR_READ(vl[a], vbw, (32 * ks * 264 + a * 16) * 2); TR_READ(vh[a], vbw, ((32 * ks + 4) * 264 + a * 16) * 2); }
        TR_WAIT4(vl[0], vh[0], vl[1], vh[1]);
        const bf16x8 vf0 = pk_frag(vl[0], vh[0]), vf1 = pk_frag(vl[1], vh[1]);
#pragma unroll
        for (int b = 0; b < 8; b += 2) {
            u32x2 k0l, k0h, k1l, k1h;
            TR_READ(k0l, kb, (32 * ks * 136 + b * 16) * 2); TR_READ(k0h, kb, ((32 * ks + 4) * 136 + b * 16) * 2);
            TR_READ(k1l, kb, (32 * ks * 136 + (b + 1) * 16) * 2); TR_READ(k1h, kb, ((32 * ks + 4) * 136 + (b + 1) * 16) * 2);
            TR_WAIT4(k0l, k0h, k1l, k1h);
            const bf16x8 kf0 = pk_frag(k0l, k0h), kf1 = pk_frag(k1l, k1h);
            acc[0][b] = mfma16(vf0, kf0, acc[0][b]); acc[1][b] = mfma16(vf1, kf0, acc[1][b]);
            acc[0][b + 1] = mfma16(vf0, kf1, acc[0][b + 1]); acc[1][b + 1] = mfma16(vf1, kf1, acc[1][b + 1]); }
    }
    float* upd = (float*)(F.ws + WS_UPD) + (size_t)(n * 8 + h) * 32768;
#pragma unroll
    for (int a = 0; a < 2; ++a)
#pragma unroll
        for (int b = 0; b < 8; ++b)
#pragma unroll
            for (int i = 0; i < 4; ++i) upd[((2 * w + a) * 16 + 4 * g4 + i) * 128 + b * 16 + ql] = acc[a][b][i];
    __syncthreads();
}
__device__ __forceinline__ void p3_mix1(const Ctx& F) {
    p3_attn(F);
    if (DUP2_MASK & 4) { __syncthreads(); p3_attn(F); }
    for (int it = F.bx; it < 512; it += F.G) upd_unit(F, it);
    if (DUP2_MASK & 8) { __syncthreads(); for (int it = F.bx; it < 512; it += F.G) upd_unit(F, it); }
}

__device__ __forceinline__ void p4_scan(const Ctx& F) {
    const float* upd = (const float*)(F.ws + WS_UPD); unsigned* prev = (unsigned*)(F.ws + WS_PREV);
    for (int p = F.bx * 512 + F.tid; p < 131072; p += F.G * 512) {
        const int h = p >> 14;
        const float gch = exp2f(gamma_log2(h) * 128.0f);
        const int within = (p & 16383) * 2;
        float s0 = 0.f, s1 = 0.f;
#pragma unroll 8
        for (int n = 0; n < 64; ++n) { const size_t o = (size_t)(n * 8 + h) * 32768 + within;
            const f32x2 uv = *(const f32x2*)(upd + o);
            prev[o >> 1] = cvt_pk_bf16(s0, s1);
            s0 = gch * s0 + uv.x; s1 = gch * s1 + uv.y; }
    }
}

__device__ __forceinline__ void ret_unit(const Ctx& F, int u) {
    const int n = u >> 3, h = u & 7;
    const bf16_t* proj = (const bf16_t*)(F.ws + WS_PROJ);
    const float* rc = (const float*)(F.ws + WS_ROPE); const float* rsn = rc + S * 64;
    LAS bf16_t* KS = (LAS bf16_t*)F.lds;
    LAS bf16_t* VS = (LAS bf16_t*)(F.lds + 34816);
    LAS bf16_t* QS = (LAS bf16_t*)(F.lds + 102400);
    LAS float* RED = (LAS float*)(F.lds + 137216);
    LAS float* TOT = (LAS float*)(F.lds + 145408);
    const int lane = F.lane, w = F.wave;
    const float lg2 = gamma_log2(h);
    const int ql = lane & 15, g4 = lane >> 4;
    const bf16_t* prev = (const bf16_t*)(F.ws + WS_PREV) + (size_t)(n * 8 + h) * 32768;
    {
        const int rowi = F.tid >> 4, ch = F.tid & 15;
        u32x4 kown[4], kpar[4], vv[8]; f32x4 c0[4], c1[4], s0[4], s1[4];
#pragma unroll
        for (int p = 0; p < 4; ++p) { const int j = p * 32 + rowi; const unsigned tok = (unsigned)(n * 128 + j);
            const bf16_t* kp = proj + tok * INW + C_KR + h * 128;
            kown[p] = *(const u32x4*)(kp + ch * 8); kpar[p] = *(const u32x4*)(kp + (ch ^ 8) * 8);
            const float* cp = rc + tok * 64 + (ch & 7) * 8; const float* sp = rsn + tok * 64 + (ch & 7) * 8;
            c0[p] = *(const f32x4*)cp; c1[p] = *(const f32x4*)(cp + 4); s0[p] = *(const f32x4*)sp; s1[p] = *(const f32x4*)(sp + 4);
            vv[2 * p] = *(const u32x4*)(proj + tok * INW + C_VR + h * 256 + ch * 8); vv[2 * p + 1] = *(const u32x4*)(proj + tok * INW + C_VR + h * 256 + (ch + 16) * 8); }
#pragma unroll
        for (int p = 0; p < 4; ++p) { const int j = p * 32 + rowi;
            float o[8]; rot8v(kown[p], kpar[p], ch, c0[p], c1[p], s0[p], s1[p], 0.08838834764831845f, o);
            u32x4 ov; ov.x = cvt_pk_bf16(o[0], o[1]); ov.y = cvt_pk_bf16(o[2], o[3]); ov.z = cvt_pk_bf16(o[4], o[5]); ov.w = cvt_pk_bf16(o[6], o[7]);
            *(LAS u32x4*)(KS + j * 136 + ch * 8) = ov; }
#pragma unroll
        for (int p = 0; p < 4; ++p) { const int j = p * 32 + rowi;
#pragma unroll
            for (int c2 = 0; c2 < 2; ++c2) { const int chv = ch + 16 * c2; const u32x4 x = vv[2 * p + c2];
                *(LAS u32x4*)(VS + j * 264 + chv * 8) = x; } }
    }
    const int iq = 16 * w + ql; const unsigned tq = (unsigned)(n * 128 + iq);
    bf16x8 qf[4];
    {
        u32x4 qv[4]; float f[4][8];
#pragma unroll
        for (int ds = 0; ds < 4; ++ds) qv[ds] = *(const u32x4*)(proj + tq * INW + C_QR + h * 128 + 32 * ds + 8 * g4);
#pragma unroll
        for (int ds = 0; ds < 4; ++ds) { f[ds][0] = bf2f(qv[ds].x & 0xffffu); f[ds][1] = bf2f(qv[ds].x >> 16); f[ds][2] = bf2f(qv[ds].y & 0xffffu); f[ds][3] = bf2f(qv[ds].y >> 16);
            f[ds][4] = bf2f(qv[ds].z & 0xffffu); f[ds][5] = bf2f(qv[ds].z >> 16); f[ds][6] = bf2f(qv[ds].w & 0xffffu); f[ds][7] = bf2f(qv[ds].w >> 16); }
        const float xi = exp2f(lg2 * (float)(iq + 1));
#pragma unroll
        for (int ds = 0; ds < 2; ++ds) {
            const float* cp = rc + tq * 64 + 32 * ds + 8 * g4; const float* sp = rsn + tq * 64 + 32 * ds + 8 * g4;
            const f32x4 c0 = *(const f32x4*)cp, c1 = *(const f32x4*)(cp + 4), s0 = *(const f32x4*)sp, s1 = *(const f32x4*)(sp + 4);
            const float cv[8] = {c0.x, c0.y, c0.z, c0.w, c1.x, c1.y, c1.z, c1.w}, sv[8] = {s0.x, s0.y, s0.z, s0.w, s1.x, s1.y, s1.z, s1.w};
            float lo[8], hi[8];
#pragma unroll
            for (int e = 0; e < 8; ++e) { const float t1 = f[ds][e], t2 = f[ds + 2][e]; lo[e] = t1 * cv[e] - t2 * sv[e]; hi[e] = t1 * sv[e] + t2 * cv[e]; }
            u32x4 o; o.x = cvt_pk_bf16(lo[0], lo[1]); o.y = cvt_pk_bf16(lo[2], lo[3]); o.z = cvt_pk_bf16(lo[4], lo[5]); o.w = cvt_pk_bf16(lo[6], lo[7]); qf[ds] = __builtin_bit_cast(bf16x8, o);
            o.x = cvt_pk_bf16(hi[0], hi[1]); o.y = cvt_pk_bf16(hi[2], hi[3]); o.z = cvt_pk_bf16(hi[4], hi[5]); o.w = cvt_pk_bf16(hi[6], hi[7]); qf[ds + 2] = __builtin_bit_cast(bf16x8, o);
            o.x = cvt_pk_bf16(lo[0] * xi, lo[1] * xi); o.y = cvt_pk_bf16(lo[2] * xi, lo[3] * xi); o.z = cvt_pk_bf16(lo[4] * xi, lo[5] * xi); o.w = cvt_pk_bf16(lo[6] * xi, lo[7] * xi);
            *(LAS u32x4*)(QS + iq * 136 + 32 * ds + 8 * g4) = o;
            o.x = cvt_pk_bf16(hi[0] * xi, hi[1] * xi); o.y = cvt_pk_bf16(hi[2] * xi, hi[3] * xi); o.z = cvt_pk_bf16(hi[4] * xi, hi[5] * xi); o.w = cvt_pk_bf16(hi[6] * xi, hi[7] * xi);
            *(LAS u32x4*)(QS + iq * 136 + 32 * (ds + 2) + 8 * g4) = o;
        }
    }
    bf16x8 pr[2][4];
#pragma unroll
    for (int a = 0; a < 2; ++a)
#pragma unroll
        for (int ds = 0; ds < 4; ++ds) pr[a][ds] = *(const bf16x8*)(prev + ((2 * w + a) * 16 + ql) * 128 + 32 * ds + 8 * g4);
    __syncthreads();
    f32x4 sc[8];
#pragma unroll
    for (int kt = 0; kt < 8; ++kt) { f32x4 a = (f32x4){0.f, 0.f, 0.f, 0.f};
#pragma unroll
        for (int ds = 0; ds < 4; ++ds) { const bf16x8 kf = *(const LAS bf16x8*)(KS + (16 * kt + ql) * 136 + 32 * ds + 8 * g4); a = mfma16(kf, qf[ds], a); }
#pragma unroll
        for (int i = 0; i < 4; ++i) { const int j = 16 * kt + 4 * g4 + i; const int df = iq - j; a[i] = (df >= 0) ? a[i] * exp2f(lg2 * (float)df) : 0.f; }
        sc[kt] = a; }
    __syncthreads();
#pragma unroll
    for (int kt = 0; kt < 8; ++kt) { u32x2 o; o.x = cvt_pk_bf16(sc[kt][0], sc[kt][1]); o.y = cvt_pk_bf16(sc[kt][2], sc[kt][3]); *(LAS u32x2*)(KS + iq * 136 + 16 * kt + 4 * g4) = o; }
    __syncthreads();
    f32x4 acc[2][8];
#pragma unroll
    for (int a = 0; a < 2; ++a)
#pragma unroll
        for (int qt = 0; qt < 8; ++qt) acc[a][qt] = (f32x4){0.f, 0.f, 0.f, 0.f};
#pragma unroll
    for (int ds = 0; ds < 4; ++ds)
#pragma unroll
        for (int qt = 0; qt < 8; ++qt) { const bf16x8 bq = *(const LAS bf16x8*)(QS + (qt * 16 + ql) * 136 + 32 * ds + 8 * g4);
            acc[0][qt] = mfma16(pr[0][ds], bq, acc[0][qt]); acc[1][qt] = mfma16(pr[1][ds], bq, acc[1][qt]); }
    const unsigned vbw = (unsigned)(size_t)VS + (unsigned)(((8 * g4 + (ql >> 2)) * 264 + 4 * (ql & 3) + 32 * w) * 2);
#pragma unroll
    for (int s = 0; s < 4; ++s) {
        u32x2 vl[2], vh[2];
#pragma unroll
        for (int a = 0; a < 2; ++a) { TR_READ(vl[a], vbw, (32 * s * 264 + a * 16) * 2); TR_READ(vh[a], vbw, ((32 * s + 4) * 264 + a * 16) * 2); }
        TR_WAIT4(vl[0], vh[0], vl[1], vh[1]);
        const bf16x8 vf0 = pk_frag(vl[0], vh[0]), vf1 = pk_frag(vl[1], vh[1]);
#pragma unroll
        for (int qt = 0; qt < 8; ++qt) if (qt >= 2 * s) { const bf16x8 bp = *(const LAS bf16x8*)(KS + (qt * 16 + ql) * 136 + 32 * s + 8 * g4);
            acc[0][qt] = mfma16(vf0, bp, acc[0][qt]); acc[1][qt] = mfma16(vf1, bp, acc[1][qt]); }
    }
#pragma unroll
    for (int qt = 0; qt < 8; ++qt) { float s1 = 0.f, s2 = 0.f;
#pragma unroll
        for (int a = 0; a < 2; ++a)
#pragma unroll
            for (int i = 0; i < 4; ++i) { const float x = acc[a][qt][i]; s1 += x; s2 += x * x; }
        s1 += __shfl_xor(s1, 16); s1 += __shfl_xor(s1, 32); s2 += __shfl_xor(s2, 16); s2 += __shfl_xor(s2, 32);
        if (g4 == 0) *(LAS f32x2*)(RED + (w * 128 + qt * 16 + ql) * 2) = (f32x2){s1, s2}; }
    __syncthreads();
    if (F.tid < 128) { float s1 = 0.f, s2 = 0.f;
#pragma unroll
        for (int ww = 0; ww < 8; ++ww) { const f32x2 v = *(const LAS f32x2*)(RED + (ww * 128 + F.tid) * 2); s1 += v.x; s2 += v.y; }
        const float mean = s1 * (1.f / 256.f); float var = s2 * (1.f / 256.f) - mean * mean; var = var > 0.f ? var : 0.f;
        *(LAS f32x2*)(TOT + F.tid * 2) = (f32x2){mean, 1.0f / sqrtf(var + 1e-5f)}; }
    __syncthreads();
    LAS bf16_t* OT = VS;
#pragma unroll
    for (int qt = 0; qt < 8; ++qt) { const f32x2 st = *(const LAS f32x2*)(TOT + (qt * 16 + ql) * 2);
#pragma unroll
        for (int a = 0; a < 2; ++a) { u32x2 o; o.x = cvt_pk_bf16((acc[a][qt][0] - st.x) * st.y, (acc[a][qt][1] - st.x) * st.y); o.y = cvt_pk_bf16((acc[a][qt][2] - st.x) * st.y, (acc[a][qt][3] - st.x) * st.y);
            *(LAS u32x2*)(OT + (qt * 16 + ql) * 264 + (2 * w + a) * 16 + 4 * g4) = o; } }
    __syncthreads();
    const float* gng = inp(F, IN_GNG) + h * 256;
    {
        const int pc = F.tid & 31;
        const f32x4 gg0 = *(const f32x4*)(gng + pc * 8), gg1 = *(const f32x4*)(gng + pc * 8 + 4);
        u32x4 gv[8];
#pragma unroll
        for (int p = 0; p < 8; ++p) { const unsigned tk = (unsigned)(n * 128 + p * 16 + (F.tid >> 5)); gv[p] = *(const u32x4*)(proj + tk * INW + C_GR + h * 256 + pc * 8); }
#pragma unroll
        for (int p = 0; p < 8; ++p) { const int row = p * 16 + (F.tid >> 5); const unsigned tk = (unsigned)(n * 128 + row);
            const u32x4 x = *(const LAS u32x4*)(OT + row * 264 + pc * 8); u32x4 o;
            o.x = cvt_pk_bf16(bf2f(x.x & 0xffffu) * gg0.x * fsilu(bf2f(gv[p].x & 0xffffu)), bf2f(x.x >> 16) * gg0.y * fsilu(bf2f(gv[p].x >> 16)));
            o.y = cvt_pk_bf16(bf2f(x.y & 0xffffu) * gg0.z * fsilu(bf2f(gv[p].y & 0xffffu)), bf2f(x.y >> 16) * gg0.w * fsilu(bf2f(gv[p].y >> 16)));
            o.z = cvt_pk_bf16(bf2f(x.z & 0xffffu) * gg1.x * fsilu(bf2f(gv[p].z & 0xffffu)), bf2f(x.z >> 16) * gg1.y * fsilu(bf2f(gv[p].z >> 16)));
            o.w = cvt_pk_bf16(bf2f(x.w & 0xffffu) * gg1.z * fsilu(bf2f(gv[p].w & 0xffffu)), bf2f(x.w >> 16) * gg1.w * fsilu(bf2f(gv[p].w >> 16)));
            *(u32x4*)((bf16_t*)(F.ws + WS_YB) + tk * D + h * 256 + pc * 8) = o; }
    }
    __syncthreads();
}
__device__ __forceinline__ void comb_item(const Ctx& F, int it) {
    const bf16_t* og = (const bf16_t*)(F.ws + WS_OG); const float* lse = (const float*)(F.ws + WS_LSE); bf16_t* ya = (bf16_t*)(F.ws + WS_YA);
    for (int rr = 0; rr < 4; ++rr) { const size_t t = (size_t)it * 32 + F.wave * 4 + rr; const int hh = F.lane >> 3;
        const float l0 = lse[(0 * (size_t)S + t) * 8 + hh], l1 = lse[(1 * (size_t)S + t) * 8 + hh], l2 = lse[(2 * (size_t)S + t) * 8 + hh];
        const float m = fmaxf(l0, fmaxf(l1, l2)); float a0 = __expf(l0 - m), a1 = __expf(l1 - m), a2 = __expf(l2 - m); const float inv = 1.f / (a0 + a1 + a2); a0 *= inv; a1 *= inv; a2 *= inv;
#pragma unroll
        for (int c = 0; c < 2; ++c) { const size_t e = t * 1024 + F.lane * 16 + c * 8;
            const u32x4 v0 = *(const u32x4*)(og + e), v1 = *(const u32x4*)(og + (size_t)S * 1024 + e), v2 = *(const u32x4*)(og + 2 * (size_t)S * 1024 + e);
            u32x4 o;
            o.x = cvt_pk_bf16(a0 * bf2f(v0.x & 0xffffu) + a1 * bf2f(v1.x & 0xffffu) + a2 * bf2f(v2.x & 0xffffu), a0 * bf2f(v0.x >> 16) + a1 * bf2f(v1.x >> 16) + a2 * bf2f(v2.x >> 16));
            o.y = cvt_pk_bf16(a0 * bf2f(v0.y & 0xffffu) + a1 * bf2f(v1.y & 0xffffu) + a2 * bf2f(v2.y & 0xffffu), a0 * bf2f(v0.y >> 16) + a1 * bf2f(v1.y >> 16) + a2 * bf2f(v2.y >> 16));
            o.z = cvt_pk_bf16(a0 * bf2f(v0.z & 0xffffu) + a1 * bf2f(v1.z & 0xffffu) + a2 * bf2f(v2.z & 0xffffu), a0 * bf2f(v0.z >> 16) + a1 * bf2f(v1.z >> 16) + a2 * bf2f(v2.z >> 16));
            o.w = cvt_pk_bf16(a0 * bf2f(v0.w & 0xffffu) + a1 * bf2f(v1.w & 0xffffu) + a2 * bf2f(v2.w & 0xffffu), a0 * bf2f(v0.w >> 16) + a1 * bf2f(v1.w >> 16) + a2 * bf2f(v2.w >> 16));
            *(u32x4*)(ya + e) = o; } }
}
__device__ __forceinline__ void p4_scan_comb(const Ctx& F) {
    p4_scan(F);
    for (int it = F.bx; it < 256; it += F.G) comb_item(F, it);
}
__device__ __forceinline__ void p5_mix2(const Ctx& F) {
    for (int it = F.bx; it < 512; it += F.G) ret_unit(F, it);
    if (DUP2_MASK & 1) { __syncthreads(); for (int it = F.bx; it < 512; it += F.G) ret_unit(F, it); }
}

__device__ __forceinline__ void p8_router(const Ctx& F) {
    LAS float* gs = (LAS float*)F.lds; LAS float* sh = gs + D; LAS float* XS = sh + D; LAS float* WSm = XS + 32 * 260; LAS float* SC = WSm + 256 * 64; LAS float* SEL = SC + 32 * 64; LAS float* RSTD = SEL + 32 * 64;
    const float* modf = (const float*)(F.ws + WS_MODF);
    for (int k = F.tid; k < D; k += 512) { gs[k] = inp(F, IN_LN2)[k] * (1.f + modf[4 * D + k]); sh[k] = modf[3 * D + k]; }
    __syncthreads();
    const float* x1 = F.out; bf16_t* H2 = (bf16_t*)(F.ws + WS_H);
    const float* rw = inp(F, IN_RW); const float* rb = inp(F, IN_RB);
    int* e_of = (int*)(F.ws + WS_EOF); int* pos_of = e_of + 65536; float* topw = (float*)(pos_of + 65536);
    unsigned* cnt = (unsigned*)(F.ws + WS_CTL) + CW_CNT;
    for (int it = F.bx; it < 256; it += F.G) {
        const int t0 = it * 32;
#pragma unroll 1
        for (int rr = 0; rr < 4; ++rr) { const int m = t0 + F.wave * 4 + rr;
            const GAS f32x4* xr = (const GAS f32x4*)(x1 + (size_t)m * D) + F.lane;
            f32x4 v[8]; float ss = 0.f;
#pragma unroll
            for (int j = 0; j < 8; ++j) { v[j] = xr[64 * j]; ss += (v[j].x * v[j].x + v[j].y * v[j].y) + (v[j].z * v[j].z + v[j].w * v[j].w); }
#pragma unroll
            for (int o = 1; o < 64; o <<= 1) ss += __shfl_xor(ss, o);
            const float rstd = 1.0f / sqrtf(ss * (1.f / D) + 1e-6f);
            if (F.lane == 0) RSTD[F.wave * 4 + rr] = rstd;
            GAS u32x2* o8 = (GAS u32x2*)(H2 + (size_t)m * D) + F.lane;
#pragma unroll
            for (int j = 0; j < 8; ++j) { const f32x4 g = *(const LAS f32x4*)(gs + 256 * j + 4 * F.lane), s = *(const LAS f32x4*)(sh + 256 * j + 4 * F.lane);
                const f32x4 y = v[j] * rstd * g + s; u32x2 w; w.x = cvt_pk_bf16(y.x, y.y); w.y = cvt_pk_bf16(y.z, y.w); o8[64 * j] = w; } }
        __syncthreads();
        const int tok = F.tid >> 4, eq = F.tid & 15;
        f32x16 ac0, ac1;
#pragma unroll
        for (int i = 0; i < 16; ++i) { ac0[i] = 0.f; ac1[i] = 0.f; }
#pragma unroll 1
        for (int kc = 0; kc < 8; ++kc) {
#pragma unroll
            for (int q = 0; q < 4; ++q) { const int idx = F.tid + 512 * q; const int row = idx >> 6, c4 = (idx & 63) * 4; const int k = kc * 256 + c4;
                const f32x4 xv = *(const f32x4*)(x1 + (size_t)(t0 + row) * D + k); const float rstd = RSTD[row];
                const f32x4 g = *(const LAS f32x4*)(gs + k), s = *(const LAS f32x4*)(sh + k);
                *(LAS f32x4*)(XS + row * 260 + c4) = xv * rstd * g + s; }
#pragma unroll
            for (int q = 0; q < 8; ++q) { const int idx = F.tid + 512 * q; const int kr = idx >> 4, c4 = (idx & 15) * 4;
                *(LAS f32x4*)(WSm + kr * 64 + c4) = *(const f32x4*)(rw + (size_t)(kc * 256 + kr) * 64 + c4); }
            __syncthreads();
            { const int i31 = F.lane & 31, kh = F.lane >> 5;
#pragma unroll 4
              for (int kp = 0; kp < 16; ++kp) { const int k = 32 * F.wave + 2 * kp + kh;
                  const float av = XS[i31 * 260 + k]; const float b0 = WSm[k * 64 + i31], b1 = WSm[k * 64 + 32 + i31];
                  ac0 = __builtin_amdgcn_mfma_f32_32x32x2f32(av, b0, ac0, 0, 0, 0); ac1 = __builtin_amdgcn_mfma_f32_32x32x2f32(av, b1, ac1, 0, 0, 0); } }
            __syncthreads();
        }
        { LAS float* RED = WSm + F.wave * 2048; const int i31 = F.lane & 31, kh = F.lane >> 5;
#pragma unroll
          for (int rg = 0; rg < 16; ++rg) { const int row = (rg & 3) + 8 * (rg >> 2) + 4 * kh; RED[row * 64 + i31] = ac0[rg]; RED[row * 64 + 32 + i31] = ac1[rg]; } }
        __syncthreads();
        f32x4 lg = (f32x4){0.f, 0.f, 0.f, 0.f};
#pragma unroll
        for (int w = 0; w < 8; ++w) lg += *(const LAS f32x4*)(WSm + w * 2048 + tok * 64 + eq * 4);
#pragma unroll
        for (int i = 0; i < 4; ++i) { const float sc = fsigm(lg[i]); SC[tok * 64 + eq * 4 + i] = sc; SEL[tok * 64 + eq * 4 + i] = sc + rb[eq * 4 + i]; }
        __syncthreads();
        if (F.tid < 32) {
            LAS float* sel = SEL + F.tid * 64; const LAS float* scp = SC + F.tid * 64;
            float gsc[8];
#pragma unroll
            for (int g = 0; g < 8; ++g) { float m1 = -3e38f, m2 = -3e38f;
#pragma unroll
                for (int j = 0; j < 8; ++j) { const float v = sel[g * 8 + j]; if (v > m1) { m2 = m1; m1 = v; } else if (v > m2) m2 = v; }
                gsc[g] = m1 + m2; }
            unsigned gmask = 0u;
#pragma unroll
            for (int r = 0; r < 4; ++r) { float best = -3e38f; int bi = 0;
#pragma unroll
                for (int g = 0; g < 8; ++g) { const bool take = !((gmask >> g) & 1u) && gsc[g] > best; best = take ? gsc[g] : best; bi = take ? g : bi; }
                gmask |= 1u << bi; }
            int idx[8]; float wv[8]; float wsum = 0.f;
#pragma unroll
            for (int r = 0; r < 8; ++r) { float best = -3e38f; int bi = 0;
                for (int e = 0; e < 64; ++e) { const float v = sel[e]; const bool take = ((gmask >> (e >> 3)) & 1u) && v > best; best = take ? v : best; bi = take ? e : bi; }
                sel[bi] = -3e38f; idx[r] = bi; wv[r] = scp[bi]; wsum += wv[r]; }
            const float sc = 2.5f / wsum; const int tk = t0 + F.tid;
#pragma unroll
            for (int r = 0; r < 8; ++r) { const unsigned pos = __hip_atomic_fetch_add(cnt + idx[r], 1u, __ATOMIC_RELAXED, __HIP_MEMORY_SCOPE_AGENT);
                e_of[tk * 8 + r] = idx[r]; pos_of[tk * 8 + r] = (int)pos; topw[tk * 8 + r] = wv[r] * sc; }
        }
        __syncthreads();
    }
}

__device__ __forceinline__ void build_moe_tab(const Ctx& F) {
    MoeTab tab = moe_tab(F.lds);
    LAS int* padstart = tab.misc + 8;
    if (F.tid < 64) {
        unsigned* cnt = (unsigned*)(F.ws + WS_CTL) + CW_CNT;
        const int c = (int)__hip_atomic_load(cnt + F.tid, __ATOMIC_RELAXED, __HIP_MEMORY_SCOPE_AGENT);
        const int nt = (c + 255) >> 8; int pre = nt;
#pragma unroll
        for (int o = 1; o < 64; o <<= 1) { const int v = __shfl_up(pre, o); if (F.tid >= o) pre += v; }
        const int excl = pre - nt;
        padstart[F.tid] = excl * 256;
        for (int r = 0; r < nt; ++r) { tab.te[excl + r] = F.tid; const int left = c - r * 256; tab.tn[excl + r] = left < 256 ? left : 256; }
        if (F.tid == 63) tab.misc[0] = pre;
    }
    __syncthreads();
}
__device__ __forceinline__ void p9_dispatch(const Ctx& F) {
    build_moe_tab(F);
    const LAS int* padstart = moe_tab(F.lds).misc + 8;
    const int* e_of = (const int*)(F.ws + WS_EOF); const int* pos_of = e_of + 65536; const float* topw = (const float*)(pos_of + 65536); int* inv = (int*)(topw + 65536);
    int* toks = (int*)(F.ws + WS_TOKS); float* wsorted = (float*)(toks + SH_ROW0);
    for (int i = F.bx * 512 + F.tid; i < 65536; i += F.G * 512) { const int e = e_of[i]; const int dest = padstart[e] + pos_of[i]; toks[dest] = i >> 3; wsorted[dest] = topw[i]; inv[i] = dest; }
}
__device__ __forceinline__ void p12_combine(const Ctx& F) {
    const bf16_t* Y = (const bf16_t*)(F.ws + WS_Y); const int* inv = (const int*)(F.ws + WS_EOF) + 3 * 65536; const float* g2 = (const float*)(F.ws + WS_MODF) + 5 * D;
    const int gw = F.vcu * 8 + F.wave, NGW = F.G * 8;
    for (int m = gw; m < S; m += NGW) {
        int rows[9];
#pragma unroll
        for (int s = 0; s < 8; ++s) rows[s] = inv[m * 8 + s];
        rows[8] = SH_ROW0 + m;
#pragma unroll
        for (int c = 0; c < 4; ++c) { const int col = c * 512 + F.lane * 8;
            float a[8] = {0.f, 0.f, 0.f, 0.f, 0.f, 0.f, 0.f, 0.f};
#pragma unroll
            for (int s = 0; s < 9; ++s) { const u32x4 v = *(const u32x4*)(Y + (size_t)rows[s] * D + col);
                a[0] += bf2f(v.x & 0xffffu); a[1] += bf2f(v.x >> 16); a[2] += bf2f(v.y & 0xffffu); a[3] += bf2f(v.y >> 16); a[4] += bf2f(v.z & 0xffffu); a[5] += bf2f(v.z >> 16); a[6] += bf2f(v.w & 0xffffu); a[7] += bf2f(v.w >> 16); }
            float* op = F.out + (size_t)m * D + col; const f32x4 x0 = *(const f32x4*)op, x1 = *(const f32x4*)(op + 4); const f32x4 ga = *(const f32x4*)(g2 + col), gb = *(const f32x4*)(g2 + col + 4);
            *(f32x4*)op = x0 + ga * (f32x4){a[0], a[1], a[2], a[3]}; *(f32x4*)(op + 4) = x1 + gb * (f32x4){a[4], a[5], a[6], a[7]}; }
    }
}


__device__ __forceinline__ void ph2_proj(const Ctx& F) {
    pg8::DenseSched Sd; Sd.init(F.ws + WS_H, D, F.ws + WS_WINT, S, INW, D, F.G, F.bx);
    EpiBf16 E{(bf16_t*)(F.ws + WS_PROJ), INW, 0};
    const int nun = (Sd.nwg - F.bx + F.G - 1) / F.G;
    const int slot = nun > 0 ? ((F.bx >> 3) + (F.bx & 7)) % nun : 0;
    Sd.i_lo = 0; Sd.i_hi = slot;
    pg8::gemm_phase<EpiBf16, pg8::DenseSched, true>(F.lds, D, Sd, E);
    __syncthreads();
    convert_items(F, CV_BG_FROM, CV_ALL, F.vcu * 8 + F.wave, F.G * 8);
    __syncthreads();
    Sd.i_lo = slot; Sd.i_hi = nun;
    pg8::gemm_phase<EpiBf16, pg8::DenseSched, true>(F.lds, D, Sd, E);
    if (DUP2_MASK & 48) { __syncthreads(); EpiBf16 E2{(bf16_t*)(F.ws + WS_PROJ), INW, (DUP2_MASK & 32) ? 1 : 0}; Sd.i_lo = 0; Sd.i_hi = nun; pg8::gemm_phase<EpiBf16, pg8::DenseSched, true>(F.lds, D, Sd, E2); }
}
__device__ __forceinline__ void ph6a_merge(const Ctx& F) {
    pg8::DenseSched Sd; Sd.init(F.ws + WS_YA, 1024, F.ws + WS_PA, S, D, 1024, F.G, F.bx);
    EpiGate<false> E{(bf16_t*)(F.ws + WS_MERGED), D, (const bf16_t*)(F.ws + WS_PROJ) + C_GA, INW};
    pg8::gemm_phase<EpiGate<false>, pg8::DenseSched, true>(F.lds, 1024, Sd, E);
}
__device__ __forceinline__ void ph6_merge(const Ctx& F) {
    pg8::DenseSched Sd; Sd.init(F.ws + WS_YB, D, F.ws + WS_PB, S, D, D, F.G, F.bx);
    EpiGate<true> E{(bf16_t*)(F.ws + WS_MERGED), D, (const bf16_t*)(F.ws + WS_PROJ) + C_GB, INW};
    pg8::gemm_phase<EpiGate<true>, pg8::DenseSched, true>(F.lds, D, Sd, E);
}
__device__ __forceinline__ void p5_mix2_a(const Ctx& F) { p5_mix2(F); __syncthreads(); ph6a_merge(F); }
__device__ __forceinline__ void ph7_wo(const Ctx& F) {
    pg8::DenseSched Sd; Sd.init(F.ws + WS_MERGED, D, F.ws + WS_WO, S, D, D, F.G, F.bx);
    EpiResid E{inp(F, IN_X), F.out, D, (const float*)(F.ws + WS_MODF) + 2 * D};
    pg8::gemm_phase<EpiResid, pg8::DenseSched, true>(F.lds, D, Sd, E);
}
__device__ __forceinline__ void ph10_gateup(const Ctx& F) {
    build_moe_tab(F);
    MoeSched1 S1{(const char*)(F.ws + WS_H), (const char*)(F.ws + WS_E1), (const int*)(F.ws + WS_TOKS), moe_tab(F.lds), F.G, F.vcu};
    EpiGateUp E{(bf16_t*)(F.ws + WS_ACT)};
    pg8::gemm_phase<EpiGateUp, MoeSched1, true>(F.lds, D, S1, E);
}
__device__ __forceinline__ void ph11_down(const Ctx& F) {
    build_moe_tab(F);
    MoeSched2 S2{(const char*)(F.ws + WS_ACT), (const char*)(F.ws + WS_E2), moe_tab(F.lds), F.G, F.vcu};
    EpiDown E{(bf16_t*)(F.ws + WS_Y), (const float*)(F.ws + WS_TOKS) + SH_ROW0};
    pg8::gemm_phase<EpiDown, MoeSched2, true>(F.lds, ED, S2, E);
}

struct Args { const float* in[22]; float* out; unsigned char* ws; int ph_lo, ph_hi; };
__global__ void __launch_bounds__(512, 2) fwd(Args args) {
    extern __shared__ __attribute__((aligned(16))) unsigned char lds_raw[];
    Ctx F;
    F.lds = (LAS unsigned char*)lds_raw;
    F.tid = threadIdx.x; F.lane = F.tid & 63; F.wave = __builtin_amdgcn_readfirstlane(F.tid >> 6);
    F.G = gridDim.x; F.bx = blockIdx.x; F.vcu = (F.G % 8 == 0) ? (F.bx % 8) * (F.G / 8) + F.bx / 8 : F.bx;
    F.out = args.out; F.ws = args.ws;
    if (F.tid == 0) {
#pragma unroll
        for (int i = 0; i < 22; ++i) ((LAS unsigned long long*)(F.lds + LDS_PTRS))[i] = (unsigned long long)args.in[i];
    }
    volatile LAS unsigned* MISC = (volatile LAS unsigned*)(F.lds + LDS_MISC);
    if (F.tid < 64) MISC[F.tid] = 0u;
    __syncthreads();
    unsigned* ctl = (unsigned*)(F.ws + WS_CTL);
    XcdBarrier bar; bar.bar = ctl + CW_BAR; bar.x = 0; bar.st = nullptr;
    if (!MK_PER_PHASE) bar = xcd_barrier_post(ctl + CW_BAR, MISC + 8);
    const int lo = args.ph_lo, hi = args.ph_hi;
#ifndef PHASE_MASK
#define PHASE_MASK 0x1fff
#endif
#define IN(k) (((PHASE_MASK >> (k)) & 1) && lo <= (k) && (k) < hi)
#define SEAM(k) do { if (IN(k) && IN((k) + 1)) xcd_barrier(bar); } while (0)

#ifndef DUP_MASK
#define DUP_MASK 0
#endif
#define RUN(k, fn) do { if (IN(k)) { fn(F); if ((DUP_MASK >> (k)) & 1) { xcd_barrier(bar); fn(F); } } SEAM(k); } while (0)
    RUN(0, p0_prologue);
    RUN(1, p1_norm1);
    RUN(2, ph2_proj);
    RUN(3, p3_mix1);
    RUN(4, p4_scan_comb);
    RUN(5, p5_mix2_a);
    RUN(6, ph6_merge);
    RUN(7, ph7_wo);
    RUN(8, p8_router);
    RUN(9, p9_dispatch);
    RUN(10, ph10_gateup);
    RUN(11, ph11_down);
    RUN(12, p12_combine);
#undef RUN
#undef IN
#undef SEAM
}

extern "C" void kernel_launch(void* const* d_in, const int* in_sizes, int n_in, void* d_out, int out_size, void* d_ws, size_t ws_size, hipStream_t stream) {
    static int grid = 0;
    if (grid == 0) {
        if (n_in != 22 || out_size != S * D || ws_size < WS_END) { fprintf(stderr, "kernel_launch: unexpected shapes / workspace (n_in %d out %d ws %zu need %zu)\n", n_in, out_size, ws_size, (size_t)WS_END); grid = -1; return; }
        int dev = 0, cus = 0, per_cu = 0;
        if (hipGetDevice(&dev) != hipSuccess || hipDeviceGetAttribute(&cus, hipDeviceAttributeMultiprocessorCount, dev) != hipSuccess) { grid = -1; return; }
        if (hipFuncSetAttribute((const void*)fwd, hipFuncAttributeMaxDynamicSharedMemorySize, LDS_BYTES) != hipSuccess) { fprintf(stderr, "kernel_launch: hipFuncSetAttribute failed\n"); grid = -1; return; }
        if (hipOccupancyMaxActiveBlocksPerMultiprocessor(&per_cu, (const void*)fwd, 512, LDS_BYTES) != hipSuccess || per_cu < 1) fprintf(stderr, "kernel_launch: occupancy query says %d\n", per_cu);
        (void)hipGetLastError();
        grid = cus;
    }
    if (grid < 0) return;
    (void)hipMemsetAsync((char*)d_ws + WS_CTL, 0, CTL_ZERO_BYTES, stream);
    Args a{};
    for (int i = 0; i < 22; ++i) a.in[i] = (const float*)d_in[i];
    a.out = (float*)d_out; a.ws = (unsigned char*)d_ws;
#if MK_PER_PHASE
    for (int p = 0; p < NPH; ++p) { a.ph_lo = p; a.ph_hi = p + 1; hipLaunchKernelGGL(fwd, dim3(grid), dim3(512), LDS_BYTES, stream, a); }
#else
    a.ph_lo = 0; a.ph_hi = NPH; hipLaunchKernelGGL(fwd, dim3(grid), dim3(512), LDS_BYTES, stream, a);
#endif
}
```

```cpp
#include <hip/hip_runtime.h>
#include <cstdio>
#include <cstdint>

#define LAS __attribute__((address_space(3)))
#define GAS __attribute__((address_space(1)))
typedef unsigned short bf16_t;
typedef short bf16x8 __attribute__((ext_vector_type(8)));
typedef short bf16x4 __attribute__((ext_vector_type(4)));
typedef float f32x4 __attribute__((ext_vector_type(4)));
typedef float f32x2 __attribute__((ext_vector_type(2)));
typedef float f32x16 __attribute__((ext_vector_type(16)));
typedef unsigned u32x4 __attribute__((ext_vector_type(4)));
typedef unsigned u32x2 __attribute__((ext_vector_type(2)));
typedef GAS unsigned gu32;

#ifndef DUP2_MASK
#define DUP2_MASK 0
#endif
#ifndef MK_PER_PHASE
#define MK_PER_PHASE 0
#endif

constexpr int S = 8192, D = 2048, INW = 19456;
constexpr int C_QA = 0, C_KA = 3072, C_VA = 6144, C_QR = 9216, C_KR = 10240, C_VR = 11264, C_GR = 13312, C_GA = 15360, C_GB = 17408;
constexpr int NE = 64, ED = 512, TOPK = 8;
constexpr int MAXT_R = 320;
constexpr int SH_ROW0 = MAXT_R * 256;
constexpr int NROWS_Y = SH_ROW0 + S;
constexpr int NPH = 13;

constexpr size_t MiB = 1u << 20;
constexpr size_t WS_CTL = 0, CTL_ZERO_BYTES = 1 * MiB;
constexpr size_t WS_MODP = 1 * MiB;
constexpr size_t WS_MODF = 1 * MiB + 512 * 1024;
constexpr size_t WS_LSE = 2 * MiB;
constexpr size_t WS_ROPE = 3 * MiB;
constexpr size_t WS_EOF = 7 * MiB;
constexpr size_t WS_TOKS = 8 * MiB;
constexpr size_t WS_PA = 10 * MiB, WS_PB = 14 * MiB, WS_WO = 22 * MiB;
constexpr size_t WS_H = 32 * MiB;
constexpr size_t WS_E1 = 64 * MiB;
constexpr size_t WS_E2 = 324 * MiB;
constexpr size_t WS_PREV = 454 * MiB;
constexpr size_t WS_YB = 486 * MiB;
constexpr size_t WS_MERGED = 518 * MiB;
constexpr size_t WS_R1 = 550 * MiB;
constexpr size_t WS_OG = WS_R1, WS_YA = WS_R1 + 48 * MiB, WS_UPD = WS_R1 + 64 * MiB, WS_ACT = WS_R1;
constexpr size_t WS_R2 = 678 * MiB;
constexpr size_t WS_WINT = WS_R2, WS_PROJ = WS_R2 + 76 * MiB, WS_Y = WS_R2;
constexpr size_t WS_END = 1058 * MiB;
constexpr int CW_TMO = 0, CW_CODE = 1, CW_BAR = 4096, CW_CNT = 8192;

constexpr int RING_BYTES = 131072;
constexpr int LDS_TAB = 131072;
constexpr int LDS_MISC = 163840 - 256;
constexpr int LDS_BYTES = 163840;

__device__ __forceinline__ float bf2f(unsigned b) { return __uint_as_float(b << 16); }
__device__ __forceinline__ unsigned cvt_pk_bf16(float lo, float hi) { unsigned r; asm("v_cvt_pk_bf16_f32 %0, %1, %2" : "=v"(r) : "v"(lo), "v"(hi)); return r; }
__device__ __forceinline__ float fsilu(float v) { return v / (1.f + __expf(-v)); }
__device__ __forceinline__ float fsigm(float v) { return 1.f / (1.f + __expf(-v)); }
#define TR_READ(dst, base, OFF) asm volatile("ds_read_b64_tr_b16 %0, %1 offset:%2" : "=&v"(dst) : "v"(base), "i"(OFF) : "memory")
#define TR_WAIT2(a, b) asm volatile("s_waitcnt lgkmcnt(0)" : "+v"(a), "+v"(b) :: "memory")
#define TR_WAIT4(a, b, c, d) asm volatile("s_waitcnt lgkmcnt(0)" : "+v"(a), "+v"(b), "+v"(c), "+v"(d) :: "memory")
typedef int i32x8 __attribute__((ext_vector_type(8)));
__device__ __forceinline__ unsigned cvt4_fp8(float a, float b, float c, float d) {
    a = fminf(fmaxf(a, -448.f), 448.f); b = fminf(fmaxf(b, -448.f), 448.f); c = fminf(fmaxf(c, -448.f), 448.f); d = fminf(fmaxf(d, -448.f), 448.f);
    int r = __builtin_amdgcn_cvt_pk_fp8_f32(a, b, 0, false); r = __builtin_amdgcn_cvt_pk_fp8_f32(c, d, r, true); return (unsigned)r;
}
__device__ __forceinline__ i32x8 ld32(const LAS unsigned char* p) { const u32x4 a = *(const LAS u32x4*)p, b = *(const LAS u32x4*)(p + 16); i32x8 r; r[0] = (int)a.x; r[1] = (int)a.y; r[2] = (int)a.z; r[3] = (int)a.w; r[4] = (int)b.x; r[5] = (int)b.y; r[6] = (int)b.z; r[7] = (int)b.w; return r; }
__device__ __forceinline__ i32x8 cat8(bf16x8 lo, bf16x8 hi) { const u32x4 a = __builtin_bit_cast(u32x4, lo), b = __builtin_bit_cast(u32x4, hi); i32x8 r; r[0] = (int)a.x; r[1] = (int)a.y; r[2] = (int)a.z; r[3] = (int)a.w; r[4] = (int)b.x; r[5] = (int)b.y; r[6] = (int)b.z; r[7] = (int)b.w; return r; }
constexpr float FP8_WS1 = 32.f, FP8_WS2 = 16.f, FP8_AS = 4.f;
#define LDS_WAIT() asm volatile("s_waitcnt lgkmcnt(0)" ::: "memory")
#define VM_WAIT() asm volatile("s_waitcnt vmcnt(0)" ::: "memory")

namespace pg8 {
constexpr int BM = 256, BK = 64, HALF = 128, HTB = HALF * BK * 2, STAGE_BYTES = 8 * HTB, NXCD = 8, WGM = 8;
__host__ __device__ __forceinline__ int lds_byte(int r, int c) { const int st = (r >> 4) * 2 + (c >> 5), rr = r & 15, cc = c & 31, ob = rr * 64 + cc * 2; return st * 1024 + (ob ^ (((ob >> 9) & 1) << 5)); }
__host__ __device__ __forceinline__ void stage_rc(int b, int& R, int& C) { const int st = b / 1024, sb = b % 1024, swz = sb ^ (((sb >> 9) & 1) << 5); R = (st >> 1) * 16 + swz / 64; C = (st & 1) * 32 + (swz % 64) / 2; }
__host__ __device__ __forceinline__ int perm32(int rho) { const int n = rho >> 4, i = rho & 15; return 8 * (i >> 2) + 4 * n + (i & 3); }

struct Unit { int row0, pn, e, nvalid; };

struct DenseSched {
    static constexpr bool RAGGED = false;
    const char* A; const char* Bt; int lda, K; int nM, nN, nwg, G, c, i_lo, i_hi;
    __device__ __forceinline__ void init(const void* A_, int lda_, const void* Bt_, int M, int N, int K_, int G_, int c_) { A = (const char*)A_; Bt = (const char*)Bt_; lda = lda_; K = K_; nM = M / BM; nN = N / BM; nwg = nM * nN; G = G_; c = c_; i_lo = 0; i_hi = 0x7fffffff; }
    __device__ __forceinline__ bool next(int i, Unit& u) const {
        if (i_lo + i >= i_hi) return false;
        const long L = (long)(i_lo + i) * G + c; if (L >= nwg) return false;
        int wgid = (int)L; { const int q = nwg / NXCD, r = nwg % NXCD, xcd = wgid % NXCD, off = wgid / NXCD; wgid = (xcd < r ? xcd * (q + 1) : r * (q + 1) + (xcd - r) * q) + off; }
        const int nig = WGM * nN, gid = wgid / nig, fm = gid * WGM, gsz = (nM - fm) < WGM ? (nM - fm) : WGM;
        u.row0 = (fm + ((wgid % nig) % gsz)) * BM; u.pn = (wgid % nig) / gsz; u.e = 0; u.nvalid = 256; return true;
    }
    __device__ __forceinline__ const char* a_base() const { return A; }
    __device__ __forceinline__ const char* b_ptr(const Unit& u) const { return Bt + (size_t)u.pn * BM * K * 2; }
    __device__ __forceinline__ void a_off(const Unit& u, int tid, unsigned (&off)[2][2]) const {
#pragma unroll
        for (int i = 0; i < 2; ++i) { int R, C; stage_rc(tid * 16 + i * 8192, R, C);
            off[0][i] = (unsigned)((u.row0 + R) * lda + C) * 2u; off[1][i] = (unsigned)((u.row0 + HALF + R) * lda + C) * 2u; }
    }
};

template <class Epi, class Sched, bool ALIGN_EPI, bool FP8 = false>
__device__ __forceinline__ void gemm_phase(LAS unsigned char* lds, const int K, const Sched& S, const Epi& E) {
    const int tid = threadIdx.x, wid = __builtin_amdgcn_readfirstlane(tid >> 6), lane = tid & 63, wr = wid >> 2, wc = wid & 3, fr = lane & 15, fq = lane >> 4;
    const int nt = FP8 ? K / 128 : K / BK;
    const int pitch = FP8 ? K : 2 * K;
    unsigned voffB[2];
#pragma unroll
    for (int i = 0; i < 2; ++i) { int R, C; stage_rc(tid * 16 + i * 8192, R, C); const int Rb = Epi::PERM ? ((R & ~31) + perm32(R & 31)) : R; voffB[i] = (unsigned)(Rb * pitch + 2 * C); }
    const size_t kstep = (size_t)(BK * 2);
    const size_t hstepB = (size_t)HALF * pitch;
    const unsigned ldsw = (unsigned)wid * 1024u;
    const int aoff = lds_byte(wr * 64 + fr, FP8 ? fq * 16 : fq * 8), boff = lds_byte(wc * 32 + fr, FP8 ? fq * 16 : fq * 8);
#define PG8_SA(b, h) (((b) * 2 + (h)) * HTB)
#define PG8_SB(b, h) ((4 + (b) * 2 + (h)) * HTB)
#define PG8_STAGE(bufoff, gbase, voff) do { _Pragma("unroll") for (int _i = 0; _i < 2; ++_i) \
        __builtin_amdgcn_global_load_lds((const unsigned*)((const char*)(gbase) + (voff)[_i]), (LAS unsigned*)(lds + (bufoff) + ldsw + _i * 8192), 16, 0, 0); } while (0)
#define PG8_LDA(dst, b, h) do { if constexpr (FP8) { _Pragma("unroll") for (int m = 0; m < 4; ++m) dst##8[m] = ld32(lds + PG8_SA(b, h) + aoff + m * 2048); } \
        else { _Pragma("unroll") for (int m = 0; m < 4; ++m) _Pragma("unroll") for (int k = 0; k < 2; ++k) dst[m][k] = *(const LAS bf16x8*)(lds + PG8_SA(b, h) + aoff + m * 2048 + k * 1024); } } while (0)
#define PG8_LDB(dst, b, h) do { if constexpr (FP8) { _Pragma("unroll") for (int n = 0; n < 2; ++n) dst##8[n] = ld32(lds + PG8_SB(b, h) + boff + n * 2048); } \
        else { _Pragma("unroll") for (int n = 0; n < 2; ++n) _Pragma("unroll") for (int k = 0; k < 2; ++k) dst[n][k] = *(const LAS bf16x8*)(lds + PG8_SB(b, h) + boff + n * 2048 + k * 1024); } } while (0)
#define PG8_MMA(ai, bj, At, Bt) do { __builtin_amdgcn_s_setprio(1); if constexpr (FP8) { _Pragma("unroll") for (int m = 0; m < 4; ++m) _Pragma("unroll") for (int n = 0; n < 2; ++n) \
        asm volatile("v_mfma_scale_f32_16x16x128_f8f6f4 %0, %1, %2, %0, %3, %3 op_sel_hi:[0,0,0]" : "+v"(acc[ai][bj][m][n]) : "v"(Bt##8[n]), "v"(At##8[m]), "v"(fp8_one)); } \
      else { _Pragma("unroll") for (int m = 0; m < 4; ++m) _Pragma("unroll") for (int n = 0; n < 2; ++n) _Pragma("unroll") for (int k = 0; k < 2; ++k) \
        acc[ai][bj][m][n] = __builtin_amdgcn_mfma_f32_16x16x32_bf16(Bt[n][k], At[m][k], acc[ai][bj][m][n], 0, 0, 0); } __builtin_amdgcn_s_setprio(0); } while (0)
#define PG8_WAIT_V(n) asm volatile("s_waitcnt vmcnt(" #n ")" ::: "memory")
#define PG8_WAIT_L(n) asm volatile("s_waitcnt lgkmcnt(" #n ")" ::: "memory")
#define PG8_BAR __builtin_amdgcn_s_barrier()
#define PG8_SCHED __builtin_amdgcn_sched_barrier(0)
    Unit cur, nxt; int ui = 0;
    if (!S.next(0, cur)) return;
    f32x4 acc[2][2][4][2];
#pragma unroll
    for (int a = 0; a < 2; ++a)
#pragma unroll
        for (int b = 0; b < 2; ++b)
#pragma unroll
            for (int m = 0; m < 4; ++m)
#pragma unroll
                for (int n = 0; n < 2; ++n) acc[a][b][m][n] = (f32x4){0.f, 0.f, 0.f, 0.f};
    bf16x8 At[4][2], B0[2][2], B1[2][2];
    i32x8 At8[4], B08[2], B18[2];
    const int fp8_one = 0x7f7f7f7f;
    unsigned coff[2][2], noff[2][2];
    S.a_off(cur, tid, coff);
    const char* const Ab = S.a_base();
    const char* cB = S.b_ptr(cur);
    PG8_STAGE(PG8_SB(0, 0), cB, voffB); PG8_STAGE(PG8_SB(0, 1), cB + hstepB, voffB); PG8_STAGE(PG8_SA(0, 0), Ab, coff[0]); PG8_STAGE(PG8_SA(0, 1), Ab, coff[1]);
    if (wr == 1) PG8_BAR;
    PG8_WAIT_V(2); PG8_BAR;
    PG8_STAGE(PG8_SB(1, 0), cB + kstep, voffB); PG8_STAGE(PG8_SA(1, 0), Ab + kstep, coff[0]); PG8_STAGE(PG8_SB(1, 1), cB + hstepB + kstep, voffB);
    PG8_WAIT_V(6); PG8_BAR;
    for (;;) {
        const bool has_next = S.next(ui + 1, nxt);
        const char* nB = has_next ? S.b_ptr(nxt) : cB;
        for (int t = 0; t < nt; t += 2) {
            const bool last = (t == nt - 2);
            const char* a1 = Ab + (size_t)(t + 1) * kstep;
            const char* a2 = last ? Ab : Ab + (size_t)(t + 2) * kstep; const char* b2 = last ? nB : cB + (size_t)(t + 2) * kstep;
            const char* a3 = a2 + kstep; const char* b3 = b2 + kstep;
            if (last && has_next) S.a_off(nxt, tid, noff);
            PG8_LDB(B0, 0, 0); PG8_LDB(B1, 0, 1); PG8_SCHED; PG8_LDA(At, 0, 0); PG8_STAGE(PG8_SA(1, 1), a1, coff[1]);
            PG8_WAIT_V(8); PG8_WAIT_L(0); PG8_BAR; PG8_MMA(0, 0, At, B0); PG8_MMA(0, 1, At, B1); PG8_BAR; PG8_SCHED;
            if (last && has_next) { coff[0][0] = noff[0][0]; coff[0][1] = noff[0][1]; coff[1][0] = noff[1][0]; coff[1][1] = noff[1][1]; }
            PG8_LDA(At, 0, 1); PG8_STAGE(PG8_SB(0, 0), b2, voffB); PG8_STAGE(PG8_SB(0, 1), b2 + hstepB, voffB); PG8_STAGE(PG8_SA(0, 0), a2, coff[0]);
            PG8_WAIT_V(8); PG8_WAIT_L(0); PG8_BAR; if (!Sched::RAGGED || cur.nvalid > HALF) { PG8_MMA(1, 0, At, B0); PG8_MMA(1, 1, At, B1); } PG8_BAR; PG8_SCHED;
            PG8_LDB(B0, 1, 0); PG8_LDB(B1, 1, 1); PG8_SCHED; PG8_LDA(At, 1, 0); PG8_STAGE(PG8_SA(0, 1), a2, coff[1]);
            PG8_WAIT_V(8); PG8_WAIT_L(0); PG8_BAR; PG8_MMA(0, 0, At, B0); PG8_MMA(0, 1, At, B1); PG8_BAR; PG8_SCHED;
            PG8_LDA(At, 1, 1); PG8_STAGE(PG8_SB(1, 0), b3, voffB); PG8_STAGE(PG8_SB(1, 1), b3 + hstepB, voffB); PG8_STAGE(PG8_SA(1, 0), a3, coff[0]);
            PG8_WAIT_V(8); PG8_WAIT_L(0); PG8_BAR; if (!Sched::RAGGED || cur.nvalid > HALF) { PG8_MMA(1, 0, At, B0); PG8_MMA(1, 1, At, B1); } PG8_BAR; PG8_SCHED;
        }
        if constexpr (ALIGN_EPI) { if (wr == 0) PG8_BAR; }
        if constexpr (FP8) asm volatile("s_nop 15\n\ts_nop 15\n\ts_nop 15" ::: "memory");
        E(acc, cur, wr, wc, fr, fq);
        if (!has_next) break;
#pragma unroll
        for (int a = 0; a < 2; ++a)
#pragma unroll
            for (int b = 0; b < 2; ++b)
#pragma unroll
                for (int m = 0; m < 4; ++m)
#pragma unroll
                    for (int n = 0; n < 2; ++n) acc[a][b][m][n] = (f32x4){0.f, 0.f, 0.f, 0.f};
        cur = nxt; cB = nB; ++ui;
        if constexpr (ALIGN_EPI) { if (wr == 1) PG8_BAR; }
    }
    PG8_WAIT_V(0);
    if constexpr (!ALIGN_EPI) { if (wr == 0) PG8_BAR; }
    PG8_BAR;
#undef PG8_SA
#undef PG8_SB
#undef PG8_STAGE
#undef PG8_LDA
#undef PG8_LDB
#undef PG8_MMA
#undef PG8_WAIT_V
#undef PG8_WAIT_L
#undef PG8_BAR
#undef PG8_SCHED
}
}
using pg8::Unit;

struct EpiBf16 {
    static constexpr bool PERM = true;
    bf16_t* O; int ldc; int nostore;
    __device__ __forceinline__ void operator()(const f32x4 (&acc)[2][2][4][2], const Unit& u, int wr, int wc, int fr, int fq) const {
        const int row0 = u.row0 + wr * 64 + fr, col0 = u.pn * 256 + wc * 32 + 8 * fq;
#pragma unroll
        for (int ai = 0; ai < 2; ++ai)
#pragma unroll
            for (int m = 0; m < 4; ++m) { bf16_t* rowp = O + (size_t)(row0 + ai * 128 + m * 16) * ldc + col0;
#pragma unroll
                for (int bj = 0; bj < 2; ++bj) { const f32x4 v0 = acc[ai][bj][m][0], v1 = acc[ai][bj][m][1];
                    u32x4 w; w.x = cvt_pk_bf16(v0[0], v0[1]); w.y = cvt_pk_bf16(v0[2], v0[3]); w.z = cvt_pk_bf16(v1[0], v1[1]); w.w = cvt_pk_bf16(v1[2], v1[3]);
                    if (!nostore) *(u32x4*)(rowp + bj * 128) = w; else asm volatile("" :: "v"(w)); } }
    }
};
template <bool ADD> struct EpiGate {
    static constexpr bool PERM = true;
    bf16_t* O; int ldc; const bf16_t* gate; int ldg;
    __device__ __forceinline__ void operator()(const f32x4 (&acc)[2][2][4][2], const Unit& u, int wr, int wc, int fr, int fq) const {
        const int row0 = u.row0 + wr * 64 + fr, col0 = u.pn * 256 + wc * 32 + 8 * fq;
#pragma unroll
        for (int ai = 0; ai < 2; ++ai)
#pragma unroll
            for (int m = 0; m < 4; ++m) { const size_t r = (size_t)(row0 + ai * 128 + m * 16); bf16_t* rowp = O + r * ldc + col0; const bf16_t* gp = gate + r * ldg + col0;
#pragma unroll
                for (int bj = 0; bj < 2; ++bj) { const f32x4 v0 = acc[ai][bj][m][0], v1 = acc[ai][bj][m][1];
                    const u32x4 g = *(const u32x4*)(gp + bj * 128);
                    float o[8];
                    o[0] = fsigm(bf2f(g.x & 0xffffu)) * v0[0]; o[1] = fsigm(bf2f(g.x >> 16)) * v0[1]; o[2] = fsigm(bf2f(g.y & 0xffffu)) * v0[2]; o[3] = fsigm(bf2f(g.y >> 16)) * v0[3];
                    o[4] = fsigm(bf2f(g.z & 0xffffu)) * v1[0]; o[5] = fsigm(bf2f(g.z >> 16)) * v1[1]; o[6] = fsigm(bf2f(g.w & 0xffffu)) * v1[2]; o[7] = fsigm(bf2f(g.w >> 16)) * v1[3];
                    if (ADD) { const u32x4 p = *(const u32x4*)(rowp + bj * 128);
                        o[0] += bf2f(p.x & 0xffffu); o[1] += bf2f(p.x >> 16); o[2] += bf2f(p.y & 0xffffu); o[3] += bf2f(p.y >> 16);
                        o[4] += bf2f(p.z & 0xffffu); o[5] += bf2f(p.z >> 16); o[6] += bf2f(p.w & 0xffffu); o[7] += bf2f(p.w >> 16); }
                    u32x4 w; w.x = cvt_pk_bf16(o[0], o[1]); w.y = cvt_pk_bf16(o[2], o[3]); w.z = cvt_pk_bf16(o[4], o[5]); w.w = cvt_pk_bf16(o[6], o[7]);
                    *(u32x4*)(rowp + bj * 128) = w; } }
    }
};
struct EpiResid {
    static constexpr bool PERM = false;
    const float* base; float* out; int ldc; const float* gvec;
    __device__ __forceinline__ void operator()(const f32x4 (&acc)[2][2][4][2], const Unit& u, int wr, int wc, int fr, int fq) const {
        const int row0 = u.row0 + wr * 64 + fr, col0 = u.pn * 256 + wc * 32 + 4 * fq;
        f32x4 gv[2][2];
#pragma unroll
        for (int bj = 0; bj < 2; ++bj)
#pragma unroll
            for (int n = 0; n < 2; ++n) gv[bj][n] = *(const f32x4*)(gvec + col0 + bj * 128 + n * 16);
#pragma unroll
        for (int ai = 0; ai < 2; ++ai)
#pragma unroll
            for (int m = 0; m < 4; ++m) { const size_t off = (size_t)(row0 + ai * 128 + m * 16) * ldc + col0;
#pragma unroll
                for (int bj = 0; bj < 2; ++bj)
#pragma unroll
                    for (int n = 0; n < 2; ++n) { const f32x4 bs = *(const f32x4*)(base + off + bj * 128 + n * 16); *(f32x4*)(out + off + bj * 128 + n * 16) = bs + gv[bj][n] * acc[ai][bj][m][n]; } }
    }
};
struct EpiGateUp {
    static constexpr bool PERM = true;
    unsigned char* ACT;
    __device__ __forceinline__ void operator()(const f32x4 (&acc)[2][2][4][2], const Unit& u, int wr, int wc, int fr, int fq) const {
        const int row0 = u.row0 + wr * 64 + fr, col0 = u.pn * 128 + wc * 32 + 8 * fq;
        constexpr float ws = 1.0f / FP8_WS1;
#pragma unroll
        for (int ai = 0; ai < 2; ++ai)
#pragma unroll
            for (int m = 0; m < 4; ++m) { unsigned char* rowp = ACT + (size_t)(row0 + ai * 128 + m * 16) * ED + col0;
                const f32x4 g0 = acc[ai][0][m][0] * ws, g1 = acc[ai][0][m][1] * ws, u0 = acc[ai][1][m][0] * (ws * FP8_AS), u1 = acc[ai][1][m][1] * (ws * FP8_AS);
                u32x2 w; w.x = cvt4_fp8(fsilu(g0[0]) * u0[0], fsilu(g0[1]) * u0[1], fsilu(g0[2]) * u0[2], fsilu(g0[3]) * u0[3]);
                w.y = cvt4_fp8(fsilu(g1[0]) * u1[0], fsilu(g1[1]) * u1[1], fsilu(g1[2]) * u1[2], fsilu(g1[3]) * u1[3]);
                *(u32x2*)rowp = w; }
    }
};
struct EpiDown {
    static constexpr bool PERM = true;
    bf16_t* Y; const float* wsorted;
    __device__ __forceinline__ void operator()(const f32x4 (&acc)[2][2][4][2], const Unit& u, int wr, int wc, int fr, int fq) const {
        const int rl0 = wr * 64 + fr, col0 = u.pn * 256 + wc * 32 + 8 * fq;
#pragma unroll
        for (int ai = 0; ai < 2; ++ai)
#pragma unroll
            for (int m = 0; m < 4; ++m) { const int rl = rl0 + ai * 128 + m * 16; const int row = u.row0 + rl;
                float wv = 1.f; if (u.e < NE) wv = (rl < u.nvalid) ? wsorted[row] : 0.f;
                wv *= 1.0f / (FP8_WS2 * FP8_AS);
                bf16_t* rowp = Y + (size_t)row * D + col0;
#pragma unroll
                for (int bj = 0; bj < 2; ++bj) { const f32x4 v0 = acc[ai][bj][m][0] * wv, v1 = acc[ai][bj][m][1] * wv;
                    u32x4 w; w.x = cvt_pk_bf16(v0[0], v0[1]); w.y = cvt_pk_bf16(v0[2], v0[3]); w.z = cvt_pk_bf16(v1[0], v1[1]); w.w = cvt_pk_bf16(v1[2], v1[3]);
                    *(u32x4*)(rowp + bj * 128) = w; } }
    }
};

struct MoeTab { LAS int* te; LAS int* tn; LAS int* misc; };
__device__ __forceinline__ MoeTab moe_tab(LAS unsigned char* lds) { MoeTab t; t.te = (LAS int*)(lds + LDS_TAB); t.tn = t.te + 352; t.misc = t.tn + 352; return t; }
struct MoeSched1 {
    static constexpr bool RAGGED = true;
    const char* H2; const char* E1; const int* toks; MoeTab tab; int G, vcu;
    __device__ __forceinline__ bool next(int i, Unit& u) const {
        const int ntr = tab.misc[0]; const int L = i * G + vcu; if (L >= 4 * (ntr + 32)) return false;
        const int t = L >> 2; u.pn = L & 3;
        if (t < ntr) { u.row0 = t * 256; u.e = tab.te[t]; u.nvalid = tab.tn[t]; } else { u.row0 = SH_ROW0 + (t - ntr) * 256; u.e = NE; u.nvalid = 256; }
        return true;
    }
    __device__ __forceinline__ const char* a_base() const { return H2; }
    __device__ __forceinline__ const char* b_ptr(const Unit& u) const { return E1 + ((size_t)u.e * 1024 + (size_t)u.pn * 256) * D; }
    __device__ __forceinline__ void a_off(const Unit& u, int tid, unsigned (&off)[2][2]) const {
#pragma unroll
        for (int i = 0; i < 2; ++i) { int R, C; pg8::stage_rc(tid * 16 + i * 8192, R, C);
#pragma unroll
            for (int h = 0; h < 2; ++h) { const int r = h * 128 + R; int tok;
                if (u.e < NE) tok = (r < u.nvalid) ? toks[u.row0 + r] : 0; else tok = u.row0 - SH_ROW0 + r;
                off[h][i] = (unsigned)(tok * D + 2 * C); } }
    }
};
struct MoeSched2 {
    static constexpr bool RAGGED = true;
    const char* ACT; const char* E2; MoeTab tab; int G, vcu;
    __device__ __forceinline__ bool next(int i, Unit& u) const {
        const int ntr = tab.misc[0]; const int L = i * G + vcu; if (L >= 8 * (ntr + 32)) return false;
        const int t = L >> 3; u.pn = L & 7;
        if (t < ntr) { u.row0 = t * 256; u.e = tab.te[t]; u.nvalid = tab.tn[t]; } else { u.row0 = SH_ROW0 + (t - ntr) * 256; u.e = NE; u.nvalid = 256; }
        return true;
    }
    __device__ __forceinline__ const char* a_base() const { return ACT; }
    __device__ __forceinline__ const char* b_ptr(const Unit& u) const { return E2 + ((size_t)u.e * 2048 + (size_t)u.pn * 256) * ED; }
    __device__ __forceinline__ void a_off(const Unit& u, int tid, unsigned (&off)[2][2]) const {
#pragma unroll
        for (int i = 0; i < 2; ++i) { int R, C; pg8::stage_rc(tid * 16 + i * 8192, R, C);
            off[0][i] = (unsigned)((u.row0 + R) * ED + 2 * C); off[1][i] = (unsigned)((u.row0 + 128 + R) * ED + 2 * C); }
    }
};

#define XB_TMO      128
#define XB_XCNT(j)  (256  + 64 * (j))
#define XB_XSUB(j)  (1280 + 64 * (j))
#define XB_XGEN(j)  (2304 + 64 * (j))
#define XB_TOP      3328
#define XB_TOPGEN   3392
#define XCD_BAR_WORDS 3456
#define XB_SPIN_CAP (1u << 18)
__device__ __forceinline__ unsigned xb_ld(unsigned* p)              { return __hip_atomic_load(p, __ATOMIC_RELAXED, __HIP_MEMORY_SCOPE_AGENT); }
__device__ __forceinline__ unsigned xb_add(unsigned* p, unsigned v) { return __hip_atomic_fetch_add(p, v, __ATOMIC_RELAXED, __HIP_MEMORY_SCOPE_AGENT); }
__device__ __forceinline__ unsigned xb_xcc_id() { return (unsigned)__builtin_amdgcn_s_getreg((3 << 11) | 20) & 0xFu; }
#define XB_SPIN(cond, bar) do { unsigned _sp = 0; while (cond) { __builtin_amdgcn_s_sleep(1); \
    if ((++_sp & 255u) == 0u) { if (xb_ld(&(bar)[XB_TMO])) break; if (_sp > XB_SPIN_CAP) { atomicAdd(&(bar)[XB_TMO], 1u); break; } } } } while (0)
struct XcdBarrier { unsigned* bar; unsigned x; volatile LAS unsigned* st; };
__device__ __forceinline__ XcdBarrier xcd_barrier_post(unsigned* bar, volatile LAS unsigned* st) {
    XcdBarrier b; b.bar = bar; b.x = xb_xcc_id(); b.st = st;
    if (threadIdx.x == 0) (void)xb_add(&bar[XB_XCNT(b.x)], 1u);
    return b;
}
__device__ __forceinline__ void xcd_barrier_complete(unsigned* bar, unsigned x, unsigned& nloc, unsigned& nx) {
    const unsigned G = gridDim.x * gridDim.y * gridDim.z;
    unsigned sum, cnt, mine, sp = 0u;
    for (;;) {
        sum = 0u; cnt = 0u; mine = 0u;
#pragma unroll
        for (unsigned j = 0; j < 16; ++j) { const unsigned c = xb_ld(&bar[XB_XCNT(j)]); sum += c; cnt += (c > 0u) ? 1u : 0u; mine = (j == x) ? c : mine; }
        if (sum == G) break;
        __builtin_amdgcn_s_sleep(1);
        if ((++sp & 255u) == 0u) { if (xb_ld(&bar[XB_TMO])) break; if (sp > XB_SPIN_CAP) { atomicAdd(&bar[XB_TMO], 1u); break; } }
    }
    nloc = mine > 0u ? mine : 1u; nx = cnt > 0u ? cnt : 1u;
}
__device__ __forceinline__ void xcd_barrier(const XcdBarrier& b) {
    asm volatile("s_waitcnt vmcnt(0)" ::: "memory");
    __syncthreads();
    if (threadIdx.x == 0) {
        unsigned* bar = b.bar;
        __builtin_amdgcn_s_waitcnt(0);
        unsigned nloc = b.st[0], nx = b.st[1];
        if (nloc == 0u) { xcd_barrier_complete(bar, b.x, nloc, nx); b.st[0] = nloc; b.st[1] = nx; }
        const unsigned old = xb_add(&bar[XB_XSUB(b.x)], 1u);
        const unsigned gen = old / nloc;
        if (old + 1u == (gen + 1u) * nloc) {
            __builtin_amdgcn_fence(__ATOMIC_RELEASE, "agent");
            asm volatile("s_waitcnt vmcnt(0)" ::: "memory");
            const unsigned og = xb_add(&bar[XB_TOP], 1u);
            const unsigned tg = og / nx;
            if (og + 1u == (tg + 1u) * nx) xb_add(&bar[XB_TOPGEN], 1u);
            else XB_SPIN(xb_ld(&bar[XB_TOPGEN]) == tg, bar);
            __builtin_amdgcn_fence(__ATOMIC_ACQUIRE, "agent");
            xb_add(&bar[XB_XGEN(b.x)], 1u);
            asm volatile("s_waitcnt vmcnt(0)" ::: "memory");
        } else {
            XB_SPIN(xb_ld(&bar[XB_XGEN(b.x)]) == gen, bar);
            __builtin_amdgcn_fence(__ATOMIC_ACQUIRE, "agent");
            asm volatile("s_waitcnt vmcnt(0)" ::: "memory");
        }
    }
    __syncthreads();
}

struct Ctx {
    LAS unsigned char* lds;
    int tid, lane, wave, G, vcu, bx;
    float* out; unsigned char* ws;
};
constexpr int LDS_PTRS = 163840 - 512;
__device__ __forceinline__ const float* inp(const Ctx& F, int i) {
    const LAS unsigned* p = (const LAS unsigned*)(F.lds + LDS_PTRS) + 2 * i;
    const unsigned lo = __builtin_amdgcn_readfirstlane(p[0]), hi = __builtin_amdgcn_readfirstlane(p[1]);
    return (const float*)(const GAS float*)(((unsigned long long)hi << 32) | lo);
}
#define IN_X 0
#define IN_C 1
#define IN_RELB 2
#define IN_WADA 3
#define IN_BADA 4
#define IN_LN1 5
#define IN_WIN 6
#define IN_QNG 7
#define IN_KNG 8
#define IN_GNG 9
#define IN_PA 10
#define IN_PB 11
#define IN_WO 12
#define IN_LN2 13
#define IN_RW 14
#define IN_RB 15
#define IN_WG 16
#define IN_WU 17
#define IN_WD 18
#define IN_WGS 19
#define IN_WUS 20
#define IN_WDS 21

struct CvItem { const float* src; unsigned char* dst; int ldw, ldt; float scale; };
constexpr int CV_WIN = 32 * 304, CV_PA = 16 * 32, CV_PB = 32 * 32, CV_WO = 32 * 32, CV_EX = 768;
constexpr int CV_DENSE = CV_WIN + CV_PA + CV_PB + CV_WO, CV_ALL = CV_DENSE + 65 * CV_EX;
#ifndef CV_BG_FROM
#define CV_BG_FROM CV_DENSE
#endif
__device__ __forceinline__ void cv_kn(int q, int nbg_count, int& kb, int& nb) {
    const int super = q >> 3, sub = q & 7; kb = (super / nbg_count) * 4 + (sub >> 1); nb = (super % nbg_count) * 2 + (sub & 1);
}
__device__ __forceinline__ CvItem cv_decode(const Ctx& F, int it) {
    CvItem c; int r = it; int kb, nb; c.scale = 0.f;
    if (r < CV_WIN) { cv_kn(r, 152, kb, nb); c.ldw = INW; c.ldt = D * 2; c.src = inp(F, IN_WIN) + (size_t)(64 * kb) * INW + 64 * nb; c.dst = F.ws + WS_WINT + ((size_t)(64 * nb) * D + 64 * kb) * 2; return c; } r -= CV_WIN;
    if (r < CV_PA) { cv_kn(r, 16, kb, nb); c.ldw = D; c.ldt = 1024 * 2; c.src = inp(F, IN_PA) + (size_t)(64 * kb) * D + 64 * nb; c.dst = F.ws + WS_PA + ((size_t)(64 * nb) * 1024 + 64 * kb) * 2; return c; } r -= CV_PA;
    if (r < CV_PB) { cv_kn(r, 16, kb, nb); c.ldw = D; c.ldt = D * 2; c.src = inp(F, IN_PB) + (size_t)(64 * kb) * D + 64 * nb; c.dst = F.ws + WS_PB + ((size_t)(64 * nb) * D + 64 * kb) * 2; return c; } r -= CV_PB;
    if (r < CV_WO) { cv_kn(r, 16, kb, nb); c.ldw = D; c.ldt = D * 2; c.src = inp(F, IN_WO) + (size_t)(64 * kb) * D + 64 * nb; c.dst = F.ws + WS_WO + ((size_t)(64 * nb) * D + 64 * kb) * 2; return c; } r -= CV_WO;
    const int e = r / CV_EX; int q = r % CV_EX;
    if (q < 512) {
        const int isup = q >> 8; q &= 255; cv_kn(q, 4, kb, nb); const int n0 = 64 * nb;
        const float* w = (e < NE) ? inp(F, isup ? IN_WU : IN_WG) + (size_t)e * D * ED : inp(F, isup ? IN_WUS : IN_WGS);
        c.ldw = ED; c.ldt = D; c.scale = FP8_WS1; c.src = w + (size_t)(64 * kb) * ED + n0;
        c.dst = F.ws + WS_E1 + ((size_t)e * 1024 + (size_t)((n0 >> 7) * 256 + (n0 & 127) + isup * 128)) * D + 64 * kb;
    } else {
        q -= 512; cv_kn(q, 16, kb, nb);
        const float* w = (e < NE) ? inp(F, IN_WD) + (size_t)e * ED * D : inp(F, IN_WDS);
        c.ldw = D; c.ldt = ED; c.scale = FP8_WS2; c.src = w + (size_t)(64 * kb) * D + 64 * nb;
        c.dst = F.ws + WS_E2 + ((size_t)e * D + (size_t)(64 * nb)) * ED + 64 * kb;
    }
    return c;
}
__device__ __forceinline__ void cv_load(const CvItem& c, int lane, f32x4 (&v)[16]) {
    const int r4 = lane >> 4, c16 = lane & 15;
#pragma unroll
    for (int i = 0; i < 16; ++i) v[i] = *(const f32x4*)(c.src + (size_t)(4 * i + r4) * c.ldw + 4 * c16);
}
__device__ __forceinline__ void cv_store(const CvItem& c, int lane, const f32x4 (&v)[16], LAS float* scr) {
    const int r4 = lane >> 4, c16 = lane & 15;
#pragma unroll
    for (int i = 0; i < 16; ++i) { LAS float* d = scr + (4 * i + r4) * 65 + 4 * c16; d[0] = v[i].x; d[1] = v[i].y; d[2] = v[i].z; d[3] = v[i].w; }
    LDS_WAIT(); asm volatile("" ::: "memory");
    const int cc = lane & 7;
    if (c.scale == 0.f) {
#pragma unroll
        for (int j = 0; j < 8; ++j) { const int n = (lane >> 3) + 8 * j; const LAS float* s = scr + (8 * cc) * 65 + n;
            u32x4 o; o.x = cvt_pk_bf16(s[0 * 65], s[1 * 65]); o.y = cvt_pk_bf16(s[2 * 65], s[3 * 65]); o.z = cvt_pk_bf16(s[4 * 65], s[5 * 65]); o.w = cvt_pk_bf16(s[6 * 65], s[7 * 65]);
            *(GAS u32x4*)(c.dst + (size_t)n * c.ldt + 16 * cc) = o; }
    } else { const float sc = c.scale;
#pragma unroll
        for (int j = 0; j < 8; ++j) { const int n = (lane >> 3) + 8 * j; const LAS float* s = scr + (8 * cc) * 65 + n;
            u32x2 o; o.x = cvt4_fp8(s[0 * 65] * sc, s[1 * 65] * sc, s[2 * 65] * sc, s[3 * 65] * sc); o.y = cvt4_fp8(s[4 * 65] * sc, s[5 * 65] * sc, s[6 * 65] * sc, s[7 * 65] * sc);
            *(GAS u32x2*)(c.dst + (size_t)n * c.ldt + 8 * cc) = o; }
    }
    LDS_WAIT(); asm volatile("" ::: "memory");
}
__device__ __forceinline__ void convert_items(const Ctx& F, int lo, int hi, int gw, int NGW) {
    LAS float* scr = (LAS float*)(F.lds + 16384 + F.wave * 16640);
    int it = lo + gw;
    if (it >= hi) return;
    f32x4 va[16], vb[16];
    CvItem ca = cv_decode(F, it), cb = ca;
    cv_load(ca, F.lane, va);
    for (;;) {
        int nx = it + NGW; const bool hb = nx < hi;
        if (hb) { cb = cv_decode(F, nx); cv_load(cb, F.lane, vb); }
        cv_store(ca, F.lane, va, scr);
        if (!hb) break;
        it = nx; nx = it + NGW; const bool ha = nx < hi;
        if (ha) { ca = cv_decode(F, nx); cv_load(ca, F.lane, va); }
        cv_store(cb, F.lane, vb, scr);
        if (!ha) break;
        it = nx;
    }
}
__device__ __forceinline__ void p0_prologue(const Ctx& F) {
    {
        const float* cvec = inp(F, IN_C); const float* wada = inp(F, IN_WADA); float* modp = (float*)(F.ws + WS_MODP);
        LAS float* red = (LAS float*)F.lds;
        for (int it = F.bx; it < 384; it += F.G) {
            const int cc = it % 48, ks = it / 48; const int col = cc * 256 + F.lane * 4; const int k0 = ks * 256 + F.wave * 32;
            f32x4 a = (f32x4){0.f, 0.f, 0.f, 0.f};
#pragma unroll 8
            for (int r = 0; r < 32; ++r) { const int k = k0 + r; const float s = fsilu(cvec[k]); const f32x4 w = *(const f32x4*)(wada + (size_t)k * 12288 + col); a += w * s; }
            *(LAS f32x4*)(red + F.wave * 256 + F.lane * 4) = a;
            __syncthreads();
            if (F.tid < 256) { float s = 0.f;
#pragma unroll
                for (int w = 0; w < 8; ++w) s += red[w * 256 + F.tid];
                modp[ks * 12288 + cc * 256 + F.tid] = s; }
            __syncthreads();
        }
    }
    {
        float* rc = (float*)(F.ws + WS_ROPE); float* rs = rc + S * 64;
        for (int idx = F.bx * 512 + F.tid; idx < S * 64; idx += F.G * 512) {
            const int pos = idx >> 6, i = idx & 63;
            double inv = 1.0; const double r = 0.86596432336006535;
            for (int q = 0; q < i; ++q) inv *= r;
            const double ang = (double)pos * inv;
            const double n = __builtin_rint(ang * 0.15915494309189535);
            const float red = (float)(ang - n * 6.283185307179586);
            rc[idx] = __cosf(red); rs[idx] = __sinf(red);
        }
    }
    convert_items(F, 0, CV_BG_FROM, F.vcu * 8 + F.wave, F.G * 8);
}

__device__ __forceinline__ float mod_sum(const Ctx& F, int n) {
    const float* modp = (const float*)(F.ws + WS_MODP); float s = inp(F, IN_BADA)[n];
#pragma unroll
    for (int k = 0; k < 8; ++k) s += modp[k * 12288 + n];
    return s;
}
__device__ __forceinline__ void norm_rows(const Ctx& F, const float* X, const LAS float* gs, const LAS float* sh, bf16_t* O) {
    const int gw = F.vcu * 8 + F.wave, NGW = F.G * 8;
    for (int m = gw; m < S; m += NGW) {
        const GAS f32x4* xr = (const GAS f32x4*)(X + (size_t)m * D) + F.lane;
        f32x4 v[8]; float ss = 0.f;
#pragma unroll
        for (int j = 0; j < 8; ++j) { v[j] = xr[64 * j]; ss += (v[j].x * v[j].x + v[j].y * v[j].y) + (v[j].z * v[j].z + v[j].w * v[j].w); }
#pragma unroll
        for (int o = 1; o < 64; o <<= 1) ss += __shfl_xor(ss, o);
        const float rstd = 1.0f / sqrtf(ss * (1.f / D) + 1e-6f);
        GAS u32x2* o8 = (GAS u32x2*)(O + (size_t)m * D) + F.lane;
#pragma unroll
        for (int j = 0; j < 8; ++j) { const f32x4 g = *(const LAS f32x4*)(gs + 256 * j + 4 * F.lane), s = *(const LAS f32x4*)(sh + 256 * j + 4 * F.lane);
            const f32x4 y = v[j] * rstd * g + s; u32x2 w; w.x = cvt_pk_bf16(y.x, y.y); w.y = cvt_pk_bf16(y.z, y.w); o8[64 * j] = w; }
    }
}
__device__ __forceinline__ void p1_norm1(const Ctx& F) {
    LAS float* gs = (LAS float*)F.lds; LAS float* sh = gs + D;
    for (int k = F.tid; k < D; k += 512) { const float shv = mod_sum(F, k), scv = mod_sum(F, D + k); gs[k] = inp(F, IN_LN1)[k] * (1.f + scv); sh[k] = shv; }
    float* modf = (float*)(F.ws + WS_MODF);
    for (int n = F.bx * 512 + F.tid; n < 12288; n += F.G * 512) modf[n] = mod_sum(F, n);
    __syncthreads();
    norm_rows(F, inp(F, IN_X), gs, sh, (bf16_t*)(F.ws + WS_H));
}


__device__ __forceinline__ bf16x8 pk_frag(u32x2 lo, u32x2 hi) { u32x4 v; v.x = lo.x; v.y = lo.y; v.z = hi.x; v.w = hi.y; return __builtin_bit_cast(bf16x8, v); }
__device__ __forceinline__ f32x4 mfma16(bf16x8 a, bf16x8 b, f32x4 c) { return __builtin_amdgcn_mfma_f32_16x16x32_bf16(a, b, c, 0, 0, 0); }
__device__ __forceinline__ float gamma_log2(int h) { return log2f(1.0f - exp2f(-5.0f - (float)h)); }

struct AttnU { int g, hh, d, r, nb, head; };
__device__ __forceinline__ AttnU attn_decode(int u) {
    AttnU U; U.g = u >> 9; const int rem = u & 511; U.hh = rem >> 6; const int rem2 = rem & 63;
    const int dsh = 2 * U.g; U.d = 1 << dsh; const int nblk = 64 >> dsh;
    U.r = rem2 / nblk; U.nb = rem2 % nblk; U.head = U.g * 8 + U.hh; return U;
}
__device__ __forceinline__ void attn_issue(const bf16_t* proj, const AttnU& U, int tid, int w, int lane, u32x4 (&kr)[8], u32x4 (&vr)[8], u32x4 (&qr)[4]) {
    const int rowi = tid >> 4, ch = tid & 15;
#pragma unroll
    for (int p = 0; p < 8; ++p) { const int cc = p * 32 + rowi; const int jk = (U.nb - 1) * 128 + cc;
        if (jk >= 0) { const unsigned off = (unsigned)(jk * U.d + U.r) * INW + U.head * 128 + ch * 8; kr[p] = *(const u32x4*)(proj + off + C_KA); vr[p] = *(const u32x4*)(proj + off + C_VA); }
        else { kr[p] = (u32x4){0u, 0u, 0u, 0u}; vr[p] = (u32x4){0u, 0u, 0u, 0u}; } }
    const int ql = lane & 15, g4 = lane >> 4; const unsigned tq = (unsigned)((U.nb * 128 + 16 * w + ql) * U.d + U.r);
#pragma unroll
    for (int ds = 0; ds < 4; ++ds) qr[ds] = *(const u32x4*)(proj + tq * INW + C_QA + U.head * 128 + 32 * ds + 8 * g4);
}
__device__ __forceinline__ void p3_attn(const Ctx& F) {
    const bf16_t* proj = (const bf16_t*)(F.ws + WS_PROJ);
    LAS bf16_t* KS = (LAS bf16_t*)F.lds;
    LAS bf16_t* VS = (LAS bf16_t*)(F.lds + 69632);
    LAS float* BT = (LAS float*)(F.lds + 139264);
    const int lane = F.lane, w = F.wave, ql = lane & 15, g4 = lane >> 4;
    const int rowi = F.tid >> 4, ch = F.tid & 15;
    u32x4 kr[8], vr[8], qr[4];
    int it = F.bx;
    if (it < 1536) { const AttnU U0 = attn_decode(it); attn_issue(proj, U0, F.tid, w, lane, kr, vr, qr); }
    for (; it < 1536; it += F.G) {
        const AttnU U = attn_decode(it);
        const int d = U.d, nb = U.nb;
        if (F.tid <= 128) { const int dist = F.tid * d; int b;
            if (dist < 16) b = dist; else { b = 16 + (int)floorf(log2f((float)dist * 0.0625f) * (16.0f / 7.0f)); b = b > 31 ? 31 : b; }
            BT[F.tid] = inp(F, IN_RELB)[b * 24 + U.head]; }
        {
            const float* kg = inp(F, IN_KNG) + ch * 8;
            const f32x4 kg0 = *(const f32x4*)kg, kg1 = *(const f32x4*)(kg + 4);
#pragma unroll
            for (int p = 0; p < 8; ++p) { const int cc = p * 32 + rowi;
                float f[8]; f[0] = bf2f(kr[p].x & 0xffffu); f[1] = bf2f(kr[p].x >> 16); f[2] = bf2f(kr[p].y & 0xffffu); f[3] = bf2f(kr[p].y >> 16);
                f[4] = bf2f(kr[p].z & 0xffffu); f[5] = bf2f(kr[p].z >> 16); f[6] = bf2f(kr[p].w & 0xffffu); f[7] = bf2f(kr[p].w >> 16);
                float ss = 0.f;
#pragma unroll
                for (int e = 0; e < 8; ++e) ss += f[e] * f[e];
                ss += __shfl_xor(ss, 1); ss += __shfl_xor(ss, 2); ss += __shfl_xor(ss, 4); ss += __shfl_xor(ss, 8);
                const float rstd = 1.0f / sqrtf(ss * (1.f / 128.f) + 1e-6f);
                u32x4 o; o.x = cvt_pk_bf16(f[0] * rstd * kg0.x, f[1] * rstd * kg0.y); o.y = cvt_pk_bf16(f[2] * rstd * kg0.z, f[3] * rstd * kg0.w);
                o.z = cvt_pk_bf16(f[4] * rstd * kg1.x, f[5] * rstd * kg1.y); o.w = cvt_pk_bf16(f[6] * rstd * kg1.z, f[7] * rstd * kg1.w);
                *(LAS u32x4*)(KS + cc * 136 + ch * 8) = o;
                *(LAS u32x4*)(VS + cc * 136 + ch * 8) = vr[p]; }
        }
        const int a = 16 * w + ql;
        const unsigned tq = (unsigned)((nb * 128 + a) * d + U.r);
        bf16x8 qf[4];
        {
            float f[4][8]; float ss = 0.f;
#pragma unroll
            for (int ds = 0; ds < 4; ++ds) { f[ds][0] = bf2f(qr[ds].x & 0xffffu); f[ds][1] = bf2f(qr[ds].x >> 16); f[ds][2] = bf2f(qr[ds].y & 0xffffu); f[ds][3] = bf2f(qr[ds].y >> 16);
                f[ds][4] = bf2f(qr[ds].z & 0xffffu); f[ds][5] = bf2f(qr[ds].z >> 16); f[ds][6] = bf2f(qr[ds].w & 0xffffu); f[ds][7] = bf2f(qr[ds].w >> 16);
#pragma unroll
                for (int e = 0; e < 8; ++e) ss += f[ds][e] * f[ds][e]; }
            ss += __shfl_xor(ss, 16); ss += __shfl_xor(ss, 32);
            const float rs = (1.0f / sqrtf(ss * (1.f / 128.f) + 1e-6f)) * 0.08838834764831845f;
#pragma unroll
            for (int ds = 0; ds < 4; ++ds) { const float* qg = inp(F, IN_QNG) + 32 * ds + 8 * g4; const f32x4 q0 = *(const f32x4*)qg, q1 = *(const f32x4*)(qg + 4); u32x4 o;
                o.x = cvt_pk_bf16(f[ds][0] * rs * q0.x, f[ds][1] * rs * q0.y); o.y = cvt_pk_bf16(f[ds][2] * rs * q0.z, f[ds][3] * rs * q0.w);
                o.z = cvt_pk_bf16(f[ds][4] * rs * q1.x, f[ds][5] * rs * q1.y); o.w = cvt_pk_bf16(f[ds][6] * rs * q1.z, f[ds][7] * rs * q1.w);
                qf[ds] = __builtin_bit_cast(bf16x8, o); }
        }
        __syncthreads();
        { const int nx = it + F.G; if (nx < 1536) { const AttnU Un = attn_decode(nx); attn_issue(proj, Un, F.tid, w, lane, kr, vr, qr); } }
        const int kbase = 32 * (w >> 1);
        f32x4 sc[10];
#pragma unroll
        for (int ti = 0; ti < 10; ++ti) { f32x4 acc = (f32x4){0.f, 0.f, 0.f, 0.f};
#pragma unroll
            for (int ds = 0; ds < 4; ++ds) { const bf16x8 kf = *(const LAS bf16x8*)(KS + (kbase + 16 * ti + ql) * 136 + 32 * ds + 8 * g4); acc = mfma16(kf, qf[ds], acc); }
            sc[ti] = acc; }
        float mx = -1e30f;
#pragma unroll
        for (int ti = 0; ti < 10; ++ti)
#pragma unroll
            for (int i = 0; i < 4; ++i) { const int cc = kbase + 16 * ti + 4 * g4 + i; const int delta = 128 + a - cc;
                const bool ok = (delta >= 0) && (delta <= 128) && (nb > 0 || cc >= 128);
                const float sv = ok ? sc[ti][i] + BT[ok ? delta : 0] : -1e30f; sc[ti][i] = sv; mx = fmaxf(mx, sv); }
        mx = fmaxf(mx, __shfl_xor(mx, 16)); mx = fmaxf(mx, __shfl_xor(mx, 32));
        float lsum = 0.f;
#pragma unroll
        for (int ti = 0; ti < 10; ++ti)
#pragma unroll
            for (int i = 0; i < 4; ++i) { const float p = __expf(sc[ti][i] - mx); sc[ti][i] = p; lsum += p; }
        lsum += __shfl_xor(lsum, 16); lsum += __shfl_xor(lsum, 32);
        bf16x8 pf[5];
#pragma unroll
        for (int s = 0; s < 5; ++s) { u32x4 o; o.x = cvt_pk_bf16(sc[2 * s][0], sc[2 * s][1]); o.y = cvt_pk_bf16(sc[2 * s][2], sc[2 * s][3]);
            o.z = cvt_pk_bf16(sc[2 * s + 1][0], sc[2 * s + 1][1]); o.w = cvt_pk_bf16(sc[2 * s + 1][2], sc[2 * s + 1][3]); pf[s] = __builtin_bit_cast(bf16x8, o); }
        const float rl = 1.0f / lsum;
        bf16_t* og = (bf16_t*)(F.ws + WS_OG) + ((unsigned)(U.g * S) + tq) * 1024u + U.hh * 128;
        const unsigned vbase = (unsigned)(size_t)VS + (unsigned)(((kbase + 4 * g4 + (ql >> 2)) * 136 + 4 * (ql & 3)) * 2);
#pragma unroll
        for (int dt = 0; dt < 8; ++dt) { f32x4 acc = (f32x4){0.f, 0.f, 0.f, 0.f};
            u32x2 lo[5], hi[5];
#pragma unroll
            for (int s = 0; s < 5; ++s) { TR_READ(lo[s], vbase, (32 * s * 136 + dt * 16) * 2); TR_READ(hi[s], vbase, ((32 * s + 16) * 136 + dt * 16) * 2); }
            TR_WAIT4(lo[0], hi[0], lo[1], hi[1]); TR_WAIT4(lo[2], hi[2], lo[3], hi[3]); TR_WAIT2(lo[4], hi[4]);
#pragma unroll
            for (int s = 0; s < 5; ++s) acc = mfma16(pk_frag(lo[s], hi[s]), pf[s], acc);
            u32x2 o; o.x = cvt_pk_bf16(acc[0] * rl, acc[1] * rl); o.y = cvt_pk_bf16(acc[2] * rl, acc[3] * rl);
            *(u32x2*)(og + dt * 16 + 4 * g4) = o; }
        if (g4 == 0) ((float*)(F.ws + WS_LSE))[((unsigned)(U.g * S) + tq) * 8u + U.hh] = mx + __logf(lsum);
        __syncthreads();
    }
}

__device__ __forceinline__ void rot8v(const u32x4 own, const u32x4 par, int ch, const f32x4 c0, const f32x4 c1, const f32x4 s0, const f32x4 s1, float scale, float (&o)[8]) {
    float a[8], b[8];
    a[0] = bf2f(own.x & 0xffffu); a[1] = bf2f(own.x >> 16); a[2] = bf2f(own.y & 0xffffu); a[3] = bf2f(own.y >> 16); a[4] = bf2f(own.z & 0xffffu); a[5] = bf2f(own.z >> 16); a[6] = bf2f(own.w & 0xffffu); a[7] = bf2f(own.w >> 16);
    b[0] = bf2f(par.x & 0xffffu); b[1] = bf2f(par.x >> 16); b[2] = bf2f(par.y & 0xffffu); b[3] = bf2f(par.y >> 16); b[4] = bf2f(par.z & 0xffffu); b[5] = bf2f(par.z >> 16); b[6] = bf2f(par.w & 0xffffu); b[7] = bf2f(par.w >> 16);
    const float cv[8] = {c0.x, c0.y, c0.z, c0.w, c1.x, c1.y, c1.z, c1.w}, sv[8] = {s0.x, s0.y, s0.z, s0.w, s1.x, s1.y, s1.z, s1.w};
#pragma unroll
    for (int e = 0; e < 8; ++e) o[e] = ((ch < 8) ? (a[e] * cv[e] - b[e] * sv[e]) : (b[e] * sv[e] + a[e] * cv[e])) * scale;
}

__device__ __forceinline__ void upd_unit(const Ctx& F, int u) {
    const int n = u >> 3, h = u & 7;
    const bf16_t* proj = (const bf16_t*)(F.ws + WS_PROJ);
    const float* rc = (const float*)(F.ws + WS_ROPE); const float* rsn = rc + S * 64;
    LAS bf16_t* KS = (LAS bf16_t*)F.lds;
    LAS bf16_t* VS = (LAS bf16_t*)(F.lds + 34816);
    const int lane = F.lane, w = F.wave;
    const float lg2 = gamma_log2(h);
    {
        const int rowi = F.tid >> 4, ch = F.tid & 15;
        u32x4 kown[4], kpar[4], vv[8]; f32x4 c0[4], c1[4], s0[4], s1[4];
#pragma unroll
        for (int p = 0; p < 4; ++p) { const int j = p * 32 + rowi; const unsigned tok = (unsigned)(n * 128 + j);
            const bf16_t* kp = proj + tok * INW + C_KR + h * 128;
            kown[p] = *(const u32x4*)(kp + ch * 8); kpar[p] = *(const u32x4*)(kp + (ch ^ 8) * 8);
            const float* cp = rc + tok * 64 + (ch & 7) * 8; const float* sp = rsn + tok * 64 + (ch & 7) * 8;
            c0[p] = *(const f32x4*)cp; c1[p] = *(const f32x4*)(cp + 4); s0[p] = *(const f32x4*)sp; s1[p] = *(const f32x4*)(sp + 4);
            vv[2 * p] = *(const u32x4*)(proj + tok * INW + C_VR + h * 256 + ch * 8); vv[2 * p + 1] = *(const u32x4*)(proj + tok * INW + C_VR + h * 256 + (ch + 16) * 8); }
#pragma unroll
        for (int p = 0; p < 4; ++p) { const int j = p * 32 + rowi;
            float o[8]; rot8v(kown[p], kpar[p], ch, c0[p], c1[p], s0[p], s1[p], 0.08838834764831845f, o);
            u32x4 ov; ov.x = cvt_pk_bf16(o[0], o[1]); ov.y = cvt_pk_bf16(o[2], o[3]); ov.z = cvt_pk_bf16(o[4], o[5]); ov.w = cvt_pk_bf16(o[6], o[7]);
            *(LAS u32x4*)(KS + j * 136 + ch * 8) = ov; }
#pragma unroll
        for (int p = 0; p < 4; ++p) { const int j = p * 32 + rowi; const float z = exp2f(lg2 * (float)(127 - j));
#pragma unroll
            for (int c2 = 0; c2 < 2; ++c2) { const int chv = ch + 16 * c2; const u32x4 x = vv[2 * p + c2];
                u32x4 ov; ov.x = cvt_pk_bf16(bf2f(x.x & 0xffffu) * z, bf2f(x.x >> 16) * z); ov.y = cvt_pk_bf16(bf2f(x.y & 0xffffu) * z, bf2f(x.y >> 16) * z);
                ov.z = cvt_pk_bf16(bf2f(x.z & 0xffffu) * z, bf2f(x.z >> 16) * z); ov.w = cvt_pk_bf16(bf2f(x.w & 0xffffu) * z, bf2f(x.w >> 16) * z);
                *(LAS u32x4*)(VS + j * 264 + chv * 8) = ov; } }
    }
    __syncthreads();
    const int ql = lane & 15, g4 = lane >> 4;
    const unsigned kb = (unsigned)(size_t)KS + (unsigned)(((8 * g4 + (ql >> 2)) * 136 + 4 * (ql & 3)) * 2);
    const unsigned vbw = (unsigned)(size_t)VS + (unsigned)(((8 * g4 + (ql >> 2)) * 264 + 4 * (ql & 3) + 32 * w) * 2);
    f32x4 acc[2][8];
#pragma unroll
    for (int a = 0; a < 2; ++a)
#pragma unroll
        for (int b = 0; b < 8; ++b) acc[a][b] = (f32x4){0.f, 0.f, 0.f, 0.f};
#pragma unroll
    for (int ks = 0; ks < 4; ++ks) {
        u32x2 vl[2], vh[2];
#pragma unroll
        for (int a = 0; a < 2; ++a) { TR_READ(vl[a], vbw, (32 * ks * 264 + a * 16) * 2); TR_READ(vh[a], vbw, ((32 * ks + 4) * 264 + a * 16) * 2); }
        TR_WAIT4(vl[0], vh[0], vl[1], vh[1]);
        const bf16x8 vf0 = pk_frag(vl[0], vh[0]), vf1 = pk_frag(vl[1], vh[1]);
#pragma unroll
        for (int b = 0; b < 8; b += 2) {
            u32x2 k0l, k0h, k1l, k1h;
            TR_READ(k0l, kb, (32 * ks * 136 + b * 16) * 2); TR_READ(k0h, kb, ((32 * ks + 4) * 136 + b * 16) * 2);
            TR_READ(k1l, kb, (32 * ks * 136 + (b + 1) * 16) * 2); TR_READ(k1h, kb, ((32 * ks + 4) * 136 + (b + 1) * 16) * 2);
            TR_WAIT4(k0l, k0h, k1l, k1h);
            const bf16x8 kf0 = pk_frag(k0l, k0h), kf1 = pk_frag(k1l, k1h);
            acc[0][b] = mfma16(vf0, kf0, acc[0][b]); acc[1][b] = mfma16(vf1, kf0, acc[1][b]);
            acc[0][b + 1] = mfma16(vf0, kf1, acc[0][b + 1]); acc[1][b + 1] = mfma16(vf1, kf1, acc[1][b + 1]); }
    }
    float* upd = (float*)(F.ws + WS_UPD) + (size_t)(n * 8 + h) * 32768;
#pragma unroll
    for (int a = 0; a < 2; ++a)
#pragma unroll
        for (int b = 0; b < 8; ++b)
#pragma unroll
            for (int i = 0; i < 4; ++i) upd[((2 * w + a) * 16 + 4 * g4 + i) * 128 + b * 16 + ql] = acc[a][b][i];
    __syncthreads();
}
__device__ __forceinline__ void p3_mix1(const Ctx& F) {
    p3_attn(F);
    if (DUP2_MASK & 4) { __syncthreads(); p3_attn(F); }
    for (int it = F.bx; it < 512; it += F.G) upd_unit(F, it);
    if (DUP2_MASK & 8) { __syncthreads(); for (int it = F.bx; it < 512; it += F.G) upd_unit(F, it); }
}

__device__ __forceinline__ void p4_scan(const Ctx& F) {
    const float* upd = (const float*)(F.ws + WS_UPD); unsigned* prev = (unsigned*)(F.ws + WS_PREV);
    for (int p = F.bx * 512 + F.tid; p < 131072; p += F.G * 512) {
        const int h = p >> 14;
        const float gch = exp2f(gamma_log2(h) * 128.0f);
        const int within = (p & 16383) * 2;
        float s0 = 0.f, s1 = 0.f;
#pragma unroll 8
        for (int n = 0; n < 64; ++n) { const size_t o = (size_t)(n * 8 + h) * 32768 + within;
            const f32x2 uv = *(const f32x2*)(upd + o);
            prev[o >> 1] = cvt_pk_bf16(s0, s1);
            s0 = gch * s0 + uv.x; s1 = gch * s1 + uv.y; }
    }
}

__device__ __forceinline__ void ret_unit(const Ctx& F, int u) {
    const int n = u >> 3, h = u & 7;
    const bf16_t* proj = (const bf16_t*)(F.ws + WS_PROJ);
    const float* rc = (const float*)(F.ws + WS_ROPE); const float* rsn = rc + S * 64;
    LAS bf16_t* KS = (LAS bf16_t*)F.lds;
    LAS bf16_t* VS = (LAS bf16_t*)(F.lds + 34816);
    LAS bf16_t* QS = (LAS bf16_t*)(F.lds + 102400);
    LAS float* RED = (LAS float*)(F.lds + 137216);
    LAS float* TOT = (LAS float*)(F.lds + 145408);
    const int lane = F.lane, w = F.wave;
    const float lg2 = gamma_log2(h);
    const int ql = lane & 15, g4 = lane >> 4;
    const bf16_t* prev = (const bf16_t*)(F.ws + WS_PREV) + (size_t)(n * 8 + h) * 32768;
    {
        const int rowi = F.tid >> 4, ch = F.tid & 15;
        u32x4 kown[4], kpar[4], vv[8]; f32x4 c0[4], c1[4], s0[4], s1[4];
#pragma unroll
        for (int p = 0; p < 4; ++p) { const int j = p * 32 + rowi; const unsigned tok = (unsigned)(n * 128 + j);
            const bf16_t* kp = proj + tok * INW + C_KR + h * 128;
            kown[p] = *(const u32x4*)(kp + ch * 8); kpar[p] = *(const u32x4*)(kp + (ch ^ 8) * 8);
            const float* cp = rc + tok * 64 + (ch & 7) * 8; const float* sp = rsn + tok * 64 + (ch & 7) * 8;
            c0[p] = *(const f32x4*)cp; c1[p] = *(const f32x4*)(cp + 4); s0[p] = *(const f32x4*)sp; s1[p] = *(const f32x4*)(sp + 4);
            vv[2 * p] = *(const u32x4*)(proj + tok * INW + C_VR + h * 256 + ch * 8); vv[2 * p + 1] = *(const u32x4*)(proj + tok * INW + C_VR + h * 256 + (ch + 16) * 8); }
#pragma unroll
        for (int p = 0; p < 4; ++p) { const int j = p * 32 + rowi;
            float o[8]; rot8v(kown[p], kpar[p], ch, c0[p], c1[p], s0[p], s1[p], 0.08838834764831845f, o);
            u32x4 ov; ov.x = cvt_pk_bf16(o[0], o[1]); ov.y = cvt_pk_bf16(o[2], o[3]); ov.z = cvt_pk_bf16(o[4], o[5]); ov.w = cvt_pk_bf16(o[6], o[7]);
            *(LAS u32x4*)(KS + j * 136 + ch * 8) = ov; }
#pragma unroll
        for (int p = 0; p < 4; ++p) { const int j = p * 32 + rowi;
#pragma unroll
            for (int c2 = 0; c2 < 2; ++c2) { const int chv = ch + 16 * c2; const u32x4 x = vv[2 * p + c2];
                *(LAS u32x4*)(VS + j * 264 + chv * 8) = x; } }
    }
    const int iq = 16 * w + ql; const unsigned tq = (unsigned)(n * 128 + iq);
    bf16x8 qf[4];
    {
        u32x4 qv[4]; float f[4][8];
#pragma unroll
        for (int ds = 0; ds < 4; ++ds) qv[ds] = *(const u32x4*)(proj + tq * INW + C_QR + h * 128 + 32 * ds + 8 * g4);
#pragma unroll
        for (int ds = 0; ds < 4; ++ds) { f[ds][0] = bf2f(qv[ds].x & 0xffffu); f[ds][1] = bf2f(qv[ds].x >> 16); f[ds][2] = bf2f(qv[ds].y & 0xffffu); f[ds][3] = bf2f(qv[ds].y >> 16);
            f[ds][4] = bf2f(qv[ds].z & 0xffffu); f[ds][5] = bf2f(qv[ds].z >> 16); f[ds][6] = bf2f(qv[ds].w & 0xffffu); f[ds][7] = bf2f(qv[ds].w >> 16); }
        const float xi = exp2f(lg2 * (float)(iq + 1));
#pragma unroll
        for (int ds = 0; ds < 2; ++ds) {
            const float* cp = rc + tq * 64 + 32 * ds + 8 * g4; const float* sp = rsn + tq * 64 + 32 * ds + 8 * g4;
            const f32x4 c0 = *(const f32x4*)cp, c1 = *(const f32x4*)(cp + 4), s0 = *(const f32x4*)sp, s1 = *(const f32x4*)(sp + 4);
            const float cv[8] = {c0.x, c0.y, c0.z, c0.w, c1.x, c1.y, c1.z, c1.w}, sv[8] = {s0.x, s0.y, s0.z, s0.w, s1.x, s1.y, s1.z, s1.w};
            float lo[8], hi[8];
#pragma unroll
            for (int e = 0; e < 8; ++e) { const float t1 = f[ds][e], t2 = f[ds + 2][e]; lo[e] = t1 * cv[e] - t2 * sv[e]; hi[e] = t1 * sv[e] + t2 * cv[e]; }
            u32x4 o; o.x = cvt_pk_bf16(lo[0], lo[1]); o.y = cvt_pk_bf16(lo[2], lo[3]); o.z = cvt_pk_bf16(lo[4], lo[5]); o.w = cvt_pk_bf16(lo[6], lo[7]); qf[ds] = __builtin_bit_cast(bf16x8, o);
            o.x = cvt_pk_bf16(hi[0], hi[1]); o.y = cvt_pk_bf16(hi[2], hi[3]); o.z = cvt_pk_bf16(hi[4], hi[5]); o.w = cvt_pk_bf16(hi[6], hi[7]); qf[ds + 2] = __builtin_bit_cast(bf16x8, o);
            o.x = cvt_pk_bf16(lo[0] * xi, lo[1] * xi); o.y = cvt_pk_bf16(lo[2] * xi, lo[3] * xi); o.z = cvt_pk_bf16(lo[4] * xi, lo[5] * xi); o.w = cvt_pk_bf16(lo[6] * xi, lo[7] * xi);
            *(LAS u32x4*)(QS + iq * 136 + 32 * ds + 8 * g4) = o;
            o.x = cvt_pk_bf16(hi[0] * xi, hi[1] * xi); o.y = cvt_pk_bf16(hi[2] * xi, hi[3] * xi); o.z = cvt_pk_bf16(hi[4] * xi, hi[5] * xi); o.w = cvt_pk_bf16(hi[6] * xi, hi[7] * xi);
            *(LAS u32x4*)(QS + iq * 136 + 32 * (ds + 2) + 8 * g4) = o;
        }
    }
    bf16x8 pr[2][4];
#pragma unroll
    for (int a = 0; a < 2; ++a)
#pragma unroll
        for (int ds = 0; ds < 4; ++ds) pr[a][ds] = *(const bf16x8*)(prev + ((2 * w + a) * 16 + ql) * 128 + 32 * ds + 8 * g4);
    __syncthreads();
    f32x4 sc[8];
#pragma unroll
    for (int kt = 0; kt < 8; ++kt) { f32x4 a = (f32x4){0.f, 0.f, 0.f, 0.f};
#pragma unroll
        for (int ds = 0; ds < 4; ++ds) { const bf16x8 kf = *(const LAS bf16x8*)(KS + (16 * kt + ql) * 136 + 32 * ds + 8 * g4); a = mfma16(kf, qf[ds], a); }
#pragma unroll
        for (int i = 0; i < 4; ++i) { const int j = 16 * kt + 4 * g4 + i; const int df = iq - j; a[i] = (df >= 0) ? a[i] * exp2f(lg2 * (float)df) : 0.f; }
        sc[kt] = a; }
    __syncthreads();
#pragma unroll
    for (int kt = 0; kt < 8; ++kt) { u32x2 o; o.x = cvt_pk_bf16(sc[kt][0], sc[kt][1]); o.y = cvt_pk_bf16(sc[kt][2], sc[kt][3]); *(LAS u32x2*)(KS + iq * 136 + 16 * kt + 4 * g4) = o; }
    __syncthreads();
    f32x4 acc[2][8];
#pragma unroll
    for (int a = 0; a < 2; ++a)
#pragma unroll
        for (int qt = 0; qt < 8; ++qt) acc[a][qt] = (f32x4){0.f, 0.f, 0.f, 0.f};
#pragma unroll
    for (int ds = 0; ds < 4; ++ds)
#pragma unroll
        for (int qt = 0; qt < 8; ++qt) { const bf16x8 bq = *(const LAS bf16x8*)(QS + (qt * 16 + ql) * 136 + 32 * ds + 8 * g4);
            acc[0][qt] = mfma16(pr[0][ds], bq, acc[0][qt]); acc[1][qt] = mfma16(pr[1][ds], bq, acc[1][qt]); }
    const unsigned vbw = (unsigned)(size_t)VS + (unsigned)(((8 * g4 + (ql >> 2)) * 264 + 4 * (ql & 3) + 32 * w) * 2);
#pragma unroll
    for (int s = 0; s < 4; ++s) {
        u32x2 vl[2], vh[2];
#pragma unroll
        for (int a = 0; a < 2; ++a) { TR_READ(vl[a], vbw, (32 * s * 264 + a * 16) * 2); TR_READ(vh[a], vbw, ((32 * s + 4) * 264 + a * 16) * 2); }
        TR_WAIT4(vl[0], vh[0], vl[1], vh[1]);
        const bf16x8 vf0 = pk_frag(vl[0], vh[0]), vf1 = pk_frag(vl[1], vh[1]);
#pragma unroll
        for (int qt = 0; qt < 8; ++qt) if (qt >= 2 * s) { const bf16x8 bp = *(const LAS bf16x8*)(KS + (qt * 16 + ql) * 136 + 32 * s + 8 * g4);
            acc[0][qt] = mfma16(vf0, bp, acc[0][qt]); acc[1][qt] = mfma16(vf1, bp, acc[1][qt]); }
    }
#pragma unroll
    for (int qt = 0; qt < 8; ++qt) { float s1 = 0.f, s2 = 0.f;
#pragma unroll
        for (int a = 0; a < 2; ++a)
#pragma unroll
            for (int i = 0; i < 4; ++i) { const float x = acc[a][qt][i]; s1 += x; s2 += x * x; }
        s1 += __shfl_xor(s1, 16); s1 += __shfl_xor(s1, 32); s2 += __shfl_xor(s2, 16); s2 += __shfl_xor(s2, 32);
        if (g4 == 0) *(LAS f32x2*)(RED + (w * 128 + qt * 16 + ql) * 2) = (f32x2){s1, s2}; }
    __syncthreads();
    if (F.tid < 128) { float s1 = 0.f, s2 = 0.f;
#pragma unroll
        for (int ww = 0; ww < 8; ++ww) { const f32x2 v = *(const LAS f32x2*)(RED + (ww * 128 + F.tid) * 2); s1 += v.x; s2 += v.y; }
        const float mean = s1 * (1.f / 256.f); float var = s2 * (1.f / 256.f) - mean * mean; var = var > 0.f ? var : 0.f;
        *(LAS f32x2*)(TOT + F.tid * 2) = (f32x2){mean, 1.0f / sqrtf(var + 1e-5f)}; }
    __syncthreads();
    LAS bf16_t* OT = VS;
#pragma unroll
    for (int qt = 0; qt < 8; ++qt) { const f32x2 st = *(const LAS f32x2*)(TOT + (qt * 16 + ql) * 2);
#pragma unroll
        for (int a = 0; a < 2; ++a) { u32x2 o; o.x = cvt_pk_bf16((acc[a][qt][0] - st.x) * st.y, (acc[a][qt][1] - st.x) * st.y); o.y = cvt_pk_bf16((acc[a][qt][2] - st.x) * st.y, (acc[a][qt][3] - st.x) * st.y);
            *(LAS u32x2*)(OT + (qt * 16 + ql) * 264 + (2 * w + a) * 16 + 4 * g4) = o; } }
    __syncthreads();
    const float* gng = inp(F, IN_GNG) + h * 256;
    {
        const int pc = F.tid & 31;
        const f32x4 gg0 = *(const f32x4*)(gng + pc * 8), gg1 = *(const f32x4*)(gng + pc * 8 + 4);
        u32x4 gv[8];
#pragma unroll
        for (int p = 0; p < 8; ++p) { const unsigned tk = (unsigned)(n * 128 + p * 16 + (F.tid >> 5)); gv[p] = *(const u32x4*)(proj + tk * INW + C_GR + h * 256 + pc * 8); }
#pragma unroll
        for (int p = 0; p < 8; ++p) { const int row = p * 16 + (F.tid >> 5); const unsigned tk = (unsigned)(n * 128 + row);
            const u32x4 x = *(const LAS u32x4*)(OT + row * 264 + pc * 8); u32x4 o;
            o.x = cvt_pk_bf16(bf2f(x.x & 0xffffu) * gg0.x * fsilu(bf2f(gv[p].x & 0xffffu)), bf2f(x.x >> 16) * gg0.y * fsilu(bf2f(gv[p].x >> 16)));
            o.y = cvt_pk_bf16(bf2f(x.y & 0xffffu) * gg0.z * fsilu(bf2f(gv[p].y & 0xffffu)), bf2f(x.y >> 16) * gg0.w * fsilu(bf2f(gv[p].y >> 16)));
            o.z = cvt_pk_bf16(bf2f(x.z & 0xffffu) * gg1.x * fsilu(bf2f(gv[p].z & 0xffffu)), bf2f(x.z >> 16) * gg1.y * fsilu(bf2f(gv[p].z >> 16)));
            o.w = cvt_pk_bf16(bf2f(x.w & 0xffffu) * gg1.z * fsilu(bf2f(gv[p].w & 0xffffu)), bf2f(x.w >> 16) * gg1.w * fsilu(bf2f(gv[p].w >> 16)));
            *(u32x4*)((bf16_t*)(F.ws + WS_YB) + tk * D + h * 256 + pc * 8) = o; }
    }
    __syncthreads();
}
__device__ __forceinline__ void comb_item(const Ctx& F, int it) {
    const bf16_t* og = (const bf16_t*)(F.ws + WS_OG); const float* lse = (const float*)(F.ws + WS_LSE); bf16_t* ya = (bf16_t*)(F.ws + WS_YA);
    for (int rr = 0; rr < 4; ++rr) { const size_t t = (size_t)it * 32 + F.wave * 4 + rr; const int hh = F.lane >> 3;
        const float l0 = lse[(0 * (size_t)S + t) * 8 + hh], l1 = lse[(1 * (size_t)S + t) * 8 + hh], l2 = lse[(2 * (size_t)S + t) * 8 + hh];
        const float m = fmaxf(l0, fmaxf(l1, l2)); float a0 = __expf(l0 - m), a1 = __expf(l1 - m), a2 = __expf(l2 - m); const float inv = 1.f / (a0 + a1 + a2); a0 *= inv; a1 *= inv; a2 *= inv;
#pragma unroll
        for (int c = 0; c < 2; ++c) { const size_t e = t * 1024 + F.lane * 16 + c * 8;
            const u32x4 v0 = *(const u32x4*)(og + e), v1 = *(const u32x4*)(og + (size_t)S * 1024 + e), v2 = *(const u32x4*)(og + 2 * (size_t)S * 1024 + e);
            u32x4 o;
            o.x = cvt_pk_bf16(a0 * bf2f(v0.x & 0xffffu) + a1 * bf2f(v1.x & 0xffffu) + a2 * bf2f(v2.x & 0xffffu), a0 * bf2f(v0.x >> 16) + a1 * bf2f(v1.x >> 16) + a2 * bf2f(v2.x >> 16));
            o.y = cvt_pk_bf16(a0 * bf2f(v0.y & 0xffffu) + a1 * bf2f(v1.y & 0xffffu) + a2 * bf2f(v2.y & 0xffffu), a0 * bf2f(v0.y >> 16) + a1 * bf2f(v1.y >> 16) + a2 * bf2f(v2.y >> 16));
            o.z = cvt_pk_bf16(a0 * bf2f(v0.z & 0xffffu) + a1 * bf2f(v1.z & 0xffffu) + a2 * bf2f(v2.z & 0xffffu), a0 * bf2f(v0.z >> 16) + a1 * bf2f(v1.z >> 16) + a2 * bf2f(v2.z >> 16));
            o.w = cvt_pk_bf16(a0 * bf2f(v0.w & 0xffffu) + a1 * bf2f(v1.w & 0xffffu) + a2 * bf2f(v2.w & 0xffffu), a0 * bf2f(v0.w >> 16) + a1 * bf2f(v1.w >> 16) + a2 * bf2f(v2.w >> 16));
            *(u32x4*)(ya + e) = o; } }
}
__device__ __forceinline__ void p4_scan_comb(const Ctx& F) {
    p4_scan(F);
    for (int it = F.bx; it < 256; it += F.G) comb_item(F, it);
}
__device__ __forceinline__ void p5_mix2(const Ctx& F) {
    for (int it = F.bx; it < 512; it += F.G) ret_unit(F, it);
    if (DUP2_MASK & 1) { __syncthreads(); for (int it = F.bx; it < 512; it += F.G) ret_unit(F, it); }
}

__device__ __forceinline__ void p8_router(const Ctx& F) {
    LAS float* gs = (LAS float*)F.lds; LAS float* sh = gs + D; LAS float* XS = sh + D; LAS float* WSm = XS + 32 * 260; LAS float* SC = WSm + 256 * 64; LAS float* SEL = SC + 32 * 64; LAS float* RSTD = SEL + 32 * 64;
    const float* modf = (const float*)(F.ws + WS_MODF);
    for (int k = F.tid; k < D; k += 512) { gs[k] = inp(F, IN_LN2)[k] * (1.f + modf[4 * D + k]); sh[k] = modf[3 * D + k]; }
    __syncthreads();
    const float* x1 = F.out; unsigned char* H2 = F.ws + WS_H;
    const float* rw = inp(F, IN_RW); const float* rb = inp(F, IN_RB);
    int* e_of = (int*)(F.ws + WS_EOF); int* pos_of = e_of + 65536; float* topw = (float*)(pos_of + 65536);
    unsigned* cnt = (unsigned*)(F.ws + WS_CTL) + CW_CNT;
    for (int it = F.bx; it < 256; it += F.G) {
        const int t0 = it * 32;
#pragma unroll 1
        for (int rr = 0; rr < 4; ++rr) { const int m = t0 + F.wave * 4 + rr;
            const GAS f32x4* xr = (const GAS f32x4*)(x1 + (size_t)m * D) + F.lane;
            f32x4 v[8]; float ss = 0.f;
#pragma unroll
            for (int j = 0; j < 8; ++j) { v[j] = xr[64 * j]; ss += (v[j].x * v[j].x + v[j].y * v[j].y) + (v[j].z * v[j].z + v[j].w * v[j].w); }
#pragma unroll
            for (int o = 1; o < 64; o <<= 1) ss += __shfl_xor(ss, o);
            const float rstd = 1.0f / sqrtf(ss * (1.f / D) + 1e-6f);
            if (F.lane == 0) RSTD[F.wave * 4 + rr] = rstd;
            GAS unsigned* o4 = (GAS unsigned*)(H2 + (size_t)m * D) + F.lane;
#pragma unroll
            for (int j = 0; j < 8; ++j) { const f32x4 g = *(const LAS f32x4*)(gs + 256 * j + 4 * F.lane), s = *(const LAS f32x4*)(sh + 256 * j + 4 * F.lane);
                const f32x4 y = v[j] * rstd * g + s; o4[64 * j] = cvt4_fp8(y.x, y.y, y.z, y.w); } }
        __syncthreads();
        const int tok = F.tid >> 4, eq = F.tid & 15;
        f32x16 ac0, ac1;
#pragma unroll
        for (int i = 0; i < 16; ++i) { ac0[i] = 0.f; ac1[i] = 0.f; }
#pragma unroll 1
        for (int kc = 0; kc < 8; ++kc) {
#pragma unroll
            for (int q = 0; q < 4; ++q) { const int idx = F.tid + 512 * q; const int row = idx >> 6, c4 = (idx & 63) * 4; const int k = kc * 256 + c4;
                const f32x4 xv = *(const f32x4*)(x1 + (size_t)(t0 + row) * D + k); const float rstd = RSTD[row];
                const f32x4 g = *(const LAS f32x4*)(gs + k), s = *(const LAS f32x4*)(sh + k);
                *(LAS f32x4*)(XS + row * 260 + c4) = xv * rstd * g + s; }
#pragma unroll
            for (int q = 0; q < 8; ++q) { const int idx = F.tid + 512 * q; const int kr = idx >> 4, c4 = (idx & 15) * 4;
                *(LAS f32x4*)(WSm + kr * 64 + c4) = *(const f32x4*)(rw + (size_t)(kc * 256 + kr) * 64 + c4); }
            __syncthreads();
            { const int i31 = F.lane & 31, kh = F.lane >> 5;
#pragma unroll 4
              for (int kp = 0; kp < 16; ++kp) { const int k = 32 * F.wave + 2 * kp + kh;
                  const float av = XS[i31 * 260 + k]; const float b0 = WSm[k * 64 + i31], b1 = WSm[k * 64 + 32 + i31];
                  ac0 = __builtin_amdgcn_mfma_f32_32x32x2f32(av, b0, ac0, 0, 0, 0); ac1 = __builtin_amdgcn_mfma_f32_32x32x2f32(av, b1, ac1, 0, 0, 0); } }
            __syncthreads();
        }
        { LAS float* RED = WSm + F.wave * 2048; const int i31 = F.lane & 31, kh = F.lane >> 5;
#pragma unroll
          for (int rg = 0; rg < 16; ++rg) { const int row = (rg & 3) + 8 * (rg >> 2) + 4 * kh; RED[row * 64 + i31] = ac0[rg]; RED[row * 64 + 32 + i31] = ac1[rg]; } }
        __syncthreads();
        f32x4 lg = (f32x4){0.f, 0.f, 0.f, 0.f};
#pragma unroll
        for (int w = 0; w < 8; ++w) lg += *(const LAS f32x4*)(WSm + w * 2048 + tok * 64 + eq * 4);
#pragma unroll
        for (int i = 0; i < 4; ++i) { const float sc = fsigm(lg[i]); SC[tok * 64 + eq * 4 + i] = sc; SEL[tok * 64 + eq * 4 + i] = sc + rb[eq * 4 + i]; }
        __syncthreads();
        if (F.tid < 32) {
            LAS float* sel = SEL + F.tid * 64; const LAS float* scp = SC + F.tid * 64;
            float gsc[8];
#pragma unroll
            for (int g = 0; g < 8; ++g) { float m1 = -3e38f, m2 = -3e38f;
#pragma unroll
                for (int j = 0; j < 8; ++j) { const float v = sel[g * 8 + j]; if (v > m1) { m2 = m1; m1 = v; } else if (v > m2) m2 = v; }
                gsc[g] = m1 + m2; }
            unsigned gmask = 0u;
#pragma unroll
            for (int r = 0; r < 4; ++r) { float best = -3e38f; int bi = 0;
#pragma unroll
                for (int g = 0; g < 8; ++g) { const bool take = !((gmask >> g) & 1u) && gsc[g] > best; best = take ? gsc[g] : best; bi = take ? g : bi; }
                gmask |= 1u << bi; }
            int idx[8]; float wv[8]; float wsum = 0.f;
#pragma unroll
            for (int r = 0; r < 8; ++r) { float best = -3e38f; int bi = 0;
                for (int e = 0; e < 64; ++e) { const float v = sel[e]; const bool take = ((gmask >> (e >> 3)) & 1u) && v > best; best = take ? v : best; bi = take ? e : bi; }
                sel[bi] = -3e38f; idx[r] = bi; wv[r] = scp[bi]; wsum += wv[r]; }
            const float sc = 2.5f / wsum; const int tk = t0 + F.tid;
#pragma unroll
            for (int r = 0; r < 8; ++r) { const unsigned pos = __hip_atomic_fetch_add(cnt + idx[r], 1u, __ATOMIC_RELAXED, __HIP_MEMORY_SCOPE_AGENT);
                e_of[tk * 8 + r] = idx[r]; pos_of[tk * 8 + r] = (int)pos; topw[tk * 8 + r] = wv[r] * sc; }
        }
        __syncthreads();
    }
}

__device__ __forceinline__ void build_moe_tab(const Ctx& F) {
    MoeTab tab = moe_tab(F.lds);
    LAS int* padstart = tab.misc + 8;
    if (F.tid < 64) {
        unsigned* cnt = (unsigned*)(F.ws + WS_CTL) + CW_CNT;
        const int c = (int)__hip_atomic_load(cnt + F.tid, __ATOMIC_RELAXED, __HIP_MEMORY_SCOPE_AGENT);
        const int nt = (c + 255) >> 8; int pre = nt;
#pragma unroll
        for (int o = 1; o < 64; o <<= 1) { const int v = __shfl_up(pre, o); if (F.tid >= o) pre += v; }
        const int excl = pre - nt;
        padstart[F.tid] = excl * 256;
        for (int r = 0; r < nt; ++r) { tab.te[excl + r] = F.tid; const int left = c - r * 256; tab.tn[excl + r] = left < 256 ? left : 256; }
        if (F.tid == 63) tab.misc[0] = pre;
    }
    __syncthreads();
}
__device__ __forceinline__ void p9_dispatch(const Ctx& F) {
    build_moe_tab(F);
    const LAS int* padstart = moe_tab(F.lds).misc + 8;
    const int* e_of = (const int*)(F.ws + WS_EOF); const int* pos_of = e_of + 65536; const float* topw = (const float*)(pos_of + 65536); int* inv = (int*)(topw + 65536);
    int* toks = (int*)(F.ws + WS_TOKS); float* wsorted = (float*)(toks + SH_ROW0);
    for (int i = F.bx * 512 + F.tid; i < 65536; i += F.G * 512) { const int e = e_of[i]; const int dest = padstart[e] + pos_of[i]; toks[dest] = i >> 3; wsorted[dest] = topw[i]; inv[i] = dest; }
}
__device__ __forceinline__ void p12_combine(const Ctx& F) {
    const bf16_t* Y = (const bf16_t*)(F.ws + WS_Y); const int* inv = (const int*)(F.ws + WS_EOF) + 3 * 65536; const float* g2 = (const float*)(F.ws + WS_MODF) + 5 * D;
    const int gw = F.vcu * 8 + F.wave, NGW = F.G * 8;
    for (int m = gw; m < S; m += NGW) {
        int rows[9];
#pragma unroll
        for (int s = 0; s < 8; ++s) rows[s] = inv[m * 8 + s];
        rows[8] = SH_ROW0 + m;
#pragma unroll
        for (int c = 0; c < 4; ++c) { const int col = c * 512 + F.lane * 8;
            float a[8] = {0.f, 0.f, 0.f, 0.f, 0.f, 0.f, 0.f, 0.f};
#pragma unroll
            for (int s = 0; s < 9; ++s) { const u32x4 v = *(const u32x4*)(Y + (size_t)rows[s] * D + col);
                a[0] += bf2f(v.x & 0xffffu); a[1] += bf2f(v.x >> 16); a[2] += bf2f(v.y & 0xffffu); a[3] += bf2f(v.y >> 16); a[4] += bf2f(v.z & 0xffffu); a[5] += bf2f(v.z >> 16); a[6] += bf2f(v.w & 0xffffu); a[7] += bf2f(v.w >> 16); }
            float* op = F.out + (size_t)m * D + col; const f32x4 x0 = *(const f32x4*)op, x1 = *(const f32x4*)(op + 4); const f32x4 ga = *(const f32x4*)(g2 + col), gb = *(const f32x4*)(g2 + col + 4);
            *(f32x4*)op = x0 + ga * (f32x4){a[0], a[1], a[2], a[3]}; *(f32x4*)(op + 4) = x1 + gb * (f32x4){a[4], a[5], a[6], a[7]}; }
    }
}


__device__ __forceinline__ void ph2_proj(const Ctx& F) {
    pg8::DenseSched Sd; Sd.init(F.ws + WS_H, D, F.ws + WS_WINT, S, INW, D, F.G, F.bx);
    EpiBf16 E{(bf16_t*)(F.ws + WS_PROJ), INW, 0};
    const int nun = (Sd.nwg - F.bx + F.G - 1) / F.G;
    const int slot = nun > 0 ? ((F.bx >> 3) + (F.bx & 7)) % nun : 0;
    Sd.i_lo = 0; Sd.i_hi = slot;
    pg8::gemm_phase<EpiBf16, pg8::DenseSched, true>(F.lds, D, Sd, E);
    __syncthreads();
    convert_items(F, CV_BG_FROM, CV_ALL, F.vcu * 8 + F.wave, F.G * 8);
    __syncthreads();
    Sd.i_lo = slot; Sd.i_hi = nun;
    pg8::gemm_phase<EpiBf16, pg8::DenseSched, true>(F.lds, D, Sd, E);
    if (DUP2_MASK & 48) { __syncthreads(); EpiBf16 E2{(bf16_t*)(F.ws + WS_PROJ), INW, (DUP2_MASK & 32) ? 1 : 0}; Sd.i_lo = 0; Sd.i_hi = nun; pg8::gemm_phase<EpiBf16, pg8::DenseSched, true>(F.lds, D, Sd, E2); }
}
__device__ __forceinline__ void ph6a_merge(const Ctx& F) {
    pg8::DenseSched Sd; Sd.init(F.ws + WS_YA, 1024, F.ws + WS_PA, S, D, 1024, F.G, F.bx);
    EpiGate<false> E{(bf16_t*)(F.ws + WS_MERGED), D, (const bf16_t*)(F.ws + WS_PROJ) + C_GA, INW};
    pg8::gemm_phase<EpiGate<false>, pg8::DenseSched, true>(F.lds, 1024, Sd, E);
}
__device__ __forceinline__ void ph6_merge(const Ctx& F) {
    pg8::DenseSched Sd; Sd.init(F.ws + WS_YB, D, F.ws + WS_PB, S, D, D, F.G, F.bx);
    EpiGate<true> E{(bf16_t*)(F.ws + WS_MERGED), D, (const bf16_t*)(F.ws + WS_PROJ) + C_GB, INW};
    pg8::gemm_phase<EpiGate<true>, pg8::DenseSched, true>(F.lds, D, Sd, E);
}
__device__ __forceinline__ void p5_mix2_a(const Ctx& F) { p5_mix2(F); __syncthreads(); ph6a_merge(F); }
__device__ __forceinline__ void ph7_wo(const Ctx& F) {
    pg8::DenseSched Sd; Sd.init(F.ws + WS_MERGED, D, F.ws + WS_WO, S, D, D, F.G, F.bx);
    EpiResid E{inp(F, IN_X), F.out, D, (const float*)(F.ws + WS_MODF) + 2 * D};
    pg8::gemm_phase<EpiResid, pg8::DenseSched, true>(F.lds, D, Sd, E);
}
__device__ __forceinline__ void ph10_gateup(const Ctx& F) {
    build_moe_tab(F);
    MoeSched1 S1{(const char*)(F.ws + WS_H), (const char*)(F.ws + WS_E1), (const int*)(F.ws + WS_TOKS), moe_tab(F.lds), F.G, F.vcu};
    EpiGateUp E{(unsigned char*)(F.ws + WS_ACT)};
    pg8::gemm_phase<EpiGateUp, MoeSched1, true, true>(F.lds, D, S1, E);
}
__device__ __forceinline__ void ph11_down(const Ctx& F) {
    build_moe_tab(F);
    MoeSched2 S2{(const char*)(F.ws + WS_ACT), (const char*)(F.ws + WS_E2), moe_tab(F.lds), F.G, F.vcu};
    EpiDown E{(bf16_t*)(F.ws + WS_Y), (const float*)(F.ws + WS_TOKS) + SH_ROW0};
    pg8::gemm_phase<EpiDown, MoeSched2, true, true>(F.lds, ED, S2, E);
}

struct Args { const float* in[22]; float* out; unsigned char* ws; int ph_lo, ph_hi; };
__global__ void __launch_bounds__(512, 2) fwd(Args args) {
    extern __shared__ __attribute__((aligned(16))) unsigned char lds_raw[];
    Ctx F;
    F.lds = (LAS unsigned char*)lds_raw;
    F.tid = threadIdx.x; F.lane = F.tid & 63; F.wave = __builtin_amdgcn_readfirstlane(F.tid >> 6);
    F.G = gridDim.x; F.bx = blockIdx.x; F.vcu = (F.G % 8 == 0) ? (F.bx % 8) * (F.G / 8) + F.bx / 8 : F.bx;
    F.out = args.out; F.ws = args.ws;
    if (F.tid == 0) {
#pragma unroll
        for (int i = 0; i < 22; ++i) ((LAS unsigned long long*)(F.lds + LDS_PTRS))[i] = (unsigned long long)args.in[i];
    }
    volatile LAS unsigned* MISC = (volatile LAS unsigned*)(F.lds + LDS_MISC);
    if (F.tid < 64) MISC[F.tid] = 0u;
    __syncthreads();
    unsigned* ctl = (unsigned*)(F.ws + WS_CTL);
    XcdBarrier bar; bar.bar = ctl + CW_BAR; bar.x = 0; bar.st = nullptr;
    if (!MK_PER_PHASE) bar = xcd_barrier_post(ctl + CW_BAR, MISC + 8);
    const int lo = args.ph_lo, hi = args.ph_hi;
#ifndef PHASE_MASK
#define PHASE_MASK 0x1fff
#endif
#define IN(k) (((PHASE_MASK >> (k)) & 1) && lo <= (k) && (k) < hi)
#define SEAM(k) do { if (IN(k) && IN((k) + 1)) xcd_barrier(bar); } while (0)

#ifndef DUP_MASK
#define DUP_MASK 0
#endif
#define RUN(k, fn) do { if (IN(k)) { fn(F); if ((DUP_MASK >> (k)) & 1) { xcd_barrier(bar); fn(F); } } SEAM(k); } while (0)
    RUN(0, p0_prologue);
    RUN(1, p1_norm1);
    RUN(2, ph2_proj);
    RUN(3, p3_mix1);
    RUN(4, p4_scan_comb);
    RUN(5, p5_mix2_a);
    RUN(6, ph6_merge);
    RUN(7, ph7_wo);
    RUN(8, p8_router);
    RUN(9, p9_dispatch);
    RUN(10, ph10_gateup);
    RUN(11, ph11_down);
    RUN(12, p12_combine);
#undef RUN
#undef IN
#undef SEAM
}

extern "C" void kernel_launch(void* const* d_in, const int* in_sizes, int n_in, void* d_out, int out_size, void* d_ws, size_t ws_size, hipStream_t stream) {
    static int grid = 0;
    if (grid == 0) {
        if (n_in != 22 || out_size != S * D || ws_size < WS_END) { fprintf(stderr, "kernel_launch: unexpected shapes / workspace (n_in %d out %d ws %zu need %zu)\n", n_in, out_size, ws_size, (size_t)WS_END); grid = -1; return; }
        int dev = 0, cus = 0, per_cu = 0;
        if (hipGetDevice(&dev) != hipSuccess || hipDeviceGetAttribute(&cus, hipDeviceAttributeMultiprocessorCount, dev) != hipSuccess) { grid = -1; return; }
        if (hipFuncSetAttribute((const void*)fwd, hipFuncAttributeMaxDynamicSharedMemorySize, LDS_BYTES) != hipSuccess) { fprintf(stderr, "kernel_launch: hipFuncSetAttribute failed\n"); grid = -1; return; }
        if (hipOccupancyMaxActiveBlocksPerMultiprocessor(&per_cu, (const void*)fwd, 512, LDS_BYTES) != hipSuccess || per_cu < 1) fprintf(stderr, "kernel_launch: occupancy query says %d\n", per_cu);
        (void)hipGetLastError();
        grid = cus;
    }
    if (grid < 0) return;
    (void)hipMemsetAsync((char*)d_ws + WS_CTL, 0, CTL_ZERO_BYTES, stream);
    Args a{};
    for (int i = 0; i < 22; ++i) a.in[i] = (const float*)d_in[i];
    a.out = (float*)d_out; a.ws = (unsigned char*)d_ws;
#if MK_PER_PHASE
    for (int p = 0; p < NPH; ++p) { a.ph_lo = p; a.ph_hi = p + 1; hipLaunchKernelGGL(fwd, dim3(grid), dim3(512), LDS_BYTES, stream, a); }
#else
    a.ph_lo = 0; a.ph_hi = NPH; hipLaunchKernelGGL(fwd, dim3(grid), dim3(512), LDS_BYTES, stream, a);
#endif
}
```

```cpp
#include <hip/hip_runtime.h>
#include <cstdio>
#include <cstdint>

#define LAS __attribute__((address_space(3)))
#define GAS __attribute__((address_space(1)))
typedef unsigned short bf16_t;
typedef short bf16x8 __attribute__((ext_vector_type(8)));
typedef short bf16x4 __attribute__((ext_vector_type(4)));
typedef float f32x4 __attribute__((ext_vector_type(4)));
typedef float f32x2 __attribute__((ext_vector_type(2)));
typedef float f32x16 __attribute__((ext_vector_type(16)));
typedef unsigned u32x4 __attribute__((ext_vector_type(4)));
typedef unsigned u32x2 __attribute__((ext_vector_type(2)));
typedef GAS unsigned gu32;

#ifndef DUP2_MASK
#define DUP2_MASK 0
#endif
#ifndef MK_PER_PHASE
#define MK_PER_PHASE 0
#endif

constexpr int S = 8192, D = 2048, INW = 19456;
constexpr int C_QA = 0, C_KA = 3072, C_VA = 6144, C_QR = 9216, C_KR = 10240, C_VR = 11264, C_GR = 13312, C_GA = 15360, C_GB = 17408;
constexpr int NE = 64, ED = 512, TOPK = 8;
constexpr int MAXT_R = 320;
constexpr int SH_ROW0 = MAXT_R * 256;
constexpr int NROWS_Y = SH_ROW0 + S;
constexpr int NPH = 13;

constexpr size_t MiB = 1u << 20;
constexpr size_t WS_CTL = 0, CTL_ZERO_BYTES = 1 * MiB;
constexpr size_t WS_MODP = 1 * MiB;
constexpr size_t WS_MODF = 1 * MiB + 512 * 1024;
constexpr size_t WS_LSE = 2 * MiB;
constexpr size_t WS_ROPE = 3 * MiB;
constexpr size_t WS_EOF = 7 * MiB;
constexpr size_t WS_TOKS = 8 * MiB;
constexpr size_t WS_PA = 10 * MiB, WS_PB = 14 * MiB, WS_WO = 22 * MiB;
constexpr size_t WS_H = 32 * MiB;
constexpr size_t WS_E1 = 64 * MiB;
constexpr size_t WS_E2 = 324 * MiB;
constexpr size_t WS_PREV = 454 * MiB;
constexpr size_t WS_YB = 486 * MiB;
constexpr size_t WS_MERGED = 518 * MiB;
constexpr size_t WS_R1 = 550 * MiB;
constexpr size_t WS_OG = WS_R1, WS_YA = WS_R1 + 48 * MiB, WS_UPD = WS_R1 + 64 * MiB, WS_ACT = WS_R1;
constexpr size_t WS_R2 = 678 * MiB;
constexpr size_t WS_WINT = WS_R2, WS_PROJ = WS_R2 + 76 * MiB, WS_Y = WS_R2;
constexpr size_t WS_END = 1058 * MiB;
constexpr int CW_TMO = 0, CW_CODE = 1, CW_BAR = 4096, CW_CNT = 8192;

constexpr int RING_BYTES = 131072;
constexpr int LDS_TAB = 131072;
constexpr int LDS_MISC = 163840 - 256;
constexpr int LDS_BYTES = 163840;

__device__ __forceinline__ float bf2f(unsigned b) { return __uint_as_float(b << 16); }
__device__ __forceinline__ unsigned cvt_pk_bf16(float lo, float hi) { unsigned r; asm("v_cvt_pk_bf16_f32 %0, %1, %2" : "=v"(r) : "v"(lo), "v"(hi)); return r; }
__device__ __forceinline__ float fsilu(float v) { return v / (1.f + __expf(-v)); }
__device__ __forceinline__ float fsigm(float v) { return 1.f / (1.f + __expf(-v)); }
#define TR_READ(dst, base, OFF) asm volatile("ds_read_b64_tr_b16 %0, %1 offset:%2" : "=&v"(dst) : "v"(base), "i"(OFF) : "memory")
#define TR_WAIT2(a, b) asm volatile("s_waitcnt lgkmcnt(0)" : "+v"(a), "+v"(b) :: "memory")
#define TR_WAIT4(a, b, c, d) asm volatile("s_waitcnt lgkmcnt(0)" : "+v"(a), "+v"(b), "+v"(c), "+v"(d) :: "memory")
typedef int i32x8 __attribute__((ext_vector_type(8)));
__device__ __forceinline__ unsigned cvt4_fp8(float a, float b, float c, float d) {
    a = fminf(fmaxf(a, -448.f), 448.f); b = fminf(fmaxf(b, -448.f), 448.f); c = fminf(fmaxf(c, -448.f), 448.f); d = fminf(fmaxf(d, -448.f), 448.f);
    int r = __builtin_amdgcn_cvt_pk_fp8_f32(a, b, 0, false); r = __builtin_amdgcn_cvt_pk_fp8_f32(c, d, r, true); return (unsigned)r;
}
__device__ __forceinline__ i32x8 ld32(const LAS unsigned char* p) { const u32x4 a = *(const LAS u32x4*)p, b = *(const LAS u32x4*)(p + 16); i32x8 r; r[0] = (int)a.x; r[1] = (int)a.y; r[2] = (int)a.z; r[3] = (int)a.w; r[4] = (int)b.x; r[5] = (int)b.y; r[6] = (int)b.z; r[7] = (int)b.w; return r; }
__device__ __forceinline__ i32x8 cat8(bf16x8 lo, bf16x8 hi) { const u32x4 a = __builtin_bit_cast(u32x4, lo), b = __builtin_bit_cast(u32x4, hi); i32x8 r; r[0] = (int)a.x; r[1] = (int)a.y; r[2] = (int)a.z; r[3] = (int)a.w; r[4] = (int)b.x; r[5] = (int)b.y; r[6] = (int)b.z; r[7] = (int)b.w; return r; }
constexpr float FP8_WS1 = 32.f, FP8_WS2 = 16.f, FP8_AS = 4.f, FP8_YS = 32.f;
#define LDS_WAIT() asm volatile("s_waitcnt lgkmcnt(0)" ::: "memory")
#define VM_WAIT() asm volatile("s_waitcnt vmcnt(0)" ::: "memory")

namespace pg8 {
constexpr int BM = 256, BK = 64, HALF = 128, HTB = HALF * BK * 2, STAGE_BYTES = 8 * HTB, NXCD = 8, WGM = 8;
__host__ __device__ __forceinline__ int lds_byte(int r, int c) { const int st = (r >> 4) * 2 + (c >> 5), rr = r & 15, cc = c & 31, ob = rr * 64 + cc * 2; return st * 1024 + (ob ^ (((ob >> 9) & 1) << 5)); }
__host__ __device__ __forceinline__ void stage_rc(int b, int& R, int& C) { const int st = b / 1024, sb = b % 1024, swz = sb ^ (((sb >> 9) & 1) << 5); R = (st >> 1) * 16 + swz / 64; C = (st & 1) * 32 + (swz % 64) / 2; }
__host__ __device__ __forceinline__ int perm32(int rho) { const int n = rho >> 4, i = rho & 15; return 8 * (i >> 2) + 4 * n + (i & 3); }

struct Unit { int row0, pn, e, nvalid; };

struct DenseSched {
    static constexpr bool RAGGED = false;
    const char* A; const char* Bt; int lda, K; int nM, nN, nwg, G, c, i_lo, i_hi;
    __device__ __forceinline__ void init(const void* A_, int lda_, const void* Bt_, int M, int N, int K_, int G_, int c_) { A = (const char*)A_; Bt = (const char*)Bt_; lda = lda_; K = K_; nM = M / BM; nN = N / BM; nwg = nM * nN; G = G_; c = c_; i_lo = 0; i_hi = 0x7fffffff; }
    __device__ __forceinline__ bool next(int i, Unit& u) const {
        if (i_lo + i >= i_hi) return false;
        const long L = (long)(i_lo + i) * G + c; if (L >= nwg) return false;
        int wgid = (int)L; { const int q = nwg / NXCD, r = nwg % NXCD, xcd = wgid % NXCD, off = wgid / NXCD; wgid = (xcd < r ? xcd * (q + 1) : r * (q + 1) + (xcd - r) * q) + off; }
        const int nig = WGM * nN, gid = wgid / nig, fm = gid * WGM, gsz = (nM - fm) < WGM ? (nM - fm) : WGM;
        u.row0 = (fm + ((wgid % nig) % gsz)) * BM; u.pn = (wgid % nig) / gsz; u.e = 0; u.nvalid = 256; return true;
    }
    __device__ __forceinline__ const char* a_base() const { return A; }
    __device__ __forceinline__ const char* b_ptr(const Unit& u) const { return Bt + (size_t)u.pn * BM * K * 2; }
    __device__ __forceinline__ void a_off(const Unit& u, int tid, unsigned (&off)[2][2]) const {
#pragma unroll
        for (int i = 0; i < 2; ++i) { int R, C; stage_rc(tid * 16 + i * 8192, R, C);
            off[0][i] = (unsigned)((u.row0 + R) * lda + C) * 2u; off[1][i] = (unsigned)((u.row0 + HALF + R) * lda + C) * 2u; }
    }
};

template <class Epi, class Sched, bool ALIGN_EPI, bool FP8 = false>
__device__ __forceinline__ void gemm_phase(LAS unsigned char* lds, const int K, const Sched& S, const Epi& E) {
    const int tid = threadIdx.x, wid = __builtin_amdgcn_readfirstlane(tid >> 6), lane = tid & 63, wr = wid >> 2, wc = wid & 3, fr = lane & 15, fq = lane >> 4;
    const int nt = FP8 ? K / 128 : K / BK;
    const int pitch = FP8 ? K : 2 * K;
    unsigned voffB[2];
#pragma unroll
    for (int i = 0; i < 2; ++i) { int R, C; stage_rc(tid * 16 + i * 8192, R, C); const int Rb = Epi::PERM ? ((R & ~31) + perm32(R & 31)) : R; voffB[i] = (unsigned)(Rb * pitch + 2 * C); }
    const size_t kstep = (size_t)(BK * 2);
    const size_t hstepB = (size_t)HALF * pitch;
    const unsigned ldsw = (unsigned)wid * 1024u;
    const int aoff = lds_byte(wr * 64 + fr, FP8 ? fq * 16 : fq * 8), boff = lds_byte(wc * 32 + fr, FP8 ? fq * 16 : fq * 8);
#define PG8_SA(b, h) (((b) * 2 + (h)) * HTB)
#define PG8_SB(b, h) ((4 + (b) * 2 + (h)) * HTB)
#define PG8_STAGE(bufoff, gbase, voff) do { _Pragma("unroll") for (int _i = 0; _i < 2; ++_i) \
        __builtin_amdgcn_global_load_lds((const unsigned*)((const char*)(gbase) + (voff)[_i]), (LAS unsigned*)(lds + (bufoff) + ldsw + _i * 8192), 16, 0, 0); } while (0)
#define PG8_LDA(dst, b, h) do { if constexpr (FP8) { _Pragma("unroll") for (int m = 0; m < 4; ++m) dst##8[m] = ld32(lds + PG8_SA(b, h) + aoff + m * 2048); } \
        else { _Pragma("unroll") for (int m = 0; m < 4; ++m) _Pragma("unroll") for (int k = 0; k < 2; ++k) dst[m][k] = *(const LAS bf16x8*)(lds + PG8_SA(b, h) + aoff + m * 2048 + k * 1024); } } while (0)
#define PG8_LDB(dst, b, h) do { if constexpr (FP8) { _Pragma("unroll") for (int n = 0; n < 2; ++n) dst##8[n] = ld32(lds + PG8_SB(b, h) + boff + n * 2048); } \
        else { _Pragma("unroll") for (int n = 0; n < 2; ++n) _Pragma("unroll") for (int k = 0; k < 2; ++k) dst[n][k] = *(const LAS bf16x8*)(lds + PG8_SB(b, h) + boff + n * 2048 + k * 1024); } } while (0)
#define PG8_MMA(ai, bj, At, Bt) do { __builtin_amdgcn_s_setprio(1); if constexpr (FP8) { _Pragma("unroll") for (int m = 0; m < 4; ++m) _Pragma("unroll") for (int n = 0; n < 2; ++n) \
        asm volatile("v_mfma_scale_f32_16x16x128_f8f6f4 %0, %1, %2, %0, %3, %3 op_sel_hi:[0,0,0]" : "+v"(acc[ai][bj][m][n]) : "v"(Bt##8[n]), "v"(At##8[m]), "v"(fp8_one)); } \
      else { _Pragma("unroll") for (int m = 0; m < 4; ++m) _Pragma("unroll") for (int n = 0; n < 2; ++n) _Pragma("unroll") for (int k = 0; k < 2; ++k) \
        acc[ai][bj][m][n] = __builtin_amdgcn_mfma_f32_16x16x32_bf16(Bt[n][k], At[m][k], acc[ai][bj][m][n], 0, 0, 0); } __builtin_amdgcn_s_setprio(0); } while (0)
#define PG8_WAIT_V(n) asm volatile("s_waitcnt vmcnt(" #n ")" ::: "memory")
#define PG8_WAIT_L(n) asm volatile("s_waitcnt lgkmcnt(" #n ")" ::: "memory")
#define PG8_BAR __builtin_amdgcn_s_barrier()
#define PG8_SCHED __builtin_amdgcn_sched_barrier(0)
    Unit cur, nxt; int ui = 0;
    if (!S.next(0, cur)) return;
    f32x4 acc[2][2][4][2];
#pragma unroll
    for (int a = 0; a < 2; ++a)
#pragma unroll
        for (int b = 0; b < 2; ++b)
#pragma unroll
            for (int m = 0; m < 4; ++m)
#pragma unroll
                for (int n = 0; n < 2; ++n) acc[a][b][m][n] = (f32x4){0.f, 0.f, 0.f, 0.f};
    bf16x8 At[4][2], B0[2][2], B1[2][2];
    i32x8 At8[4], B08[2], B18[2];
    const int fp8_one = 0x7f7f7f7f;
    unsigned coff[2][2], noff[2][2];
    S.a_off(cur, tid, coff);
    const char* const Ab = S.a_base();
    const char* cB = S.b_ptr(cur);
    PG8_STAGE(PG8_SB(0, 0), cB, voffB); PG8_STAGE(PG8_SB(0, 1), cB + hstepB, voffB); PG8_STAGE(PG8_SA(0, 0), Ab, coff[0]); PG8_STAGE(PG8_SA(0, 1), Ab, coff[1]);
    if (wr == 1) PG8_BAR;
    PG8_WAIT_V(2); PG8_BAR;
    PG8_STAGE(PG8_SB(1, 0), cB + kstep, voffB); PG8_STAGE(PG8_SA(1, 0), Ab + kstep, coff[0]); PG8_STAGE(PG8_SB(1, 1), cB + hstepB + kstep, voffB);
    PG8_WAIT_V(6); PG8_BAR;
    for (;;) {
        const bool has_next = S.next(ui + 1, nxt);
        const char* nB = has_next ? S.b_ptr(nxt) : cB;
        for (int t = 0; t < nt; t += 2) {
            const bool last = (t == nt - 2);
            const char* a1 = Ab + (size_t)(t + 1) * kstep;
            const char* a2 = last ? Ab : Ab + (size_t)(t + 2) * kstep; const char* b2 = last ? nB : cB + (size_t)(t + 2) * kstep;
            const char* a3 = a2 + kstep; const char* b3 = b2 + kstep;
            if (last && has_next) S.a_off(nxt, tid, noff);
            PG8_LDB(B0, 0, 0); PG8_LDB(B1, 0, 1); PG8_SCHED; PG8_LDA(At, 0, 0); PG8_STAGE(PG8_SA(1, 1), a1, coff[1]);
            PG8_WAIT_V(8); PG8_WAIT_L(0); PG8_BAR; PG8_MMA(0, 0, At, B0); PG8_MMA(0, 1, At, B1); PG8_BAR; PG8_SCHED;
            if (last && has_next) { coff[0][0] = noff[0][0]; coff[0][1] = noff[0][1]; coff[1][0] = noff[1][0]; coff[1][1] = noff[1][1]; }
            PG8_LDA(At, 0, 1); PG8_STAGE(PG8_SB(0, 0), b2, voffB); PG8_STAGE(PG8_SB(0, 1), b2 + hstepB, voffB); PG8_STAGE(PG8_SA(0, 0), a2, coff[0]);
            PG8_WAIT_V(8); PG8_WAIT_L(0); PG8_BAR; if (!Sched::RAGGED || cur.nvalid > HALF) { PG8_MMA(1, 0, At, B0); PG8_MMA(1, 1, At, B1); } PG8_BAR; PG8_SCHED;
            PG8_LDB(B0, 1, 0); PG8_LDB(B1, 1, 1); PG8_SCHED; PG8_LDA(At, 1, 0); PG8_STAGE(PG8_SA(0, 1), a2, coff[1]);
            PG8_WAIT_V(8); PG8_WAIT_L(0); PG8_BAR; PG8_MMA(0, 0, At, B0); PG8_MMA(0, 1, At, B1); PG8_BAR; PG8_SCHED;
            PG8_LDA(At, 1, 1); PG8_STAGE(PG8_SB(1, 0), b3, voffB); PG8_STAGE(PG8_SB(1, 1), b3 + hstepB, voffB); PG8_STAGE(PG8_SA(1, 0), a3, coff[0]);
            PG8_WAIT_V(8); PG8_WAIT_L(0); PG8_BAR; if (!Sched::RAGGED || cur.nvalid > HALF) { PG8_MMA(1, 0, At, B0); PG8_MMA(1, 1, At, B1); } PG8_BAR; PG8_SCHED;
        }
        if constexpr (ALIGN_EPI) { if (wr == 0) PG8_BAR; }
        if constexpr (FP8) asm volatile("s_nop 15\n\ts_nop 15\n\ts_nop 15" ::: "memory");
        E(acc, cur, wr, wc, fr, fq);
        if (!has_next) break;
#pragma unroll
        for (int a = 0; a < 2; ++a)
#pragma unroll
            for (int b = 0; b < 2; ++b)
#pragma unroll
                for (int m = 0; m < 4; ++m)
#pragma unroll
                    for (int n = 0; n < 2; ++n) acc[a][b][m][n] = (f32x4){0.f, 0.f, 0.f, 0.f};
        cur = nxt; cB = nB; ++ui;
        if constexpr (ALIGN_EPI) { if (wr == 1) PG8_BAR; }
    }
    PG8_WAIT_V(0);
    if constexpr (!ALIGN_EPI) { if (wr == 0) PG8_BAR; }
    PG8_BAR;
#undef PG8_SA
#undef PG8_SB
#undef PG8_STAGE
#undef PG8_LDA
#undef PG8_LDB
#undef PG8_MMA
#undef PG8_WAIT_V
#undef PG8_WAIT_L
#undef PG8_BAR
#undef PG8_SCHED
}
}
using pg8::Unit;

struct EpiBf16 {
    static constexpr bool PERM = true;
    bf16_t* O; int ldc; int nostore;
    __device__ __forceinline__ void operator()(const f32x4 (&acc)[2][2][4][2], const Unit& u, int wr, int wc, int fr, int fq) const {
        const int row0 = u.row0 + wr * 64 + fr, col0 = u.pn * 256 + wc * 32 + 8 * fq;
#pragma unroll
        for (int ai = 0; ai < 2; ++ai)
#pragma unroll
            for (int m = 0; m < 4; ++m) { bf16_t* rowp = O + (size_t)(row0 + ai * 128 + m * 16) * ldc + col0;
#pragma unroll
                for (int bj = 0; bj < 2; ++bj) { const f32x4 v0 = acc[ai][bj][m][0], v1 = acc[ai][bj][m][1];
                    u32x4 w; w.x = cvt_pk_bf16(v0[0], v0[1]); w.y = cvt_pk_bf16(v0[2], v0[3]); w.z = cvt_pk_bf16(v1[0], v1[1]); w.w = cvt_pk_bf16(v1[2], v1[3]);
                    if (!nostore) *(u32x4*)(rowp + bj * 128) = w; else asm volatile("" :: "v"(w)); } }
    }
};
template <bool ADD> struct EpiGate {
    static constexpr bool PERM = true;
    bf16_t* O; int ldc; const bf16_t* gate; int ldg;
    __device__ __forceinline__ void operator()(const f32x4 (&acc)[2][2][4][2], const Unit& u, int wr, int wc, int fr, int fq) const {
        const int row0 = u.row0 + wr * 64 + fr, col0 = u.pn * 256 + wc * 32 + 8 * fq;
#pragma unroll
        for (int ai = 0; ai < 2; ++ai)
#pragma unroll
            for (int m = 0; m < 4; ++m) { const size_t r = (size_t)(row0 + ai * 128 + m * 16); bf16_t* rowp = O + r * ldc + col0; const bf16_t* gp = gate + r * ldg + col0;
#pragma unroll
                for (int bj = 0; bj < 2; ++bj) { const f32x4 v0 = acc[ai][bj][m][0], v1 = acc[ai][bj][m][1];
                    const u32x4 g = *(const u32x4*)(gp + bj * 128);
                    float o[8];
                    o[0] = fsigm(bf2f(g.x & 0xffffu)) * v0[0]; o[1] = fsigm(bf2f(g.x >> 16)) * v0[1]; o[2] = fsigm(bf2f(g.y & 0xffffu)) * v0[2]; o[3] = fsigm(bf2f(g.y >> 16)) * v0[3];
                    o[4] = fsigm(bf2f(g.z & 0xffffu)) * v1[0]; o[5] = fsigm(bf2f(g.z >> 16)) * v1[1]; o[6] = fsigm(bf2f(g.w & 0xffffu)) * v1[2]; o[7] = fsigm(bf2f(g.w >> 16)) * v1[3];
                    if (ADD) { const u32x4 p = *(const u32x4*)(rowp + bj * 128);
                        o[0] += bf2f(p.x & 0xffffu); o[1] += bf2f(p.x >> 16); o[2] += bf2f(p.y & 0xffffu); o[3] += bf2f(p.y >> 16);
                        o[4] += bf2f(p.z & 0xffffu); o[5] += bf2f(p.z >> 16); o[6] += bf2f(p.w & 0xffffu); o[7] += bf2f(p.w >> 16); }
                    u32x4 w; w.x = cvt_pk_bf16(o[0], o[1]); w.y = cvt_pk_bf16(o[2], o[3]); w.z = cvt_pk_bf16(o[4], o[5]); w.w = cvt_pk_bf16(o[6], o[7]);
                    *(u32x4*)(rowp + bj * 128) = w; } }
    }
};
struct EpiResid {
    static constexpr bool PERM = false;
    const float* base; float* out; int ldc; const float* gvec;
    __device__ __forceinline__ void operator()(const f32x4 (&acc)[2][2][4][2], const Unit& u, int wr, int wc, int fr, int fq) const {
        const int row0 = u.row0 + wr * 64 + fr, col0 = u.pn * 256 + wc * 32 + 4 * fq;
        f32x4 gv[2][2];
#pragma unroll
        for (int bj = 0; bj < 2; ++bj)
#pragma unroll
            for (int n = 0; n < 2; ++n) gv[bj][n] = *(const f32x4*)(gvec + col0 + bj * 128 + n * 16);
#pragma unroll
        for (int ai = 0; ai < 2; ++ai)
#pragma unroll
            for (int m = 0; m < 4; ++m) { const size_t off = (size_t)(row0 + ai * 128 + m * 16) * ldc + col0;
#pragma unroll
                for (int bj = 0; bj < 2; ++bj)
#pragma unroll
                    for (int n = 0; n < 2; ++n) { const f32x4 bs = *(const f32x4*)(base + off + bj * 128 + n * 16); *(f32x4*)(out + off + bj * 128 + n * 16) = bs + gv[bj][n] * acc[ai][bj][m][n]; } }
    }
};
struct EpiGateUp {
    static constexpr bool PERM = true;
    unsigned char* ACT;
    __device__ __forceinline__ void operator()(const f32x4 (&acc)[2][2][4][2], const Unit& u, int wr, int wc, int fr, int fq) const {
        const int row0 = u.row0 + wr * 64 + fr, col0 = u.pn * 128 + wc * 32 + 8 * fq;
        constexpr float ws = 1.0f / FP8_WS1;
#pragma unroll
        for (int ai = 0; ai < 2; ++ai)
#pragma unroll
            for (int m = 0; m < 4; ++m) { unsigned char* rowp = ACT + (size_t)(row0 + ai * 128 + m * 16) * ED + col0;
                const f32x4 g0 = acc[ai][0][m][0] * ws, g1 = acc[ai][0][m][1] * ws, u0 = acc[ai][1][m][0] * (ws * FP8_AS), u1 = acc[ai][1][m][1] * (ws * FP8_AS);
                u32x2 w; w.x = cvt4_fp8(fsilu(g0[0]) * u0[0], fsilu(g0[1]) * u0[1], fsilu(g0[2]) * u0[2], fsilu(g0[3]) * u0[3]);
                w.y = cvt4_fp8(fsilu(g1[0]) * u1[0], fsilu(g1[1]) * u1[1], fsilu(g1[2]) * u1[2], fsilu(g1[3]) * u1[3]);
                *(u32x2*)rowp = w; }
    }
};
struct EpiDown {
    static constexpr bool PERM = true;
    unsigned char* Y; const float* wsorted;
    __device__ __forceinline__ void operator()(const f32x4 (&acc)[2][2][4][2], const Unit& u, int wr, int wc, int fr, int fq) const {
        const int rl0 = wr * 64 + fr, col0 = u.pn * 256 + wc * 32 + 8 * fq;
#pragma unroll
        for (int ai = 0; ai < 2; ++ai)
#pragma unroll
            for (int m = 0; m < 4; ++m) { const int rl = rl0 + ai * 128 + m * 16; const int row = u.row0 + rl;
                float wv = 1.f; if (u.e < NE) wv = (rl < u.nvalid) ? wsorted[row] : 0.f;
                wv *= FP8_YS / (FP8_WS2 * FP8_AS);
                unsigned char* rowp = Y + (size_t)row * D + col0;
#pragma unroll
                for (int bj = 0; bj < 2; ++bj) { const f32x4 v0 = acc[ai][bj][m][0] * wv, v1 = acc[ai][bj][m][1] * wv;
                    u32x2 w; w.x = cvt4_fp8(v0[0], v0[1], v0[2], v0[3]); w.y = cvt4_fp8(v1[0], v1[1], v1[2], v1[3]);
                    *(u32x2*)(rowp + bj * 128) = w; } }
    }
};

struct MoeTab { LAS int* te; LAS int* tn; LAS int* misc; };
__device__ __forceinline__ MoeTab moe_tab(LAS unsigned char* lds) { MoeTab t; t.te = (LAS int*)(lds + LDS_TAB); t.tn = t.te + 352; t.misc = t.tn + 352; return t; }
struct MoeSched1 {
    static constexpr bool RAGGED = true;
    const char* H2; const char* E1; const int* toks; MoeTab tab; int G, vcu;
    __device__ __forceinline__ bool next(int i, Unit& u) const {
        const int ntr = tab.misc[0]; const int L = i * G + vcu; if (L >= 4 * (ntr + 32)) return false;
        const int t = L >> 2; u.pn = L & 3;
        if (t < ntr) { u.row0 = t * 256; u.e = tab.te[t]; u.nvalid = tab.tn[t]; } else { u.row0 = SH_ROW0 + (t - ntr) * 256; u.e = NE; u.nvalid = 256; }
        return true;
    }
    __device__ __forceinline__ const char* a_base() const { return H2; }
    __device__ __forceinline__ const char* b_ptr(const Unit& u) const { return E1 + ((size_t)u.e * 1024 + (size_t)u.pn * 256) * D; }
    __device__ __forceinline__ void a_off(const Unit& u, int tid, unsigned (&off)[2][2]) const {
#pragma unroll
        for (int i = 0; i < 2; ++i) { int R, C; pg8::stage_rc(tid * 16 + i * 8192, R, C);
#pragma unroll
            for (int h = 0; h < 2; ++h) { const int r = h * 128 + R; int tok;
                if (u.e < NE) tok = (r < u.nvalid) ? toks[u.row0 + r] : 0; else tok = u.row0 - SH_ROW0 + r;
                off[h][i] = (unsigned)(tok * D + 2 * C); } }
    }
};
struct MoeSched2 {
    static constexpr bool RAGGED = true;
    const char* ACT; const char* E2; MoeTab tab; int G, vcu;
    __device__ __forceinline__ bool next(int i, Unit& u) const {
        const int ntr = tab.misc[0]; const int L = i * G + vcu; if (L >= 8 * (ntr + 32)) return false;
        const int t = L >> 3; u.pn = L & 7;
        if (t < ntr) { u.row0 = t * 256; u.e = tab.te[t]; u.nvalid = tab.tn[t]; } else { u.row0 = SH_ROW0 + (t - ntr) * 256; u.e = NE; u.nvalid = 256; }
        return true;
    }
    __device__ __forceinline__ const char* a_base() const { return ACT; }
    __device__ __forceinline__ const char* b_ptr(const Unit& u) const { return E2 + ((size_t)u.e * 2048 + (size_t)u.pn * 256) * ED; }
    __device__ __forceinline__ void a_off(const Unit& u, int tid, unsigned (&off)[2][2]) const {
#pragma unroll
        for (int i = 0; i < 2; ++i) { int R, C; pg8::stage_rc(tid * 16 + i * 8192, R, C);
            off[0][i] = (unsigned)((u.row0 + R) * ED + 2 * C); off[1][i] = (unsigned)((u.row0 + 128 + R) * ED + 2 * C); }
    }
};

#define XB_TMO      128
#define XB_XCNT(j)  (256  + 64 * (j))
#define XB_XSUB(j)  (1280 + 64 * (j))
#define XB_XGEN(j)  (2304 + 64 * (j))
#define XB_TOP      3328
#define XB_TOPGEN   3392
#define XCD_BAR_WORDS 3456
#define XB_SPIN_CAP (1u << 18)
__device__ __forceinline__ unsigned xb_ld(unsigned* p)              { return __hip_atomic_load(p, __ATOMIC_RELAXED, __HIP_MEMORY_SCOPE_AGENT); }
__device__ __forceinline__ unsigned xb_add(unsigned* p, unsigned v) { return __hip_atomic_fetch_add(p, v, __ATOMIC_RELAXED, __HIP_MEMORY_SCOPE_AGENT); }
__device__ __forceinline__ unsigned xb_xcc_id() { return (unsigned)__builtin_amdgcn_s_getreg((3 << 11) | 20) & 0xFu; }
#define XB_SPIN(cond, bar) do { unsigned _sp = 0; while (cond) { __builtin_amdgcn_s_sleep(1); \
    if ((++_sp & 255u) == 0u) { if (xb_ld(&(bar)[XB_TMO])) break; if (_sp > XB_SPIN_CAP) { atomicAdd(&(bar)[XB_TMO], 1u); break; } } } } while (0)
struct XcdBarrier { unsigned* bar; unsigned x; volatile LAS unsigned* st; };
__device__ __forceinline__ XcdBarrier xcd_barrier_post(unsigned* bar, volatile LAS unsigned* st) {
    XcdBarrier b; b.bar = bar; b.x = xb_xcc_id(); b.st = st;
    if (threadIdx.x == 0) (void)xb_add(&bar[XB_XCNT(b.x)], 1u);
    return b;
}
__device__ __forceinline__ void xcd_barrier_complete(unsigned* bar, unsigned x, unsigned& nloc, unsigned& nx) {
    const unsigned G = gridDim.x * gridDim.y * gridDim.z;
    unsigned sum, cnt, mine, sp = 0u;
    for (;;) {
        sum = 0u; cnt = 0u; mine = 0u;
#pragma unroll
        for (unsigned j = 0; j < 16; ++j) { const unsigned c = xb_ld(&bar[XB_XCNT(j)]); sum += c; cnt += (c > 0u) ? 1u : 0u; mine = (j == x) ? c : mine; }
        if (sum == G) break;
        __builtin_amdgcn_s_sleep(1);
        if ((++sp & 255u) == 0u) { if (xb_ld(&bar[XB_TMO])) break; if (sp > XB_SPIN_CAP) { atomicAdd(&bar[XB_TMO], 1u); break; } }
    }
    nloc = mine > 0u ? mine : 1u; nx = cnt > 0u ? cnt : 1u;
}
__device__ __forceinline__ void xcd_barrier(const XcdBarrier& b) {
    asm volatile("s_waitcnt vmcnt(0)" ::: "memory");
    __syncthreads();
    if (threadIdx.x == 0) {
        unsigned* bar = b.bar;
        __builtin_amdgcn_s_waitcnt(0);
        unsigned nloc = b.st[0], nx = b.st[1];
        if (nloc == 0u) { xcd_barrier_complete(bar, b.x, nloc, nx); b.st[0] = nloc; b.st[1] = nx; }
        const unsigned old = xb_add(&bar[XB_XSUB(b.x)], 1u);
        const unsigned gen = old / nloc;
        if (old + 1u == (gen + 1u) * nloc) {
            __builtin_amdgcn_fence(__ATOMIC_RELEASE, "agent");
            asm volatile("s_waitcnt vmcnt(0)" ::: "memory");
            const unsigned og = xb_add(&bar[XB_TOP], 1u);
            const unsigned tg = og / nx;
            if (og + 1u == (tg + 1u) * nx) xb_add(&bar[XB_TOPGEN], 1u);
            else XB_SPIN(xb_ld(&bar[XB_TOPGEN]) == tg, bar);
            __builtin_amdgcn_fence(__ATOMIC_ACQUIRE, "agent");
            xb_add(&bar[XB_XGEN(b.x)], 1u);
            asm volatile("s_waitcnt vmcnt(0)" ::: "memory");
        } else {
            XB_SPIN(xb_ld(&bar[XB_XGEN(b.x)]) == gen, bar);
            __builtin_amdgcn_fence(__ATOMIC_ACQUIRE, "agent");
            asm volatile("s_waitcnt vmcnt(0)" ::: "memory");
        }
    }
    __syncthreads();
}

struct Ctx {
    LAS unsigned char* lds;
    int tid, lane, wave, G, vcu, bx;
    float* out; unsigned char* ws;
};
constexpr int LDS_PTRS = 163840 - 512;
__device__ __forceinline__ const float* inp(const Ctx& F, int i) {
    const LAS unsigned* p = (const LAS unsigned*)(F.lds + LDS_PTRS) + 2 * i;
    const unsigned lo = __builtin_amdgcn_readfirstlane(p[0]), hi = __builtin_amdgcn_readfirstlane(p[1]);
    return (const float*)(const GAS float*)(((unsigned long long)hi << 32) | lo);
}
#define IN_X 0
#define IN_C 1
#define IN_RELB 2
#define IN_WADA 3
#define IN_BADA 4
#define IN_LN1 5
#define IN_WIN 6
#define IN_QNG 7
#define IN_KNG 8
#define IN_GNG 9
#define IN_PA 10
#define IN_PB 11
#define IN_WO 12
#define IN_LN2 13
#define IN_RW 14
#define IN_RB 15
#define IN_WG 16
#define IN_WU 17
#define IN_WD 18
#define IN_WGS 19
#define IN_WUS 20
#define IN_WDS 21

struct CvItem { const float* src; unsigned char* dst; int ldw, ldt; float scale; };
constexpr int CV_WIN = 32 * 304, CV_PA = 16 * 32, CV_PB = 32 * 32, CV_WO = 32 * 32, CV_EX = 768;
constexpr int CV_DENSE = CV_WIN + CV_PA + CV_PB + CV_WO, CV_ALL = CV_DENSE + 65 * CV_EX;
#ifndef CV_BG_FROM
#define CV_BG_FROM CV_DENSE
#endif
__device__ __forceinline__ void cv_kn(int q, int nbg_count, int& kb, int& nb) {
    const int super = q >> 3, sub = q & 7; kb = (super / nbg_count) * 4 + (sub >> 1); nb = (super % nbg_count) * 2 + (sub & 1);
}
__device__ __forceinline__ CvItem cv_decode(const Ctx& F, int it) {
    CvItem c; int r = it; int kb, nb; c.scale = 0.f;
    if (r < CV_WIN) { cv_kn(r, 152, kb, nb); c.ldw = INW; c.ldt = D * 2; c.src = inp(F, IN_WIN) + (size_t)(64 * kb) * INW + 64 * nb; c.dst = F.ws + WS_WINT + ((size_t)(64 * nb) * D + 64 * kb) * 2; return c; } r -= CV_WIN;
    if (r < CV_PA) { cv_kn(r, 16, kb, nb); c.ldw = D; c.ldt = 1024 * 2; c.src = inp(F, IN_PA) + (size_t)(64 * kb) * D + 64 * nb; c.dst = F.ws + WS_PA + ((size_t)(64 * nb) * 1024 + 64 * kb) * 2; return c; } r -= CV_PA;
    if (r < CV_PB) { cv_kn(r, 16, kb, nb); c.ldw = D; c.ldt = D * 2; c.src = inp(F, IN_PB) + (size_t)(64 * kb) * D + 64 * nb; c.dst = F.ws + WS_PB + ((size_t)(64 * nb) * D + 64 * kb) * 2; return c; } r -= CV_PB;
    if (r < CV_WO) { cv_kn(r, 16, kb, nb); c.ldw = D; c.ldt = D * 2; c.src = inp(F, IN_WO) + (size_t)(64 * kb) * D + 64 * nb; c.dst = F.ws + WS_WO + ((size_t)(64 * nb) * D + 64 * kb) * 2; return c; } r -= CV_WO;
    const int e = r / CV_EX; int q = r % CV_EX;
    if (q < 512) {
        const int isup = q >> 8; q &= 255; cv_kn(q, 4, kb, nb); const int n0 = 64 * nb;
        const float* w = (e < NE) ? inp(F, isup ? IN_WU : IN_WG) + (size_t)e * D * ED : inp(F, isup ? IN_WUS : IN_WGS);
        c.ldw = ED; c.ldt = D; c.scale = FP8_WS1; c.src = w + (size_t)(64 * kb) * ED + n0;
        c.dst = F.ws + WS_E1 + ((size_t)e * 1024 + (size_t)((n0 >> 7) * 256 + (n0 & 127) + isup * 128)) * D + 64 * kb;
    } else {
        q -= 512; cv_kn(q, 16, kb, nb);
        const float* w = (e < NE) ? inp(F, IN_WD) + (size_t)e * ED * D : inp(F, IN_WDS);
        c.ldw = D; c.ldt = ED; c.scale = FP8_WS2; c.src = w + (size_t)(64 * kb) * D + 64 * nb;
        c.dst = F.ws + WS_E2 + ((size_t)e * D + (size_t)(64 * nb)) * ED + 64 * kb;
    }
    return c;
}
__device__ __forceinline__ void cv_load(const CvItem& c, int lane, f32x4 (&v)[16]) {
    const int r4 = lane >> 4, c16 = lane & 15;
#pragma unroll
    for (int i = 0; i < 16; ++i) v[i] = *(const f32x4*)(c.src + (size_t)(4 * i + r4) * c.ldw + 4 * c16);
}
__device__ __forceinline__ void cv_store(const CvItem& c, int lane, const f32x4 (&v)[16], LAS float* scr) {
    const int r4 = lane >> 4, c16 = lane & 15;
#pragma unroll
    for (int i = 0; i < 16; ++i) { LAS float* d = scr + (4 * i + r4) * 65 + 4 * c16; d[0] = v[i].x; d[1] = v[i].y; d[2] = v[i].z; d[3] = v[i].w; }
    LDS_WAIT(); asm volatile("" ::: "memory");
    const int cc = lane & 7;
    if (c.scale == 0.f) {
#pragma unroll
        for (int j = 0; j < 8; ++j) { const int n = (lane >> 3) + 8 * j; const LAS float* s = scr + (8 * cc) * 65 + n;
            u32x4 o; o.x = cvt_pk_bf16(s[0 * 65], s[1 * 65]); o.y = cvt_pk_bf16(s[2 * 65], s[3 * 65]); o.z = cvt_pk_bf16(s[4 * 65], s[5 * 65]); o.w = cvt_pk_bf16(s[6 * 65], s[7 * 65]);
            *(GAS u32x4*)(c.dst + (size_t)n * c.ldt + 16 * cc) = o; }
    } else { const float sc = c.scale;
#pragma unroll
        for (int j = 0; j < 8; ++j) { const int n = (lane >> 3) + 8 * j; const LAS float* s = scr + (8 * cc) * 65 + n;
            u32x2 o; o.x = cvt4_fp8(s[0 * 65] * sc, s[1 * 65] * sc, s[2 * 65] * sc, s[3 * 65] * sc); o.y = cvt4_fp8(s[4 * 65] * sc, s[5 * 65] * sc, s[6 * 65] * sc, s[7 * 65] * sc);
            *(GAS u32x2*)(c.dst + (size_t)n * c.ldt + 8 * cc) = o; }
    }
    LDS_WAIT(); asm volatile("" ::: "memory");
}
__device__ __forceinline__ void convert_items(const Ctx& F, int lo, int hi, int gw, int NGW) {
    LAS float* scr = (LAS float*)(F.lds + 16384 + F.wave * 16640);
    int it = lo + gw;
    if (it >= hi) return;
    f32x4 va[16], vb[16];
    CvItem ca = cv_decode(F, it), cb = ca;
    cv_load(ca, F.lane, va);
    for (;;) {
        int nx = it + NGW; const bool hb = nx < hi;
        if (hb) { cb = cv_decode(F, nx); cv_load(cb, F.lane, vb); }
        cv_store(ca, F.lane, va, scr);
        if (!hb) break;
        it = nx; nx = it + NGW; const bool ha = nx < hi;
        if (ha) { ca = cv_decode(F, nx); cv_load(ca, F.lane, va); }
        cv_store(cb, F.lane, vb, scr);
        if (!ha) break;
        it = nx;
    }
}
__device__ __forceinline__ void p0_prologue(const Ctx& F) {
    {
        const float* cvec = inp(F, IN_C); const float* wada = inp(F, IN_WADA); float* modp = (float*)(F.ws + WS_MODP);
        LAS float* red = (LAS float*)F.lds;
        for (int it = F.bx; it < 384; it += F.G) {
            const int cc = it % 48, ks = it / 48; const int col = cc * 256 + F.lane * 4; const int k0 = ks * 256 + F.wave * 32;
            f32x4 a = (f32x4){0.f, 0.f, 0.f, 0.f};
#pragma unroll 8
            for (int r = 0; r < 32; ++r) { const int k = k0 + r; const float s = fsilu(cvec[k]); const f32x4 w = *(const f32x4*)(wada + (size_t)k * 12288 + col); a += w * s; }
            *(LAS f32x4*)(red + F.wave * 256 + F.lane * 4) = a;
            __syncthreads();
            if (F.tid < 256) { float s = 0.f;
#pragma unroll
                for (int w = 0; w < 8; ++w) s += red[w * 256 + F.tid];
                modp[ks * 12288 + cc * 256 + F.tid] = s; }
            __syncthreads();
        }
    }
    {
        float* rc = (float*)(F.ws + WS_ROPE); float* rs = rc + S * 64;
        for (int idx = F.bx * 512 + F.tid; idx < S * 64; idx += F.G * 512) {
            const int pos = idx >> 6, i = idx & 63;
            double inv = 1.0; const double r = 0.86596432336006535;
            for (int q = 0; q < i; ++q) inv *= r;
            const double ang = (double)pos * inv;
            const double n = __builtin_rint(ang * 0.15915494309189535);
            const float red = (float)(ang - n * 6.283185307179586);
            rc[idx] = __cosf(red); rs[idx] = __sinf(red);
        }
    }
    convert_items(F, 0, CV_BG_FROM, F.vcu * 8 + F.wave, F.G * 8);
}

__device__ __forceinline__ float mod_sum(const Ctx& F, int n) {
    const float* modp = (const float*)(F.ws + WS_MODP); float s = inp(F, IN_BADA)[n];
#pragma unroll
    for (int k = 0; k < 8; ++k) s += modp[k * 12288 + n];
    return s;
}
__device__ __forceinline__ void norm_rows(const Ctx& F, const float* X, const LAS float* gs, const LAS float* sh, bf16_t* O) {
    const int gw = F.vcu * 8 + F.wave, NGW = F.G * 8;
    for (int m = gw; m < S; m += NGW) {
        const GAS f32x4* xr = (const GAS f32x4*)(X + (size_t)m * D) + F.lane;
        f32x4 v[8]; float ss = 0.f;
#pragma unroll
        for (int j = 0; j < 8; ++j) { v[j] = xr[64 * j]; ss += (v[j].x * v[j].x + v[j].y * v[j].y) + (v[j].z * v[j].z + v[j].w * v[j].w); }
#pragma unroll
        for (int o = 1; o < 64; o <<= 1) ss += __shfl_xor(ss, o);
        const float rstd = 1.0f / sqrtf(ss * (1.f / D) + 1e-6f);
        GAS u32x2* o8 = (GAS u32x2*)(O + (size_t)m * D) + F.lane;
#pragma unroll
        for (int j = 0; j < 8; ++j) { const f32x4 g = *(const LAS f32x4*)(gs + 256 * j + 4 * F.lane), s = *(const LAS f32x4*)(sh + 256 * j + 4 * F.lane);
            const f32x4 y = v[j] * rstd * g + s; u32x2 w; w.x = cvt_pk_bf16(y.x, y.y); w.y = cvt_pk_bf16(y.z, y.w); o8[64 * j] = w; }
    }
}
__device__ __forceinline__ void p1_norm1(const Ctx& F) {
    LAS float* gs = (LAS float*)F.lds; LAS float* sh = gs + D;
    for (int k = F.tid; k < D; k += 512) { const float shv = mod_sum(F, k), scv = mod_sum(F, D + k); gs[k] = inp(F, IN_LN1)[k] * (1.f + scv); sh[k] = shv; }
    float* modf = (float*)(F.ws + WS_MODF);
    for (int n = F.bx * 512 + F.tid; n < 12288; n += F.G * 512) modf[n] = mod_sum(F, n);
    __syncthreads();
    norm_rows(F, inp(F, IN_X), gs, sh, (bf16_t*)(F.ws + WS_H));
}


__device__ __forceinline__ bf16x8 pk_frag(u32x2 lo, u32x2 hi) { u32x4 v; v.x = lo.x; v.y = lo.y; v.z = hi.x; v.w = hi.y; return __builtin_bit_cast(bf16x8, v); }
__device__ __forceinline__ f32x4 mfma16(bf16x8 a, bf16x8 b, f32x4 c) { return __builtin_amdgcn_mfma_f32_16x16x32_bf16(a, b, c, 0, 0, 0); }
__device__ __forceinline__ float gamma_log2(int h) { return log2f(1.0f - exp2f(-5.0f - (float)h)); }

struct AttnU { int g, hh, d, r, nb, head; };
__device__ __forceinline__ AttnU attn_decode(int u) {
    AttnU U; U.g = u >> 9; const int rem = u & 511; U.hh = rem >> 6; const int rem2 = rem & 63;
    const int dsh = 2 * U.g; U.d = 1 << dsh; const int nblk = 64 >> dsh;
    U.r = rem2 / nblk; U.nb = rem2 % nblk; U.head = U.g * 8 + U.hh; return U;
}
__device__ __forceinline__ void attn_issue(const bf16_t* proj, const AttnU& U, int tid, int w, int lane, u32x4 (&kr)[8], u32x4 (&vr)[8], u32x4 (&qr)[4]) {
    const int rowi = tid >> 4, ch = tid & 15;
#pragma unroll
    for (int p = 0; p < 8; ++p) { const int cc = p * 32 + rowi; const int jk = (U.nb - 1) * 128 + cc;
        if (jk >= 0) { const unsigned off = (unsigned)(jk * U.d + U.r) * INW + U.head * 128 + ch * 8; kr[p] = *(const u32x4*)(proj + off + C_KA); vr[p] = *(const u32x4*)(proj + off + C_VA); }
        else { kr[p] = (u32x4){0u, 0u, 0u, 0u}; vr[p] = (u32x4){0u, 0u, 0u, 0u}; } }
    const int ql = lane & 15, g4 = lane >> 4; const unsigned tq = (unsigned)((U.nb * 128 + 16 * w + ql) * U.d + U.r);
#pragma unroll
    for (int ds = 0; ds < 4; ++ds) qr[ds] = *(const u32x4*)(proj + tq * INW + C_QA + U.head * 128 + 32 * ds + 8 * g4);
}
__device__ __forceinline__ void p3_attn(const Ctx& F) {
    const bf16_t* proj = (const bf16_t*)(F.ws + WS_PROJ);
    LAS bf16_t* KS = (LAS bf16_t*)F.lds;
    LAS bf16_t* VS = (LAS bf16_t*)(F.lds + 69632);
    LAS float* BT = (LAS float*)(F.lds + 139264);
    const int lane = F.lane, w = F.wave, ql = lane & 15, g4 = lane >> 4;
    const int rowi = F.tid >> 4, ch = F.tid & 15;
    u32x4 kr[8], vr[8], qr[4];
    int it = F.bx;
    if (it < 1536) { const AttnU U0 = attn_decode(it); attn_issue(proj, U0, F.tid, w, lane, kr, vr, qr); }
    for (; it < 1536; it += F.G) {
        const AttnU U = attn_decode(it);
        const int d = U.d, nb = U.nb;
        if (F.tid <= 128) { const int dist = F.tid * d; int b;
            if (dist < 16) b = dist; else { b = 16 + (int)floorf(log2f((float)dist * 0.0625f) * (16.0f / 7.0f)); b = b > 31 ? 31 : b; }
            BT[F.tid] = inp(F, IN_RELB)[b * 24 + U.head]; }
        {
            const float* kg = inp(F, IN_KNG) + ch * 8;
            const f32x4 kg0 = *(const f32x4*)kg, kg1 = *(const f32x4*)(kg + 4);
#pragma unroll
            for (int p = 0; p < 8; ++p) { const int cc = p * 32 + rowi;
                float f[8]; f[0] = bf2f(kr[p].x & 0xffffu); f[1] = bf2f(kr[p].x >> 16); f[2] = bf2f(kr[p].y & 0xffffu); f[3] = bf2f(kr[p].y >> 16);
                f[4] = bf2f(kr[p].z & 0xffffu); f[5] = bf2f(kr[p].z >> 16); f[6] = bf2f(kr[p].w & 0xffffu); f[7] = bf2f(kr[p].w >> 16);
                float ss = 0.f;
#pragma unroll
                for (int e = 0; e < 8; ++e) ss += f[e] * f[e];
                ss += __shfl_xor(ss, 1); ss += __shfl_xor(ss, 2); ss += __shfl_xor(ss, 4); ss += __shfl_xor(ss, 8);
                const float rstd = 1.0f / sqrtf(ss * (1.f / 128.f) + 1e-6f);
                u32x4 o; o.x = cvt_pk_bf16(f[0] * rstd * kg0.x, f[1] * rstd * kg0.y); o.y = cvt_pk_bf16(f[2] * rstd * kg0.z, f[3] * rstd * kg0.w);
                o.z = cvt_pk_bf16(f[4] * rstd * kg1.x, f[5] * rstd * kg1.y); o.w = cvt_pk_bf16(f[6] * rstd * kg1.z, f[7] * rstd * kg1.w);
                *(LAS u32x4*)(KS + cc * 136 + ch * 8) = o;
                *(LAS u32x4*)(VS + cc * 136 + ch * 8) = vr[p]; }
        }
        const int a = 16 * w + ql;
        const unsigned tq = (unsigned)((nb * 128 + a) * d + U.r);
        bf16x8 qf[4];
        {
            float f[4][8]; float ss = 0.f;
#pragma unroll
            for (int ds = 0; ds < 4; ++ds) { f[ds][0] = bf2f(qr[ds].x & 0xffffu); f[ds][1] = bf2f(qr[ds].x >> 16); f[ds][2] = bf2f(qr[ds].y & 0xffffu); f[ds][3] = bf2f(qr[ds].y >> 16);
                f[ds][4] = bf2f(qr[ds].z & 0xffffu); f[ds][5] = bf2f(qr[ds].z >> 16); f[ds][6] = bf2f(qr[ds].w & 0xffffu); f[ds][7] = bf2f(qr[ds].w >> 16);
#pragma unroll
                for (int e = 0; e < 8; ++e) ss += f[ds][e] * f[ds][e]; }
            ss += __shfl_xor(ss, 16); ss += __shfl_xor(ss, 32);
            const float rs = (1.0f / sqrtf(ss * (1.f / 128.f) + 1e-6f)) * 0.08838834764831845f;
#pragma unroll
            for (int ds = 0; ds < 4; ++ds) { const float* qg = inp(F, IN_QNG) + 32 * ds + 8 * g4; const f32x4 q0 = *(const f32x4*)qg, q1 = *(const f32x4*)(qg + 4); u32x4 o;
                o.x = cvt_pk_bf16(f[ds][0] * rs * q0.x, f[ds][1] * rs * q0.y); o.y = cvt_pk_bf16(f[ds][2] * rs * q0.z, f[ds][3] * rs * q0.w);
                o.z = cvt_pk_bf16(f[ds][4] * rs * q1.x, f[ds][5] * rs * q1.y); o.w = cvt_pk_bf16(f[ds][6] * rs * q1.z, f[ds][7] * rs * q1.w);
                qf[ds] = __builtin_bit_cast(bf16x8, o); }
        }
        __syncthreads();
        { const int nx = it + F.G; if (nx < 1536) { const AttnU Un = attn_decode(nx); attn_issue(proj, Un, F.tid, w, lane, kr, vr, qr); } }
        const int kbase = 32 * (w >> 1);
        f32x4 sc[10];
#pragma unroll
        for (int ti = 0; ti < 10; ++ti) { f32x4 acc = (f32x4){0.f, 0.f, 0.f, 0.f};
#pragma unroll
            for (int ds = 0; ds < 4; ++ds) { const bf16x8 kf = *(const LAS bf16x8*)(KS + (kbase + 16 * ti + ql) * 136 + 32 * ds + 8 * g4); acc = mfma16(kf, qf[ds], acc); }
            sc[ti] = acc; }
        float mx = -1e30f;
#pragma unroll
        for (int ti = 0; ti < 10; ++ti)
#pragma unroll
            for (int i = 0; i < 4; ++i) { const int cc = kbase + 16 * ti + 4 * g4 + i; const int delta = 128 + a - cc;
                const bool ok = (delta >= 0) && (delta <= 128) && (nb > 0 || cc >= 128);
                const float sv = ok ? sc[ti][i] + BT[ok ? delta : 0] : -1e30f; sc[ti][i] = sv; mx = fmaxf(mx, sv); }
        mx = fmaxf(mx, __shfl_xor(mx, 16)); mx = fmaxf(mx, __shfl_xor(mx, 32));
        float lsum = 0.f;
#pragma unroll
        for (int ti = 0; ti < 10; ++ti)
#pragma unroll
            for (int i = 0; i < 4; ++i) { const float p = __expf(sc[ti][i] - mx); sc[ti][i] = p; lsum += p; }
        lsum += __shfl_xor(lsum, 16); lsum += __shfl_xor(lsum, 32);
        bf16x8 pf[5];
#pragma unroll
        for (int s = 0; s < 5; ++s) { u32x4 o; o.x = cvt_pk_bf16(sc[2 * s][0], sc[2 * s][1]); o.y = cvt_pk_bf16(sc[2 * s][2], sc[2 * s][3]);
            o.z = cvt_pk_bf16(sc[2 * s + 1][0], sc[2 * s + 1][1]); o.w = cvt_pk_bf16(sc[2 * s + 1][2], sc[2 * s + 1][3]); pf[s] = __builtin_bit_cast(bf16x8, o); }
        const float rl = 1.0f / lsum;
        bf16_t* og = (bf16_t*)(F.ws + WS_OG) + ((unsigned)(U.g * S) + tq) * 1024u + U.hh * 128;
        const unsigned vbase = (unsigned)(size_t)VS + (unsigned)(((kbase + 4 * g4 + (ql >> 2)) * 136 + 4 * (ql & 3)) * 2);
#pragma unroll
        for (int dt = 0; dt < 8; ++dt) { f32x4 acc = (f32x4){0.f, 0.f, 0.f, 0.f};
            u32x2 lo[5], hi[5];
#pragma unroll
            for (int s = 0; s < 5; ++s) { TR_READ(lo[s], vbase, (32 * s * 136 + dt * 16) * 2); TR_READ(hi[s], vbase, ((32 * s + 16) * 136 + dt * 16) * 2); }
            TR_WAIT4(lo[0], hi[0], lo[1], hi[1]); TR_WAIT4(lo[2], hi[2], lo[3], hi[3]); TR_WAIT2(lo[4], hi[4]);
#pragma unroll
            for (int s = 0; s < 5; ++s) acc = mfma16(pk_frag(lo[s], hi[s]), pf[s], acc);
            u32x2 o; o.x = cvt_pk_bf16(acc[0] * rl, acc[1] * rl); o.y = cvt_pk_bf16(acc[2] * rl, acc[3] * rl);
            *(u32x2*)(og + dt * 16 + 4 * g4) = o; }
        if (g4 == 0) ((float*)(F.ws + WS_LSE))[((unsigned)(U.g * S) + tq) * 8u + U.hh] = mx + __logf(lsum);
        __syncthreads();
    }
}

__device__ __forceinline__ void rot8v(const u32x4 own, const u32x4 par, int ch, const f32x4 c0, const f32x4 c1, const f32x4 s0, const f32x4 s1, float scale, float (&o)[8]) {
    float a[8], b[8];
    a[0] = bf2f(own.x & 0xffffu); a[1] = bf2f(own.x >> 16); a[2] = bf2f(own.y & 0xffffu); a[3] = bf2f(own.y >> 16); a[4] = bf2f(own.z & 0xffffu); a[5] = bf2f(own.z >> 16); a[6] = bf2f(own.w & 0xffffu); a[7] = bf2f(own.w >> 16);
    b[0] = bf2f(par.x & 0xffffu); b[1] = bf2f(par.x >> 16); b[2] = bf2f(par.y & 0xffffu); b[3] = bf2f(par.y >> 16); b[4] = bf2f(par.z & 0xffffu); b[5] = bf2f(par.z >> 16); b[6] = bf2f(par.w & 0xffffu); b[7] = bf2f(par.w >> 16);
    const float cv[8] = {c0.x, c0.y, c0.z, c0.w, c1.x, c1.y, c1.z, c1.w}, sv[8] = {s0.x, s0.y, s0.z, s0.w, s1.x, s1.y, s1.z, s1.w};
#pragma unroll
    for (int e = 0; e < 8; ++e) o[e] = ((ch < 8) ? (a[e] * cv[e] - b[e] * sv[e]) : (b[e] * sv[e] + a[e] * cv[e])) * scale;
}

__device__ __forceinline__ void upd_unit(const Ctx& F, int u) {
    const int n = u >> 3, h = u & 7;
    const bf16_t* proj = (const bf16_t*)(F.ws + WS_PROJ);
    const float* rc = (const float*)(F.ws + WS_ROPE); const float* rsn = rc + S * 64;
    LAS bf16_t* KS = (LAS bf16_t*)F.lds;
    LAS bf16_t* VS = (LAS bf16_t*)(F.lds + 34816);
    const int lane = F.lane, w = F.wave;
    const float lg2 = gamma_log2(h);
    {
        const int rowi = F.tid >> 4, ch = F.tid & 15;
        u32x4 kown[4], kpar[4], vv[8]; f32x4 c0[4], c1[4], s0[4], s1[4];
#pragma unroll
        for (int p = 0; p < 4; ++p) { const int j = p * 32 + rowi; const unsigned tok = (unsigned)(n * 128 + j);
            const bf16_t* kp = proj + tok * INW + C_KR + h * 128;
            kown[p] = *(const u32x4*)(kp + ch * 8); kpar[p] = *(const u32x4*)(kp + (ch ^ 8) * 8);
            const float* cp = rc + tok * 64 + (ch & 7) * 8; const float* sp = rsn + tok * 64 + (ch & 7) * 8;
            c0[p] = *(const f32x4*)cp; c1[p] = *(const f32x4*)(cp + 4); s0[p] = *(const f32x4*)sp; s1[p] = *(const f32x4*)(sp + 4);
            vv[2 * p] = *(const u32x4*)(proj + tok * INW + C_VR + h * 256 + ch * 8); vv[2 * p + 1] = *(const u32x4*)(proj + tok * INW + C_VR + h * 256 + (ch + 16) * 8); }
#pragma unroll
        for (int p = 0; p < 4; ++p) { const int j = p * 32 + rowi;
            float o[8]; rot8v(kown[p], kpar[p], ch, c0[p], c1[p], s0[p], s1[p], 0.08838834764831845f, o);
            u32x4 ov; ov.x = cvt_pk_bf16(o[0], o[1]); ov.y = cvt_pk_bf16(o[2], o[3]); ov.z = cvt_pk_bf16(o[4], o[5]); ov.w = cvt_pk_bf16(o[6], o[7]);
            *(LAS u32x4*)(KS + j * 136 + ch * 8) = ov; }
#pragma unroll
        for (int p = 0; p < 4; ++p) { const int j = p * 32 + rowi; const float z = exp2f(lg2 * (float)(127 - j));
#pragma unroll
            for (int c2 = 0; c2 < 2; ++c2) { const int chv = ch + 16 * c2; const u32x4 x = vv[2 * p + c2];
                u32x4 ov; ov.x = cvt_pk_bf16(bf2f(x.x & 0xffffu) * z, bf2f(x.x >> 16) * z); ov.y = cvt_pk_bf16(bf2f(x.y & 0xffffu) * z, bf2f(x.y >> 16) * z);
                ov.z = cvt_pk_bf16(bf2f(x.z & 0xffffu) * z, bf2f(x.z >> 16) * z); ov.w = cvt_pk_bf16(bf2f(x.w & 0xffffu) * z, bf2f(x.w >> 16) * z);
                *(LAS u32x4*)(VS + j * 264 + chv * 8) = ov; } }
    }
    __syncthreads();
    const int ql = lane & 15, g4 = lane >> 4;
    const unsigned kb = (unsigned)(size_t)KS + (unsigned)(((8 * g4 + (ql >> 2)) * 136 + 4 * (ql & 3)) * 2);
    const unsigned vbw = (unsigned)(size_t)VS + (unsigned)(((8 * g4 + (ql >> 2)) * 264 + 4 * (ql & 3) + 32 * w) * 2);
    f32x4 acc[2][8];
#pragma unroll
    for (int a = 0; a < 2; ++a)
#pragma unroll
        for (int b = 0; b < 8; ++b) acc[a][b] = (f32x4){0.f, 0.f, 0.f, 0.f};
#pragma unroll
    for (int ks = 0; ks < 4; ++ks) {
        u32x2 vl[2], vh[2];
#pragma unroll
        for (int a = 0; a < 2; ++a) { TR_READ(vl[a], vbw, (32 * ks * 264 + a * 16) * 2); TR_READ(vh[a], vbw, ((32 * ks + 4) * 264 + a * 16) * 2); }
        TR_WAIT4(vl[0], vh[0], vl[1], vh[1]);
        const bf16x8 vf0 = pk_frag(vl[0], vh[0]), vf1 = pk_frag(vl[1], vh[1]);
#pragma unroll
        for (int b = 0; b < 8; b += 2) {
            u32x2 k0l, k0h, k1l, k1h;
            TR_READ(k0l, kb, (32 * ks * 136 + b * 16) * 2); TR_READ(k0h, kb, ((32 * ks + 4) * 136 + b * 16) * 2);
            TR_READ(k1l, kb, (32 * ks * 136 + (b + 1) * 16) * 2); TR_READ(k1h, kb, ((32 * ks + 4) * 136 + (b + 1) * 16) * 2);
            TR_WAIT4(k0l, k0h, k1l, k1h);
            const bf16x8 kf0 = pk_frag(k0l, k0h), kf1 = pk_frag(k1l, k1h);
            acc[0][b] = mfma16(vf0, kf0, acc[0][b]); acc[1][b] = mfma16(vf1, kf0, acc[1][b]);
            acc[0][b + 1] = mfma16(vf0, kf1, acc[0][b + 1]); acc[1][b + 1] = mfma16(vf1, kf1, acc[1][b + 1]); }
    }
    float* upd = (float*)(F.ws + WS_UPD) + (size_t)(n * 8 + h) * 32768;
#pragma unroll
    for (int a = 0; a < 2; ++a)
#pragma unroll
        for (int b = 0; b < 8; ++b)
#pragma unroll
            for (int i = 0; i < 4; ++i) upd[((2 * w + a) * 16 + 4 * g4 + i) * 128 + b * 16 + ql] = acc[a][b][i];
    __syncthreads();
}
__device__ __forceinline__ void p3_mix1(const Ctx& F) {
    p3_attn(F);
    if (DUP2_MASK & 4) { __syncthreads(); p3_attn(F); }
    for (int it = F.bx; it < 512; it += F.G) upd_unit(F, it);
    if (DUP2_MASK & 8) { __syncthreads(); for (int it = F.bx; it < 512; it += F.G) upd_unit(F, it); }
}

__device__ __forceinline__ void p4_scan(const Ctx& F) {
    const float* upd = (const float*)(F.ws + WS_UPD); unsigned* prev = (unsigned*)(F.ws + WS_PREV);
    for (int p = F.bx * 512 + F.tid; p < 131072; p += F.G * 512) {
        const int h = p >> 14;
        const float gch = exp2f(gamma_log2(h) * 128.0f);
        const int within = (p & 16383) * 2;
        float s0 = 0.f, s1 = 0.f;
#pragma unroll 8
        for (int n = 0; n < 64; ++n) { const size_t o = (size_t)(n * 8 + h) * 32768 + within;
            const f32x2 uv = *(const f32x2*)(upd + o);
            prev[o >> 1] = cvt_pk_bf16(s0, s1);
            s0 = gch * s0 + uv.x; s1 = gch * s1 + uv.y; }
    }
}

__device__ __forceinline__ void ret_unit(const Ctx& F, int u) {
    const int n = u >> 3, h = u & 7;
    const bf16_t* proj = (const bf16_t*)(F.ws + WS_PROJ);
    const float* rc = (const float*)(F.ws + WS_ROPE); const float* rsn = rc + S * 64;
    LAS bf16_t* KS = (LAS bf16_t*)F.lds;
    LAS bf16_t* VS = (LAS bf16_t*)(F.lds + 34816);
    LAS bf16_t* QS = (LAS bf16_t*)(F.lds + 102400);
    LAS float* RED = (LAS float*)(F.lds + 137216);
    LAS float* TOT = (LAS float*)(F.lds + 145408);
    const int lane = F.lane, w = F.wave;
    const float lg2 = gamma_log2(h);
    const int ql = lane & 15, g4 = lane >> 4;
    const bf16_t* prev = (const bf16_t*)(F.ws + WS_PREV) + (size_t)(n * 8 + h) * 32768;
    {
        const int rowi = F.tid >> 4, ch = F.tid & 15;
        u32x4 kown[4], kpar[4], vv[8]; f32x4 c0[4], c1[4], s0[4], s1[4];
#pragma unroll
        for (int p = 0; p < 4; ++p) { const int j = p * 32 + rowi; const unsigned tok = (unsigned)(n * 128 + j);
            const bf16_t* kp = proj + tok * INW + C_KR + h * 128;
            kown[p] = *(const u32x4*)(kp + ch * 8); kpar[p] = *(const u32x4*)(kp + (ch ^ 8) * 8);
            const float* cp = rc + tok * 64 + (ch & 7) * 8; const float* sp = rsn + tok * 64 + (ch & 7) * 8;
            c0[p] = *(const f32x4*)cp; c1[p] = *(const f32x4*)(cp + 4); s0[p] = *(const f32x4*)sp; s1[p] = *(const f32x4*)(sp + 4);
            vv[2 * p] = *(const u32x4*)(proj + tok * INW + C_VR + h * 256 + ch * 8); vv[2 * p + 1] = *(const u32x4*)(proj + tok * INW + C_VR + h * 256 + (ch + 16) * 8); }
#pragma unroll
        for (int p = 0; p < 4; ++p) { const int j = p * 32 + rowi;
            float o[8]; rot8v(kown[p], kpar[p], ch, c0[p], c1[p], s0[p], s1[p], 0.08838834764831845f, o);
            u32x4 ov; ov.x = cvt_pk_bf16(o[0], o[1]); ov.y = cvt_pk_bf16(o[2], o[3]); ov.z = cvt_pk_bf16(o[4], o[5]); ov.w = cvt_pk_bf16(o[6], o[7]);
            *(LAS u32x4*)(KS + j * 136 + ch * 8) = ov; }
#pragma unroll
        for (int p = 0; p < 4; ++p) { const int j = p * 32 + rowi;
#pragma unroll
            for (int c2 = 0; c2 < 2; ++c2) { const int chv = ch + 16 * c2; const u32x4 x = vv[2 * p + c2];
                *(LAS u32x4*)(VS + j * 264 + chv * 8) = x; } }
    }
    const int iq = 16 * w + ql; const unsigned tq = (unsigned)(n * 128 + iq);
    bf16x8 qf[4];
    {
        u32x4 qv[4]; float f[4][8];
#pragma unroll
        for (int ds = 0; ds < 4; ++ds) qv[ds] = *(const u32x4*)(proj + tq * INW + C_QR + h * 128 + 32 * ds + 8 * g4);
#pragma unroll
        for (int ds = 0; ds < 4; ++ds) { f[ds][0] = bf2f(qv[ds].x & 0xffffu); f[ds][1] = bf2f(qv[ds].x >> 16); f[ds][2] = bf2f(qv[ds].y & 0xffffu); f[ds][3] = bf2f(qv[ds].y >> 16);
            f[ds][4] = bf2f(qv[ds].z & 0xffffu); f[ds][5] = bf2f(qv[ds].z >> 16); f[ds][6] = bf2f(qv[ds].w & 0xffffu); f[ds][7] = bf2f(qv[ds].w >> 16); }
        const float xi = exp2f(lg2 * (float)(iq + 1));
#pragma unroll
        for (int ds = 0; ds < 2; ++ds) {
            const float* cp = rc + tq * 64 + 32 * ds + 8 * g4; const float* sp = rsn + tq * 64 + 32 * ds + 8 * g4;
            const f32x4 c0 = *(const f32x4*)cp, c1 = *(const f32x4*)(cp + 4), s0 = *(const f32x4*)sp, s1 = *(const f32x4*)(sp + 4);
            const float cv[8] = {c0.x, c0.y, c0.z, c0.w, c1.x, c1.y, c1.z, c1.w}, sv[8] = {s0.x, s0.y, s0.z, s0.w, s1.x, s1.y, s1.z, s1.w};
            float lo[8], hi[8];
#pragma unroll
            for (int e = 0; e < 8; ++e) { const float t1 = f[ds][e], t2 = f[ds + 2][e]; lo[e] = t1 * cv[e] - t2 * sv[e]; hi[e] = t1 * sv[e] + t2 * cv[e]; }
            u32x4 o; o.x = cvt_pk_bf16(lo[0], lo[1]); o.y = cvt_pk_bf16(lo[2], lo[3]); o.z = cvt_pk_bf16(lo[4], lo[5]); o.w = cvt_pk_bf16(lo[6], lo[7]); qf[ds] = __builtin_bit_cast(bf16x8, o);
            o.x = cvt_pk_bf16(hi[0], hi[1]); o.y = cvt_pk_bf16(hi[2], hi[3]); o.z = cvt_pk_bf16(hi[4], hi[5]); o.w = cvt_pk_bf16(hi[6], hi[7]); qf[ds + 2] = __builtin_bit_cast(bf16x8, o);
            o.x = cvt_pk_bf16(lo[0] * xi, lo[1] * xi); o.y = cvt_pk_bf16(lo[2] * xi, lo[3] * xi); o.z = cvt_pk_bf16(lo[4] * xi, lo[5] * xi); o.w = cvt_pk_bf16(lo[6] * xi, lo[7] * xi);
            *(LAS u32x4*)(QS + iq * 136 + 32 * ds + 8 * g4) = o;
            o.x = cvt_pk_bf16(hi[0] * xi, hi[1] * xi); o.y = cvt_pk_bf16(hi[2] * xi, hi[3] * xi); o.z = cvt_pk_bf16(hi[4] * xi, hi[5] * xi); o.w = cvt_pk_bf16(hi[6] * xi, hi[7] * xi);
            *(LAS u32x4*)(QS + iq * 136 + 32 * (ds + 2) + 8 * g4) = o;
        }
    }
    bf16x8 pr[2][4];
#pragma unroll
    for (int a = 0; a < 2; ++a)
#pragma unroll
        for (int ds = 0; ds < 4; ++ds) pr[a][ds] = *(const bf16x8*)(prev + ((2 * w + a) * 16 + ql) * 128 + 32 * ds + 8 * g4);
    __syncthreads();
    f32x4 sc[8];
#pragma unroll
    for (int kt = 0; kt < 8; ++kt) { f32x4 a = (f32x4){0.f, 0.f, 0.f, 0.f};
#pragma unroll
        for (int ds = 0; ds < 4; ++ds) { const bf16x8 kf = *(const LAS bf16x8*)(KS + (16 * kt + ql) * 136 + 32 * ds + 8 * g4); a = mfma16(kf, qf[ds], a); }
#pragma unroll
        for (int i = 0; i < 4; ++i) { const int j = 16 * kt + 4 * g4 + i; const int df = iq - j; a[i] = (df >= 0) ? a[i] * exp2f(lg2 * (float)df) : 0.f; }
        sc[kt] = a; }
    __syncthreads();
#pragma unroll
    for (int kt = 0; kt < 8; ++kt) { u32x2 o; o.x = cvt_pk_bf16(sc[kt][0], sc[kt][1]); o.y = cvt_pk_bf16(sc[kt][2], sc[kt][3]); *(LAS u32x2*)(KS + iq * 136 + 16 * kt + 4 * g4) = o; }
    __syncthreads();
    f32x4 acc[2][8];
#pragma unroll
    for (int a = 0; a < 2; ++a)
#pragma unroll
        for (int qt = 0; qt < 8; ++qt) acc[a][qt] = (f32x4){0.f, 0.f, 0.f, 0.f};
#pragma unroll
    for (int ds = 0; ds < 4; ++ds)
#pragma unroll
        for (int qt = 0; qt < 8; ++qt) { const bf16x8 bq = *(const LAS bf16x8*)(QS + (qt * 16 + ql) * 136 + 32 * ds + 8 * g4);
            acc[0][qt] = mfma16(pr[0][ds], bq, acc[0][qt]); acc[1][qt] = mfma16(pr[1][ds], bq, acc[1][qt]); }
    const unsigned vbw = (unsigned)(size_t)VS + (unsigned)(((8 * g4 + (ql >> 2)) * 264 + 4 * (ql & 3) + 32 * w) * 2);
#pragma unroll
    for (int s = 0; s < 4; ++s) {
        u32x2 vl[2], vh[2];
#pragma unroll
        for (int a = 0; a < 2; ++a) { TR_READ(vl[a], vbw, (32 * s * 264 + a * 16) * 2); TR_READ(vh[a], vbw, ((32 * s + 4) * 264 + a * 16) * 2); }
        TR_WAIT4(vl[0], vh[0], vl[1], vh[1]);
        const bf16x8 vf0 = pk_frag(vl[0], vh[0]), vf1 = pk_frag(vl[1], vh[1]);
#pragma unroll
        for (int qt = 0; qt < 8; ++qt) if (qt >= 2 * s) { const bf16x8 bp = *(const LAS bf16x8*)(KS + (qt * 16 + ql) * 136 + 32 * s + 8 * g4);
            acc[0][qt] = mfma16(vf0, bp, acc[0][qt]); acc[1][qt] = mfma16(vf1, bp, acc[1][qt]); }
    }
#pragma unroll
    for (int qt = 0; qt < 8; ++qt) { float s1 = 0.f, s2 = 0.f;
#pragma unroll
        for (int a = 0; a < 2; ++a)
#pragma unroll
            for (int i = 0; i < 4; ++i) { const float x = acc[a][qt][i]; s1 += x; s2 += x * x; }
        s1 += __shfl_xor(s1, 16); s1 += __shfl_xor(s1, 32); s2 += __shfl_xor(s2, 16); s2 += __shfl_xor(s2, 32);
        if (g4 == 0) *(LAS f32x2*)(RED + (w * 128 + qt * 16 + ql) * 2) = (f32x2){s1, s2}; }
    __syncthreads();
    if (F.tid < 128) { float s1 = 0.f, s2 = 0.f;
#pragma unroll
        for (int ww = 0; ww < 8; ++ww) { const f32x2 v = *(const LAS f32x2*)(RED + (ww * 128 + F.tid) * 2); s1 += v.x; s2 += v.y; }
        const float mean = s1 * (1.f / 256.f); float var = s2 * (1.f / 256.f) - mean * mean; var = var > 0.f ? var : 0.f;
        *(LAS f32x2*)(TOT + F.tid * 2) = (f32x2){mean, 1.0f / sqrtf(var + 1e-5f)}; }
    __syncthreads();
    LAS bf16_t* OT = VS;
#pragma unroll
    for (int qt = 0; qt < 8; ++qt) { const f32x2 st = *(const LAS f32x2*)(TOT + (qt * 16 + ql) * 2);
#pragma unroll
        for (int a = 0; a < 2; ++a) { u32x2 o; o.x = cvt_pk_bf16((acc[a][qt][0] - st.x) * st.y, (acc[a][qt][1] - st.x) * st.y); o.y = cvt_pk_bf16((acc[a][qt][2] - st.x) * st.y, (acc[a][qt][3] - st.x) * st.y);
            *(LAS u32x2*)(OT + (qt * 16 + ql) * 264 + (2 * w + a) * 16 + 4 * g4) = o; } }
    __syncthreads();
    const float* gng = inp(F, IN_GNG) + h * 256;
    {
        const int pc = F.tid & 31;
        const f32x4 gg0 = *(const f32x4*)(gng + pc * 8), gg1 = *(const f32x4*)(gng + pc * 8 + 4);
        u32x4 gv[8];
#pragma unroll
        for (int p = 0; p < 8; ++p) { const unsigned tk = (unsigned)(n * 128 + p * 16 + (F.tid >> 5)); gv[p] = *(const u32x4*)(proj + tk * INW + C_GR + h * 256 + pc * 8); }
#pragma unroll
        for (int p = 0; p < 8; ++p) { const int row = p * 16 + (F.tid >> 5); const unsigned tk = (unsigned)(n * 128 + row);
            const u32x4 x = *(const LAS u32x4*)(OT + row * 264 + pc * 8); u32x4 o;
            o.x = cvt_pk_bf16(bf2f(x.x & 0xffffu) * gg0.x * fsilu(bf2f(gv[p].x & 0xffffu)), bf2f(x.x >> 16) * gg0.y * fsilu(bf2f(gv[p].x >> 16)));
            o.y = cvt_pk_bf16(bf2f(x.y & 0xffffu) * gg0.z * fsilu(bf2f(gv[p].y & 0xffffu)), bf2f(x.y >> 16) * gg0.w * fsilu(bf2f(gv[p].y >> 16)));
            o.z = cvt_pk_bf16(bf2f(x.z & 0xffffu) * gg1.x * fsilu(bf2f(gv[p].z & 0xffffu)), bf2f(x.z >> 16) * gg1.y * fsilu(bf2f(gv[p].z >> 16)));
            o.w = cvt_pk_bf16(bf2f(x.w & 0xffffu) * gg1.z * fsilu(bf2f(gv[p].w & 0xffffu)), bf2f(x.w >> 16) * gg1.w * fsilu(bf2f(gv[p].w >> 16)));
            *(u32x4*)((bf16_t*)(F.ws + WS_YB) + tk * D + h * 256 + pc * 8) = o; }
    }
    __syncthreads();
}
__device__ __forceinline__ void comb_item(const Ctx& F, int it) {
    const bf16_t* og = (const bf16_t*)(F.ws + WS_OG); const float* lse = (const float*)(F.ws + WS_LSE); bf16_t* ya = (bf16_t*)(F.ws + WS_YA);
    for (int rr = 0; rr < 4; ++rr) { const size_t t = (size_t)it * 32 + F.wave * 4 + rr; const int hh = F.lane >> 3;
        const float l0 = lse[(0 * (size_t)S + t) * 8 + hh], l1 = lse[(1 * (size_t)S + t) * 8 + hh], l2 = lse[(2 * (size_t)S + t) * 8 + hh];
        const float m = fmaxf(l0, fmaxf(l1, l2)); float a0 = __expf(l0 - m), a1 = __expf(l1 - m), a2 = __expf(l2 - m); const float inv = 1.f / (a0 + a1 + a2); a0 *= inv; a1 *= inv; a2 *= inv;
#pragma unroll
        for (int c = 0; c < 2; ++c) { const size_t e = t * 1024 + F.lane * 16 + c * 8;
            const u32x4 v0 = *(const u32x4*)(og + e), v1 = *(const u32x4*)(og + (size_t)S * 1024 + e), v2 = *(const u32x4*)(og + 2 * (size_t)S * 1024 + e);
            u32x4 o;
            o.x = cvt_pk_bf16(a0 * bf2f(v0.x & 0xffffu) + a1 * bf2f(v1.x & 0xffffu) + a2 * bf2f(v2.x & 0xffffu), a0 * bf2f(v0.x >> 16) + a1 * bf2f(v1.x >> 16) + a2 * bf2f(v2.x >> 16));
            o.y = cvt_pk_bf16(a0 * bf2f(v0.y & 0xffffu) + a1 * bf2f(v1.y & 0xffffu) + a2 * bf2f(v2.y & 0xffffu), a0 * bf2f(v0.y >> 16) + a1 * bf2f(v1.y >> 16) + a2 * bf2f(v2.y >> 16));
            o.z = cvt_pk_bf16(a0 * bf2f(v0.z & 0xffffu) + a1 * bf2f(v1.z & 0xffffu) + a2 * bf2f(v2.z & 0xffffu), a0 * bf2f(v0.z >> 16) + a1 * bf2f(v1.z >> 16) + a2 * bf2f(v2.z >> 16));
            o.w = cvt_pk_bf16(a0 * bf2f(v0.w & 0xffffu) + a1 * bf2f(v1.w & 0xffffu) + a2 * bf2f(v2.w & 0xffffu), a0 * bf2f(v0.w >> 16) + a1 * bf2f(v1.w >> 16) + a2 * bf2f(v2.w >> 16));
            *(u32x4*)(ya + e) = o; } }
}
__device__ __forceinline__ void p4_scan_comb(const Ctx& F) {
    p4_scan(F);
    for (int it = F.bx; it < 256; it += F.G) comb_item(F, it);
}
__device__ __forceinline__ void p5_mix2(const Ctx& F) {
    for (int it = F.bx; it < 512; it += F.G) ret_unit(F, it);
    if (DUP2_MASK & 1) { __syncthreads(); for (int it = F.bx; it < 512; it += F.G) ret_unit(F, it); }
}

__device__ __forceinline__ void p8_router(const Ctx& F) {
    LAS float* gs = (LAS float*)F.lds; LAS float* sh = gs + D; LAS float* XS = sh + D; LAS float* WSm = XS + 32 * 260; LAS float* SC = WSm + 256 * 64; LAS float* SEL = SC + 32 * 64; LAS float* RSTD = SEL + 32 * 64;
    const float* modf = (const float*)(F.ws + WS_MODF);
    for (int k = F.tid; k < D; k += 512) { gs[k] = inp(F, IN_LN2)[k] * (1.f + modf[4 * D + k]); sh[k] = modf[3 * D + k]; }
    __syncthreads();
    const float* x1 = F.out; unsigned char* H2 = F.ws + WS_H;
    const float* rw = inp(F, IN_RW); const float* rb = inp(F, IN_RB);
    int* e_of = (int*)(F.ws + WS_EOF); int* pos_of = e_of + 65536; float* topw = (float*)(pos_of + 65536);
    unsigned* cnt = (unsigned*)(F.ws + WS_CTL) + CW_CNT;
    for (int it = F.bx; it < 256; it += F.G) {
        const int t0 = it * 32;
#pragma unroll 1
        for (int rr = 0; rr < 4; ++rr) { const int m = t0 + F.wave * 4 + rr;
            const GAS f32x4* xr = (const GAS f32x4*)(x1 + (size_t)m * D) + F.lane;
            f32x4 v[8]; float ss = 0.f;
#pragma unroll
            for (int j = 0; j < 8; ++j) { v[j] = xr[64 * j]; ss += (v[j].x * v[j].x + v[j].y * v[j].y) + (v[j].z * v[j].z + v[j].w * v[j].w); }
#pragma unroll
            for (int o = 1; o < 64; o <<= 1) ss += __shfl_xor(ss, o);
            const float rstd = 1.0f / sqrtf(ss * (1.f / D) + 1e-6f);
            if (F.lane == 0) RSTD[F.wave * 4 + rr] = rstd;
            GAS unsigned* o4 = (GAS unsigned*)(H2 + (size_t)m * D) + F.lane;
#pragma unroll
            for (int j = 0; j < 8; ++j) { const f32x4 g = *(const LAS f32x4*)(gs + 256 * j + 4 * F.lane), s = *(const LAS f32x4*)(sh + 256 * j + 4 * F.lane);
                const f32x4 y = v[j] * rstd * g + s; o4[64 * j] = cvt4_fp8(y.x, y.y, y.z, y.w); } }
        __syncthreads();
        const int tok = F.tid >> 4, eq = F.tid & 15;
        f32x16 ac0, ac1;
#pragma unroll
        for (int i = 0; i < 16; ++i) { ac0[i] = 0.f; ac1[i] = 0.f; }
#pragma unroll 1
        for (int kc = 0; kc < 8; ++kc) {
#pragma unroll
            for (int q = 0; q < 4; ++q) { const int idx = F.tid + 512 * q; const int row = idx >> 6, c4 = (idx & 63) * 4; const int k = kc * 256 + c4;
                const f32x4 xv = *(const f32x4*)(x1 + (size_t)(t0 + row) * D + k); const float rstd = RSTD[row];
                const f32x4 g = *(const LAS f32x4*)(gs + k), s = *(const LAS f32x4*)(sh + k);
                *(LAS f32x4*)(XS + row * 260 + c4) = xv * rstd * g + s; }
#pragma unroll
            for (int q = 0; q < 8; ++q) { const int idx = F.tid + 512 * q; const int kr = idx >> 4, c4 = (idx & 15) * 4;
                *(LAS f32x4*)(WSm + kr * 64 + c4) = *(const f32x4*)(rw + (size_t)(kc * 256 + kr) * 64 + c4); }
            __syncthreads();
            { const int i31 = F.lane & 31, kh = F.lane >> 5;
#pragma unroll 4
              for (int kp = 0; kp < 16; ++kp) { const int k = 32 * F.wave + 2 * kp + kh;
                  const float av = XS[i31 * 260 + k]; const float b0 = WSm[k * 64 + i31], b1 = WSm[k * 64 + 32 + i31];
                  ac0 = __builtin_amdgcn_mfma_f32_32x32x2f32(av, b0, ac0, 0, 0, 0); ac1 = __builtin_amdgcn_mfma_f32_32x32x2f32(av, b1, ac1, 0, 0, 0); } }
            __syncthreads();
        }
        { LAS float* RED = WSm + F.wave * 2048; const int i31 = F.lane & 31, kh = F.lane >> 5;
#pragma unroll
          for (int rg = 0; rg < 16; ++rg) { const int row = (rg & 3) + 8 * (rg >> 2) + 4 * kh; RED[row * 64 + i31] = ac0[rg]; RED[row * 64 + 32 + i31] = ac1[rg]; } }
        __syncthreads();
        f32x4 lg = (f32x4){0.f, 0.f, 0.f, 0.f};
#pragma unroll
        for (int w = 0; w < 8; ++w) lg += *(const LAS f32x4*)(WSm + w * 2048 + tok * 64 + eq * 4);
#pragma unroll
        for (int i = 0; i < 4; ++i) { const float sc = fsigm(lg[i]); SC[tok * 64 + eq * 4 + i] = sc; SEL[tok * 64 + eq * 4 + i] = sc + rb[eq * 4 + i]; }
        __syncthreads();
        if (F.tid < 32) {
            LAS float* sel = SEL + F.tid * 64; const LAS float* scp = SC + F.tid * 64;
            float gsc[8];
#pragma unroll
            for (int g = 0; g < 8; ++g) { float m1 = -3e38f, m2 = -3e38f;
#pragma unroll
                for (int j = 0; j < 8; ++j) { const float v = sel[g * 8 + j]; if (v > m1) { m2 = m1; m1 = v; } else if (v > m2) m2 = v; }
                gsc[g] = m1 + m2; }
            unsigned gmask = 0u;
#pragma unroll
            for (int r = 0; r < 4; ++r) { float best = -3e38f; int bi = 0;
#pragma unroll
                for (int g = 0; g < 8; ++g) { const bool take = !((gmask >> g) & 1u) && gsc[g] > best; best = take ? gsc[g] : best; bi = take ? g : bi; }
                gmask |= 1u << bi; }
            int idx[8]; float wv[8]; float wsum = 0.f;
#pragma unroll
            for (int r = 0; r < 8; ++r) { float best = -3e38f; int bi = 0;
                for (int e = 0; e < 64; ++e) { const float v = sel[e]; const bool take = ((gmask >> (e >> 3)) & 1u) && v > best; best = take ? v : best; bi = take ? e : bi; }
                sel[bi] = -3e38f; idx[r] = bi; wv[r] = scp[bi]; wsum += wv[r]; }
            const float sc = 2.5f / wsum; const int tk = t0 + F.tid;
#pragma unroll
            for (int r = 0; r < 8; ++r) { const unsigned pos = __hip_atomic_fetch_add(cnt + idx[r], 1u, __ATOMIC_RELAXED, __HIP_MEMORY_SCOPE_AGENT);
                e_of[tk * 8 + r] = idx[r]; pos_of[tk * 8 + r] = (int)pos; topw[tk * 8 + r] = wv[r] * sc; }
        }
        __syncthreads();
    }
}

__device__ __forceinline__ void build_moe_tab(const Ctx& F) {
    MoeTab tab = moe_tab(F.lds);
    LAS int* padstart = tab.misc + 8;
    if (F.tid < 64) {
        unsigned* cnt = (unsigned*)(F.ws + WS_CTL) + CW_CNT;
        const int c = (int)__hip_atomic_load(cnt + F.tid, __ATOMIC_RELAXED, __HIP_MEMORY_SCOPE_AGENT);
        const int nt = (c + 255) >> 8; int pre = nt;
#pragma unroll
        for (int o = 1; o < 64; o <<= 1) { const int v = __shfl_up(pre, o); if (F.tid >= o) pre += v; }
        const int excl = pre - nt;
        padstart[F.tid] = excl * 256;
        for (int r = 0; r < nt; ++r) { tab.te[excl + r] = F.tid; const int left = c - r * 256; tab.tn[excl + r] = left < 256 ? left : 256; }
        if (F.tid == 63) tab.misc[0] = pre;
    }
    __syncthreads();
}
__device__ __forceinline__ void p9_dispatch(const Ctx& F) {
    build_moe_tab(F);
    const LAS int* padstart = moe_tab(F.lds).misc + 8;
    const int* e_of = (const int*)(F.ws + WS_EOF); const int* pos_of = e_of + 65536; const float* topw = (const float*)(pos_of + 65536); int* inv = (int*)(topw + 65536);
    int* toks = (int*)(F.ws + WS_TOKS); float* wsorted = (float*)(toks + SH_ROW0);
    for (int i = F.bx * 512 + F.tid; i < 65536; i += F.G * 512) { const int e = e_of[i]; const int dest = padstart[e] + pos_of[i]; toks[dest] = i >> 3; wsorted[dest] = topw[i]; inv[i] = dest; }
}
__device__ __forceinline__ void p12_combine(const Ctx& F) {
    const unsigned char* Y = F.ws + WS_Y; const int* inv = (const int*)(F.ws + WS_EOF) + 3 * 65536; const float* g2 = (const float*)(F.ws + WS_MODF) + 5 * D;
    const int gw = F.vcu * 8 + F.wave, NGW = F.G * 8;
    for (int m = gw; m < S; m += NGW) {
        int rows[9];
#pragma unroll
        for (int s = 0; s < 8; ++s) rows[s] = inv[m * 8 + s];
        rows[8] = SH_ROW0 + m;
#pragma unroll
        for (int c = 0; c < 2; ++c) { const int col = c * 1024 + F.lane * 16;
            u32x4 v[9];
#pragma unroll
            for (int s = 0; s < 9; ++s) v[s] = *(const u32x4*)(Y + (size_t)rows[s] * D + col);
            float a[16];
#pragma unroll
            for (int e = 0; e < 16; ++e) a[e] = 0.f;
#pragma unroll
            for (int s = 0; s < 9; ++s) { const unsigned w4[4] = {v[s].x, v[s].y, v[s].z, v[s].w};
#pragma unroll
                for (int q = 0; q < 4; ++q) { const f32x2 lo = __builtin_amdgcn_cvt_pk_f32_fp8((int)w4[q], false), hi = __builtin_amdgcn_cvt_pk_f32_fp8((int)w4[q], true);
                    a[4 * q] += lo.x; a[4 * q + 1] += lo.y; a[4 * q + 2] += hi.x; a[4 * q + 3] += hi.y; } }
            float* op = F.out + (size_t)m * D + col;
#pragma unroll
            for (int q = 0; q < 4; ++q) { const f32x4 x0 = *(const f32x4*)(op + 4 * q); const f32x4 gq = *(const f32x4*)(g2 + col + 4 * q) * (1.0f / FP8_YS);
                *(f32x4*)(op + 4 * q) = x0 + gq * (f32x4){a[4 * q], a[4 * q + 1], a[4 * q + 2], a[4 * q + 3]}; } }
    }
}


__device__ __forceinline__ void ph2_proj(const Ctx& F) {
    pg8::DenseSched Sd; Sd.init(F.ws + WS_H, D, F.ws + WS_WINT, S, INW, D, F.G, F.bx);
    EpiBf16 E{(bf16_t*)(F.ws + WS_PROJ), INW, 0};
    const int nun = (Sd.nwg - F.bx + F.G - 1) / F.G;
    const int slot = nun > 0 ? ((F.bx >> 3) + (F.bx & 7)) % nun : 0;
    Sd.i_lo = 0; Sd.i_hi = slot;
    pg8::gemm_phase<EpiBf16, pg8::DenseSched, true>(F.lds, D, Sd, E);
    __syncthreads();
    convert_items(F, CV_BG_FROM, CV_ALL, F.vcu * 8 + F.wave, F.G * 8);
    __syncthreads();
    Sd.i_lo = slot; Sd.i_hi = nun;
    pg8::gemm_phase<EpiBf16, pg8::DenseSched, true>(F.lds, D, Sd, E);
    if (DUP2_MASK & 48) { __syncthreads(); EpiBf16 E2{(bf16_t*)(F.ws + WS_PROJ), INW, (DUP2_MASK & 32) ? 1 : 0}; Sd.i_lo = 0; Sd.i_hi = nun; pg8::gemm_phase<EpiBf16, pg8::DenseSched, true>(F.lds, D, Sd, E2); }
}
__device__ __forceinline__ void ph6a_merge(const Ctx& F) {
    pg8::DenseSched Sd; Sd.init(F.ws + WS_YA, 1024, F.ws + WS_PA, S, D, 1024, F.G, F.bx);
    EpiGate<false> E{(bf16_t*)(F.ws + WS_MERGED), D, (const bf16_t*)(F.ws + WS_PROJ) + C_GA, INW};
    pg8::gemm_phase<EpiGate<false>, pg8::DenseSched, true>(F.lds, 1024, Sd, E);
}
__device__ __forceinline__ void ph6_merge(const Ctx& F) {
    pg8::DenseSched Sd; Sd.init(F.ws + WS_YB, D, F.ws + WS_PB, S, D, D, F.G, F.bx);
    EpiGate<true> E{(bf16_t*)(F.ws + WS_MERGED), D, (const bf16_t*)(F.ws + WS_PROJ) + C_GB, INW};
    pg8::gemm_phase<EpiGate<true>, pg8::DenseSched, true>(F.lds, D, Sd, E);
}
__device__ __forceinline__ void p5_mix2_a(const Ctx& F) { p5_mix2(F); __syncthreads(); ph6a_merge(F); }
__device__ __forceinline__ void ph7_wo(const Ctx& F) {
    pg8::DenseSched Sd; Sd.init(F.ws + WS_MERGED, D, F.ws + WS_WO, S, D, D, F.G, F.bx);
    EpiResid E{inp(F, IN_X), F.out, D, (const float*)(F.ws + WS_MODF) + 2 * D};
    pg8::gemm_phase<EpiResid, pg8::DenseSched, true>(F.lds, D, Sd, E);
}
__device__ __forceinline__ void ph10_gateup(const Ctx& F) {
    build_moe_tab(F);
    MoeSched1 S1{(const char*)(F.ws + WS_H), (const char*)(F.ws + WS_E1), (const int*)(F.ws + WS_TOKS), moe_tab(F.lds), F.G, F.vcu};
    EpiGateUp E{(unsigned char*)(F.ws + WS_ACT)};
    pg8::gemm_phase<EpiGateUp, MoeSched1, true, true>(F.lds, D, S1, E);
}
__device__ __forceinline__ void ph11_down(const Ctx& F) {
    build_moe_tab(F);
    MoeSched2 S2{(const char*)(F.ws + WS_ACT), (const char*)(F.ws + WS_E2), moe_tab(F.lds), F.G, F.vcu};
    EpiDown E{(unsigned char*)(F.ws + WS_Y), (const float*)(F.ws + WS_TOKS) + SH_ROW0};
    pg8::gemm_phase<EpiDown, MoeSched2, true, true>(F.lds, ED, S2, E);
}

struct Args { const float* in[22]; float* out; unsigned char* ws; int ph_lo, ph_hi; };
__global__ void __launch_bounds__(512, 2) fwd(Args args) {
    extern __shared__ __attribute__((aligned(16))) unsigned char lds_raw[];
    Ctx F;
    F.lds = (LAS unsigned char*)lds_raw;
    F.tid = threadIdx.x; F.lane = F.tid & 63; F.wave = __builtin_amdgcn_readfirstlane(F.tid >> 6);
    F.G = gridDim.x; F.bx = blockIdx.x; F.vcu = (F.G % 8 == 0) ? (F.bx % 8) * (F.G / 8) + F.bx / 8 : F.bx;
    F.out = args.out; F.ws = args.ws;
    if (F.tid == 0) {
#pragma unroll
        for (int i = 0; i < 22; ++i) ((LAS unsigned long long*)(F.lds + LDS_PTRS))[i] = (unsigned long long)args.in[i];
    }
    volatile LAS unsigned* MISC = (volatile LAS unsigned*)(F.lds + LDS_MISC);
    if (F.tid < 64) MISC[F.tid] = 0u;
    __syncthreads();
    unsigned* ctl = (unsigned*)(F.ws + WS_CTL);
    XcdBarrier bar; bar.bar = ctl + CW_BAR; bar.x = 0; bar.st = nullptr;
    if (!MK_PER_PHASE) bar = xcd_barrier_post(ctl + CW_BAR, MISC + 8);
    const int lo = args.ph_lo, hi = args.ph_hi;
#ifndef PHASE_MASK
#define PHASE_MASK 0x1fff
#endif
#define IN(k) (((PHASE_MASK >> (k)) & 1) && lo <= (k) && (k) < hi)
#define SEAM(k) do { if (IN(k) && IN((k) + 1)) xcd_barrier(bar); } while (0)

#ifndef DUP_MASK
#define DUP_MASK 0
#endif
#define RUN(k, fn) do { if (IN(k)) { fn(F); if ((DUP_MASK >> (k)) & 1) { xcd_barrier(bar); fn(F); } } SEAM(k); } while (0)
    RUN(0, p0_prologue);
    RUN(1, p1_norm1);
    RUN(2, ph2_proj);
    RUN(3, p3_mix1);
    RUN(4, p4_scan_comb);
    RUN(5, p5_mix2_a);
    RUN(6, ph6_merge);
    RUN(7, ph7_wo);
    RUN(8, p8_router);
    RUN(9, p9_dispatch);
    RUN(10, ph10_gateup);
    RUN(11, ph11_down);
    RUN(12, p12_combine);
#undef RUN
#undef IN
#undef SEAM
}

extern "C" void kernel_launch(void* const* d_in, const int* in_sizes, int n_in, void* d_out, int out_size, void* d_ws, size_t ws_size, hipStream_t stream) {
    static int grid = 0;
    if (grid == 0) {
        if (n_in != 22 || out_size != S * D || ws_size < WS_END) { fprintf(stderr, "kernel_launch: unexpected shapes / workspace (n_in %d out %d ws %zu need %zu)\n", n_in, out_size, ws_size, (size_t)WS_END); grid = -1; return; }
        int dev = 0, cus = 0, per_cu = 0;
        if (hipGetDevice(&dev) != hipSuccess || hipDeviceGetAttribute(&cus, hipDeviceAttributeMultiprocessorCount, dev) != hipSuccess) { grid = -1; return; }
        if (hipFuncSetAttribute((const void*)fwd, hipFuncAttributeMaxDynamicSharedMemorySize, LDS_BYTES) != hipSuccess) { fprintf(stderr, "kernel_launch: hipFuncSetAttribute failed\n"); grid = -1; return; }
        if (hipOccupancyMaxActiveBlocksPerMultiprocessor(&per_cu, (const void*)fwd, 512, LDS_BYTES) != hipSuccess || per_cu < 1) fprintf(stderr, "kernel_launch: occupancy query says %d\n", per_cu);
        (void)hipGetLastError();
        grid = cus;
    }
    if (grid < 0) return;
    (void)hipMemsetAsync((char*)d_ws + WS_CTL, 0, CTL_ZERO_BYTES, stream);
    Args a{};
    for (int i = 0; i < 22; ++i) a.in[i] = (const float*)d_in[i];
    a.out = (float*)d_out; a.ws = (unsigned char*)d_ws;
#if MK_PER_PHASE
    for (int p = 0; p < NPH; ++p) { a.ph_lo = p; a.ph_hi = p + 1; hipLaunchKernelGGL(fwd, dim3(grid), dim3(512), LDS_BYTES, stream, a); }
#else
    a.ph_lo = 0; a.ph_hi = NPH; hipLaunchKernelGGL(fwd, dim3(grid), dim3(512), LDS_BYTES, stream, a);
#endif
}
```

```cpp
#include <hip/hip_runtime.h>
#include <cstdio>
#include <cstdint>

#define LAS __attribute__((address_space(3)))
#define GAS __attribute__((address_space(1)))
typedef unsigned short bf16_t;
typedef short bf16x8 __attribute__((ext_vector_type(8)));
typedef short bf16x4 __attribute__((ext_vector_type(4)));
typedef float f32x4 __attribute__((ext_vector_type(4)));
typedef float f32x2 __attribute__((ext_vector_type(2)));
typedef float f32x16 __attribute__((ext_vector_type(16)));
typedef unsigned u32x4 __attribute__((ext_vector_type(4)));
typedef unsigned u32x2 __attribute__((ext_vector_type(2)));
typedef GAS unsigned gu32;

#ifndef DUP2_MASK
#define DUP2_MASK 0
#endif
#ifndef MK_PER_PHASE
#define MK_PER_PHASE 0
#endif

constexpr int S = 8192, D = 2048, INW = 19456;
constexpr int C_QA = 0, C_KA = 3072, C_VA = 6144, C_QR = 9216, C_KR = 10240, C_VR = 11264, C_GR = 13312, C_GA = 15360, C_GB = 17408;
constexpr int NE = 64, ED = 512, TOPK = 8;
constexpr int MAXT_R = 320;
constexpr int SH_ROW0 = MAXT_R * 256;
constexpr int NROWS_Y = SH_ROW0 + S;
constexpr int NPH = 13;

constexpr size_t MiB = 1u << 20;
constexpr size_t WS_CTL = 0, CTL_ZERO_BYTES = 1 * MiB;
constexpr size_t WS_MODP = 1 * MiB;
constexpr size_t WS_MODF = 1 * MiB + 512 * 1024;
constexpr size_t WS_LSE = 2 * MiB;
constexpr size_t WS_ROPE = 3 * MiB;
constexpr size_t WS_EOF = 7 * MiB;
constexpr size_t WS_TOKS = 8 * MiB;
constexpr size_t WS_PA = 10 * MiB, WS_PB = 14 * MiB, WS_WO = 22 * MiB;
constexpr size_t WS_H = 32 * MiB;
constexpr size_t WS_E1 = 64 * MiB;
constexpr size_t WS_H8 = 194 * MiB;
constexpr size_t WS_WIN8 = 210 * MiB;
constexpr size_t WS_E2 = 324 * MiB;
constexpr size_t WS_PREV = 454 * MiB;
constexpr size_t WS_YB = 486 * MiB;
constexpr size_t WS_MERGED = 518 * MiB;
constexpr size_t WS_R1 = 550 * MiB;
constexpr size_t WS_OG = WS_R1, WS_YA = WS_R1 + 48 * MiB, WS_UPD = WS_R1 + 64 * MiB, WS_ACT = WS_R1;
constexpr size_t WS_R2 = 678 * MiB;
constexpr size_t WS_WINT = WS_R2, WS_PROJ = WS_R2 + 76 * MiB, WS_Y = WS_R2;
constexpr size_t WS_END = 1058 * MiB;
constexpr int CW_TMO = 0, CW_CODE = 1, CW_BAR = 4096, CW_CNT = 8192;

constexpr int RING_BYTES = 131072;
constexpr int LDS_TAB = 131072;
constexpr int LDS_MISC = 163840 - 256;
constexpr int LDS_BYTES = 163840;

__device__ __forceinline__ float bf2f(unsigned b) { return __uint_as_float(b << 16); }
__device__ __forceinline__ unsigned cvt_pk_bf16(float lo, float hi) { unsigned r; asm("v_cvt_pk_bf16_f32 %0, %1, %2" : "=v"(r) : "v"(lo), "v"(hi)); return r; }
__device__ __forceinline__ float fsilu(float v) { return v / (1.f + __expf(-v)); }
__device__ __forceinline__ float fsigm(float v) { return 1.f / (1.f + __expf(-v)); }
#define TR_READ(dst, base, OFF) asm volatile("ds_read_b64_tr_b16 %0, %1 offset:%2" : "=&v"(dst) : "v"(base), "i"(OFF) : "memory")
#define TR_WAIT2(a, b) asm volatile("s_waitcnt lgkmcnt(0)" : "+v"(a), "+v"(b) :: "memory")
#define TR_WAIT4(a, b, c, d) asm volatile("s_waitcnt lgkmcnt(0)" : "+v"(a), "+v"(b), "+v"(c), "+v"(d) :: "memory")
typedef int i32x8 __attribute__((ext_vector_type(8)));
__device__ __forceinline__ unsigned cvt4_fp8(float a, float b, float c, float d) {
    a = fminf(fmaxf(a, -448.f), 448.f); b = fminf(fmaxf(b, -448.f), 448.f); c = fminf(fmaxf(c, -448.f), 448.f); d = fminf(fmaxf(d, -448.f), 448.f);
    int r = __builtin_amdgcn_cvt_pk_fp8_f32(a, b, 0, false); r = __builtin_amdgcn_cvt_pk_fp8_f32(c, d, r, true); return (unsigned)r;
}
__device__ __forceinline__ i32x8 ld32(const LAS unsigned char* p) { const u32x4 a = *(const LAS u32x4*)p, b = *(const LAS u32x4*)(p + 16); i32x8 r; r[0] = (int)a.x; r[1] = (int)a.y; r[2] = (int)a.z; r[3] = (int)a.w; r[4] = (int)b.x; r[5] = (int)b.y; r[6] = (int)b.z; r[7] = (int)b.w; return r; }
__device__ __forceinline__ i32x8 cat8(bf16x8 lo, bf16x8 hi) { const u32x4 a = __builtin_bit_cast(u32x4, lo), b = __builtin_bit_cast(u32x4, hi); i32x8 r; r[0] = (int)a.x; r[1] = (int)a.y; r[2] = (int)a.z; r[3] = (int)a.w; r[4] = (int)b.x; r[5] = (int)b.y; r[6] = (int)b.z; r[7] = (int)b.w; return r; }
constexpr float FP8_WIN = 32.f;
__host__ __device__ __forceinline__ bool proj_tile_fp8(int pn) { return (pn >= 24 && pn < 36) || pn >= 44; }
constexpr float FP8_WS1 = 32.f, FP8_WS2 = 16.f, FP8_AS = 4.f, FP8_YS = 32.f;
#define LDS_WAIT() asm volatile("s_waitcnt lgkmcnt(0)" ::: "memory")
#define VM_WAIT() asm volatile("s_waitcnt vmcnt(0)" ::: "memory")

namespace pg8 {
constexpr int BM = 256, BK = 64, HALF = 128, HTB = HALF * BK * 2, STAGE_BYTES = 8 * HTB, NXCD = 8, WGM = 8;
__host__ __device__ __forceinline__ int lds_byte(int r, int c) { const int st = (r >> 4) * 2 + (c >> 5), rr = r & 15, cc = c & 31, ob = rr * 64 + cc * 2; return st * 1024 + (ob ^ (((ob >> 9) & 1) << 5)); }
__host__ __device__ __forceinline__ void stage_rc(int b, int& R, int& C) { const int st = b / 1024, sb = b % 1024, swz = sb ^ (((sb >> 9) & 1) << 5); R = (st >> 1) * 16 + swz / 64; C = (st & 1) * 32 + (swz % 64) / 2; }
__host__ __device__ __forceinline__ int perm32(int rho) { const int n = rho >> 4, i = rho & 15; return 8 * (i >> 2) + 4 * n + (i & 3); }

struct Unit { int row0, pn, e, nvalid; };

struct DenseSched {
    static constexpr bool RAGGED = false;
    const char* A; const char* Bt; int lda, K; int nM, nN, nwg, G, c, i_lo, i_hi;
    __device__ __forceinline__ void init(const void* A_, int lda_, const void* Bt_, int M, int N, int K_, int G_, int c_) { A = (const char*)A_; Bt = (const char*)Bt_; lda = lda_; K = K_; nM = M / BM; nN = N / BM; nwg = nM * nN; G = G_; c = c_; i_lo = 0; i_hi = 0x7fffffff; }
    __device__ __forceinline__ bool next(int i, Unit& u) const {
        if (i_lo + i >= i_hi) return false;
        const long L = (long)(i_lo + i) * G + c; if (L >= nwg) return false;
        int wgid = (int)L; { const int q = nwg / NXCD, r = nwg % NXCD, xcd = wgid % NXCD, off = wgid / NXCD; wgid = (xcd < r ? xcd * (q + 1) : r * (q + 1) + (xcd - r) * q) + off; }
        const int nig = WGM * nN, gid = wgid / nig, fm = gid * WGM, gsz = (nM - fm) < WGM ? (nM - fm) : WGM;
        u.row0 = (fm + ((wgid % nig) % gsz)) * BM; u.pn = (wgid % nig) / gsz; u.e = 0; u.nvalid = 256; return true;
    }
    __device__ __forceinline__ const char* a_base() const { return A; }
    __device__ __forceinline__ const char* b_ptr(const Unit& u) const { return Bt + (size_t)u.pn * BM * K * 2; }
    __device__ __forceinline__ void a_off(const Unit& u, int tid, unsigned (&off)[2][2]) const {
#pragma unroll
        for (int i = 0; i < 2; ++i) { int R, C; stage_rc(tid * 16 + i * 8192, R, C);
            off[0][i] = (unsigned)((u.row0 + R) * lda + C) * 2u; off[1][i] = (unsigned)((u.row0 + HALF + R) * lda + C) * 2u; }
    }
};


template <bool FP8SET> struct ProjSched {
    static constexpr bool RAGGED = false;
    static constexpr int ntl = FP8SET ? 44 : 32, nM = 32, nwg = nM * ntl;
    const char* A; const char* Bt; int apitch, bpitch; int G, c, i_lo, i_hi;
    __device__ __forceinline__ void init(const void* A_, int apitch_, const void* Bt_, int bpitch_, int G_, int c_) { A = (const char*)A_; Bt = (const char*)Bt_; apitch = apitch_; bpitch = bpitch_; G = G_; c = c_; i_lo = 0; i_hi = 0x7fffffff; }
    __device__ __forceinline__ int count() const { return c < nwg ? (nwg - c + G - 1) / G : 0; }
    __device__ __forceinline__ bool next(int i, Unit& u) const {
        if (i_lo + i >= i_hi) return false;
        const long L = (long)(i_lo + i) * G + c; if (L >= nwg) return false;
        int wgid = (int)L; { const int q = nwg / NXCD, r = nwg % NXCD, xcd = wgid % NXCD, off = wgid / NXCD; wgid = (xcd < r ? xcd * (q + 1) : r * (q + 1) + (xcd - r) * q) + off; }
        const int nig = WGM * ntl, gid = wgid / nig, fm = gid * WGM, gsz = (nM - fm) < WGM ? (nM - fm) : WGM;
        u.row0 = (fm + ((wgid % nig) % gsz)) * BM; const int t = (wgid % nig) / gsz;
        u.pn = FP8SET ? (t < 12 ? 24 + t : 32 + t) : (t < 24 ? t : t + 12); u.e = 0; u.nvalid = 256; return true;
    }
    __device__ __forceinline__ const char* a_base() const { return A; }
    __device__ __forceinline__ const char* b_ptr(const Unit& u) const { return Bt + (size_t)u.pn * BM * bpitch; }
    __device__ __forceinline__ void a_off(const Unit& u, int tid, unsigned (&off)[2][2]) const {
#pragma unroll
        for (int i = 0; i < 2; ++i) { int R, C; stage_rc(tid * 16 + i * 8192, R, C);
            off[0][i] = (unsigned)((u.row0 + R) * apitch + 2 * C); off[1][i] = (unsigned)((u.row0 + HALF + R) * apitch + 2 * C); }
    }
};

template <class Epi, class Sched, bool ALIGN_EPI, bool FP8 = false>
__device__ __forceinline__ void gemm_phase(LAS unsigned char* lds, const int K, const Sched& S, const Epi& E) {
    const int tid = threadIdx.x, wid = __builtin_amdgcn_readfirstlane(tid >> 6), lane = tid & 63, wr = wid >> 2, wc = wid & 3, fr = lane & 15, fq = lane >> 4;
    const int nt = FP8 ? K / 128 : K / BK;
    const int pitch = FP8 ? K : 2 * K;
    unsigned voffB[2];
#pragma unroll
    for (int i = 0; i < 2; ++i) { int R, C; stage_rc(tid * 16 + i * 8192, R, C); const int Rb = Epi::PERM ? ((R & ~31) + perm32(R & 31)) : R; voffB[i] = (unsigned)(Rb * pitch + 2 * C); }
    const size_t kstep = (size_t)(BK * 2);
    const size_t hstepB = (size_t)HALF * pitch;
    const unsigned ldsw = (unsigned)wid * 1024u;
    const int aoff = lds_byte(wr * 64 + fr, FP8 ? fq * 16 : fq * 8), boff = lds_byte(wc * 32 + fr, FP8 ? fq * 16 : fq * 8);
#define PG8_SA(b, h) (((b) * 2 + (h)) * HTB)
#define PG8_SB(b, h) ((4 + (b) * 2 + (h)) * HTB)
#define PG8_STAGE(bufoff, gbase, voff) do { _Pragma("unroll") for (int _i = 0; _i < 2; ++_i) \
        __builtin_amdgcn_global_load_lds((const unsigned*)((const char*)(gbase) + (voff)[_i]), (LAS unsigned*)(lds + (bufoff) + ldsw + _i * 8192), 16, 0, 0); } while (0)
#define PG8_LDA(dst, b, h) do { if constexpr (FP8) { _Pragma("unroll") for (int m = 0; m < 4; ++m) dst##8[m] = ld32(lds + PG8_SA(b, h) + aoff + m * 2048); } \
        else { _Pragma("unroll") for (int m = 0; m < 4; ++m) _Pragma("unroll") for (int k = 0; k < 2; ++k) dst[m][k] = *(const LAS bf16x8*)(lds + PG8_SA(b, h) + aoff + m * 2048 + k * 1024); } } while (0)
#define PG8_LDB(dst, b, h) do { if constexpr (FP8) { _Pragma("unroll") for (int n = 0; n < 2; ++n) dst##8[n] = ld32(lds + PG8_SB(b, h) + boff + n * 2048); } \
        else { _Pragma("unroll") for (int n = 0; n < 2; ++n) _Pragma("unroll") for (int k = 0; k < 2; ++k) dst[n][k] = *(const LAS bf16x8*)(lds + PG8_SB(b, h) + boff + n * 2048 + k * 1024); } } while (0)
#define PG8_MMA(ai, bj, At, Bt) do { __builtin_amdgcn_s_setprio(1); if constexpr (FP8) { _Pragma("unroll") for (int m = 0; m < 4; ++m) _Pragma("unroll") for (int n = 0; n < 2; ++n) \
        asm volatile("v_mfma_scale_f32_16x16x128_f8f6f4 %0, %1, %2, %0, %3, %3 op_sel_hi:[0,0,0]" : "+v"(acc[ai][bj][m][n]) : "v"(Bt##8[n]), "v"(At##8[m]), "v"(fp8_one)); } \
      else { _Pragma("unroll") for (int m = 0; m < 4; ++m) _Pragma("unroll") for (int n = 0; n < 2; ++n) _Pragma("unroll") for (int k = 0; k < 2; ++k) \
        acc[ai][bj][m][n] = __builtin_amdgcn_mfma_f32_16x16x32_bf16(Bt[n][k], At[m][k], acc[ai][bj][m][n], 0, 0, 0); } __builtin_amdgcn_s_setprio(0); } while (0)
#define PG8_WAIT_V(n) asm volatile("s_waitcnt vmcnt(" #n ")" ::: "memory")
#define PG8_WAIT_L(n) asm volatile("s_waitcnt lgkmcnt(" #n ")" ::: "memory")
#define PG8_BAR __builtin_amdgcn_s_barrier()
#define PG8_SCHED __builtin_amdgcn_sched_barrier(0)
    Unit cur, nxt; int ui = 0;
    if (!S.next(0, cur)) return;
    f32x4 acc[2][2][4][2];
#pragma unroll
    for (int a = 0; a < 2; ++a)
#pragma unroll
        for (int b = 0; b < 2; ++b)
#pragma unroll
            for (int m = 0; m < 4; ++m)
#pragma unroll
                for (int n = 0; n < 2; ++n) acc[a][b][m][n] = (f32x4){0.f, 0.f, 0.f, 0.f};
    bf16x8 At[4][2], B0[2][2], B1[2][2];
    i32x8 At8[4], B08[2], B18[2];
    const int fp8_one = 0x7f7f7f7f;
    unsigned coff[2][2], noff[2][2];
    S.a_off(cur, tid, coff);
    const char* const Ab = S.a_base();
    const char* cB = S.b_ptr(cur);
    PG8_STAGE(PG8_SB(0, 0), cB, voffB); PG8_STAGE(PG8_SB(0, 1), cB + hstepB, voffB); PG8_STAGE(PG8_SA(0, 0), Ab, coff[0]); PG8_STAGE(PG8_SA(0, 1), Ab, coff[1]);
    if (wr == 1) PG8_BAR;
    PG8_WAIT_V(2); PG8_BAR;
    PG8_STAGE(PG8_SB(1, 0), cB + kstep, voffB); PG8_STAGE(PG8_SA(1, 0), Ab + kstep, coff[0]); PG8_STAGE(PG8_SB(1, 1), cB + hstepB + kstep, voffB);
    PG8_WAIT_V(6); PG8_BAR;
    for (;;) {
        const bool has_next = S.next(ui + 1, nxt);
        const char* nB = has_next ? S.b_ptr(nxt) : cB;
        for (int t = 0; t < nt; t += 2) {
            const bool last = (t == nt - 2);
            const char* a1 = Ab + (size_t)(t + 1) * kstep;
            const char* a2 = last ? Ab : Ab + (size_t)(t + 2) * kstep; const char* b2 = last ? nB : cB + (size_t)(t + 2) * kstep;
            const char* a3 = a2 + kstep; const char* b3 = b2 + kstep;
            if (last && has_next) S.a_off(nxt, tid, noff);
            PG8_LDB(B0, 0, 0); PG8_LDB(B1, 0, 1); PG8_SCHED; PG8_LDA(At, 0, 0); PG8_STAGE(PG8_SA(1, 1), a1, coff[1]);
            PG8_WAIT_V(8); PG8_WAIT_L(0); PG8_BAR; PG8_MMA(0, 0, At, B0); PG8_MMA(0, 1, At, B1); PG8_BAR; PG8_SCHED;
            if (last && has_next) { coff[0][0] = noff[0][0]; coff[0][1] = noff[0][1]; coff[1][0] = noff[1][0]; coff[1][1] = noff[1][1]; }
            PG8_LDA(At, 0, 1); PG8_STAGE(PG8_SB(0, 0), b2, voffB); PG8_STAGE(PG8_SB(0, 1), b2 + hstepB, voffB); PG8_STAGE(PG8_SA(0, 0), a2, coff[0]);
            PG8_WAIT_V(8); PG8_WAIT_L(0); PG8_BAR; if (!Sched::RAGGED || cur.nvalid > HALF) { PG8_MMA(1, 0, At, B0); PG8_MMA(1, 1, At, B1); } PG8_BAR; PG8_SCHED;
            PG8_LDB(B0, 1, 0); PG8_LDB(B1, 1, 1); PG8_SCHED; PG8_LDA(At, 1, 0); PG8_STAGE(PG8_SA(0, 1), a2, coff[1]);
            PG8_WAIT_V(8); PG8_WAIT_L(0); PG8_BAR; PG8_MMA(0, 0, At, B0); PG8_MMA(0, 1, At, B1); PG8_BAR; PG8_SCHED;
            PG8_LDA(At, 1, 1); PG8_STAGE(PG8_SB(1, 0), b3, voffB); PG8_STAGE(PG8_SB(1, 1), b3 + hstepB, voffB); PG8_STAGE(PG8_SA(1, 0), a3, coff[0]);
            PG8_WAIT_V(8); PG8_WAIT_L(0); PG8_BAR; if (!Sched::RAGGED || cur.nvalid > HALF) { PG8_MMA(1, 0, At, B0); PG8_MMA(1, 1, At, B1); } PG8_BAR; PG8_SCHED;
        }
        if constexpr (ALIGN_EPI) { if (wr == 0) PG8_BAR; }
        if constexpr (FP8) asm volatile("s_nop 15\n\ts_nop 15\n\ts_nop 15" ::: "memory");
        E(acc, cur, wr, wc, fr, fq);
        if (!has_next) break;
#pragma unroll
        for (int a = 0; a < 2; ++a)
#pragma unroll
            for (int b = 0; b < 2; ++b)
#pragma unroll
                for (int m = 0; m < 4; ++m)
#pragma unroll
                    for (int n = 0; n < 2; ++n) acc[a][b][m][n] = (f32x4){0.f, 0.f, 0.f, 0.f};
        cur = nxt; cB = nB; ++ui;
        if constexpr (ALIGN_EPI) { if (wr == 1) PG8_BAR; }
    }
    PG8_WAIT_V(0);
    if constexpr (!ALIGN_EPI) { if (wr == 0) PG8_BAR; }
    PG8_BAR;
#undef PG8_SA
#undef PG8_SB
#undef PG8_STAGE
#undef PG8_LDA
#undef PG8_LDB
#undef PG8_MMA
#undef PG8_WAIT_V
#undef PG8_WAIT_L
#undef PG8_BAR
#undef PG8_SCHED
}
}
using pg8::Unit;

struct EpiBf16 {
    static constexpr bool PERM = true;
    bf16_t* O; int ldc; int nostore; float scale;
    __device__ __forceinline__ void operator()(const f32x4 (&acc)[2][2][4][2], const Unit& u, int wr, int wc, int fr, int fq) const {
        const int row0 = u.row0 + wr * 64 + fr, col0 = u.pn * 256 + wc * 32 + 8 * fq;
#pragma unroll
        for (int ai = 0; ai < 2; ++ai)
#pragma unroll
            for (int m = 0; m < 4; ++m) { bf16_t* rowp = O + (size_t)(row0 + ai * 128 + m * 16) * ldc + col0;
#pragma unroll
                for (int bj = 0; bj < 2; ++bj) { const f32x4 v0 = acc[ai][bj][m][0] * scale, v1 = acc[ai][bj][m][1] * scale;
                    u32x4 w; w.x = cvt_pk_bf16(v0[0], v0[1]); w.y = cvt_pk_bf16(v0[2], v0[3]); w.z = cvt_pk_bf16(v1[0], v1[1]); w.w = cvt_pk_bf16(v1[2], v1[3]);
                    if (!nostore) *(u32x4*)(rowp + bj * 128) = w; else asm volatile("" :: "v"(w)); } }
    }
};
template <bool ADD> struct EpiGate {
    static constexpr bool PERM = true;
    bf16_t* O; int ldc; const bf16_t* gate; int ldg;
    __device__ __forceinline__ void operator()(const f32x4 (&acc)[2][2][4][2], const Unit& u, int wr, int wc, int fr, int fq) const {
        const int row0 = u.row0 + wr * 64 + fr, col0 = u.pn * 256 + wc * 32 + 8 * fq;
#pragma unroll
        for (int ai = 0; ai < 2; ++ai)
#pragma unroll
            for (int m = 0; m < 4; ++m) { const size_t r = (size_t)(row0 + ai * 128 + m * 16); bf16_t* rowp = O + r * ldc + col0; const bf16_t* gp = gate + r * ldg + col0;
#pragma unroll
                for (int bj = 0; bj < 2; ++bj) { const f32x4 v0 = acc[ai][bj][m][0], v1 = acc[ai][bj][m][1];
                    const u32x4 g = *(const u32x4*)(gp + bj * 128);
                    float o[8];
                    o[0] = fsigm(bf2f(g.x & 0xffffu)) * v0[0]; o[1] = fsigm(bf2f(g.x >> 16)) * v0[1]; o[2] = fsigm(bf2f(g.y & 0xffffu)) * v0[2]; o[3] = fsigm(bf2f(g.y >> 16)) * v0[3];
                    o[4] = fsigm(bf2f(g.z & 0xffffu)) * v1[0]; o[5] = fsigm(bf2f(g.z >> 16)) * v1[1]; o[6] = fsigm(bf2f(g.w & 0xffffu)) * v1[2]; o[7] = fsigm(bf2f(g.w >> 16)) * v1[3];
                    if (ADD) { const u32x4 p = *(const u32x4*)(rowp + bj * 128);
                        o[0] += bf2f(p.x & 0xffffu); o[1] += bf2f(p.x >> 16); o[2] += bf2f(p.y & 0xffffu); o[3] += bf2f(p.y >> 16);
                        o[4] += bf2f(p.z & 0xffffu); o[5] += bf2f(p.z >> 16); o[6] += bf2f(p.w & 0xffffu); o[7] += bf2f(p.w >> 16); }
                    u32x4 w; w.x = cvt_pk_bf16(o[0], o[1]); w.y = cvt_pk_bf16(o[2], o[3]); w.z = cvt_pk_bf16(o[4], o[5]); w.w = cvt_pk_bf16(o[6], o[7]);
                    *(u32x4*)(rowp + bj * 128) = w; } }
    }
};
struct EpiResid {
    static constexpr bool PERM = false;
    const float* base; float* out; int ldc; const float* gvec;
    __device__ __forceinline__ void operator()(const f32x4 (&acc)[2][2][4][2], const Unit& u, int wr, int wc, int fr, int fq) const {
        const int row0 = u.row0 + wr * 64 + fr, col0 = u.pn * 256 + wc * 32 + 4 * fq;
        f32x4 gv[2][2];
#pragma unroll
        for (int bj = 0; bj < 2; ++bj)
#pragma unroll
            for (int n = 0; n < 2; ++n) gv[bj][n] = *(const f32x4*)(gvec + col0 + bj * 128 + n * 16);
#pragma unroll
        for (int ai = 0; ai < 2; ++ai)
#pragma unroll
            for (int m = 0; m < 4; ++m) { const size_t off = (size_t)(row0 + ai * 128 + m * 16) * ldc + col0;
#pragma unroll
                for (int bj = 0; bj < 2; ++bj)
#pragma unroll
                    for (int n = 0; n < 2; ++n) { const f32x4 bs = *(const f32x4*)(base + off + bj * 128 + n * 16); *(f32x4*)(out + off + bj * 128 + n * 16) = bs + gv[bj][n] * acc[ai][bj][m][n]; } }
    }
};
struct EpiGateUp {
    static constexpr bool PERM = true;
    unsigned char* ACT;
    __device__ __forceinline__ void operator()(const f32x4 (&acc)[2][2][4][2], const Unit& u, int wr, int wc, int fr, int fq) const {
        const int row0 = u.row0 + wr * 64 + fr, col0 = u.pn * 128 + wc * 32 + 8 * fq;
        constexpr float ws = 1.0f / FP8_WS1;
#pragma unroll
        for (int ai = 0; ai < 2; ++ai)
#pragma unroll
            for (int m = 0; m < 4; ++m) { unsigned char* rowp = ACT + (size_t)(row0 + ai * 128 + m * 16) * ED + col0;
                const f32x4 g0 = acc[ai][0][m][0] * ws, g1 = acc[ai][0][m][1] * ws, u0 = acc[ai][1][m][0] * (ws * FP8_AS), u1 = acc[ai][1][m][1] * (ws * FP8_AS);
                u32x2 w; w.x = cvt4_fp8(fsilu(g0[0]) * u0[0], fsilu(g0[1]) * u0[1], fsilu(g0[2]) * u0[2], fsilu(g0[3]) * u0[3]);
                w.y = cvt4_fp8(fsilu(g1[0]) * u1[0], fsilu(g1[1]) * u1[1], fsilu(g1[2]) * u1[2], fsilu(g1[3]) * u1[3]);
                *(u32x2*)rowp = w; }
    }
};
struct EpiDown {
    static constexpr bool PERM = true;
    unsigned char* Y; const float* wsorted;
    __device__ __forceinline__ void operator()(const f32x4 (&acc)[2][2][4][2], const Unit& u, int wr, int wc, int fr, int fq) const {
        const int rl0 = wr * 64 + fr, col0 = u.pn * 256 + wc * 32 + 8 * fq;
#pragma unroll
        for (int ai = 0; ai < 2; ++ai)
#pragma unroll
            for (int m = 0; m < 4; ++m) { const int rl = rl0 + ai * 128 + m * 16; const int row = u.row0 + rl;
                float wv = 1.f; if (u.e < NE) wv = (rl < u.nvalid) ? wsorted[row] : 0.f;
                wv *= FP8_YS / (FP8_WS2 * FP8_AS);
                unsigned char* rowp = Y + (size_t)row * D + col0;
#pragma unroll
                for (int bj = 0; bj < 2; ++bj) { const f32x4 v0 = acc[ai][bj][m][0] * wv, v1 = acc[ai][bj][m][1] * wv;
                    u32x2 w; w.x = cvt4_fp8(v0[0], v0[1], v0[2], v0[3]); w.y = cvt4_fp8(v1[0], v1[1], v1[2], v1[3]);
                    *(u32x2*)(rowp + bj * 128) = w; } }
    }
};

struct MoeTab { LAS int* te; LAS int* tn; LAS int* misc; };
__device__ __forceinline__ MoeTab moe_tab(LAS unsigned char* lds) { MoeTab t; t.te = (LAS int*)(lds + LDS_TAB); t.tn = t.te + 352; t.misc = t.tn + 352; return t; }
struct MoeSched1 {
    static constexpr bool RAGGED = true;
    const char* H2; const char* E1; const int* toks; MoeTab tab; int G, vcu;
    __device__ __forceinline__ bool next(int i, Unit& u) const {
        const int ntr = tab.misc[0]; const int L = i * G + vcu; if (L >= 4 * (ntr + 32)) return false;
        const int t = L >> 2; u.pn = L & 3;
        if (t < ntr) { u.row0 = t * 256; u.e = tab.te[t]; u.nvalid = tab.tn[t]; } else { u.row0 = SH_ROW0 + (t - ntr) * 256; u.e = NE; u.nvalid = 256; }
        return true;
    }
    __device__ __forceinline__ const char* a_base() const { return H2; }
    __device__ __forceinline__ const char* b_ptr(const Unit& u) const { return E1 + ((size_t)u.e * 1024 + (size_t)u.pn * 256) * D; }
    __device__ __forceinline__ void a_off(const Unit& u, int tid, unsigned (&off)[2][2]) const {
#pragma unroll
        for (int i = 0; i < 2; ++i) { int R, C; pg8::stage_rc(tid * 16 + i * 8192, R, C);
#pragma unroll
            for (int h = 0; h < 2; ++h) { const int r = h * 128 + R; int tok;
                if (u.e < NE) tok = (r < u.nvalid) ? toks[u.row0 + r] : 0; else tok = u.row0 - SH_ROW0 + r;
                off[h][i] = (unsigned)(tok * D + 2 * C); } }
    }
};
struct MoeSched2 {
    static constexpr bool RAGGED = true;
    const char* ACT; const char* E2; MoeTab tab; int G, vcu;
    __device__ __forceinline__ bool next(int i, Unit& u) const {
        const int ntr = tab.misc[0]; const int L = i * G + vcu; if (L >= 8 * (ntr + 32)) return false;
        const int t = L >> 3; u.pn = L & 7;
        if (t < ntr) { u.row0 = t * 256; u.e = tab.te[t]; u.nvalid = tab.tn[t]; } else { u.row0 = SH_ROW0 + (t - ntr) * 256; u.e = NE; u.nvalid = 256; }
        return true;
    }
    __device__ __forceinline__ const char* a_base() const { return ACT; }
    __device__ __forceinline__ const char* b_ptr(const Unit& u) const { return E2 + ((size_t)u.e * 2048 + (size_t)u.pn * 256) * ED; }
    __device__ __forceinline__ void a_off(const Unit& u, int tid, unsigned (&off)[2][2]) const {
#pragma unroll
        for (int i = 0; i < 2; ++i) { int R, C; pg8::stage_rc(tid * 16 + i * 8192, R, C);
            off[0][i] = (unsigned)((u.row0 + R) * ED + 2 * C); off[1][i] = (unsigned)((u.row0 + 128 + R) * ED + 2 * C); }
    }
};

#define XB_TMO      128
#define XB_XCNT(j)  (256  + 64 * (j))
#define XB_XSUB(j)  (1280 + 64 * (j))
#define XB_XGEN(j)  (2304 + 64 * (j))
#define XB_TOP      3328
#define XB_TOPGEN   3392
#define XCD_BAR_WORDS 3456
#define XB_SPIN_CAP (1u << 18)
__device__ __forceinline__ unsigned xb_ld(unsigned* p)              { return __hip_atomic_load(p, __ATOMIC_RELAXED, __HIP_MEMORY_SCOPE_AGENT); }
__device__ __forceinline__ unsigned xb_add(unsigned* p, unsigned v) { return __hip_atomic_fetch_add(p, v, __ATOMIC_RELAXED, __HIP_MEMORY_SCOPE_AGENT); }
__device__ __forceinline__ unsigned xb_xcc_id() { return (unsigned)__builtin_amdgcn_s_getreg((3 << 11) | 20) & 0xFu; }
#define XB_SPIN(cond, bar) do { unsigned _sp = 0; while (cond) { __builtin_amdgcn_s_sleep(1); \
    if ((++_sp & 255u) == 0u) { if (xb_ld(&(bar)[XB_TMO])) break; if (_sp > XB_SPIN_CAP) { atomicAdd(&(bar)[XB_TMO], 1u); break; } } } } while (0)
struct XcdBarrier { unsigned* bar; unsigned x; volatile LAS unsigned* st; };
__device__ __forceinline__ XcdBarrier xcd_barrier_post(unsigned* bar, volatile LAS unsigned* st) {
    XcdBarrier b; b.bar = bar; b.x = xb_xcc_id(); b.st = st;
    if (threadIdx.x == 0) (void)xb_add(&bar[XB_XCNT(b.x)], 1u);
    return b;
}
__device__ __forceinline__ void xcd_barrier_complete(unsigned* bar, unsigned x, unsigned& nloc, unsigned& nx) {
    const unsigned G = gridDim.x * gridDim.y * gridDim.z;
    unsigned sum, cnt, mine, sp = 0u;
    for (;;) {
        sum = 0u; cnt = 0u; mine = 0u;
#pragma unroll
        for (unsigned j = 0; j < 16; ++j) { const unsigned c = xb_ld(&bar[XB_XCNT(j)]); sum += c; cnt += (c > 0u) ? 1u : 0u; mine = (j == x) ? c : mine; }
        if (sum == G) break;
        __builtin_amdgcn_s_sleep(1);
        if ((++sp & 255u) == 0u) { if (xb_ld(&bar[XB_TMO])) break; if (sp > XB_SPIN_CAP) { atomicAdd(&bar[XB_TMO], 1u); break; } }
    }
    nloc = mine > 0u ? mine : 1u; nx = cnt > 0u ? cnt : 1u;
}
__device__ __forceinline__ void xcd_barrier(const XcdBarrier& b) {
    asm volatile("s_waitcnt vmcnt(0)" ::: "memory");
    __syncthreads();
    if (threadIdx.x == 0) {
        unsigned* bar = b.bar;
        __builtin_amdgcn_s_waitcnt(0);
        unsigned nloc = b.st[0], nx = b.st[1];
        if (nloc == 0u) { xcd_barrier_complete(bar, b.x, nloc, nx); b.st[0] = nloc; b.st[1] = nx; }
        const unsigned old = xb_add(&bar[XB_XSUB(b.x)], 1u);
        const unsigned gen = old / nloc;
        if (old + 1u == (gen + 1u) * nloc) {
            __builtin_amdgcn_fence(__ATOMIC_RELEASE, "agent");
            asm volatile("s_waitcnt vmcnt(0)" ::: "memory");
            const unsigned og = xb_add(&bar[XB_TOP], 1u);
            const unsigned tg = og / nx;
            if (og + 1u == (tg + 1u) * nx) xb_add(&bar[XB_TOPGEN], 1u);
            else XB_SPIN(xb_ld(&bar[XB_TOPGEN]) == tg, bar);
            __builtin_amdgcn_fence(__ATOMIC_ACQUIRE, "agent");
            xb_add(&bar[XB_XGEN(b.x)], 1u);
            asm volatile("s_waitcnt vmcnt(0)" ::: "memory");
        } else {
            XB_SPIN(xb_ld(&bar[XB_XGEN(b.x)]) == gen, bar);
            __builtin_amdgcn_fence(__ATOMIC_ACQUIRE, "agent");
            asm volatile("s_waitcnt vmcnt(0)" ::: "memory");
        }
    }
    __syncthreads();
}

struct Ctx {
    LAS unsigned char* lds;
    int tid, lane, wave, G, vcu, bx;
    float* out; unsigned char* ws;
};
constexpr int LDS_PTRS = 163840 - 512;
__device__ __forceinline__ const float* inp(const Ctx& F, int i) {
    const LAS unsigned* p = (const LAS unsigned*)(F.lds + LDS_PTRS) + 2 * i;
    const unsigned lo = __builtin_amdgcn_readfirstlane(p[0]), hi = __builtin_amdgcn_readfirstlane(p[1]);
    return (const float*)(const GAS float*)(((unsigned long long)hi << 32) | lo);
}
#define IN_X 0
#define IN_C 1
#define IN_RELB 2
#define IN_WADA 3
#define IN_BADA 4
#define IN_LN1 5
#define IN_WIN 6
#define IN_QNG 7
#define IN_KNG 8
#define IN_GNG 9
#define IN_PA 10
#define IN_PB 11
#define IN_WO 12
#define IN_LN2 13
#define IN_RW 14
#define IN_RB 15
#define IN_WG 16
#define IN_WU 17
#define IN_WD 18
#define IN_WGS 19
#define IN_WUS 20
#define IN_WDS 21

struct CvItem { const float* src; unsigned char* dst; int ldw, ldt; float scale; };
constexpr int CV_WIN = 32 * 304, CV_PA = 16 * 32, CV_PB = 32 * 32, CV_WO = 32 * 32, CV_EX = 768;
constexpr int CV_DENSE = CV_WIN + CV_PA + CV_PB + CV_WO, CV_ALL = CV_DENSE + 65 * CV_EX;
#ifndef CV_BG_FROM
#define CV_BG_FROM CV_DENSE
#endif
__device__ __forceinline__ void cv_kn(int q, int nbg_count, int& kb, int& nb) {
    const int super = q >> 3, sub = q & 7; kb = (super / nbg_count) * 4 + (sub >> 1); nb = (super % nbg_count) * 2 + (sub & 1);
}
__device__ __forceinline__ CvItem cv_decode(const Ctx& F, int it) {
    CvItem c; int r = it; int kb, nb; c.scale = 0.f;
    if (r < CV_WIN) { cv_kn(r, 152, kb, nb); c.ldw = INW; c.src = inp(F, IN_WIN) + (size_t)(64 * kb) * INW + 64 * nb;
        if (proj_tile_fp8(nb >> 2)) { c.ldt = D; c.scale = FP8_WIN; c.dst = F.ws + WS_WIN8 + (size_t)(64 * nb) * D + 64 * kb; }
        else { c.ldt = D * 2; c.dst = F.ws + WS_WINT + ((size_t)(64 * nb) * D + 64 * kb) * 2; }
        return c; } r -= CV_WIN;
    if (r < CV_PA) { cv_kn(r, 16, kb, nb); c.ldw = D; c.ldt = 1024 * 2; c.src = inp(F, IN_PA) + (size_t)(64 * kb) * D + 64 * nb; c.dst = F.ws + WS_PA + ((size_t)(64 * nb) * 1024 + 64 * kb) * 2; return c; } r -= CV_PA;
    if (r < CV_PB) { cv_kn(r, 16, kb, nb); c.ldw = D; c.ldt = D * 2; c.src = inp(F, IN_PB) + (size_t)(64 * kb) * D + 64 * nb; c.dst = F.ws + WS_PB + ((size_t)(64 * nb) * D + 64 * kb) * 2; return c; } r -= CV_PB;
    if (r < CV_WO) { cv_kn(r, 16, kb, nb); c.ldw = D; c.ldt = D * 2; c.src = inp(F, IN_WO) + (size_t)(64 * kb) * D + 64 * nb; c.dst = F.ws + WS_WO + ((size_t)(64 * nb) * D + 64 * kb) * 2; return c; } r -= CV_WO;
    const int e = r / CV_EX; int q = r % CV_EX;
    if (q < 512) {
        const int isup = q >> 8; q &= 255; cv_kn(q, 4, kb, nb); const int n0 = 64 * nb;
        const float* w = (e < NE) ? inp(F, isup ? IN_WU : IN_WG) + (size_t)e * D * ED : inp(F, isup ? IN_WUS : IN_WGS);
        c.ldw = ED; c.ldt = D; c.scale = FP8_WS1; c.src = w + (size_t)(64 * kb) * ED + n0;
        c.dst = F.ws + WS_E1 + ((size_t)e * 1024 + (size_t)((n0 >> 7) * 256 + (n0 & 127) + isup * 128)) * D + 64 * kb;
    } else {
        q -= 512; cv_kn(q, 16, kb, nb);
        const float* w = (e < NE) ? inp(F, IN_WD) + (size_t)e * ED * D : inp(F, IN_WDS);
        c.ldw = D; c.ldt = ED; c.scale = FP8_WS2; c.src = w + (size_t)(64 * kb) * D + 64 * nb;
        c.dst = F.ws + WS_E2 + ((size_t)e * D + (size_t)(64 * nb)) * ED + 64 * kb;
    }
    return c;
}
__device__ __forceinline__ void cv_load(const CvItem& c, int lane, f32x4 (&v)[16]) {
    const int r4 = lane >> 4, c16 = lane & 15;
#pragma unroll
    for (int i = 0; i < 16; ++i) v[i] = *(const f32x4*)(c.src + (size_t)(4 * i + r4) * c.ldw + 4 * c16);
}
__device__ __forceinline__ void cv_store(const CvItem& c, int lane, const f32x4 (&v)[16], LAS float* scr) {
    const int r4 = lane >> 4, c16 = lane & 15;
#pragma unroll
    for (int i = 0; i < 16; ++i) { LAS float* d = scr + (4 * i + r4) * 65 + 4 * c16; d[0] = v[i].x; d[1] = v[i].y; d[2] = v[i].z; d[3] = v[i].w; }
    LDS_WAIT(); asm volatile("" ::: "memory");
    const int cc = lane & 7;
    if (c.scale == 0.f) {
#pragma unroll
        for (int j = 0; j < 8; ++j) { const int n = (lane >> 3) + 8 * j; const LAS float* s = scr + (8 * cc) * 65 + n;
            u32x4 o; o.x = cvt_pk_bf16(s[0 * 65], s[1 * 65]); o.y = cvt_pk_bf16(s[2 * 65], s[3 * 65]); o.z = cvt_pk_bf16(s[4 * 65], s[5 * 65]); o.w = cvt_pk_bf16(s[6 * 65], s[7 * 65]);
            *(GAS u32x4*)(c.dst + (size_t)n * c.ldt + 16 * cc) = o; }
    } else { const float sc = c.scale;
#pragma unroll
        for (int j = 0; j < 8; ++j) { const int n = (lane >> 3) + 8 * j; const LAS float* s = scr + (8 * cc) * 65 + n;
            u32x2 o; o.x = cvt4_fp8(s[0 * 65] * sc, s[1 * 65] * sc, s[2 * 65] * sc, s[3 * 65] * sc); o.y = cvt4_fp8(s[4 * 65] * sc, s[5 * 65] * sc, s[6 * 65] * sc, s[7 * 65] * sc);
            *(GAS u32x2*)(c.dst + (size_t)n * c.ldt + 8 * cc) = o; }
    }
    LDS_WAIT(); asm volatile("" ::: "memory");
}
__device__ __forceinline__ void convert_items(const Ctx& F, int lo, int hi, int gw, int NGW) {
    LAS float* scr = (LAS float*)(F.lds + 16384 + F.wave * 16640);
    int it = lo + gw;
    if (it >= hi) return;
    f32x4 va[16], vb[16];
    CvItem ca = cv_decode(F, it), cb = ca;
    cv_load(ca, F.lane, va);
    for (;;) {
        int nx = it + NGW; const bool hb = nx < hi;
        if (hb) { cb = cv_decode(F, nx); cv_load(cb, F.lane, vb); }
        cv_store(ca, F.lane, va, scr);
        if (!hb) break;
        it = nx; nx = it + NGW; const bool ha = nx < hi;
        if (ha) { ca = cv_decode(F, nx); cv_load(ca, F.lane, va); }
        cv_store(cb, F.lane, vb, scr);
        if (!ha) break;
        it = nx;
    }
}
__device__ __forceinline__ void p0_prologue(const Ctx& F) {
    {
        const float* cvec = inp(F, IN_C); const float* wada = inp(F, IN_WADA); float* modp = (float*)(F.ws + WS_MODP);
        LAS float* red = (LAS float*)F.lds;
        for (int it = F.bx; it < 384; it += F.G) {
            const int cc = it % 48, ks = it / 48; const int col = cc * 256 + F.lane * 4; const int k0 = ks * 256 + F.wave * 32;
            f32x4 a = (f32x4){0.f, 0.f, 0.f, 0.f};
#pragma unroll 8
            for (int r = 0; r < 32; ++r) { const int k = k0 + r; const float s = fsilu(cvec[k]); const f32x4 w = *(const f32x4*)(wada + (size_t)k * 12288 + col); a += w * s; }
            *(LAS f32x4*)(red + F.wave * 256 + F.lane * 4) = a;
            __syncthreads();
            if (F.tid < 256) { float s = 0.f;
#pragma unroll
                for (int w = 0; w < 8; ++w) s += red[w * 256 + F.tid];
                modp[ks * 12288 + cc * 256 + F.tid] = s; }
            __syncthreads();
        }
    }
    {
        float* rc = (float*)(F.ws + WS_ROPE); float* rs = rc + S * 64;
        for (int idx = F.bx * 512 + F.tid; idx < S * 64; idx += F.G * 512) {
            const int pos = idx >> 6, i = idx & 63;
            double inv = 1.0; const double r = 0.86596432336006535;
            for (int q = 0; q < i; ++q) inv *= r;
            const double ang = (double)pos * inv;
            const double n = __builtin_rint(ang * 0.15915494309189535);
            const float red = (float)(ang - n * 6.283185307179586);
            rc[idx] = __cosf(red); rs[idx] = __sinf(red);
        }
    }
    convert_items(F, 0, CV_BG_FROM, F.vcu * 8 + F.wave, F.G * 8);
}

__device__ __forceinline__ float mod_sum(const Ctx& F, int n) {
    const float* modp = (const float*)(F.ws + WS_MODP); float s = inp(F, IN_BADA)[n];
#pragma unroll
    for (int k = 0; k < 8; ++k) s += modp[k * 12288 + n];
    return s;
}
__device__ __forceinline__ void norm_rows(const Ctx& F, const float* X, const LAS float* gs, const LAS float* sh, bf16_t* O, unsigned char* O8) {
    const int gw = F.vcu * 8 + F.wave, NGW = F.G * 8;
    for (int m = gw; m < S; m += NGW) {
        const GAS f32x4* xr = (const GAS f32x4*)(X + (size_t)m * D) + F.lane;
        f32x4 v[8]; float ss = 0.f;
#pragma unroll
        for (int j = 0; j < 8; ++j) { v[j] = xr[64 * j]; ss += (v[j].x * v[j].x + v[j].y * v[j].y) + (v[j].z * v[j].z + v[j].w * v[j].w); }
#pragma unroll
        for (int o = 1; o < 64; o <<= 1) ss += __shfl_xor(ss, o);
        const float rstd = 1.0f / sqrtf(ss * (1.f / D) + 1e-6f);
        GAS u32x2* o8 = (GAS u32x2*)(O + (size_t)m * D) + F.lane; GAS unsigned* o4 = (GAS unsigned*)(O8 + (size_t)m * D) + F.lane;
#pragma unroll
        for (int j = 0; j < 8; ++j) { const f32x4 g = *(const LAS f32x4*)(gs + 256 * j + 4 * F.lane), s = *(const LAS f32x4*)(sh + 256 * j + 4 * F.lane);
            const f32x4 y = v[j] * rstd * g + s; u32x2 w; w.x = cvt_pk_bf16(y.x, y.y); w.y = cvt_pk_bf16(y.z, y.w); o8[64 * j] = w; o4[64 * j] = cvt4_fp8(y.x, y.y, y.z, y.w); }
    }
}
__device__ __forceinline__ void p1_norm1(const Ctx& F) {
    LAS float* gs = (LAS float*)F.lds; LAS float* sh = gs + D;
    for (int k = F.tid; k < D; k += 512) { const float shv = mod_sum(F, k), scv = mod_sum(F, D + k); gs[k] = inp(F, IN_LN1)[k] * (1.f + scv); sh[k] = shv; }
    float* modf = (float*)(F.ws + WS_MODF);
    for (int n = F.bx * 512 + F.tid; n < 12288; n += F.G * 512) modf[n] = mod_sum(F, n);
    __syncthreads();
    norm_rows(F, inp(F, IN_X), gs, sh, (bf16_t*)(F.ws + WS_H), F.ws + WS_H8);
}


__device__ __forceinline__ bf16x8 pk_frag(u32x2 lo, u32x2 hi) { u32x4 v; v.x = lo.x; v.y = lo.y; v.z = hi.x; v.w = hi.y; return __builtin_bit_cast(bf16x8, v); }
__device__ __forceinline__ f32x4 mfma16(bf16x8 a, bf16x8 b, f32x4 c) { return __builtin_amdgcn_mfma_f32_16x16x32_bf16(a, b, c, 0, 0, 0); }
__device__ __forceinline__ float gamma_log2(int h) { return log2f(1.0f - exp2f(-5.0f - (float)h)); }

struct AttnU { int g, hh, d, r, nb, head; };
__device__ __forceinline__ AttnU attn_decode(int u) {
    AttnU U; U.g = u >> 9; const int rem = u & 511; U.hh = rem >> 6; const int rem2 = rem & 63;
    const int dsh = 2 * U.g; U.d = 1 << dsh; const int nblk = 64 >> dsh;
    U.r = rem2 / nblk; U.nb = rem2 % nblk; U.head = U.g * 8 + U.hh; return U;
}
__device__ __forceinline__ void attn_issue(const bf16_t* proj, const AttnU& U, int tid, int w, int lane, u32x4 (&kr)[8], u32x4 (&vr)[8], u32x4 (&qr)[4]) {
    const int rowi = tid >> 4, ch = tid & 15;
#pragma unroll
    for (int p = 0; p < 8; ++p) { const int cc = p * 32 + rowi; const int jk = (U.nb - 1) * 128 + cc;
        if (jk >= 0) { const unsigned off = (unsigned)(jk * U.d + U.r) * INW + U.head * 128 + ch * 8; kr[p] = *(const u32x4*)(proj + off + C_KA); vr[p] = *(const u32x4*)(proj + off + C_VA); }
        else { kr[p] = (u32x4){0u, 0u, 0u, 0u}; vr[p] = (u32x4){0u, 0u, 0u, 0u}; } }
    const int ql = lane & 15, g4 = lane >> 4; const unsigned tq = (unsigned)((U.nb * 128 + 16 * w + ql) * U.d + U.r);
#pragma unroll
    for (int ds = 0; ds < 4; ++ds) qr[ds] = *(const u32x4*)(proj + tq * INW + C_QA + U.head * 128 + 32 * ds + 8 * g4);
}
__device__ __forceinline__ void p3_attn(const Ctx& F) {
    const bf16_t* proj = (const bf16_t*)(F.ws + WS_PROJ);
    LAS bf16_t* KS = (LAS bf16_t*)F.lds;
    LAS bf16_t* VS = (LAS bf16_t*)(F.lds + 69632);
    LAS float* BT = (LAS float*)(F.lds + 139264);
    const int lane = F.lane, w = F.wave, ql = lane & 15, g4 = lane >> 4;
    const int rowi = F.tid >> 4, ch = F.tid & 15;
    u32x4 kr[8], vr[8], qr[4];
    int it = F.bx;
    if (it < 1536) { const AttnU U0 = attn_decode(it); attn_issue(proj, U0, F.tid, w, lane, kr, vr, qr); }
    for (; it < 1536; it += F.G) {
        const AttnU U = attn_decode(it);
        const int d = U.d, nb = U.nb;
        if (F.tid <= 128) { const int dist = F.tid * d; int b;
            if (dist < 16) b = dist; else { b = 16 + (int)floorf(log2f((float)dist * 0.0625f) * (16.0f / 7.0f)); b = b > 31 ? 31 : b; }
            BT[F.tid] = inp(F, IN_RELB)[b * 24 + U.head]; }
        {
            const float* kg = inp(F, IN_KNG) + ch * 8;
            const f32x4 kg0 = *(const f32x4*)kg, kg1 = *(const f32x4*)(kg + 4);
#pragma unroll
            for (int p = 0; p < 8; ++p) { const int cc = p * 32 + rowi;
                float f[8]; f[0] = bf2f(kr[p].x & 0xffffu); f[1] = bf2f(kr[p].x >> 16); f[2] = bf2f(kr[p].y & 0xffffu); f[3] = bf2f(kr[p].y >> 16);
                f[4] = bf2f(kr[p].z & 0xffffu); f[5] = bf2f(kr[p].z >> 16); f[6] = bf2f(kr[p].w & 0xffffu); f[7] = bf2f(kr[p].w >> 16);
                float ss = 0.f;
#pragma unroll
                for (int e = 0; e < 8; ++e) ss += f[e] * f[e];
                ss += __shfl_xor(ss, 1); ss += __shfl_xor(ss, 2); ss += __shfl_xor(ss, 4); ss += __shfl_xor(ss, 8);
                const float rstd = 1.0f / sqrtf(ss * (1.f / 128.f) + 1e-6f);
                u32x4 o; o.x = cvt_pk_bf16(f[0] * rstd * kg0.x, f[1] * rstd * kg0.y); o.y = cvt_pk_bf16(f[2] * rstd * kg0.z, f[3] * rstd * kg0.w);
                o.z = cvt_pk_bf16(f[4] * rstd * kg1.x, f[5] * rstd * kg1.y); o.w = cvt_pk_bf16(f[6] * rstd * kg1.z, f[7] * rstd * kg1.w);
                *(LAS u32x4*)(KS + cc * 136 + ch * 8) = o;
                *(LAS u32x4*)(VS + cc * 136 + ch * 8) = vr[p]; }
        }
        const int a = 16 * w + ql;
        const unsigned tq = (unsigned)((nb * 128 + a) * d + U.r);
        bf16x8 qf[4];
        {
            float f[4][8]; float ss = 0.f;
#pragma unroll
            for (int ds = 0; ds < 4; ++ds) { f[ds][0] = bf2f(qr[ds].x & 0xffffu); f[ds][1] = bf2f(qr[ds].x >> 16); f[ds][2] = bf2f(qr[ds].y & 0xffffu); f[ds][3] = bf2f(qr[ds].y >> 16);
                f[ds][4] = bf2f(qr[ds].z & 0xffffu); f[ds][5] = bf2f(qr[ds].z >> 16); f[ds][6] = bf2f(qr[ds].w & 0xffffu); f[ds][7] = bf2f(qr[ds].w >> 16);
#pragma unroll
                for (int e = 0; e < 8; ++e) ss += f[ds][e] * f[ds][e]; }
            ss += __shfl_xor(ss, 16); ss += __shfl_xor(ss, 32);
            const float rs = (1.0f / sqrtf(ss * (1.f / 128.f) + 1e-6f)) * 0.08838834764831845f;
#pragma unroll
            for (int ds = 0; ds < 4; ++ds) { const float* qg = inp(F, IN_QNG) + 32 * ds + 8 * g4; const f32x4 q0 = *(const f32x4*)qg, q1 = *(const f32x4*)(qg + 4); u32x4 o;
                o.x = cvt_pk_bf16(f[ds][0] * rs * q0.x, f[ds][1] * rs * q0.y); o.y = cvt_pk_bf16(f[ds][2] * rs * q0.z, f[ds][3] * rs * q0.w);
                o.z = cvt_pk_bf16(f[ds][4] * rs * q1.x, f[ds][5] * rs * q1.y); o.w = cvt_pk_bf16(f[ds][6] * rs * q1.z, f[ds][7] * rs * q1.w);
                qf[ds] = __builtin_bit_cast(bf16x8, o); }
        }
        __syncthreads();
        { const int nx = it + F.G; if (nx < 1536) { const AttnU Un = attn_decode(nx); attn_issue(proj, Un, F.tid, w, lane, kr, vr, qr); } }
        const int kbase = 32 * (w >> 1);
        f32x4 sc[10];
#pragma unroll
        for (int ti = 0; ti < 10; ++ti) { f32x4 acc = (f32x4){0.f, 0.f, 0.f, 0.f};
#pragma unroll
            for (int ds = 0; ds < 4; ++ds) { const bf16x8 kf = *(const LAS bf16x8*)(KS + (kbase + 16 * ti + ql) * 136 + 32 * ds + 8 * g4); acc = mfma16(kf, qf[ds], acc); }
            sc[ti] = acc; }
        float mx = -1e30f;
#pragma unroll
        for (int ti = 0; ti < 10; ++ti)
#pragma unroll
            for (int i = 0; i < 4; ++i) { const int cc = kbase + 16 * ti + 4 * g4 + i; const int delta = 128 + a - cc;
                const bool ok = (delta >= 0) && (delta <= 128) && (nb > 0 || cc >= 128);
                const float sv = ok ? sc[ti][i] + BT[ok ? delta : 0] : -1e30f; sc[ti][i] = sv; mx = fmaxf(mx, sv); }
        mx = fmaxf(mx, __shfl_xor(mx, 16)); mx = fmaxf(mx, __shfl_xor(mx, 32));
        float lsum = 0.f;
#pragma unroll
        for (int ti = 0; ti < 10; ++ti)
#pragma unroll
            for (int i = 0; i < 4; ++i) { const float p = __expf(sc[ti][i] - mx); sc[ti][i] = p; lsum += p; }
        lsum += __shfl_xor(lsum, 16); lsum += __shfl_xor(lsum, 32);
        bf16x8 pf[5];
#pragma unroll
        for (int s = 0; s < 5; ++s) { u32x4 o; o.x = cvt_pk_bf16(sc[2 * s][0], sc[2 * s][1]); o.y = cvt_pk_bf16(sc[2 * s][2], sc[2 * s][3]);
            o.z = cvt_pk_bf16(sc[2 * s + 1][0], sc[2 * s + 1][1]); o.w = cvt_pk_bf16(sc[2 * s + 1][2], sc[2 * s + 1][3]); pf[s] = __builtin_bit_cast(bf16x8, o); }
        const float rl = 1.0f / lsum;
        bf16_t* og = (bf16_t*)(F.ws + WS_OG) + ((unsigned)(U.g * S) + tq) * 1024u + U.hh * 128;
        const unsigned vbase = (unsigned)(size_t)VS + (unsigned)(((kbase + 4 * g4 + (ql >> 2)) * 136 + 4 * (ql & 3)) * 2);
#pragma unroll
        for (int dt = 0; dt < 8; ++dt) { f32x4 acc = (f32x4){0.f, 0.f, 0.f, 0.f};
            u32x2 lo[5], hi[5];
#pragma unroll
            for (int s = 0; s < 5; ++s) { TR_READ(lo[s], vbase, (32 * s * 136 + dt * 16) * 2); TR_READ(hi[s], vbase, ((32 * s + 16) * 136 + dt * 16) * 2); }
            TR_WAIT4(lo[0], hi[0], lo[1], hi[1]); TR_WAIT4(lo[2], hi[2], lo[3], hi[3]); TR_WAIT2(lo[4], hi[4]);
#pragma unroll
            for (int s = 0; s < 5; ++s) acc = mfma16(pk_frag(lo[s], hi[s]), pf[s], acc);
            u32x2 o; o.x = cvt_pk_bf16(acc[0] * rl, acc[1] * rl); o.y = cvt_pk_bf16(acc[2] * rl, acc[3] * rl);
            *(u32x2*)(og + dt * 16 + 4 * g4) = o; }
        if (g4 == 0) ((float*)(F.ws + WS_LSE))[((unsigned)(U.g * S) + tq) * 8u + U.hh] = mx + __logf(lsum);
        __syncthreads();
    }
}

__device__ __forceinline__ void rot8v(const u32x4 own, const u32x4 par, int ch, const f32x4 c0, const f32x4 c1, const f32x4 s0, const f32x4 s1, float scale, float (&o)[8]) {
    float a[8], b[8];
    a[0] = bf2f(own.x & 0xffffu); a[1] = bf2f(own.x >> 16); a[2] = bf2f(own.y & 0xffffu); a[3] = bf2f(own.y >> 16); a[4] = bf2f(own.z & 0xffffu); a[5] = bf2f(own.z >> 16); a[6] = bf2f(own.w & 0xffffu); a[7] = bf2f(own.w >> 16);
    b[0] = bf2f(par.x & 0xffffu); b[1] = bf2f(par.x >> 16); b[2] = bf2f(par.y & 0xffffu); b[3] = bf2f(par.y >> 16); b[4] = bf2f(par.z & 0xffffu); b[5] = bf2f(par.z >> 16); b[6] = bf2f(par.w & 0xffffu); b[7] = bf2f(par.w >> 16);
    const float cv[8] = {c0.x, c0.y, c0.z, c0.w, c1.x, c1.y, c1.z, c1.w}, sv[8] = {s0.x, s0.y, s0.z, s0.w, s1.x, s1.y, s1.z, s1.w};
#pragma unroll
    for (int e = 0; e < 8; ++e) o[e] = ((ch < 8) ? (a[e] * cv[e] - b[e] * sv[e]) : (b[e] * sv[e] + a[e] * cv[e])) * scale;
}

__device__ __forceinline__ void upd_unit(const Ctx& F, int u) {
    const int n = u >> 3, h = u & 7;
    const bf16_t* proj = (const bf16_t*)(F.ws + WS_PROJ);
    const float* rc = (const float*)(F.ws + WS_ROPE); const float* rsn = rc + S * 64;
    LAS bf16_t* KS = (LAS bf16_t*)F.lds;
    LAS bf16_t* VS = (LAS bf16_t*)(F.lds + 34816);
    const int lane = F.lane, w = F.wave;
    const float lg2 = gamma_log2(h);
    {
        const int rowi = F.tid >> 4, ch = F.tid & 15;
        u32x4 kown[4], kpar[4], vv[8]; f32x4 c0[4], c1[4], s0[4], s1[4];
#pragma unroll
        for (int p = 0; p < 4; ++p) { const int j = p * 32 + rowi; const unsigned tok = (unsigned)(n * 128 + j);
            const bf16_t* kp = proj + tok * INW + C_KR + h * 128;
            kown[p] = *(const u32x4*)(kp + ch * 8); kpar[p] = *(const u32x4*)(kp + (ch ^ 8) * 8);
            const float* cp = rc + tok * 64 + (ch & 7) * 8; const float* sp = rsn + tok * 64 + (ch & 7) * 8;
            c0[p] = *(const f32x4*)cp; c1[p] = *(const f32x4*)(cp + 4); s0[p] = *(const f32x4*)sp; s1[p] = *(const f32x4*)(sp + 4);
            vv[2 * p] = *(const u32x4*)(proj + tok * INW + C_VR + h * 256 + ch * 8); vv[2 * p + 1] = *(const u32x4*)(proj + tok * INW + C_VR + h * 256 + (ch + 16) * 8); }
#pragma unroll
        for (int p = 0; p < 4; ++p) { const int j = p * 32 + rowi;
            float o[8]; rot8v(kown[p], kpar[p], ch, c0[p], c1[p], s0[p], s1[p], 0.08838834764831845f, o);
            u32x4 ov; ov.x = cvt_pk_bf16(o[0], o[1]); ov.y = cvt_pk_bf16(o[2], o[3]); ov.z = cvt_pk_bf16(o[4], o[5]); ov.w = cvt_pk_bf16(o[6], o[7]);
            *(LAS u32x4*)(KS + j * 136 + ch * 8) = ov; }
#pragma unroll
        for (int p = 0; p < 4; ++p) { const int j = p * 32 + rowi; const float z = exp2f(lg2 * (float)(127 - j));
#pragma unroll
            for (int c2 = 0; c2 < 2; ++c2) { const int chv = ch + 16 * c2; const u32x4 x = vv[2 * p + c2];
                u32x4 ov; ov.x = cvt_pk_bf16(bf2f(x.x & 0xffffu) * z, bf2f(x.x >> 16) * z); ov.y = cvt_pk_bf16(bf2f(x.y & 0xffffu) * z, bf2f(x.y >> 16) * z);
                ov.z = cvt_pk_bf16(bf2f(x.z & 0xffffu) * z, bf2f(x.z >> 16) * z); ov.w = cvt_pk_bf16(bf2f(x.w & 0xffffu) * z, bf2f(x.w >> 16) * z);
                *(LAS u32x4*)(VS + j * 264 + chv * 8) = ov; } }
    }
    __syncthreads();
    const int ql = lane & 15, g4 = lane >> 4;
    const unsigned kb = (unsigned)(size_t)KS + (unsigned)(((8 * g4 + (ql >> 2)) * 136 + 4 * (ql & 3)) * 2);
    const unsigned vbw = (unsigned)(size_t)VS + (unsigned)(((8 * g4 + (ql >> 2)) * 264 + 4 * (ql & 3) + 32 * w) * 2);
    f32x4 acc[2][8];
#pragma unroll
    for (int a = 0; a < 2; ++a)
#pragma unroll
        for (int b = 0; b < 8; ++b) acc[a][b] = (f32x4){0.f, 0.f, 0.f, 0.f};
#pragma unroll
    for (int ks = 0; ks < 4; ++ks) {
        u32x2 vl[2], vh[2];
#pragma unroll
        for (int a = 0; a < 2; ++a) { TR_READ(vl[a], vbw, (32 * ks * 264 + a * 16) * 2); TR_READ(vh[a], vbw, ((32 * ks + 4) * 264 + a * 16) * 2); }
        TR_WAIT4(vl[0], vh[0], vl[1], vh[1]);
        const bf16x8 vf0 = pk_frag(vl[0], vh[0]), vf1 = pk_frag(vl[1], vh[1]);
#pragma unroll
        for (int b = 0; b < 8; b += 2) {
            u32x2 k0l, k0h, k1l, k1h;
            TR_READ(k0l, kb, (32 * ks * 136 + b * 16) * 2); TR_READ(k0h, kb, ((32 * ks + 4) * 136 + b * 16) * 2);
            TR_READ(k1l, kb, (32 * ks * 136 + (b + 1) * 16) * 2); TR_READ(k1h, kb, ((32 * ks + 4) * 136 + (b + 1) * 16) * 2);
            TR_WAIT4(k0l, k0h, k1l, k1h);
            const bf16x8 kf0 = pk_frag(k0l, k0h), kf1 = pk_frag(k1l, k1h);
            acc[0][b] = mfma16(vf0, kf0, acc[0][b]); acc[1][b] = mfma16(vf1, kf0, acc[1][b]);
            acc[0][b + 1] = mfma16(vf0, kf1, acc[0][b + 1]); acc[1][b + 1] = mfma16(vf1, kf1, acc[1][b + 1]); }
    }
    float* upd = (float*)(F.ws + WS_UPD) + (size_t)(n * 8 + h) * 32768;
#pragma unroll
    for (int a = 0; a < 2; ++a)
#pragma unroll
        for (int b = 0; b < 8; ++b)
#pragma unroll
            for (int i = 0; i < 4; ++i) upd[((2 * w + a) * 16 + 4 * g4 + i) * 128 + b * 16 + ql] = acc[a][b][i];
    __syncthreads();
}
__device__ __forceinline__ void p3_mix1(const Ctx& F) {
    p3_attn(F);
    if (DUP2_MASK & 4) { __syncthreads(); p3_attn(F); }
    for (int it = F.bx; it < 512; it += F.G) upd_unit(F, it);
    if (DUP2_MASK & 8) { __syncthreads(); for (int it = F.bx; it < 512; it += F.G) upd_unit(F, it); }
}

__device__ __forceinline__ void p4_scan(const Ctx& F) {
    const float* upd = (const float*)(F.ws + WS_UPD); unsigned* prev = (unsigned*)(F.ws + WS_PREV);
    for (int p = F.bx * 512 + F.tid; p < 131072; p += F.G * 512) {
        const int h = p >> 14;
        const float gch = exp2f(gamma_log2(h) * 128.0f);
        const int within = (p & 16383) * 2;
        float s0 = 0.f, s1 = 0.f;
#pragma unroll 8
        for (int n = 0; n < 64; ++n) { const size_t o = (size_t)(n * 8 + h) * 32768 + within;
            const f32x2 uv = *(const f32x2*)(upd + o);
            prev[o >> 1] = cvt_pk_bf16(s0, s1);
            s0 = gch * s0 + uv.x; s1 = gch * s1 + uv.y; }
    }
}

__device__ __forceinline__ void ret_unit(const Ctx& F, int u) {
    const int n = u >> 3, h = u & 7;
    const bf16_t* proj = (const bf16_t*)(F.ws + WS_PROJ);
    const float* rc = (const float*)(F.ws + WS_ROPE); const float* rsn = rc + S * 64;
    LAS bf16_t* KS = (LAS bf16_t*)F.lds;
    LAS bf16_t* VS = (LAS bf16_t*)(F.lds + 34816);
    LAS bf16_t* QS = (LAS bf16_t*)(F.lds + 102400);
    LAS float* RED = (LAS float*)(F.lds + 137216);
    LAS float* TOT = (LAS float*)(F.lds + 145408);
    const int lane = F.lane, w = F.wave;
    const float lg2 = gamma_log2(h);
    const int ql = lane & 15, g4 = lane >> 4;
    const bf16_t* prev = (const bf16_t*)(F.ws + WS_PREV) + (size_t)(n * 8 + h) * 32768;
    {
        const int rowi = F.tid >> 4, ch = F.tid & 15;
        u32x4 kown[4], kpar[4], vv[8]; f32x4 c0[4], c1[4], s0[4], s1[4];
#pragma unroll
        for (int p = 0; p < 4; ++p) { const int j = p * 32 + rowi; const unsigned tok = (unsigned)(n * 128 + j);
            const bf16_t* kp = proj + tok * INW + C_KR + h * 128;
            kown[p] = *(const u32x4*)(kp + ch * 8); kpar[p] = *(const u32x4*)(kp + (ch ^ 8) * 8);
            const float* cp = rc + tok * 64 + (ch & 7) * 8; const float* sp = rsn + tok * 64 + (ch & 7) * 8;
            c0[p] = *(const f32x4*)cp; c1[p] = *(const f32x4*)(cp + 4); s0[p] = *(const f32x4*)sp; s1[p] = *(const f32x4*)(sp + 4);
            vv[2 * p] = *(const u32x4*)(proj + tok * INW + C_VR + h * 256 + ch * 8); vv[2 * p + 1] = *(const u32x4*)(proj + tok * INW + C_VR + h * 256 + (ch + 16) * 8); }
#pragma unroll
        for (int p = 0; p < 4; ++p) { const int j = p * 32 + rowi;
            float o[8]; rot8v(kown[p], kpar[p], ch, c0[p], c1[p], s0[p], s1[p], 0.08838834764831845f, o);
            u32x4 ov; ov.x = cvt_pk_bf16(o[0], o[1]); ov.y = cvt_pk_bf16(o[2], o[3]); ov.z = cvt_pk_bf16(o[4], o[5]); ov.w = cvt_pk_bf16(o[6], o[7]);
            *(LAS u32x4*)(KS + j * 136 + ch * 8) = ov; }
#pragma unroll
        for (int p = 0; p < 4; ++p) { const int j = p * 32 + rowi;
#pragma unroll
            for (int c2 = 0; c2 < 2; ++c2) { const int chv = ch + 16 * c2; const u32x4 x = vv[2 * p + c2];
                *(LAS u32x4*)(VS + j * 264 + chv * 8) = x; } }
    }
    const int iq = 16 * w + ql; const unsigned tq = (unsigned)(n * 128 + iq);
    bf16x8 qf[4];
    {
        u32x4 qv[4]; float f[4][8];
#pragma unroll
        for (int ds = 0; ds < 4; ++ds) qv[ds] = *(const u32x4*)(proj + tq * INW + C_QR + h * 128 + 32 * ds + 8 * g4);
#pragma unroll
        for (int ds = 0; ds < 4; ++ds) { f[ds][0] = bf2f(qv[ds].x & 0xffffu); f[ds][1] = bf2f(qv[ds].x >> 16); f[ds][2] = bf2f(qv[ds].y & 0xffffu); f[ds][3] = bf2f(qv[ds].y >> 16);
            f[ds][4] = bf2f(qv[ds].z & 0xffffu); f[ds][5] = bf2f(qv[ds].z >> 16); f[ds][6] = bf2f(qv[ds].w & 0xffffu); f[ds][7] = bf2f(qv[ds].w >> 16); }
        const float xi = exp2f(lg2 * (float)(iq + 1));
#pragma unroll
        for (int ds = 0; ds < 2; ++ds) {
            const float* cp = rc + tq * 64 + 32 * ds + 8 * g4; const float* sp = rsn + tq * 64 + 32 * ds + 8 * g4;
            const f32x4 c0 = *(const f32x4*)cp, c1 = *(const f32x4*)(cp + 4), s0 = *(const f32x4*)sp, s1 = *(const f32x4*)(sp + 4);
            const float cv[8] = {c0.x, c0.y, c0.z, c0.w, c1.x, c1.y, c1.z, c1.w}, sv[8] = {s0.x, s0.y, s0.z, s0.w, s1.x, s1.y, s1.z, s1.w};
            float lo[8], hi[8];
#pragma unroll
            for (int e = 0; e < 8; ++e) { const float t1 = f[ds][e], t2 = f[ds + 2][e]; lo[e] = t1 * cv[e] - t2 * sv[e]; hi[e] = t1 * sv[e] + t2 * cv[e]; }
            u32x4 o; o.x = cvt_pk_bf16(lo[0], lo[1]); o.y = cvt_pk_bf16(lo[2], lo[3]); o.z = cvt_pk_bf16(lo[4], lo[5]); o.w = cvt_pk_bf16(lo[6], lo[7]); qf[ds] = __builtin_bit_cast(bf16x8, o);
            o.x = cvt_pk_bf16(hi[0], hi[1]); o.y = cvt_pk_bf16(hi[2], hi[3]); o.z = cvt_pk_bf16(hi[4], hi[5]); o.w = cvt_pk_bf16(hi[6], hi[7]); qf[ds + 2] = __builtin_bit_cast(bf16x8, o);
            o.x = cvt_pk_bf16(lo[0] * xi, lo[1] * xi); o.y = cvt_pk_bf16(lo[2] * xi, lo[3] * xi); o.z = cvt_pk_bf16(lo[4] * xi, lo[5] * xi); o.w = cvt_pk_bf16(lo[6] * xi, lo[7] * xi);
            *(LAS u32x4*)(QS + iq * 136 + 32 * ds + 8 * g4) = o;
            o.x = cvt_pk_bf16(hi[0] * xi, hi[1] * xi); o.y = cvt_pk_bf16(hi[2] * xi, hi[3] * xi); o.z = cvt_pk_bf16(hi[4] * xi, hi[5] * xi); o.w = cvt_pk_bf16(hi[6] * xi, hi[7] * xi);
            *(LAS u32x4*)(QS + iq * 136 + 32 * (ds + 2) + 8 * g4) = o;
        }
    }
    bf16x8 pr[2][4];
#pragma unroll
    for (int a = 0; a < 2; ++a)
#pragma unroll
        for (int ds = 0; ds < 4; ++ds) pr[a][ds] = *(const bf16x8*)(prev + ((2 * w + a) * 16 + ql) * 128 + 32 * ds + 8 * g4);
    __syncthreads();
    f32x4 sc[8];
#pragma unroll
    for (int kt = 0; kt < 8; ++kt) { f32x4 a = (f32x4){0.f, 0.f, 0.f, 0.f};
#pragma unroll
        for (int ds = 0; ds < 4; ++ds) { const bf16x8 kf = *(const LAS bf16x8*)(KS + (16 * kt + ql) * 136 + 32 * ds + 8 * g4); a = mfma16(kf, qf[ds], a); }
#pragma unroll
        for (int i = 0; i < 4; ++i) { const int j = 16 * kt + 4 * g4 + i; const int df = iq - j; a[i] = (df >= 0) ? a[i] * exp2f(lg2 * (float)df) : 0.f; }
        sc[kt] = a; }
    __syncthreads();
#pragma unroll
    for (int kt = 0; kt < 8; ++kt) { u32x2 o; o.x = cvt_pk_bf16(sc[kt][0], sc[kt][1]); o.y = cvt_pk_bf16(sc[kt][2], sc[kt][3]); *(LAS u32x2*)(KS + iq * 136 + 16 * kt + 4 * g4) = o; }
    __syncthreads();
    f32x4 acc[2][8];
#pragma unroll
    for (int a = 0; a < 2; ++a)
#pragma unroll
        for (int qt = 0; qt < 8; ++qt) acc[a][qt] = (f32x4){0.f, 0.f, 0.f, 0.f};
#pragma unroll
    for (int ds = 0; ds < 4; ++ds)
#pragma unroll
        for (int qt = 0; qt < 8; ++qt) { const bf16x8 bq = *(const LAS bf16x8*)(QS + (qt * 16 + ql) * 136 + 32 * ds + 8 * g4);
            acc[0][qt] = mfma16(pr[0][ds], bq, acc[0][qt]); acc[1][qt] = mfma16(pr[1][ds], bq, acc[1][qt]); }
    const unsigned vbw = (unsigned)(size_t)VS + (unsigned)(((8 * g4 + (ql >> 2)) * 264 + 4 * (ql & 3) + 32 * w) * 2);
#pragma unroll
    for (int s = 0; s < 4; ++s) {
        u32x2 vl[2], vh[2];
#pragma unroll
        for (int a = 0; a < 2; ++a) { TR_READ(vl[a], vbw, (32 * s * 264 + a * 16) * 2); TR_READ(vh[a], vbw, ((32 * s + 4) * 264 + a * 16) * 2); }
        TR_WAIT4(vl[0], vh[0], vl[1], vh[1]);
        const bf16x8 vf0 = pk_frag(vl[0], vh[0]), vf1 = pk_frag(vl[1], vh[1]);
#pragma unroll
        for (int qt = 0; qt < 8; ++qt) if (qt >= 2 * s) { const bf16x8 bp = *(const LAS bf16x8*)(KS + (qt * 16 + ql) * 136 + 32 * s + 8 * g4);
            acc[0][qt] = mfma16(vf0, bp, acc[0][qt]); acc[1][qt] = mfma16(vf1, bp, acc[1][qt]); }
    }
#pragma unroll
    for (int qt = 0; qt < 8; ++qt) { float s1 = 0.f, s2 = 0.f;
#pragma unroll
        for (int a = 0; a < 2; ++a)
#pragma unroll
            for (int i = 0; i < 4; ++i) { const float x = acc[a][qt][i]; s1 += x; s2 += x * x; }
        s1 += __shfl_xor(s1, 16); s1 += __shfl_xor(s1, 32); s2 += __shfl_xor(s2, 16); s2 += __shfl_xor(s2, 32);
        if (g4 == 0) *(LAS f32x2*)(RED + (w * 128 + qt * 16 + ql) * 2) = (f32x2){s1, s2}; }
    __syncthreads();
    if (F.tid < 128) { float s1 = 0.f, s2 = 0.f;
#pragma unroll
        for (int ww = 0; ww < 8; ++ww) { const f32x2 v = *(const LAS f32x2*)(RED + (ww * 128 + F.tid) * 2); s1 += v.x; s2 += v.y; }
        const float mean = s1 * (1.f / 256.f); float var = s2 * (1.f / 256.f) - mean * mean; var = var > 0.f ? var : 0.f;
        *(LAS f32x2*)(TOT + F.tid * 2) = (f32x2){mean, 1.0f / sqrtf(var + 1e-5f)}; }
    __syncthreads();
    LAS bf16_t* OT = VS;
#pragma unroll
    for (int qt = 0; qt < 8; ++qt) { const f32x2 st = *(const LAS f32x2*)(TOT + (qt * 16 + ql) * 2);
#pragma unroll
        for (int a = 0; a < 2; ++a) { u32x2 o; o.x = cvt_pk_bf16((acc[a][qt][0] - st.x) * st.y, (acc[a][qt][1] - st.x) * st.y); o.y = cvt_pk_bf16((acc[a][qt][2] - st.x) * st.y, (acc[a][qt][3] - st.x) * st.y);
            *(LAS u32x2*)(OT + (qt * 16 + ql) * 264 + (2 * w + a) * 16 + 4 * g4) = o; } }
    __syncthreads();
    const float* gng = inp(F, IN_GNG) + h * 256;
    {
        const int pc = F.tid & 31;
        const f32x4 gg0 = *(const f32x4*)(gng + pc * 8), gg1 = *(const f32x4*)(gng + pc * 8 + 4);
        u32x4 gv[8];
#pragma unroll
        for (int p = 0; p < 8; ++p) { const unsigned tk = (unsigned)(n * 128 + p * 16 + (F.tid >> 5)); gv[p] = *(const u32x4*)(proj + tk * INW + C_GR + h * 256 + pc * 8); }
#pragma unroll
        for (int p = 0; p < 8; ++p) { const int row = p * 16 + (F.tid >> 5); const unsigned tk = (unsigned)(n * 128 + row);
            const u32x4 x = *(const LAS u32x4*)(OT + row * 264 + pc * 8); u32x4 o;
            o.x = cvt_pk_bf16(bf2f(x.x & 0xffffu) * gg0.x * fsilu(bf2f(gv[p].x & 0xffffu)), bf2f(x.x >> 16) * gg0.y * fsilu(bf2f(gv[p].x >> 16)));
            o.y = cvt_pk_bf16(bf2f(x.y & 0xffffu) * gg0.z * fsilu(bf2f(gv[p].y & 0xffffu)), bf2f(x.y >> 16) * gg0.w * fsilu(bf2f(gv[p].y >> 16)));
            o.z = cvt_pk_bf16(bf2f(x.z & 0xffffu) * gg1.x * fsilu(bf2f(gv[p].z & 0xffffu)), bf2f(x.z >> 16) * gg1.y * fsilu(bf2f(gv[p].z >> 16)));
            o.w = cvt_pk_bf16(bf2f(x.w & 0xffffu) * gg1.z * fsilu(bf2f(gv[p].w & 0xffffu)), bf2f(x.w >> 16) * gg1.w * fsilu(bf2f(gv[p].w >> 16)));
            *(u32x4*)((bf16_t*)(F.ws + WS_YB) + tk * D + h * 256 + pc * 8) = o; }
    }
    __syncthreads();
}
__device__ __forceinline__ void comb_item(const Ctx& F, int it) {
    const bf16_t* og = (const bf16_t*)(F.ws + WS_OG); const float* lse = (const float*)(F.ws + WS_LSE); bf16_t* ya = (bf16_t*)(F.ws + WS_YA);
    for (int rr = 0; rr < 4; ++rr) { const size_t t = (size_t)it * 32 + F.wave * 4 + rr; const int hh = F.lane >> 3;
        const float l0 = lse[(0 * (size_t)S + t) * 8 + hh], l1 = lse[(1 * (size_t)S + t) * 8 + hh], l2 = lse[(2 * (size_t)S + t) * 8 + hh];
        const float m = fmaxf(l0, fmaxf(l1, l2)); float a0 = __expf(l0 - m), a1 = __expf(l1 - m), a2 = __expf(l2 - m); const float inv = 1.f / (a0 + a1 + a2); a0 *= inv; a1 *= inv; a2 *= inv;
#pragma unroll
        for (int c = 0; c < 2; ++c) { const size_t e = t * 1024 + F.lane * 16 + c * 8;
            const u32x4 v0 = *(const u32x4*)(og + e), v1 = *(const u32x4*)(og + (size_t)S * 1024 + e), v2 = *(const u32x4*)(og + 2 * (size_t)S * 1024 + e);
            u32x4 o;
            o.x = cvt_pk_bf16(a0 * bf2f(v0.x & 0xffffu) + a1 * bf2f(v1.x & 0xffffu) + a2 * bf2f(v2.x & 0xffffu), a0 * bf2f(v0.x >> 16) + a1 * bf2f(v1.x >> 16) + a2 * bf2f(v2.x >> 16));
            o.y = cvt_pk_bf16(a0 * bf2f(v0.y & 0xffffu) + a1 * bf2f(v1.y & 0xffffu) + a2 * bf2f(v2.y & 0xffffu), a0 * bf2f(v0.y >> 16) + a1 * bf2f(v1.y >> 16) + a2 * bf2f(v2.y >> 16));
            o.z = cvt_pk_bf16(a0 * bf2f(v0.z & 0xffffu) + a1 * bf2f(v1.z & 0xffffu) + a2 * bf2f(v2.z & 0xffffu), a0 * bf2f(v0.z >> 16) + a1 * bf2f(v1.z >> 16) + a2 * bf2f(v2.z >> 16));
            o.w = cvt_pk_bf16(a0 * bf2f(v0.w & 0xffffu) + a1 * bf2f(v1.w & 0xffffu) + a2 * bf2f(v2.w & 0xffffu), a0 * bf2f(v0.w >> 16) + a1 * bf2f(v1.w >> 16) + a2 * bf2f(v2.w >> 16));
            *(u32x4*)(ya + e) = o; } }
}
__device__ __forceinline__ void p4_scan_comb(const Ctx& F) {
    p4_scan(F);
    for (int it = F.bx; it < 256; it += F.G) comb_item(F, it);
}
__device__ __forceinline__ void p5_mix2(const Ctx& F) {
    for (int it = F.bx; it < 512; it += F.G) ret_unit(F, it);
    if (DUP2_MASK & 1) { __syncthreads(); for (int it = F.bx; it < 512; it += F.G) ret_unit(F, it); }
}

__device__ __forceinline__ void p8_router(const Ctx& F) {
    LAS float* gs = (LAS float*)F.lds; LAS float* sh = gs + D; LAS float* XS = sh + D; LAS float* WSm = XS + 32 * 260; LAS float* SC = WSm + 256 * 64; LAS float* SEL = SC + 32 * 64; LAS float* RSTD = SEL + 32 * 64;
    const float* modf = (const float*)(F.ws + WS_MODF);
    for (int k = F.tid; k < D; k += 512) { gs[k] = inp(F, IN_LN2)[k] * (1.f + modf[4 * D + k]); sh[k] = modf[3 * D + k]; }
    __syncthreads();
    const float* x1 = F.out; unsigned char* H2 = F.ws + WS_H;
    const float* rw = inp(F, IN_RW); const float* rb = inp(F, IN_RB);
    int* e_of = (int*)(F.ws + WS_EOF); int* pos_of = e_of + 65536; float* topw = (float*)(pos_of + 65536);
    unsigned* cnt = (unsigned*)(F.ws + WS_CTL) + CW_CNT;
    for (int it = F.bx; it < 256; it += F.G) {
        const int t0 = it * 32;
#pragma unroll 1
        for (int rr = 0; rr < 4; ++rr) { const int m = t0 + F.wave * 4 + rr;
            const GAS f32x4* xr = (const GAS f32x4*)(x1 + (size_t)m * D) + F.lane;
            f32x4 v[8]; float ss = 0.f;
#pragma unroll
            for (int j = 0; j < 8; ++j) { v[j] = xr[64 * j]; ss += (v[j].x * v[j].x + v[j].y * v[j].y) + (v[j].z * v[j].z + v[j].w * v[j].w); }
#pragma unroll
            for (int o = 1; o < 64; o <<= 1) ss += __shfl_xor(ss, o);
            const float rstd = 1.0f / sqrtf(ss * (1.f / D) + 1e-6f);
            if (F.lane == 0) RSTD[F.wave * 4 + rr] = rstd;
            GAS unsigned* o4 = (GAS unsigned*)(H2 + (size_t)m * D) + F.lane;
#pragma unroll
            for (int j = 0; j < 8; ++j) { const f32x4 g = *(const LAS f32x4*)(gs + 256 * j + 4 * F.lane), s = *(const LAS f32x4*)(sh + 256 * j + 4 * F.lane);
                const f32x4 y = v[j] * rstd * g + s; o4[64 * j] = cvt4_fp8(y.x, y.y, y.z, y.w); } }
        __syncthreads();
        const int tok = F.tid >> 4, eq = F.tid & 15;
        f32x16 ac0, ac1;
#pragma unroll
        for (int i = 0; i < 16; ++i) { ac0[i] = 0.f; ac1[i] = 0.f; }
#pragma unroll 1
        for (int kc = 0; kc < 8; ++kc) {
#pragma unroll
            for (int q = 0; q < 4; ++q) { const int idx = F.tid + 512 * q; const int row = idx >> 6, c4 = (idx & 63) * 4; const int k = kc * 256 + c4;
                const f32x4 xv = *(const f32x4*)(x1 + (size_t)(t0 + row) * D + k); const float rstd = RSTD[row];
                const f32x4 g = *(const LAS f32x4*)(gs + k), s = *(const LAS f32x4*)(sh + k);
                *(LAS f32x4*)(XS + row * 260 + c4) = xv * rstd * g + s; }
#pragma unroll
            for (int q = 0; q < 8; ++q) { const int idx = F.tid + 512 * q; const int kr = idx >> 4, c4 = (idx & 15) * 4;
                *(LAS f32x4*)(WSm + kr * 64 + c4) = *(const f32x4*)(rw + (size_t)(kc * 256 + kr) * 64 + c4); }
            __syncthreads();
            { const int i31 = F.lane & 31, kh = F.lane >> 5;
#pragma unroll 4
              for (int kp = 0; kp < 16; ++kp) { const int k = 32 * F.wave + 2 * kp + kh;
                  const float av = XS[i31 * 260 + k]; const float b0 = WSm[k * 64 + i31], b1 = WSm[k * 64 + 32 + i31];
                  ac0 = __builtin_amdgcn_mfma_f32_32x32x2f32(av, b0, ac0, 0, 0, 0); ac1 = __builtin_amdgcn_mfma_f32_32x32x2f32(av, b1, ac1, 0, 0, 0); } }
            __syncthreads();
        }
        { LAS float* RED = WSm + F.wave * 2048; const int i31 = F.lane & 31, kh = F.lane >> 5;
#pragma unroll
          for (int rg = 0; rg < 16; ++rg) { const int row = (rg & 3) + 8 * (rg >> 2) + 4 * kh; RED[row * 64 + i31] = ac0[rg]; RED[row * 64 + 32 + i31] = ac1[rg]; } }
        __syncthreads();
        f32x4 lg = (f32x4){0.f, 0.f, 0.f, 0.f};
#pragma unroll
        for (int w = 0; w < 8; ++w) lg += *(const LAS f32x4*)(WSm + w * 2048 + tok * 64 + eq * 4);
#pragma unroll
        for (int i = 0; i < 4; ++i) { const float sc = fsigm(lg[i]); SC[tok * 64 + eq * 4 + i] = sc; SEL[tok * 64 + eq * 4 + i] = sc + rb[eq * 4 + i]; }
        __syncthreads();
        if (F.tid < 32) {
            LAS float* sel = SEL + F.tid * 64; const LAS float* scp = SC + F.tid * 64;
            float gsc[8];
#pragma unroll
            for (int g = 0; g < 8; ++g) { float m1 = -3e38f, m2 = -3e38f;
#pragma unroll
                for (int j = 0; j < 8; ++j) { const float v = sel[g * 8 + j]; if (v > m1) { m2 = m1; m1 = v; } else if (v > m2) m2 = v; }
                gsc[g] = m1 + m2; }
            unsigned gmask = 0u;
#pragma unroll
            for (int r = 0; r < 4; ++r) { float best = -3e38f; int bi = 0;
#pragma unroll
                for (int g = 0; g < 8; ++g) { const bool take = !((gmask >> g) & 1u) && gsc[g] > best; best = take ? gsc[g] : best; bi = take ? g : bi; }
                gmask |= 1u << bi; }
            int idx[8]; float wv[8]; float wsum = 0.f;
#pragma unroll
            for (int r = 0; r < 8; ++r) { float best = -3e38f; int bi = 0;
                for (int e = 0; e < 64; ++e) { const float v = sel[e]; const bool take = ((gmask >> (e >> 3)) & 1u) && v > best; best = take ? v : best; bi = take ? e : bi; }
                sel[bi] = -3e38f; idx[r] = bi; wv[r] = scp[bi]; wsum += wv[r]; }
            const float sc = 2.5f / wsum; const int tk = t0 + F.tid;
#pragma unroll
            for (int r = 0; r < 8; ++r) { const unsigned pos = __hip_atomic_fetch_add(cnt + idx[r], 1u, __ATOMIC_RELAXED, __HIP_MEMORY_SCOPE_AGENT);
                e_of[tk * 8 + r] = idx[r]; pos_of[tk * 8 + r] = (int)pos; topw[tk * 8 + r] = wv[r] * sc; }
        }
        __syncthreads();
    }
}

__device__ __forceinline__ void build_moe_tab(const Ctx& F) {
    MoeTab tab = moe_tab(F.lds);
    LAS int* padstart = tab.misc + 8;
    if (F.tid < 64) {
        unsigned* cnt = (unsigned*)(F.ws + WS_CTL) + CW_CNT;
        const int c = (int)__hip_atomic_load(cnt + F.tid, __ATOMIC_RELAXED, __HIP_MEMORY_SCOPE_AGENT);
        const int nt = (c + 255) >> 8; int pre = nt;
#pragma unroll
        for (int o = 1; o < 64; o <<= 1) { const int v = __shfl_up(pre, o); if (F.tid >= o) pre += v; }
        const int excl = pre - nt;
        padstart[F.tid] = excl * 256;
        for (int r = 0; r < nt; ++r) { tab.te[excl + r] = F.tid; const int left = c - r * 256; tab.tn[excl + r] = left < 256 ? left : 256; }
        if (F.tid == 63) tab.misc[0] = pre;
    }
    __syncthreads();
}
__device__ __forceinline__ void p9_dispatch(const Ctx& F) {
    build_moe_tab(F);
    const LAS int* padstart = moe_tab(F.lds).misc + 8;
    const int* e_of = (const int*)(F.ws + WS_EOF); const int* pos_of = e_of + 65536; const float* topw = (const float*)(pos_of + 65536); int* inv = (int*)(topw + 65536);
    int* toks = (int*)(F.ws + WS_TOKS); float* wsorted = (float*)(toks + SH_ROW0);
    for (int i = F.bx * 512 + F.tid; i < 65536; i += F.G * 512) { const int e = e_of[i]; const int dest = padstart[e] + pos_of[i]; toks[dest] = i >> 3; wsorted[dest] = topw[i]; inv[i] = dest; }
}
__device__ __forceinline__ void p12_combine(const Ctx& F) {
    const unsigned char* Y = F.ws + WS_Y; const int* inv = (const int*)(F.ws + WS_EOF) + 3 * 65536; const float* g2 = (const float*)(F.ws + WS_MODF) + 5 * D;
    const int gw = F.vcu * 8 + F.wave, NGW = F.G * 8;
    for (int m = gw; m < S; m += NGW) {
        int rows[9];
#pragma unroll
        for (int s = 0; s < 8; ++s) rows[s] = inv[m * 8 + s];
        rows[8] = SH_ROW0 + m;
#pragma unroll
        for (int c = 0; c < 2; ++c) { const int col = c * 1024 + F.lane * 16;
            u32x4 v[9];
#pragma unroll
            for (int s = 0; s < 9; ++s) v[s] = *(const u32x4*)(Y + (size_t)rows[s] * D + col);
            float a[16];
#pragma unroll
            for (int e = 0; e < 16; ++e) a[e] = 0.f;
#pragma unroll
            for (int s = 0; s < 9; ++s) { const unsigned w4[4] = {v[s].x, v[s].y, v[s].z, v[s].w};
#pragma unroll
                for (int q = 0; q < 4; ++q) { const f32x2 lo = __builtin_amdgcn_cvt_pk_f32_fp8((int)w4[q], false), hi = __builtin_amdgcn_cvt_pk_f32_fp8((int)w4[q], true);
                    a[4 * q] += lo.x; a[4 * q + 1] += lo.y; a[4 * q + 2] += hi.x; a[4 * q + 3] += hi.y; } }
            float* op = F.out + (size_t)m * D + col;
#pragma unroll
            for (int q = 0; q < 4; ++q) { const f32x4 x0 = *(const f32x4*)(op + 4 * q); const f32x4 gq = *(const f32x4*)(g2 + col + 4 * q) * (1.0f / FP8_YS);
                *(f32x4*)(op + 4 * q) = x0 + gq * (f32x4){a[4 * q], a[4 * q + 1], a[4 * q + 2], a[4 * q + 3]}; } }
    }
}


__device__ __forceinline__ void ph2_proj(const Ctx& F) {
    pg8::ProjSched<false> Sa; Sa.init(F.ws + WS_H, D * 2, F.ws + WS_WINT, D * 2, F.G, F.bx);
    pg8::ProjSched<true> Sb; Sb.init(F.ws + WS_H8, D, F.ws + WS_WIN8, D, F.G, F.bx);
    EpiBf16 Ea{(bf16_t*)(F.ws + WS_PROJ), INW, 0, 1.0f}; EpiBf16 Eb{(bf16_t*)(F.ws + WS_PROJ), INW, 0, 1.0f / FP8_WIN};
    const int na = Sa.count(), nb = Sb.count(), ntot = na + nb;
    const int slot = ntot > 0 ? ((F.bx >> 3) + (F.bx & 7)) % ntot : 0;
    const int sa = slot < na ? slot : na, sb = slot < na ? 0 : slot - na;
    Sa.i_lo = 0; Sa.i_hi = sa; pg8::gemm_phase<EpiBf16, pg8::ProjSched<false>, true, false>(F.lds, D, Sa, Ea);
    if (slot < na) { __syncthreads(); convert_items(F, CV_BG_FROM, CV_ALL, F.vcu * 8 + F.wave, F.G * 8); __syncthreads(); }
    Sa.i_lo = sa; Sa.i_hi = na; pg8::gemm_phase<EpiBf16, pg8::ProjSched<false>, true, false>(F.lds, D, Sa, Ea);
    Sb.i_lo = 0; Sb.i_hi = sb; pg8::gemm_phase<EpiBf16, pg8::ProjSched<true>, true, true>(F.lds, D, Sb, Eb);
    if (slot >= na) { __syncthreads(); convert_items(F, CV_BG_FROM, CV_ALL, F.vcu * 8 + F.wave, F.G * 8); __syncthreads(); }
    Sb.i_lo = sb; Sb.i_hi = nb; pg8::gemm_phase<EpiBf16, pg8::ProjSched<true>, true, true>(F.lds, D, Sb, Eb);
}
__device__ __forceinline__ void ph6a_merge(const Ctx& F) {
    pg8::DenseSched Sd; Sd.init(F.ws + WS_YA, 1024, F.ws + WS_PA, S, D, 1024, F.G, F.bx);
    EpiGate<false> E{(bf16_t*)(F.ws + WS_MERGED), D, (const bf16_t*)(F.ws + WS_PROJ) + C_GA, INW};
    pg8::gemm_phase<EpiGate<false>, pg8::DenseSched, true>(F.lds, 1024, Sd, E);
}
__device__ __forceinline__ void ph6_merge(const Ctx& F) {
    pg8::DenseSched Sd; Sd.init(F.ws + WS_YB, D, F.ws + WS_PB, S, D, D, F.G, F.bx);
    EpiGate<true> E{(bf16_t*)(F.ws + WS_MERGED), D, (const bf16_t*)(F.ws + WS_PROJ) + C_GB, INW};
    pg8::gemm_phase<EpiGate<true>, pg8::DenseSched, true>(F.lds, D, Sd, E);
}
__device__ __forceinline__ void p5_mix2_a(const Ctx& F) { p5_mix2(F); __syncthreads(); ph6a_merge(F); }
__device__ __forceinline__ void ph7_wo(const Ctx& F) {
    pg8::DenseSched Sd; Sd.init(F.ws + WS_MERGED, D, F.ws + WS_WO, S, D, D, F.G, F.bx);
    EpiResid E{inp(F, IN_X), F.out, D, (const float*)(F.ws + WS_MODF) + 2 * D};
    pg8::gemm_phase<EpiResid, pg8::DenseSched, true>(F.lds, D, Sd, E);
}
__device__ __forceinline__ void ph10_gateup(const Ctx& F) {
    build_moe_tab(F);
    MoeSched1 S1{(const char*)(F.ws + WS_H), (const char*)(F.ws + WS_E1), (const int*)(F.ws + WS_TOKS), moe_tab(F.lds), F.G, F.vcu};
    EpiGateUp E{(unsigned char*)(F.ws + WS_ACT)};
    pg8::gemm_phase<EpiGateUp, MoeSched1, true, true>(F.lds, D, S1, E);
}
__device__ __forceinline__ void ph11_down(const Ctx& F) {
    build_moe_tab(F);
    MoeSched2 S2{(const char*)(F.ws + WS_ACT), (const char*)(F.ws + WS_E2), moe_tab(F.lds), F.G, F.vcu};
    EpiDown E{(unsigned char*)(F.ws + WS_Y), (const float*)(F.ws + WS_TOKS) + SH_ROW0};
    pg8::gemm_phase<EpiDown, MoeSched2, true, true>(F.lds, ED, S2, E);
}

struct Args { const float* in[22]; float* out; unsigned char* ws; int ph_lo, ph_hi; };
__global__ void __launch_bounds__(512, 2) fwd(Args args) {
    extern __shared__ __attribute__((aligned(16))) unsigned char lds_raw[];
    Ctx F;
    F.lds = (LAS unsigned char*)lds_raw;
    F.tid = threadIdx.x; F.lane = F.tid & 63; F.wave = __builtin_amdgcn_readfirstlane(F.tid >> 6);
    F.G = gridDim.x; F.bx = blockIdx.x; F.vcu = (F.G % 8 == 0) ? (F.bx % 8) * (F.G / 8) + F.bx / 8 : F.bx;
    F.out = args.out; F.ws = args.ws;
    if (F.tid == 0) {
#pragma unroll
        for (int i = 0; i < 22; ++i) ((LAS unsigned long long*)(F.lds + LDS_PTRS))[i] = (unsigned long long)args.in[i];
    }
    volatile LAS unsigned* MISC = (volatile LAS unsigned*)(F.lds + LDS_MISC);
    if (F.tid < 64) MISC[F.tid] = 0u;
    __syncthreads();
    unsigned* ctl = (unsigned*)(F.ws + WS_CTL);
    XcdBarrier bar; bar.bar = ctl + CW_BAR; bar.x = 0; bar.st = nullptr;
    if (!MK_PER_PHASE) bar = xcd_barrier_post(ctl + CW_BAR, MISC + 8);
    const int lo = args.ph_lo, hi = args.ph_hi;
#ifndef PHASE_MASK
#define PHASE_MASK 0x1fff
#endif
#define IN(k) (((PHASE_MASK >> (k)) & 1) && lo <= (k) && (k) < hi)
#define SEAM(k) do { if (IN(k) && IN((k) + 1)) xcd_barrier(bar); } while (0)

#ifndef DUP_MASK
#define DUP_MASK 0
#endif
#define RUN(k, fn) do { if (IN(k)) { fn(F); if ((DUP_MASK >> (k)) & 1) { xcd_barrier(bar); fn(F); } } SEAM(k); } while (0)
    RUN(0, p0_prologue);
    RUN(1, p1_norm1);
    RUN(2, ph2_proj);
    RUN(3, p3_mix1);
    RUN(4, p4_scan_comb);
    RUN(5, p5_mix2_a);
    RUN(6, ph6_merge);
    RUN(7, ph7_wo);
    RUN(8, p8_router);
    RUN(9, p9_dispatch);
    RUN(10, ph10_gateup);
    RUN(11, ph11_down);
    RUN(12, p12_combine);
#undef RUN
#undef IN
#undef SEAM
}

extern "C" void kernel_launch(void* const* d_in, const int* in_sizes, int n_in, void* d_out, int out_size, void* d_ws, size_t ws_size, hipStream_t stream) {
    static int grid = 0;
    if (grid == 0) {
        if (n_in != 22 || out_size != S * D || ws_size < WS_END) { fprintf(stderr, "kernel_launch: unexpected shapes / workspace (n_in %d out %d ws %zu need %zu)\n", n_in, out_size, ws_size, (size_t)WS_END); grid = -1; return; }
        int dev = 0, cus = 0, per_cu = 0;
        if (hipGetDevice(&dev) != hipSuccess || hipDeviceGetAttribute(&cus, hipDeviceAttributeMultiprocessorCount, dev) != hipSuccess) { grid = -1; return; }
        if (hipFuncSetAttribute((const void*)fwd, hipFuncAttributeMaxDynamicSharedMemorySize, LDS_BYTES) != hipSuccess) { fprintf(stderr, "kernel_launch: hipFuncSetAttribute failed\n"); grid = -1; return; }
        if (hipOccupancyMaxActiveBlocksPerMultiprocessor(&per_cu, (const void*)fwd, 512, LDS_BYTES) != hipSuccess || per_cu < 1) fprintf(stderr, "kernel_launch: occupancy query says %d\n", per_cu);
        (void)hipGetLastError();
        grid = cus;
    }
    if (grid < 0) return;
    (void)hipMemsetAsync((char*)d_ws + WS_CTL, 0, CTL_ZERO_BYTES, stream);
    Args a{};
    for (int i = 0; i < 22; ++i) a.in[i] = (const float*)d_in[i];
    a.out = (float*)d_out; a.ws = (unsigned char*)d_ws;
#if MK_PER_PHASE
    for (int p = 0; p < NPH; ++p) { a.ph_lo = p; a.ph_hi = p + 1; hipLaunchKernelGGL(fwd, dim3(grid), dim3(512), LDS_BYTES, stream, a); }
#else
    a.ph_lo = 0; a.ph_hi = NPH; hipLaunchKernelGGL(fwd, dim3(grid), dim3(512), LDS_BYTES, stream, a);
#endif
}
```

```cpp
#include <hip/hip_runtime.h>
#include <cstdio>
#include <cstdint>

#define LAS __attribute__((address_space(3)))
#define GAS __attribute__((address_space(1)))
typedef unsigned short bf16_t;
typedef short bf16x8 __attribute__((ext_vector_type(8)));
typedef short bf16x4 __attribute__((ext_vector_type(4)));
typedef float f32x4 __attribute__((ext_vector_type(4)));
typedef float f32x2 __attribute__((ext_vector_type(2)));
typedef float f32x16 __attribute__((ext_vector_type(16)));
typedef unsigned u32x4 __attribute__((ext_vector_type(4)));
typedef unsigned u32x2 __attribute__((ext_vector_type(2)));
typedef GAS unsigned gu32;

#ifndef DUP2_MASK
#define DUP2_MASK 0
#endif
#ifndef MK_PER_PHASE
#define MK_PER_PHASE 0
#endif

constexpr int S = 8192, D = 2048, INW = 19456;
constexpr int C_QA = 0, C_KA = 3072, C_VA = 6144, C_QR = 9216, C_KR = 10240, C_VR = 11264, C_GR = 13312, C_GA = 15360, C_GB = 17408;
constexpr int NE = 64, ED = 512, TOPK = 8;
constexpr int MAXT_R = 320;
constexpr int SH_ROW0 = MAXT_R * 256;
constexpr int NROWS_Y = SH_ROW0 + S;
constexpr int NPH = 13;

constexpr size_t MiB = 1u << 20;
constexpr size_t WS_CTL = 0, CTL_ZERO_BYTES = 1 * MiB;
constexpr size_t WS_MODP = 1 * MiB;
constexpr size_t WS_MODF = 1 * MiB + 512 * 1024;
constexpr size_t WS_LSE = 2 * MiB;
constexpr size_t WS_ROPE = 3 * MiB;
constexpr size_t WS_EOF = 7 * MiB;
constexpr size_t WS_TOKS = 8 * MiB;
constexpr size_t WS_PA = 10 * MiB, WS_PB = 14 * MiB, WS_WO = 22 * MiB;
constexpr size_t WS_H = 32 * MiB;
constexpr size_t WS_E1 = 64 * MiB;
constexpr size_t WS_H8 = 194 * MiB;
constexpr size_t WS_WIN8 = 210 * MiB;
constexpr size_t WS_E2 = 324 * MiB;
constexpr size_t WS_PREV = 454 * MiB;
constexpr size_t WS_YB = 486 * MiB;
constexpr size_t WS_MERGED = 518 * MiB;
constexpr size_t WS_R1 = 550 * MiB;
constexpr size_t WS_OG = WS_R1, WS_YA = WS_R1 + 48 * MiB, WS_UPD = WS_R1 + 64 * MiB, WS_ACT = WS_R1;
constexpr size_t WS_R2 = 678 * MiB;
constexpr size_t WS_WINT = WS_R2, WS_PROJ = WS_R2 + 76 * MiB, WS_Y = WS_R2;
constexpr size_t WS_END = 1058 * MiB;
constexpr int CW_TMO = 0, CW_CODE = 1, CW_BAR = 4096, CW_CNT = 8192;

constexpr int RING_BYTES = 131072;
constexpr int LDS_TAB = 131072;
constexpr int LDS_MISC = 163840 - 256;
constexpr int LDS_BYTES = 163840;

__device__ __forceinline__ float bf2f(unsigned b) { return __uint_as_float(b << 16); }
__device__ __forceinline__ unsigned cvt_pk_bf16(float lo, float hi) { unsigned r; asm("v_cvt_pk_bf16_f32 %0, %1, %2" : "=v"(r) : "v"(lo), "v"(hi)); return r; }
__device__ __forceinline__ float fsilu(float v) { return v / (1.f + __expf(-v)); }
__device__ __forceinline__ float fsigm(float v) { return 1.f / (1.f + __expf(-v)); }
#define TR_READ(dst, base, OFF) asm volatile("ds_read_b64_tr_b16 %0, %1 offset:%2" : "=&v"(dst) : "v"(base), "i"(OFF) : "memory")
#define TR_WAIT2(a, b) asm volatile("s_waitcnt lgkmcnt(0)" : "+v"(a), "+v"(b) :: "memory")
#define TR_WAIT4(a, b, c, d) asm volatile("s_waitcnt lgkmcnt(0)" : "+v"(a), "+v"(b), "+v"(c), "+v"(d) :: "memory")
typedef int i32x8 __attribute__((ext_vector_type(8)));
__device__ __forceinline__ unsigned cvt4_fp8(float a, float b, float c, float d) {
    a = fminf(fmaxf(a, -448.f), 448.f); b = fminf(fmaxf(b, -448.f), 448.f); c = fminf(fmaxf(c, -448.f), 448.f); d = fminf(fmaxf(d, -448.f), 448.f);
    int r = __builtin_amdgcn_cvt_pk_fp8_f32(a, b, 0, false); r = __builtin_amdgcn_cvt_pk_fp8_f32(c, d, r, true); return (unsigned)r;
}
__device__ __forceinline__ i32x8 ld32(const LAS unsigned char* p) { const u32x4 a = *(const LAS u32x4*)p, b = *(const LAS u32x4*)(p + 16); i32x8 r; r[0] = (int)a.x; r[1] = (int)a.y; r[2] = (int)a.z; r[3] = (int)a.w; r[4] = (int)b.x; r[5] = (int)b.y; r[6] = (int)b.z; r[7] = (int)b.w; return r; }
__device__ __forceinline__ i32x8 cat8(bf16x8 lo, bf16x8 hi) { const u32x4 a = __builtin_bit_cast(u32x4, lo), b = __builtin_bit_cast(u32x4, hi); i32x8 r; r[0] = (int)a.x; r[1] = (int)a.y; r[2] = (int)a.z; r[3] = (int)a.w; r[4] = (int)b.x; r[5] = (int)b.y; r[6] = (int)b.z; r[7] = (int)b.w; return r; }
constexpr float FP8_WIN = 32.f;
#ifndef PROJ_ALL_FP8
#define PROJ_ALL_FP8 1
#endif
__host__ __device__ __forceinline__ bool proj_tile_fp8(int pn) { return PROJ_ALL_FP8 || (pn >= 24 && pn < 36) || pn >= 44; }
constexpr float FP8_WS1 = 32.f, FP8_WS2 = 16.f, FP8_AS = 4.f, FP8_YS = 32.f;
#define LDS_WAIT() asm volatile("s_waitcnt lgkmcnt(0)" ::: "memory")
#define VM_WAIT() asm volatile("s_waitcnt vmcnt(0)" ::: "memory")

namespace pg8 {
constexpr int BM = 256, BK = 64, HALF = 128, HTB = HALF * BK * 2, STAGE_BYTES = 8 * HTB, NXCD = 8, WGM = 8;
__host__ __device__ __forceinline__ int lds_byte(int r, int c) { const int st = (r >> 4) * 2 + (c >> 5), rr = r & 15, cc = c & 31, ob = rr * 64 + cc * 2; return st * 1024 + (ob ^ (((ob >> 9) & 1) << 5)); }
__host__ __device__ __forceinline__ void stage_rc(int b, int& R, int& C) { const int st = b / 1024, sb = b % 1024, swz = sb ^ (((sb >> 9) & 1) << 5); R = (st >> 1) * 16 + swz / 64; C = (st & 1) * 32 + (swz % 64) / 2; }
__host__ __device__ __forceinline__ int perm32(int rho) { const int n = rho >> 4, i = rho & 15; return 8 * (i >> 2) + 4 * n + (i & 3); }

struct Unit { int row0, pn, e, nvalid; };

struct DenseSched {
    static constexpr bool RAGGED = false;
    const char* A; const char* Bt; int lda, K; int nM, nN, nwg, G, c, i_lo, i_hi;
    __device__ __forceinline__ void init(const void* A_, int lda_, const void* Bt_, int M, int N, int K_, int G_, int c_) { A = (const char*)A_; Bt = (const char*)Bt_; lda = lda_; K = K_; nM = M / BM; nN = N / BM; nwg = nM * nN; G = G_; c = c_; i_lo = 0; i_hi = 0x7fffffff; }
    __device__ __forceinline__ bool next(int i, Unit& u) const {
        if (i_lo + i >= i_hi) return false;
        const long L = (long)(i_lo + i) * G + c; if (L >= nwg) return false;
        int wgid = (int)L; { const int q = nwg / NXCD, r = nwg % NXCD, xcd = wgid % NXCD, off = wgid / NXCD; wgid = (xcd < r ? xcd * (q + 1) : r * (q + 1) + (xcd - r) * q) + off; }
        const int nig = WGM * nN, gid = wgid / nig, fm = gid * WGM, gsz = (nM - fm) < WGM ? (nM - fm) : WGM;
        u.row0 = (fm + ((wgid % nig) % gsz)) * BM; u.pn = (wgid % nig) / gsz; u.e = 0; u.nvalid = 256; return true;
    }
    __device__ __forceinline__ const char* a_base() const { return A; }
    __device__ __forceinline__ const char* b_ptr(const Unit& u) const { return Bt + (size_t)u.pn * BM * K * 2; }
    __device__ __forceinline__ void a_off(const Unit& u, int tid, unsigned (&off)[2][2]) const {
#pragma unroll
        for (int i = 0; i < 2; ++i) { int R, C; stage_rc(tid * 16 + i * 8192, R, C);
            off[0][i] = (unsigned)((u.row0 + R) * lda + C) * 2u; off[1][i] = (unsigned)((u.row0 + HALF + R) * lda + C) * 2u; }
    }
};


template <bool FP8SET> struct ProjSched {
    static constexpr bool RAGGED = false;
    static constexpr int ntl = PROJ_ALL_FP8 ? (FP8SET ? 76 : 0) : (FP8SET ? 44 : 32), nM = 32, nwg = nM * ntl;
    const char* A; const char* Bt; int apitch, bpitch; int G, c, i_lo, i_hi;
    __device__ __forceinline__ void init(const void* A_, int apitch_, const void* Bt_, int bpitch_, int G_, int c_) { A = (const char*)A_; Bt = (const char*)Bt_; apitch = apitch_; bpitch = bpitch_; G = G_; c = c_; i_lo = 0; i_hi = 0x7fffffff; }
    __device__ __forceinline__ int count() const { return c < nwg ? (nwg - c + G - 1) / G : 0; }
    __device__ __forceinline__ bool next(int i, Unit& u) const {
        if (i_lo + i >= i_hi) return false;
        const long L = (long)(i_lo + i) * G + c; if (L >= nwg) return false;
        int wgid = (int)L; { const int q = nwg / NXCD, r = nwg % NXCD, xcd = wgid % NXCD, off = wgid / NXCD; wgid = (xcd < r ? xcd * (q + 1) : r * (q + 1) + (xcd - r) * q) + off; }
        const int nig = WGM * ntl, gid = wgid / nig, fm = gid * WGM, gsz = (nM - fm) < WGM ? (nM - fm) : WGM;
        u.row0 = (fm + ((wgid % nig) % gsz)) * BM; const int t = (wgid % nig) / gsz;
        u.pn = PROJ_ALL_FP8 ? t : (FP8SET ? (t < 12 ? 24 + t : 32 + t) : (t < 24 ? t : t + 12)); u.e = 0; u.nvalid = 256; return true;
    }
    __device__ __forceinline__ const char* a_base() const { return A; }
    __device__ __forceinline__ const char* b_ptr(const Unit& u) const { return Bt + (size_t)u.pn * BM * bpitch; }
    __device__ __forceinline__ void a_off(const Unit& u, int tid, unsigned (&off)[2][2]) const {
#pragma unroll
        for (int i = 0; i < 2; ++i) { int R, C; stage_rc(tid * 16 + i * 8192, R, C);
            off[0][i] = (unsigned)((u.row0 + R) * apitch + 2 * C); off[1][i] = (unsigned)((u.row0 + HALF + R) * apitch + 2 * C); }
    }
};

template <class Epi, class Sched, bool ALIGN_EPI, bool FP8 = false>
__device__ __forceinline__ void gemm_phase(LAS unsigned char* lds, const int K, const Sched& S, const Epi& E) {
    const int tid = threadIdx.x, wid = __builtin_amdgcn_readfirstlane(tid >> 6), lane = tid & 63, wr = wid >> 2, wc = wid & 3, fr = lane & 15, fq = lane >> 4;
    const int nt = FP8 ? K / 128 : K / BK;
    const int pitch = FP8 ? K : 2 * K;
    unsigned voffB[2];
#pragma unroll
    for (int i = 0; i < 2; ++i) { int R, C; stage_rc(tid * 16 + i * 8192, R, C); const int Rb = Epi::PERM ? ((R & ~31) + perm32(R & 31)) : R; voffB[i] = (unsigned)(Rb * pitch + 2 * C); }
    const size_t kstep = (size_t)(BK * 2);
    const size_t hstepB = (size_t)HALF * pitch;
    const unsigned ldsw = (unsigned)wid * 1024u;
    const int aoff = lds_byte(wr * 64 + fr, FP8 ? fq * 16 : fq * 8), boff = lds_byte(wc * 32 + fr, FP8 ? fq * 16 : fq * 8);
#define PG8_SA(b, h) (((b) * 2 + (h)) * HTB)
#define PG8_SB(b, h) ((4 + (b) * 2 + (h)) * HTB)
#define PG8_STAGE(bufoff, gbase, voff) do { _Pragma("unroll") for (int _i = 0; _i < 2; ++_i) \
        __builtin_amdgcn_global_load_lds((const unsigned*)((const char*)(gbase) + (voff)[_i]), (LAS unsigned*)(lds + (bufoff) + ldsw + _i * 8192), 16, 0, 0); } while (0)
#define PG8_LDA(dst, b, h) do { if constexpr (FP8) { _Pragma("unroll") for (int m = 0; m < 4; ++m) dst##8[m] = ld32(lds + PG8_SA(b, h) + aoff + m * 2048); } \
        else { _Pragma("unroll") for (int m = 0; m < 4; ++m) _Pragma("unroll") for (int k = 0; k < 2; ++k) dst[m][k] = *(const LAS bf16x8*)(lds + PG8_SA(b, h) + aoff + m * 2048 + k * 1024); } } while (0)
#define PG8_LDB(dst, b, h) do { if constexpr (FP8) { _Pragma("unroll") for (int n = 0; n < 2; ++n) dst##8[n] = ld32(lds + PG8_SB(b, h) + boff + n * 2048); } \
        else { _Pragma("unroll") for (int n = 0; n < 2; ++n) _Pragma("unroll") for (int k = 0; k < 2; ++k) dst[n][k] = *(const LAS bf16x8*)(lds + PG8_SB(b, h) + boff + n * 2048 + k * 1024); } } while (0)
#define PG8_MMA(ai, bj, At, Bt) do { __builtin_amdgcn_s_setprio(1); if constexpr (FP8) { _Pragma("unroll") for (int m = 0; m < 4; ++m) _Pragma("unroll") for (int n = 0; n < 2; ++n) \
        asm volatile("v_mfma_scale_f32_16x16x128_f8f6f4 %0, %1, %2, %0, %3, %3 op_sel_hi:[0,0,0]" : "+v"(acc[ai][bj][m][n]) : "v"(Bt##8[n]), "v"(At##8[m]), "v"(fp8_one)); } \
      else { _Pragma("unroll") for (int m = 0; m < 4; ++m) _Pragma("unroll") for (int n = 0; n < 2; ++n) _Pragma("unroll") for (int k = 0; k < 2; ++k) \
        acc[ai][bj][m][n] = __builtin_amdgcn_mfma_f32_16x16x32_bf16(Bt[n][k], At[m][k], acc[ai][bj][m][n], 0, 0, 0); } __builtin_amdgcn_s_setprio(0); } while (0)
#define PG8_WAIT_V(n) asm volatile("s_waitcnt vmcnt(" #n ")" ::: "memory")
#define PG8_WAIT_L(n) asm volatile("s_waitcnt lgkmcnt(" #n ")" ::: "memory")
#define PG8_BAR __builtin_amdgcn_s_barrier()
#define PG8_SCHED __builtin_amdgcn_sched_barrier(0)
    Unit cur, nxt; int ui = 0;
    if (!S.next(0, cur)) return;
    f32x4 acc[2][2][4][2];
#pragma unroll
    for (int a = 0; a < 2; ++a)
#pragma unroll
        for (int b = 0; b < 2; ++b)
#pragma unroll
            for (int m = 0; m < 4; ++m)
#pragma unroll
                for (int n = 0; n < 2; ++n) acc[a][b][m][n] = (f32x4){0.f, 0.f, 0.f, 0.f};
    bf16x8 At[4][2], B0[2][2], B1[2][2];
    i32x8 At8[4], B08[2], B18[2];
    const int fp8_one = 0x7f7f7f7f;
    unsigned coff[2][2], noff[2][2];
    S.a_off(cur, tid, coff);
    const char* const Ab = S.a_base();
    const char* cB = S.b_ptr(cur);
    PG8_STAGE(PG8_SB(0, 0), cB, voffB); PG8_STAGE(PG8_SB(0, 1), cB + hstepB, voffB); PG8_STAGE(PG8_SA(0, 0), Ab, coff[0]); PG8_STAGE(PG8_SA(0, 1), Ab, coff[1]);
    if (wr == 1) PG8_BAR;
    PG8_WAIT_V(2); PG8_BAR;
    PG8_STAGE(PG8_SB(1, 0), cB + kstep, voffB); PG8_STAGE(PG8_SA(1, 0), Ab + kstep, coff[0]); PG8_STAGE(PG8_SB(1, 1), cB + hstepB + kstep, voffB);
    PG8_WAIT_V(6); PG8_BAR;
    for (;;) {
        const bool has_next = S.next(ui + 1, nxt);
        const char* nB = has_next ? S.b_ptr(nxt) : cB;
        for (int t = 0; t < nt; t += 2) {
            const bool last = (t == nt - 2);
            const char* a1 = Ab + (size_t)(t + 1) * kstep;
            const char* a2 = last ? Ab : Ab + (size_t)(t + 2) * kstep; const char* b2 = last ? nB : cB + (size_t)(t + 2) * kstep;
            const char* a3 = a2 + kstep; const char* b3 = b2 + kstep;
            if (last && has_next) S.a_off(nxt, tid, noff);
            PG8_LDB(B0, 0, 0); PG8_LDB(B1, 0, 1); PG8_SCHED; PG8_LDA(At, 0, 0); PG8_STAGE(PG8_SA(1, 1), a1, coff[1]);
            PG8_WAIT_V(8); PG8_WAIT_L(0); PG8_BAR; PG8_MMA(0, 0, At, B0); PG8_MMA(0, 1, At, B1); PG8_BAR; PG8_SCHED;
            if (last && has_next) { coff[0][0] = noff[0][0]; coff[0][1] = noff[0][1]; coff[1][0] = noff[1][0]; coff[1][1] = noff[1][1]; }
            PG8_LDA(At, 0, 1); PG8_STAGE(PG8_SB(0, 0), b2, voffB); PG8_STAGE(PG8_SB(0, 1), b2 + hstepB, voffB); PG8_STAGE(PG8_SA(0, 0), a2, coff[0]);
            PG8_WAIT_V(8); PG8_WAIT_L(0); PG8_BAR; if (!Sched::RAGGED || cur.nvalid > HALF) { PG8_MMA(1, 0, At, B0); PG8_MMA(1, 1, At, B1); } PG8_BAR; PG8_SCHED;
            PG8_LDB(B0, 1, 0); PG8_LDB(B1, 1, 1); PG8_SCHED; PG8_LDA(At, 1, 0); PG8_STAGE(PG8_SA(0, 1), a2, coff[1]);
            PG8_WAIT_V(8); PG8_WAIT_L(0); PG8_BAR; PG8_MMA(0, 0, At, B0); PG8_MMA(0, 1, At, B1); PG8_BAR; PG8_SCHED;
            PG8_LDA(At, 1, 1); PG8_STAGE(PG8_SB(1, 0), b3, voffB); PG8_STAGE(PG8_SB(1, 1), b3 + hstepB, voffB); PG8_STAGE(PG8_SA(1, 0), a3, coff[0]);
            PG8_WAIT_V(8); PG8_WAIT_L(0); PG8_BAR; if (!Sched::RAGGED || cur.nvalid > HALF) { PG8_MMA(1, 0, At, B0); PG8_MMA(1, 1, At, B1); } PG8_BAR; PG8_SCHED;
        }
        if constexpr (ALIGN_EPI) { if (wr == 0) PG8_BAR; }
        if constexpr (FP8) asm volatile("s_nop 15\n\ts_nop 15\n\ts_nop 15" ::: "memory");
        E(acc, cur, wr, wc, fr, fq);
        if (!has_next) break;
#pragma unroll
        for (int a = 0; a < 2; ++a)
#pragma unroll
            for (int b = 0; b < 2; ++b)
#pragma unroll
                for (int m = 0; m < 4; ++m)
#pragma unroll
                    for (int n = 0; n < 2; ++n) acc[a][b][m][n] = (f32x4){0.f, 0.f, 0.f, 0.f};
        cur = nxt; cB = nB; ++ui;
        if constexpr (ALIGN_EPI) { if (wr == 1) PG8_BAR; }
    }
    PG8_WAIT_V(0);
    if constexpr (!ALIGN_EPI) { if (wr == 0) PG8_BAR; }
    PG8_BAR;
#undef PG8_SA
#undef PG8_SB
#undef PG8_STAGE
#undef PG8_LDA
#undef PG8_LDB
#undef PG8_MMA
#undef PG8_WAIT_V
#undef PG8_WAIT_L
#undef PG8_BAR
#undef PG8_SCHED
}
}
using pg8::Unit;

struct EpiBf16 {
    static constexpr bool PERM = true;
    bf16_t* O; int ldc; int nostore; float scale;
    __device__ __forceinline__ void operator()(const f32x4 (&acc)[2][2][4][2], const Unit& u, int wr, int wc, int fr, int fq) const {
        const int row0 = u.row0 + wr * 64 + fr, col0 = u.pn * 256 + wc * 32 + 8 * fq;
#pragma unroll
        for (int ai = 0; ai < 2; ++ai)
#pragma unroll
            for (int m = 0; m < 4; ++m) { bf16_t* rowp = O + (size_t)(row0 + ai * 128 + m * 16) * ldc + col0;
#pragma unroll
                for (int bj = 0; bj < 2; ++bj) { const f32x4 v0 = acc[ai][bj][m][0] * scale, v1 = acc[ai][bj][m][1] * scale;
                    u32x4 w; w.x = cvt_pk_bf16(v0[0], v0[1]); w.y = cvt_pk_bf16(v0[2], v0[3]); w.z = cvt_pk_bf16(v1[0], v1[1]); w.w = cvt_pk_bf16(v1[2], v1[3]);
                    if (!nostore) *(u32x4*)(rowp + bj * 128) = w; else asm volatile("" :: "v"(w)); } }
    }
};
template <bool ADD> struct EpiGate {
    static constexpr bool PERM = true;
    bf16_t* O; int ldc; const bf16_t* gate; int ldg;
    __device__ __forceinline__ void operator()(const f32x4 (&acc)[2][2][4][2], const Unit& u, int wr, int wc, int fr, int fq) const {
        const int row0 = u.row0 + wr * 64 + fr, col0 = u.pn * 256 + wc * 32 + 8 * fq;
#pragma unroll
        for (int ai = 0; ai < 2; ++ai)
#pragma unroll
            for (int m = 0; m < 4; ++m) { const size_t r = (size_t)(row0 + ai * 128 + m * 16); bf16_t* rowp = O + r * ldc + col0; const bf16_t* gp = gate + r * ldg + col0;
#pragma unroll
                for (int bj = 0; bj < 2; ++bj) { const f32x4 v0 = acc[ai][bj][m][0], v1 = acc[ai][bj][m][1];
                    const u32x4 g = *(const u32x4*)(gp + bj * 128);
                    float o[8];
                    o[0] = fsigm(bf2f(g.x & 0xffffu)) * v0[0]; o[1] = fsigm(bf2f(g.x >> 16)) * v0[1]; o[2] = fsigm(bf2f(g.y & 0xffffu)) * v0[2]; o[3] = fsigm(bf2f(g.y >> 16)) * v0[3];
                    o[4] = fsigm(bf2f(g.z & 0xffffu)) * v1[0]; o[5] = fsigm(bf2f(g.z >> 16)) * v1[1]; o[6] = fsigm(bf2f(g.w & 0xffffu)) * v1[2]; o[7] = fsigm(bf2f(g.w >> 16)) * v1[3];
                    if (ADD) { const u32x4 p = *(const u32x4*)(rowp + bj * 128);
                        o[0] += bf2f(p.x & 0xffffu); o[1] += bf2f(p.x >> 16); o[2] += bf2f(p.y & 0xffffu); o[3] += bf2f(p.y >> 16);
                        o[4] += bf2f(p.z & 0xffffu); o[5] += bf2f(p.z >> 16); o[6] += bf2f(p.w & 0xffffu); o[7] += bf2f(p.w >> 16); }
                    u32x4 w; w.x = cvt_pk_bf16(o[0], o[1]); w.y = cvt_pk_bf16(o[2], o[3]); w.z = cvt_pk_bf16(o[4], o[5]); w.w = cvt_pk_bf16(o[6], o[7]);
                    *(u32x4*)(rowp + bj * 128) = w; } }
    }
};
struct EpiResid {
    static constexpr bool PERM = false;
    const float* base; float* out; int ldc; const float* gvec;
    __device__ __forceinline__ void operator()(const f32x4 (&acc)[2][2][4][2], const Unit& u, int wr, int wc, int fr, int fq) const {
        const int row0 = u.row0 + wr * 64 + fr, col0 = u.pn * 256 + wc * 32 + 4 * fq;
        f32x4 gv[2][2];
#pragma unroll
        for (int bj = 0; bj < 2; ++bj)
#pragma unroll
            for (int n = 0; n < 2; ++n) gv[bj][n] = *(const f32x4*)(gvec + col0 + bj * 128 + n * 16);
#pragma unroll
        for (int ai = 0; ai < 2; ++ai)
#pragma unroll
            for (int m = 0; m < 4; ++m) { const size_t off = (size_t)(row0 + ai * 128 + m * 16) * ldc + col0;
#pragma unroll
                for (int bj = 0; bj < 2; ++bj)
#pragma unroll
                    for (int n = 0; n < 2; ++n) { const f32x4 bs = *(const f32x4*)(base + off + bj * 128 + n * 16); *(f32x4*)(out + off + bj * 128 + n * 16) = bs + gv[bj][n] * acc[ai][bj][m][n]; } }
    }
};
struct EpiGateUp {
    static constexpr bool PERM = true;
    unsigned char* ACT;
    __device__ __forceinline__ void operator()(const f32x4 (&acc)[2][2][4][2], const Unit& u, int wr, int wc, int fr, int fq) const {
        const int row0 = u.row0 + wr * 64 + fr, col0 = u.pn * 128 + wc * 32 + 8 * fq;
        constexpr float ws = 1.0f / FP8_WS1;
#pragma unroll
        for (int ai = 0; ai < 2; ++ai)
#pragma unroll
            for (int m = 0; m < 4; ++m) { unsigned char* rowp = ACT + (size_t)(row0 + ai * 128 + m * 16) * ED + col0;
                const f32x4 g0 = acc[ai][0][m][0] * ws, g1 = acc[ai][0][m][1] * ws, u0 = acc[ai][1][m][0] * (ws * FP8_AS), u1 = acc[ai][1][m][1] * (ws * FP8_AS);
                u32x2 w; w.x = cvt4_fp8(fsilu(g0[0]) * u0[0], fsilu(g0[1]) * u0[1], fsilu(g0[2]) * u0[2], fsilu(g0[3]) * u0[3]);
                w.y = cvt4_fp8(fsilu(g1[0]) * u1[0], fsilu(g1[1]) * u1[1], fsilu(g1[2]) * u1[2], fsilu(g1[3]) * u1[3]);
                *(u32x2*)rowp = w; }
    }
};
struct EpiDown {
    static constexpr bool PERM = true;
    unsigned char* Y; const float* wsorted;
    __device__ __forceinline__ void operator()(const f32x4 (&acc)[2][2][4][2], const Unit& u, int wr, int wc, int fr, int fq) const {
        const int rl0 = wr * 64 + fr, col0 = u.pn * 256 + wc * 32 + 8 * fq;
#pragma unroll
        for (int ai = 0; ai < 2; ++ai)
#pragma unroll
            for (int m = 0; m < 4; ++m) { const int rl = rl0 + ai * 128 + m * 16; const int row = u.row0 + rl;
                float wv = 1.f; if (u.e < NE) wv = (rl < u.nvalid) ? wsorted[row] : 0.f;
                wv *= FP8_YS / (FP8_WS2 * FP8_AS);
                unsigned char* rowp = Y + (size_t)row * D + col0;
#pragma unroll
                for (int bj = 0; bj < 2; ++bj) { const f32x4 v0 = acc[ai][bj][m][0] * wv, v1 = acc[ai][bj][m][1] * wv;
                    u32x2 w; w.x = cvt4_fp8(v0[0], v0[1], v0[2], v0[3]); w.y = cvt4_fp8(v1[0], v1[1], v1[2], v1[3]);
                    *(u32x2*)(rowp + bj * 128) = w; } }
    }
};

struct MoeTab { LAS int* te; LAS int* tn; LAS int* misc; };
__device__ __forceinline__ MoeTab moe_tab(LAS unsigned char* lds) { MoeTab t; t.te = (LAS int*)(lds + LDS_TAB); t.tn = t.te + 352; t.misc = t.tn + 352; return t; }
struct MoeSched1 {
    static constexpr bool RAGGED = true;
    const char* H2; const char* E1; const int* toks; MoeTab tab; int G, vcu;
    __device__ __forceinline__ bool next(int i, Unit& u) const {
        const int ntr = tab.misc[0]; const int L = i * G + vcu; if (L >= 4 * (ntr + 32)) return false;
        const int t = L >> 2; u.pn = L & 3;
        if (t < ntr) { u.row0 = t * 256; u.e = tab.te[t]; u.nvalid = tab.tn[t]; } else { u.row0 = SH_ROW0 + (t - ntr) * 256; u.e = NE; u.nvalid = 256; }
        return true;
    }
    __device__ __forceinline__ const char* a_base() const { return H2; }
    __device__ __forceinline__ const char* b_ptr(const Unit& u) const { return E1 + ((size_t)u.e * 1024 + (size_t)u.pn * 256) * D; }
    __device__ __forceinline__ void a_off(const Unit& u, int tid, unsigned (&off)[2][2]) const {
#pragma unroll
        for (int i = 0; i < 2; ++i) { int R, C; pg8::stage_rc(tid * 16 + i * 8192, R, C);
#pragma unroll
            for (int h = 0; h < 2; ++h) { const int r = h * 128 + R; int tok;
                if (u.e < NE) tok = (r < u.nvalid) ? toks[u.row0 + r] : 0; else tok = u.row0 - SH_ROW0 + r;
                off[h][i] = (unsigned)(tok * D + 2 * C); } }
    }
};
struct MoeSched2 {
    static constexpr bool RAGGED = true;
    const char* ACT; const char* E2; MoeTab tab; int G, vcu;
    __device__ __forceinline__ bool next(int i, Unit& u) const {
        const int ntr = tab.misc[0]; const int L = i * G + vcu; if (L >= 8 * (ntr + 32)) return false;
        const int t = L >> 3; u.pn = L & 7;
        if (t < ntr) { u.row0 = t * 256; u.e = tab.te[t]; u.nvalid = tab.tn[t]; } else { u.row0 = SH_ROW0 + (t - ntr) * 256; u.e = NE; u.nvalid = 256; }
        return true;
    }
    __device__ __forceinline__ const char* a_base() const { return ACT; }
    __device__ __forceinline__ const char* b_ptr(const Unit& u) const { return E2 + ((size_t)u.e * 2048 + (size_t)u.pn * 256) * ED; }
    __device__ __forceinline__ void a_off(const Unit& u, int tid, unsigned (&off)[2][2]) const {
#pragma unroll
        for (int i = 0; i < 2; ++i) { int R, C; pg8::stage_rc(tid * 16 + i * 8192, R, C);
            off[0][i] = (unsigned)((u.row0 + R) * ED + 2 * C); off[1][i] = (unsigned)((u.row0 + 128 + R) * ED + 2 * C); }
    }
};

#define XB_TMO      128
#define XB_XCNT(j)  (256  + 64 * (j))
#define XB_XSUB(j)  (1280 + 64 * (j))
#define XB_XGEN(j)  (2304 + 64 * (j))
#define XB_TOP      3328
#define XB_TOPGEN   3392
#define XCD_BAR_WORDS 3456
#define XB_SPIN_CAP (1u << 18)
__device__ __forceinline__ unsigned xb_ld(unsigned* p)              { return __hip_atomic_load(p, __ATOMIC_RELAXED, __HIP_MEMORY_SCOPE_AGENT); }
__device__ __forceinline__ unsigned xb_add(unsigned* p, unsigned v) { return __hip_atomic_fetch_add(p, v, __ATOMIC_RELAXED, __HIP_MEMORY_SCOPE_AGENT); }
__device__ __forceinline__ unsigned xb_xcc_id() { return (unsigned)__builtin_amdgcn_s_getreg((3 << 11) | 20) & 0xFu; }
#define XB_SPIN(cond, bar) do { unsigned _sp = 0; while (cond) { __builtin_amdgcn_s_sleep(1); \
    if ((++_sp & 255u) == 0u) { if (xb_ld(&(bar)[XB_TMO])) break; if (_sp > XB_SPIN_CAP) { atomicAdd(&(bar)[XB_TMO], 1u); break; } } } } while (0)
struct XcdBarrier { unsigned* bar; unsigned x; volatile LAS unsigned* st; };
__device__ __forceinline__ XcdBarrier xcd_barrier_post(unsigned* bar, volatile LAS unsigned* st) {
    XcdBarrier b; b.bar = bar; b.x = xb_xcc_id(); b.st = st;
    if (threadIdx.x == 0) (void)xb_add(&bar[XB_XCNT(b.x)], 1u);
    return b;
}
__device__ __forceinline__ void xcd_barrier_complete(unsigned* bar, unsigned x, unsigned& nloc, unsigned& nx) {
    const unsigned G = gridDim.x * gridDim.y * gridDim.z;
    unsigned sum, cnt, mine, sp = 0u;
    for (;;) {
        sum = 0u; cnt = 0u; mine = 0u;
#pragma unroll
        for (unsigned j = 0; j < 16; ++j) { const unsigned c = xb_ld(&bar[XB_XCNT(j)]); sum += c; cnt += (c > 0u) ? 1u : 0u; mine = (j == x) ? c : mine; }
        if (sum == G) break;
        __builtin_amdgcn_s_sleep(1);
        if ((++sp & 255u) == 0u) { if (xb_ld(&bar[XB_TMO])) break; if (sp > XB_SPIN_CAP) { atomicAdd(&bar[XB_TMO], 1u); break; } }
    }
    nloc = mine > 0u ? mine : 1u; nx = cnt > 0u ? cnt : 1u;
}
__device__ __forceinline__ void xcd_barrier(const XcdBarrier& b) {
    asm volatile("s_waitcnt vmcnt(0)" ::: "memory");
    __syncthreads();
    if (threadIdx.x == 0) {
        unsigned* bar = b.bar;
        __builtin_amdgcn_s_waitcnt(0);
        unsigned nloc = b.st[0], nx = b.st[1];
        if (nloc == 0u) { xcd_barrier_complete(bar, b.x, nloc, nx); b.st[0] = nloc; b.st[1] = nx; }
        const unsigned old = xb_add(&bar[XB_XSUB(b.x)], 1u);
        const unsigned gen = old / nloc;
        if (old + 1u == (gen + 1u) * nloc) {
            __builtin_amdgcn_fence(__ATOMIC_RELEASE, "agent");
            asm volatile("s_waitcnt vmcnt(0)" ::: "memory");
            const unsigned og = xb_add(&bar[XB_TOP], 1u);
            const unsigned tg = og / nx;
            if (og + 1u == (tg + 1u) * nx) xb_add(&bar[XB_TOPGEN], 1u);
            else XB_SPIN(xb_ld(&bar[XB_TOPGEN]) == tg, bar);
            __builtin_amdgcn_fence(__ATOMIC_ACQUIRE, "agent");
            xb_add(&bar[XB_XGEN(b.x)], 1u);
            asm volatile("s_waitcnt vmcnt(0)" ::: "memory");
        } else {
            XB_SPIN(xb_ld(&bar[XB_XGEN(b.x)]) == gen, bar);
            __builtin_amdgcn_fence(__ATOMIC_ACQUIRE, "agent");
            asm volatile("s_waitcnt vmcnt(0)" ::: "memory");
        }
    }
    __syncthreads();
}

struct Ctx {
    LAS unsigned char* lds;
    int tid, lane, wave, G, vcu, bx;
    float* out; unsigned char* ws;
};
constexpr int LDS_PTRS = 163840 - 512;
__device__ __forceinline__ const float* inp(const Ctx& F, int i) {
    const LAS unsigned* p = (const LAS unsigned*)(F.lds + LDS_PTRS) + 2 * i;
    const unsigned lo = __builtin_amdgcn_readfirstlane(p[0]), hi = __builtin_amdgcn_readfirstlane(p[1]);
    return (const float*)(const GAS float*)(((unsigned long long)hi << 32) | lo);
}
#define IN_X 0
#define IN_C 1
#define IN_RELB 2
#define IN_WADA 3
#define IN_BADA 4
#define IN_LN1 5
#define IN_WIN 6
#define IN_QNG 7
#define IN_KNG 8
#define IN_GNG 9
#define IN_PA 10
#define IN_PB 11
#define IN_WO 12
#define IN_LN2 13
#define IN_RW 14
#define IN_RB 15
#define IN_WG 16
#define IN_WU 17
#define IN_WD 18
#define IN_WGS 19
#define IN_WUS 20
#define IN_WDS 21

struct CvItem { const float* src; unsigned char* dst; int ldw, ldt; float scale; };
constexpr int CV_WIN = 32 * 304, CV_PA = 16 * 32, CV_PB = 32 * 32, CV_WO = 32 * 32, CV_EX = 768;
constexpr int CV_DENSE = CV_WIN + CV_PA + CV_PB + CV_WO, CV_ALL = CV_DENSE + 65 * CV_EX;
#ifndef CV_BG_FROM
#define CV_BG_FROM CV_DENSE
#endif
__device__ __forceinline__ void cv_kn(int q, int nbg_count, int& kb, int& nb) {
    const int super = q >> 3, sub = q & 7; kb = (super / nbg_count) * 4 + (sub >> 1); nb = (super % nbg_count) * 2 + (sub & 1);
}
__device__ __forceinline__ CvItem cv_decode(const Ctx& F, int it) {
    CvItem c; int r = it; int kb, nb; c.scale = 0.f;
    if (r < CV_WIN) { cv_kn(r, 152, kb, nb); c.ldw = INW; c.src = inp(F, IN_WIN) + (size_t)(64 * kb) * INW + 64 * nb;
        if (proj_tile_fp8(nb >> 2)) { c.ldt = D; c.scale = FP8_WIN; c.dst = F.ws + WS_WIN8 + (size_t)(64 * nb) * D + 64 * kb; }
        else { c.ldt = D * 2; c.dst = F.ws + WS_WINT + ((size_t)(64 * nb) * D + 64 * kb) * 2; }
        return c; } r -= CV_WIN;
    if (r < CV_PA) { cv_kn(r, 16, kb, nb); c.ldw = D; c.ldt = 1024 * 2; c.src = inp(F, IN_PA) + (size_t)(64 * kb) * D + 64 * nb; c.dst = F.ws + WS_PA + ((size_t)(64 * nb) * 1024 + 64 * kb) * 2; return c; } r -= CV_PA;
    if (r < CV_PB) { cv_kn(r, 16, kb, nb); c.ldw = D; c.ldt = D * 2; c.src = inp(F, IN_PB) + (size_t)(64 * kb) * D + 64 * nb; c.dst = F.ws + WS_PB + ((size_t)(64 * nb) * D + 64 * kb) * 2; return c; } r -= CV_PB;
    if (r < CV_WO) { cv_kn(r, 16, kb, nb); c.ldw = D; c.ldt = D * 2; c.src = inp(F, IN_WO) + (size_t)(64 * kb) * D + 64 * nb; c.dst = F.ws + WS_WO + ((size_t)(64 * nb) * D + 64 * kb) * 2; return c; } r -= CV_WO;
    const int e = r / CV_EX; int q = r % CV_EX;
    if (q < 512) {
        const int isup = q >> 8; q &= 255; cv_kn(q, 4, kb, nb); const int n0 = 64 * nb;
        const float* w = (e < NE) ? inp(F, isup ? IN_WU : IN_WG) + (size_t)e * D * ED : inp(F, isup ? IN_WUS : IN_WGS);
        c.ldw = ED; c.ldt = D; c.scale = FP8_WS1; c.src = w + (size_t)(64 * kb) * ED + n0;
        c.dst = F.ws + WS_E1 + ((size_t)e * 1024 + (size_t)((n0 >> 7) * 256 + (n0 & 127) + isup * 128)) * D + 64 * kb;
    } else {
        q -= 512; cv_kn(q, 16, kb, nb);
        const float* w = (e < NE) ? inp(F, IN_WD) + (size_t)e * ED * D : inp(F, IN_WDS);
        c.ldw = D; c.ldt = ED; c.scale = FP8_WS2; c.src = w + (size_t)(64 * kb) * D + 64 * nb;
        c.dst = F.ws + WS_E2 + ((size_t)e * D + (size_t)(64 * nb)) * ED + 64 * kb;
    }
    return c;
}
__device__ __forceinline__ void cv_load(const CvItem& c, int lane, f32x4 (&v)[16]) {
    const int r4 = lane >> 4, c16 = lane & 15;
#pragma unroll
    for (int i = 0; i < 16; ++i) v[i] = *(const f32x4*)(c.src + (size_t)(4 * i + r4) * c.ldw + 4 * c16);
}
__device__ __forceinline__ void cv_store(const CvItem& c, int lane, const f32x4 (&v)[16], LAS float* scr) {
    const int r4 = lane >> 4, c16 = lane & 15;
#pragma unroll
    for (int i = 0; i < 16; ++i) { LAS float* d = scr + (4 * i + r4) * 65 + 4 * c16; d[0] = v[i].x; d[1] = v[i].y; d[2] = v[i].z; d[3] = v[i].w; }
    LDS_WAIT(); asm volatile("" ::: "memory");
    const int cc = lane & 7;
    if (c.scale == 0.f) {
#pragma unroll
        for (int j = 0; j < 8; ++j) { const int n = (lane >> 3) + 8 * j; const LAS float* s = scr + (8 * cc) * 65 + n;
            u32x4 o; o.x = cvt_pk_bf16(s[0 * 65], s[1 * 65]); o.y = cvt_pk_bf16(s[2 * 65], s[3 * 65]); o.z = cvt_pk_bf16(s[4 * 65], s[5 * 65]); o.w = cvt_pk_bf16(s[6 * 65], s[7 * 65]);
            *(GAS u32x4*)(c.dst + (size_t)n * c.ldt + 16 * cc) = o; }
    } else { const float sc = c.scale;
#pragma unroll
        for (int j = 0; j < 8; ++j) { const int n = (lane >> 3) + 8 * j; const LAS float* s = scr + (8 * cc) * 65 + n;
            u32x2 o; o.x = cvt4_fp8(s[0 * 65] * sc, s[1 * 65] * sc, s[2 * 65] * sc, s[3 * 65] * sc); o.y = cvt4_fp8(s[4 * 65] * sc, s[5 * 65] * sc, s[6 * 65] * sc, s[7 * 65] * sc);
            *(GAS u32x2*)(c.dst + (size_t)n * c.ldt + 8 * cc) = o; }
    }
    LDS_WAIT(); asm volatile("" ::: "memory");
}
__device__ __forceinline__ void convert_items(const Ctx& F, int lo, int hi, int gw, int NGW) {
    LAS float* scr = (LAS float*)(F.lds + 16384 + F.wave * 16640);
    int it = lo + gw;
    if (it >= hi) return;
    f32x4 va[16], vb[16];
    CvItem ca = cv_decode(F, it), cb = ca;
    cv_load(ca, F.lane, va);
    for (;;) {
        int nx = it + NGW; const bool hb = nx < hi;
        if (hb) { cb = cv_decode(F, nx); cv_load(cb, F.lane, vb); }
        cv_store(ca, F.lane, va, scr);
        if (!hb) break;
        it = nx; nx = it + NGW; const bool ha = nx < hi;
        if (ha) { ca = cv_decode(F, nx); cv_load(ca, F.lane, va); }
        cv_store(cb, F.lane, vb, scr);
        if (!ha) break;
        it = nx;
    }
}
__device__ __forceinline__ void p0_prologue(const Ctx& F) {
    {
        const float* cvec = inp(F, IN_C); const float* wada = inp(F, IN_WADA); float* modp = (float*)(F.ws + WS_MODP);
        LAS float* red = (LAS float*)F.lds;
        for (int it = F.bx; it < 384; it += F.G) {
            const int cc = it % 48, ks = it / 48; const int col = cc * 256 + F.lane * 4; const int k0 = ks * 256 + F.wave * 32;
            f32x4 a = (f32x4){0.f, 0.f, 0.f, 0.f};
#pragma unroll 8
            for (int r = 0; r < 32; ++r) { const int k = k0 + r; const float s = fsilu(cvec[k]); const f32x4 w = *(const f32x4*)(wada + (size_t)k * 12288 + col); a += w * s; }
            *(LAS f32x4*)(red + F.wave * 256 + F.lane * 4) = a;
            __syncthreads();
            if (F.tid < 256) { float s = 0.f;
#pragma unroll
                for (int w = 0; w < 8; ++w) s += red[w * 256 + F.tid];
                modp[ks * 12288 + cc * 256 + F.tid] = s; }
            __syncthreads();
        }
    }
    {
        float* rc = (float*)(F.ws + WS_ROPE); float* rs = rc + S * 64;
        for (int idx = F.bx * 512 + F.tid; idx < S * 64; idx += F.G * 512) {
            const int pos = idx >> 6, i = idx & 63;
            double inv = 1.0; const double r = 0.86596432336006535;
            for (int q = 0; q < i; ++q) inv *= r;
            const double ang = (double)pos * inv;
            const double n = __builtin_rint(ang * 0.15915494309189535);
            const float red = (float)(ang - n * 6.283185307179586);
            rc[idx] = __cosf(red); rs[idx] = __sinf(red);
        }
    }
    convert_items(F, 0, CV_BG_FROM, F.vcu * 8 + F.wave, F.G * 8);
}

__device__ __forceinline__ float mod_sum(const Ctx& F, int n) {
    const float* modp = (const float*)(F.ws + WS_MODP); float s = inp(F, IN_BADA)[n];
#pragma unroll
    for (int k = 0; k < 8; ++k) s += modp[k * 12288 + n];
    return s;
}
__device__ __forceinline__ void norm_rows(const Ctx& F, const float* X, const LAS float* gs, const LAS float* sh, bf16_t* O, unsigned char* O8) {
    const int gw = F.vcu * 8 + F.wave, NGW = F.G * 8;
    for (int m = gw; m < S; m += NGW) {
        const GAS f32x4* xr = (const GAS f32x4*)(X + (size_t)m * D) + F.lane;
        f32x4 v[8]; float ss = 0.f;
#pragma unroll
        for (int j = 0; j < 8; ++j) { v[j] = xr[64 * j]; ss += (v[j].x * v[j].x + v[j].y * v[j].y) + (v[j].z * v[j].z + v[j].w * v[j].w); }
#pragma unroll
        for (int o = 1; o < 64; o <<= 1) ss += __shfl_xor(ss, o);
        const float rstd = 1.0f / sqrtf(ss * (1.f / D) + 1e-6f);
        GAS u32x2* o8 = (GAS u32x2*)(O + (size_t)m * D) + F.lane; GAS unsigned* o4 = (GAS unsigned*)(O8 + (size_t)m * D) + F.lane;
#pragma unroll
        for (int j = 0; j < 8; ++j) { const f32x4 g = *(const LAS f32x4*)(gs + 256 * j + 4 * F.lane), s = *(const LAS f32x4*)(sh + 256 * j + 4 * F.lane);
            const f32x4 y = v[j] * rstd * g + s; u32x2 w; w.x = cvt_pk_bf16(y.x, y.y); w.y = cvt_pk_bf16(y.z, y.w); if (!PROJ_ALL_FP8) o8[64 * j] = w; o4[64 * j] = cvt4_fp8(y.x, y.y, y.z, y.w); }
    }
}
__device__ __forceinline__ void p1_norm1(const Ctx& F) {
    LAS float* gs = (LAS float*)F.lds; LAS float* sh = gs + D;
    for (int k = F.tid; k < D; k += 512) { const float shv = mod_sum(F, k), scv = mod_sum(F, D + k); gs[k] = inp(F, IN_LN1)[k] * (1.f + scv); sh[k] = shv; }
    float* modf = (float*)(F.ws + WS_MODF);
    for (int n = F.bx * 512 + F.tid; n < 12288; n += F.G * 512) modf[n] = mod_sum(F, n);
    __syncthreads();
    norm_rows(F, inp(F, IN_X), gs, sh, (bf16_t*)(F.ws + WS_H), F.ws + WS_H8);
}


__device__ __forceinline__ bf16x8 pk_frag(u32x2 lo, u32x2 hi) { u32x4 v; v.x = lo.x; v.y = lo.y; v.z = hi.x; v.w = hi.y; return __builtin_bit_cast(bf16x8, v); }
__device__ __forceinline__ f32x4 mfma16(bf16x8 a, bf16x8 b, f32x4 c) { return __builtin_amdgcn_mfma_f32_16x16x32_bf16(a, b, c, 0, 0, 0); }
__device__ __forceinline__ float gamma_log2(int h) { return log2f(1.0f - exp2f(-5.0f - (float)h)); }

struct AttnU { int g, hh, d, r, nb, head; };
__device__ __forceinline__ AttnU attn_decode(int u) {
    AttnU U; U.g = u >> 9; const int rem = u & 511; U.hh = rem >> 6; const int rem2 = rem & 63;
    const int dsh = 2 * U.g; U.d = 1 << dsh; const int nblk = 64 >> dsh;
    U.r = rem2 / nblk; U.nb = rem2 % nblk; U.head = U.g * 8 + U.hh; return U;
}
__device__ __forceinline__ void attn_issue(const bf16_t* proj, const AttnU& U, int tid, int w, int lane, u32x4 (&kr)[8], u32x4 (&vr)[8], u32x4 (&qr)[4]) {
    const int rowi = tid >> 4, ch = tid & 15;
#pragma unroll
    for (int p = 0; p < 8; ++p) { const int cc = p * 32 + rowi; const int jk = (U.nb - 1) * 128 + cc;
        if (jk >= 0) { const unsigned off = (unsigned)(jk * U.d + U.r) * INW + U.head * 128 + ch * 8; kr[p] = *(const u32x4*)(proj + off + C_KA); vr[p] = *(const u32x4*)(proj + off + C_VA); }
        else { kr[p] = (u32x4){0u, 0u, 0u, 0u}; vr[p] = (u32x4){0u, 0u, 0u, 0u}; } }
    const int ql = lane & 15, g4 = lane >> 4; const unsigned tq = (unsigned)((U.nb * 128 + 16 * w + ql) * U.d + U.r);
#pragma unroll
    for (int ds = 0; ds < 4; ++ds) qr[ds] = *(const u32x4*)(proj + tq * INW + C_QA + U.head * 128 + 32 * ds + 8 * g4);
}
__device__ __forceinline__ void p3_attn(const Ctx& F) {
    const bf16_t* proj = (const bf16_t*)(F.ws + WS_PROJ);
    LAS bf16_t* KS = (LAS bf16_t*)F.lds;
    LAS bf16_t* VS = (LAS bf16_t*)(F.lds + 69632);
    LAS float* BT = (LAS float*)(F.lds + 139264);
    const int lane = F.lane, w = F.wave, ql = lane & 15, g4 = lane >> 4;
    const int rowi = F.tid >> 4, ch = F.tid & 15;
    u32x4 kr[8], vr[8], qr[4];
    int it = F.bx;
    if (it < 1536) { const AttnU U0 = attn_decode(it); attn_issue(proj, U0, F.tid, w, lane, kr, vr, qr); }
    for (; it < 1536; it += F.G) {
        const AttnU U = attn_decode(it);
        const int d = U.d, nb = U.nb;
        if (F.tid <= 128) { const int dist = F.tid * d; int b;
            if (dist < 16) b = dist; else { b = 16 + (int)floorf(log2f((float)dist * 0.0625f) * (16.0f / 7.0f)); b = b > 31 ? 31 : b; }
            BT[F.tid] = inp(F, IN_RELB)[b * 24 + U.head]; }
        {
            const float* kg = inp(F, IN_KNG) + ch * 8;
            const f32x4 kg0 = *(const f32x4*)kg, kg1 = *(const f32x4*)(kg + 4);
#pragma unroll
            for (int p = 0; p < 8; ++p) { const int cc = p * 32 + rowi;
                float f[8]; f[0] = bf2f(kr[p].x & 0xffffu); f[1] = bf2f(kr[p].x >> 16); f[2] = bf2f(kr[p].y & 0xffffu); f[3] = bf2f(kr[p].y >> 16);
                f[4] = bf2f(kr[p].z & 0xffffu); f[5] = bf2f(kr[p].z >> 16); f[6] = bf2f(kr[p].w & 0xffffu); f[7] = bf2f(kr[p].w >> 16);
                float ss = 0.f;
#pragma unroll
                for (int e = 0; e < 8; ++e) ss += f[e] * f[e];
                ss += __shfl_xor(ss, 1); ss += __shfl_xor(ss, 2); ss += __shfl_xor(ss, 4); ss += __shfl_xor(ss, 8);
                const float rstd = 1.0f / sqrtf(ss * (1.f / 128.f) + 1e-6f);
                u32x4 o; o.x = cvt_pk_bf16(f[0] * rstd * kg0.x, f[1] * rstd * kg0.y); o.y = cvt_pk_bf16(f[2] * rstd * kg0.z, f[3] * rstd * kg0.w);
                o.z = cvt_pk_bf16(f[4] * rstd * kg1.x, f[5] * rstd * kg1.y); o.w = cvt_pk_bf16(f[6] * rstd * kg1.z, f[7] * rstd * kg1.w);
                *(LAS u32x4*)(KS + cc * 136 + ch * 8) = o;
                *(LAS u32x4*)(VS + cc * 136 + ch * 8) = vr[p]; }
        }
        const int a = 16 * w + ql;
        const unsigned tq = (unsigned)((nb * 128 + a) * d + U.r);
        bf16x8 qf[4];
        {
            float f[4][8]; float ss = 0.f;
#pragma unroll
            for (int ds = 0; ds < 4; ++ds) { f[ds][0] = bf2f(qr[ds].x & 0xffffu); f[ds][1] = bf2f(qr[ds].x >> 16); f[ds][2] = bf2f(qr[ds].y & 0xffffu); f[ds][3] = bf2f(qr[ds].y >> 16);
                f[ds][4] = bf2f(qr[ds].z & 0xffffu); f[ds][5] = bf2f(qr[ds].z >> 16); f[ds][6] = bf2f(qr[ds].w & 0xffffu); f[ds][7] = bf2f(qr[ds].w >> 16);
#pragma unroll
                for (int e = 0; e < 8; ++e) ss += f[ds][e] * f[ds][e]; }
            ss += __shfl_xor(ss, 16); ss += __shfl_xor(ss, 32);
            const float rs = (1.0f / sqrtf(ss * (1.f / 128.f) + 1e-6f)) * 0.08838834764831845f;
#pragma unroll
            for (int ds = 0; ds < 4; ++ds) { const float* qg = inp(F, IN_QNG) + 32 * ds + 8 * g4; const f32x4 q0 = *(const f32x4*)qg, q1 = *(const f32x4*)(qg + 4); u32x4 o;
                o.x = cvt_pk_bf16(f[ds][0] * rs * q0.x, f[ds][1] * rs * q0.y); o.y = cvt_pk_bf16(f[ds][2] * rs * q0.z, f[ds][3] * rs * q0.w);
                o.z = cvt_pk_bf16(f[ds][4] * rs * q1.x, f[ds][5] * rs * q1.y); o.w = cvt_pk_bf16(f[ds][6] * rs * q1.z, f[ds][7] * rs * q1.w);
                qf[ds] = __builtin_bit_cast(bf16x8, o); }
        }
        __syncthreads();
        { const int nx = it + F.G; if (nx < 1536) { const AttnU Un = attn_decode(nx); attn_issue(proj, Un, F.tid, w, lane, kr, vr, qr); } }
        const int kbase = 32 * (w >> 1);
        f32x4 sc[10];
#pragma unroll
        for (int ti = 0; ti < 10; ++ti) { f32x4 acc = (f32x4){0.f, 0.f, 0.f, 0.f};
#pragma unroll
            for (int ds = 0; ds < 4; ++ds) { const bf16x8 kf = *(const LAS bf16x8*)(KS + (kbase + 16 * ti + ql) * 136 + 32 * ds + 8 * g4); acc = mfma16(kf, qf[ds], acc); }
            sc[ti] = acc; }
        float mx = -1e30f;
#pragma unroll
        for (int ti = 0; ti < 10; ++ti)
#pragma unroll
            for (int i = 0; i < 4; ++i) { const int cc = kbase + 16 * ti + 4 * g4 + i; const int delta = 128 + a - cc;
                const bool ok = (delta >= 0) && (delta <= 128) && (nb > 0 || cc >= 128);
                const float sv = ok ? sc[ti][i] + BT[ok ? delta : 0] : -1e30f; sc[ti][i] = sv; mx = fmaxf(mx, sv); }
        mx = fmaxf(mx, __shfl_xor(mx, 16)); mx = fmaxf(mx, __shfl_xor(mx, 32));
        float lsum = 0.f;
#pragma unroll
        for (int ti = 0; ti < 10; ++ti)
#pragma unroll
            for (int i = 0; i < 4; ++i) { const float p = __expf(sc[ti][i] - mx); sc[ti][i] = p; lsum += p; }
        lsum += __shfl_xor(lsum, 16); lsum += __shfl_xor(lsum, 32);
        bf16x8 pf[5];
#pragma unroll
        for (int s = 0; s < 5; ++s) { u32x4 o; o.x = cvt_pk_bf16(sc[2 * s][0], sc[2 * s][1]); o.y = cvt_pk_bf16(sc[2 * s][2], sc[2 * s][3]);
            o.z = cvt_pk_bf16(sc[2 * s + 1][0], sc[2 * s + 1][1]); o.w = cvt_pk_bf16(sc[2 * s + 1][2], sc[2 * s + 1][3]); pf[s] = __builtin_bit_cast(bf16x8, o); }
        const float rl = 1.0f / lsum;
        bf16_t* og = (bf16_t*)(F.ws + WS_OG) + ((unsigned)(U.g * S) + tq) * 1024u + U.hh * 128;
        const unsigned vbase = (unsigned)(size_t)VS + (unsigned)(((kbase + 4 * g4 + (ql >> 2)) * 136 + 4 * (ql & 3)) * 2);
#pragma unroll
        for (int dt = 0; dt < 8; ++dt) { f32x4 acc = (f32x4){0.f, 0.f, 0.f, 0.f};
            u32x2 lo[5], hi[5];
#pragma unroll
            for (int s = 0; s < 5; ++s) { TR_READ(lo[s], vbase, (32 * s * 136 + dt * 16) * 2); TR_READ(hi[s], vbase, ((32 * s + 16) * 136 + dt * 16) * 2); }
            TR_WAIT4(lo[0], hi[0], lo[1], hi[1]); TR_WAIT4(lo[2], hi[2], lo[3], hi[3]); TR_WAIT2(lo[4], hi[4]);
#pragma unroll
            for (int s = 0; s < 5; ++s) acc = mfma16(pk_frag(lo[s], hi[s]), pf[s], acc);
            u32x2 o; o.x = cvt_pk_bf16(acc[0] * rl, acc[1] * rl); o.y = cvt_pk_bf16(acc[2] * rl, acc[3] * rl);
            *(u32x2*)(og + dt * 16 + 4 * g4) = o; }
        if (g4 == 0) ((float*)(F.ws + WS_LSE))[((unsigned)(U.g * S) + tq) * 8u + U.hh] = mx + __logf(lsum);
        __syncthreads();
    }
}

__device__ __forceinline__ void rot8v(const u32x4 own, const u32x4 par, int ch, const f32x4 c0, const f32x4 c1, const f32x4 s0, const f32x4 s1, float scale, float (&o)[8]) {
    float a[8], b[8];
    a[0] = bf2f(own.x & 0xffffu); a[1] = bf2f(own.x >> 16); a[2] = bf2f(own.y & 0xffffu); a[3] = bf2f(own.y >> 16); a[4] = bf2f(own.z & 0xffffu); a[5] = bf2f(own.z >> 16); a[6] = bf2f(own.w & 0xffffu); a[7] = bf2f(own.w >> 16);
    b[0] = bf2f(par.x & 0xffffu); b[1] = bf2f(par.x >> 16); b[2] = bf2f(par.y & 0xffffu); b[3] = bf2f(par.y >> 16); b[4] = bf2f(par.z & 0xffffu); b[5] = bf2f(par.z >> 16); b[6] = bf2f(par.w & 0xffffu); b[7] = bf2f(par.w >> 16);
    const float cv[8] = {c0.x, c0.y, c0.z, c0.w, c1.x, c1.y, c1.z, c1.w}, sv[8] = {s0.x, s0.y, s0.z, s0.w, s1.x, s1.y, s1.z, s1.w};
#pragma unroll
    for (int e = 0; e < 8; ++e) o[e] = ((ch < 8) ? (a[e] * cv[e] - b[e] * sv[e]) : (b[e] * sv[e] + a[e] * cv[e])) * scale;
}

__device__ __forceinline__ void upd_unit(const Ctx& F, int u) {
    const int n = u >> 3, h = u & 7;
    const bf16_t* proj = (const bf16_t*)(F.ws + WS_PROJ);
    const float* rc = (const float*)(F.ws + WS_ROPE); const float* rsn = rc + S * 64;
    LAS bf16_t* KS = (LAS bf16_t*)F.lds;
    LAS bf16_t* VS = (LAS bf16_t*)(F.lds + 34816);
    const int lane = F.lane, w = F.wave;
    const float lg2 = gamma_log2(h);
    {
        const int rowi = F.tid >> 4, ch = F.tid & 15;
        u32x4 kown[4], kpar[4], vv[8]; f32x4 c0[4], c1[4], s0[4], s1[4];
#pragma unroll
        for (int p = 0; p < 4; ++p) { const int j = p * 32 + rowi; const unsigned tok = (unsigned)(n * 128 + j);
            const bf16_t* kp = proj + tok * INW + C_KR + h * 128;
            kown[p] = *(const u32x4*)(kp + ch * 8); kpar[p] = *(const u32x4*)(kp + (ch ^ 8) * 8);
            const float* cp = rc + tok * 64 + (ch & 7) * 8; const float* sp = rsn + tok * 64 + (ch & 7) * 8;
            c0[p] = *(const f32x4*)cp; c1[p] = *(const f32x4*)(cp + 4); s0[p] = *(const f32x4*)sp; s1[p] = *(const f32x4*)(sp + 4);
            vv[2 * p] = *(const u32x4*)(proj + tok * INW + C_VR + h * 256 + ch * 8); vv[2 * p + 1] = *(const u32x4*)(proj + tok * INW + C_VR + h * 256 + (ch + 16) * 8); }
#pragma unroll
        for (int p = 0; p < 4; ++p) { const int j = p * 32 + rowi;
            float o[8]; rot8v(kown[p], kpar[p], ch, c0[p], c1[p], s0[p], s1[p], 0.08838834764831845f, o);
            u32x4 ov; ov.x = cvt_pk_bf16(o[0], o[1]); ov.y = cvt_pk_bf16(o[2], o[3]); ov.z = cvt_pk_bf16(o[4], o[5]); ov.w = cvt_pk_bf16(o[6], o[7]);
            *(LAS u32x4*)(KS + j * 136 + ch * 8) = ov; }
#pragma unroll
        for (int p = 0; p < 4; ++p) { const int j = p * 32 + rowi; const float z = exp2f(lg2 * (float)(127 - j));
#pragma unroll
            for (int c2 = 0; c2 < 2; ++c2) { const int chv = ch + 16 * c2; const u32x4 x = vv[2 * p + c2];
                u32x4 ov; ov.x = cvt_pk_bf16(bf2f(x.x & 0xffffu) * z, bf2f(x.x >> 16) * z); ov.y = cvt_pk_bf16(bf2f(x.y & 0xffffu) * z, bf2f(x.y >> 16) * z);
                ov.z = cvt_pk_bf16(bf2f(x.z & 0xffffu) * z, bf2f(x.z >> 16) * z); ov.w = cvt_pk_bf16(bf2f(x.w & 0xffffu) * z, bf2f(x.w >> 16) * z);
                *(LAS u32x4*)(VS + j * 264 + chv * 8) = ov; } }
    }
    __syncthreads();
    const int ql = lane & 15, g4 = lane >> 4;
    const unsigned kb = (unsigned)(size_t)KS + (unsigned)(((8 * g4 + (ql >> 2)) * 136 + 4 * (ql & 3)) * 2);
    const unsigned vbw = (unsigned)(size_t)VS + (unsigned)(((8 * g4 + (ql >> 2)) * 264 + 4 * (ql & 3) + 32 * w) * 2);
    f32x4 acc[2][8];
#pragma unroll
    for (int a = 0; a < 2; ++a)
#pragma unroll
        for (int b = 0; b < 8; ++b) acc[a][b] = (f32x4){0.f, 0.f, 0.f, 0.f};
#pragma unroll
    for (int ks = 0; ks < 4; ++ks) {
        u32x2 vl[2], vh[2];
#pragma unroll
        for (int a = 0; a < 2; ++a) { TR_READ(vl[a], vbw, (32 * ks * 264 + a * 16) * 2); TR_READ(vh[a], vbw, ((32 * ks + 4) * 264 + a * 16) * 2); }
        TR_WAIT4(vl[0], vh[0], vl[1], vh[1]);
        const bf16x8 vf0 = pk_frag(vl[0], vh[0]), vf1 = pk_frag(vl[1], vh[1]);
#pragma unroll
        for (int b = 0; b < 8; b += 2) {
            u32x2 k0l, k0h, k1l, k1h;
            TR_READ(k0l, kb, (32 * ks * 136 + b * 16) * 2); TR_READ(k0h, kb, ((32 * ks + 4) * 136 + b * 16) * 2);
            TR_READ(k1l, kb, (32 * ks * 136 + (b + 1) * 16) * 2); TR_READ(k1h, kb, ((32 * ks + 4) * 136 + (b + 1) * 16) * 2);
            TR_WAIT4(k0l, k0h, k1l, k1h);
            const bf16x8 kf0 = pk_frag(k0l, k0h), kf1 = pk_frag(k1l, k1h);
            acc[0][b] = mfma16(vf0, kf0, acc[0][b]); acc[1][b] = mfma16(vf1, kf0, acc[1][b]);
            acc[0][b + 1] = mfma16(vf0, kf1, acc[0][b + 1]); acc[1][b + 1] = mfma16(vf1, kf1, acc[1][b + 1]); }
    }
    float* upd = (float*)(F.ws + WS_UPD) + (size_t)(n * 8 + h) * 32768;
#pragma unroll
    for (int a = 0; a < 2; ++a)
#pragma unroll
        for (int b = 0; b < 8; ++b)
#pragma unroll
            for (int i = 0; i < 4; ++i) upd[((2 * w + a) * 16 + 4 * g4 + i) * 128 + b * 16 + ql] = acc[a][b][i];
    __syncthreads();
}
__device__ __forceinline__ void p3_mix1(const Ctx& F) {
    p3_attn(F);
    if (DUP2_MASK & 4) { __syncthreads(); p3_attn(F); }
    for (int it = F.bx; it < 512; it += F.G) upd_unit(F, it);
    if (DUP2_MASK & 8) { __syncthreads(); for (int it = F.bx; it < 512; it += F.G) upd_unit(F, it); }
}

__device__ __forceinline__ void p4_scan(const Ctx& F) {
    const float* upd = (const float*)(F.ws + WS_UPD); unsigned* prev = (unsigned*)(F.ws + WS_PREV);
    for (int p = F.bx * 512 + F.tid; p < 131072; p += F.G * 512) {
        const int h = p >> 14;
        const float gch = exp2f(gamma_log2(h) * 128.0f);
        const int within = (p & 16383) * 2;
        float s0 = 0.f, s1 = 0.f;
#pragma unroll 8
        for (int n = 0; n < 64; ++n) { const size_t o = (size_t)(n * 8 + h) * 32768 + within;
            const f32x2 uv = *(const f32x2*)(upd + o);
            prev[o >> 1] = cvt_pk_bf16(s0, s1);
            s0 = gch * s0 + uv.x; s1 = gch * s1 + uv.y; }
    }
}

__device__ __forceinline__ void ret_unit(const Ctx& F, int u) {
    const int n = u >> 3, h = u & 7;
    const bf16_t* proj = (const bf16_t*)(F.ws + WS_PROJ);
    const float* rc = (const float*)(F.ws + WS_ROPE); const float* rsn = rc + S * 64;
    LAS bf16_t* KS = (LAS bf16_t*)F.lds;
    LAS bf16_t* VS = (LAS bf16_t*)(F.lds + 34816);
    LAS bf16_t* QS = (LAS bf16_t*)(F.lds + 102400);
    LAS float* RED = (LAS float*)(F.lds + 137216);
    LAS float* TOT = (LAS float*)(F.lds + 145408);
    const int lane = F.lane, w = F.wave;
    const float lg2 = gamma_log2(h);
    const int ql = lane & 15, g4 = lane >> 4;
    const bf16_t* prev = (const bf16_t*)(F.ws + WS_PREV) + (size_t)(n * 8 + h) * 32768;
    {
        const int rowi = F.tid >> 4, ch = F.tid & 15;
        u32x4 kown[4], kpar[4], vv[8]; f32x4 c0[4], c1[4], s0[4], s1[4];
#pragma unroll
        for (int p = 0; p < 4; ++p) { const int j = p * 32 + rowi; const unsigned tok = (unsigned)(n * 128 + j);
            const bf16_t* kp = proj + tok * INW + C_KR + h * 128;
            kown[p] = *(const u32x4*)(kp + ch * 8); kpar[p] = *(const u32x4*)(kp + (ch ^ 8) * 8);
            const float* cp = rc + tok * 64 + (ch & 7) * 8; const float* sp = rsn + tok * 64 + (ch & 7) * 8;
            c0[p] = *(const f32x4*)cp; c1[p] = *(const f32x4*)(cp + 4); s0[p] = *(const f32x4*)sp; s1[p] = *(const f32x4*)(sp + 4);
            vv[2 * p] = *(const u32x4*)(proj + tok * INW + C_VR + h * 256 + ch * 8); vv[2 * p + 1] = *(const u32x4*)(proj + tok * INW + C_VR + h * 256 + (ch + 16) * 8); }
#pragma unroll
        for (int p = 0; p < 4; ++p) { const int j = p * 32 + rowi;
            float o[8]; rot8v(kown[p], kpar[p], ch, c0[p], c1[p], s0[p], s1[p], 0.08838834764831845f, o);
            u32x4 ov; ov.x = cvt_pk_bf16(o[0], o[1]); ov.y = cvt_pk_bf16(o[2], o[3]); ov.z = cvt_pk_bf16(o[4], o[5]); ov.w = cvt_pk_bf16(o[6], o[7]);
            *(LAS u32x4*)(KS + j * 136 + ch * 8) = ov; }
#pragma unroll
        for (int p = 0; p < 4; ++p) { const int j = p * 32 + rowi;
#pragma unroll
            for (int c2 = 0; c2 < 2; ++c2) { const int chv = ch + 16 * c2; const u32x4 x = vv[2 * p + c2];
                *(LAS u32x4*)(VS + j * 264 + chv * 8) = x; } }
    }
    const int iq = 16 * w + ql; const unsigned tq = (unsigned)(n * 128 + iq);
    bf16x8 qf[4];
    {
        u32x4 qv[4]; float f[4][8];
#pragma unroll
        for (int ds = 0; ds < 4; ++ds) qv[ds] = *(const u32x4*)(proj + tq * INW + C_QR + h * 128 + 32 * ds + 8 * g4);
#pragma unroll
        for (int ds = 0; ds < 4; ++ds) { f[ds][0] = bf2f(qv[ds].x & 0xffffu); f[ds][1] = bf2f(qv[ds].x >> 16); f[ds][2] = bf2f(qv[ds].y & 0xffffu); f[ds][3] = bf2f(qv[ds].y >> 16);
            f[ds][4] = bf2f(qv[ds].z & 0xffffu); f[ds][5] = bf2f(qv[ds].z >> 16); f[ds][6] = bf2f(qv[ds].w & 0xffffu); f[ds][7] = bf2f(qv[ds].w >> 16); }
        const float xi = exp2f(lg2 * (float)(iq + 1));
#pragma unroll
        for (int ds = 0; ds < 2; ++ds) {
            const float* cp = rc + tq * 64 + 32 * ds + 8 * g4; const float* sp = rsn + tq * 64 + 32 * ds + 8 * g4;
            const f32x4 c0 = *(const f32x4*)cp, c1 = *(const f32x4*)(cp + 4), s0 = *(const f32x4*)sp, s1 = *(const f32x4*)(sp + 4);
            const float cv[8] = {c0.x, c0.y, c0.z, c0.w, c1.x, c1.y, c1.z, c1.w}, sv[8] = {s0.x, s0.y, s0.z, s0.w, s1.x, s1.y, s1.z, s1.w};
            float lo[8], hi[8];
#pragma unroll
            for (int e = 0; e < 8; ++e) { const float t1 = f[ds][e], t2 = f[ds + 2][e]; lo[e] = t1 * cv[e] - t2 * sv[e]; hi[e] = t1 * sv[e] + t2 * cv[e]; }
            u32x4 o; o.x = cvt_pk_bf16(lo[0], lo[1]); o.y = cvt_pk_bf16(lo[2], lo[3]); o.z = cvt_pk_bf16(lo[4], lo[5]); o.w = cvt_pk_bf16(lo[6], lo[7]); qf[ds] = __builtin_bit_cast(bf16x8, o);
            o.x = cvt_pk_bf16(hi[0], hi[1]); o.y = cvt_pk_bf16(hi[2], hi[3]); o.z = cvt_pk_bf16(hi[4], hi[5]); o.w = cvt_pk_bf16(hi[6], hi[7]); qf[ds + 2] = __builtin_bit_cast(bf16x8, o);
            o.x = cvt_pk_bf16(lo[0] * xi, lo[1] * xi); o.y = cvt_pk_bf16(lo[2] * xi, lo[3] * xi); o.z = cvt_pk_bf16(lo[4] * xi, lo[5] * xi); o.w = cvt_pk_bf16(lo[6] * xi, lo[7] * xi);
            *(LAS u32x4*)(QS + iq * 136 + 32 * ds + 8 * g4) = o;
            o.x = cvt_pk_bf16(hi[0] * xi, hi[1] * xi); o.y = cvt_pk_bf16(hi[2] * xi, hi[3] * xi); o.z = cvt_pk_bf16(hi[4] * xi, hi[5] * xi); o.w = cvt_pk_bf16(hi[6] * xi, hi[7] * xi);
            *(LAS u32x4*)(QS + iq * 136 + 32 * (ds + 2) + 8 * g4) = o;
        }
    }
    bf16x8 pr[2][4];
#pragma unroll
    for (int a = 0; a < 2; ++a)
#pragma unroll
        for (int ds = 0; ds < 4; ++ds) pr[a][ds] = *(const bf16x8*)(prev + ((2 * w + a) * 16 + ql) * 128 + 32 * ds + 8 * g4);
    __syncthreads();
    f32x4 sc[8];
#pragma unroll
    for (int kt = 0; kt < 8; ++kt) { f32x4 a = (f32x4){0.f, 0.f, 0.f, 0.f};
#pragma unroll
        for (int ds = 0; ds < 4; ++ds) { const bf16x8 kf = *(const LAS bf16x8*)(KS + (16 * kt + ql) * 136 + 32 * ds + 8 * g4); a = mfma16(kf, qf[ds], a); }
#pragma unroll
        for (int i = 0; i < 4; ++i) { const int j = 16 * kt + 4 * g4 + i; const int df = iq - j; a[i] = (df >= 0) ? a[i] * exp2f(lg2 * (float)df) : 0.f; }
        sc[kt] = a; }
    __syncthreads();
#pragma unroll
    for (int kt = 0; kt < 8; ++kt) { u32x2 o; o.x = cvt_pk_bf16(sc[kt][0], sc[kt][1]); o.y = cvt_pk_bf16(sc[kt][2], sc[kt][3]); *(LAS u32x2*)(KS + iq * 136 + 16 * kt + 4 * g4) = o; }
    __syncthreads();
    f32x4 acc[2][8];
#pragma unroll
    for (int a = 0; a < 2; ++a)
#pragma unroll
        for (int qt = 0; qt < 8; ++qt) acc[a][qt] = (f32x4){0.f, 0.f, 0.f, 0.f};
#pragma unroll
    for (int ds = 0; ds < 4; ++ds)
#pragma unroll
        for (int qt = 0; qt < 8; ++qt) { const bf16x8 bq = *(const LAS bf16x8*)(QS + (qt * 16 + ql) * 136 + 32 * ds + 8 * g4);
            acc[0][qt] = mfma16(pr[0][ds], bq, acc[0][qt]); acc[1][qt] = mfma16(pr[1][ds], bq, acc[1][qt]); }
    const unsigned vbw = (unsigned)(size_t)VS + (unsigned)(((8 * g4 + (ql >> 2)) * 264 + 4 * (ql & 3) + 32 * w) * 2);
#pragma unroll
    for (int s = 0; s < 4; ++s) {
        u32x2 vl[2], vh[2];
#pragma unroll
        for (int a = 0; a < 2; ++a) { TR_READ(vl[a], vbw, (32 * s * 264 + a * 16) * 2); TR_READ(vh[a], vbw, ((32 * s + 4) * 264 + a * 16) * 2); }
        TR_WAIT4(vl[0], vh[0], vl[1], vh[1]);
        const bf16x8 vf0 = pk_frag(vl[0], vh[0]), vf1 = pk_frag(vl[1], vh[1]);
#pragma unroll
        for (int qt = 0; qt < 8; ++qt) if (qt >= 2 * s) { const bf16x8 bp = *(const LAS bf16x8*)(KS + (qt * 16 + ql) * 136 + 32 * s + 8 * g4);
            acc[0][qt] = mfma16(vf0, bp, acc[0][qt]); acc[1][qt] = mfma16(vf1, bp, acc[1][qt]); }
    }
#pragma unroll
    for (int qt = 0; qt < 8; ++qt) { float s1 = 0.f, s2 = 0.f;
#pragma unroll
        for (int a = 0; a < 2; ++a)
#pragma unroll
            for (int i = 0; i < 4; ++i) { const float x = acc[a][qt][i]; s1 += x; s2 += x * x; }
        s1 += __shfl_xor(s1, 16); s1 += __shfl_xor(s1, 32); s2 += __shfl_xor(s2, 16); s2 += __shfl_xor(s2, 32);
        if (g4 == 0) *(LAS f32x2*)(RED + (w * 128 + qt * 16 + ql) * 2) = (f32x2){s1, s2}; }
    __syncthreads();
    if (F.tid < 128) { float s1 = 0.f, s2 = 0.f;
#pragma unroll
        for (int ww = 0; ww < 8; ++ww) { const f32x2 v = *(const LAS f32x2*)(RED + (ww * 128 + F.tid) * 2); s1 += v.x; s2 += v.y; }
        const float mean = s1 * (1.f / 256.f); float var = s2 * (1.f / 256.f) - mean * mean; var = var > 0.f ? var : 0.f;
        *(LAS f32x2*)(TOT + F.tid * 2) = (f32x2){mean, 1.0f / sqrtf(var + 1e-5f)}; }
    __syncthreads();
    LAS bf16_t* OT = VS;
#pragma unroll
    for (int qt = 0; qt < 8; ++qt) { const f32x2 st = *(const LAS f32x2*)(TOT + (qt * 16 + ql) * 2);
#pragma unroll
        for (int a = 0; a < 2; ++a) { u32x2 o; o.x = cvt_pk_bf16((acc[a][qt][0] - st.x) * st.y, (acc[a][qt][1] - st.x) * st.y); o.y = cvt_pk_bf16((acc[a][qt][2] - st.x) * st.y, (acc[a][qt][3] - st.x) * st.y);
            *(LAS u32x2*)(OT + (qt * 16 + ql) * 264 + (2 * w + a) * 16 + 4 * g4) = o; } }
    __syncthreads();
    const float* gng = inp(F, IN_GNG) + h * 256;
    {
        const int pc = F.tid & 31;
        const f32x4 gg0 = *(const f32x4*)(gng + pc * 8), gg1 = *(const f32x4*)(gng + pc * 8 + 4);
        u32x4 gv[8];
#pragma unroll
        for (int p = 0; p < 8; ++p) { const unsigned tk = (unsigned)(n * 128 + p * 16 + (F.tid >> 5)); gv[p] = *(const u32x4*)(proj + tk * INW + C_GR + h * 256 + pc * 8); }
#pragma unroll
        for (int p = 0; p < 8; ++p) { const int row = p * 16 + (F.tid >> 5); const unsigned tk = (unsigned)(n * 128 + row);
            const u32x4 x = *(const LAS u32x4*)(OT + row * 264 + pc * 8); u32x4 o;
            o.x = cvt_pk_bf16(bf2f(x.x & 0xffffu) * gg0.x * fsilu(bf2f(gv[p].x & 0xffffu)), bf2f(x.x >> 16) * gg0.y * fsilu(bf2f(gv[p].x >> 16)));
            o.y = cvt_pk_bf16(bf2f(x.y & 0xffffu) * gg0.z * fsilu(bf2f(gv[p].y & 0xffffu)), bf2f(x.y >> 16) * gg0.w * fsilu(bf2f(gv[p].y >> 16)));
            o.z = cvt_pk_bf16(bf2f(x.z & 0xffffu) * gg1.x * fsilu(bf2f(gv[p].z & 0xffffu)), bf2f(x.z >> 16) * gg1.y * fsilu(bf2f(gv[p].z >> 16)));
            o.w = cvt_pk_bf16(bf2f(x.w & 0xffffu) * gg1.z * fsilu(bf2f(gv[p].w & 0xffffu)), bf2f(x.w >> 16) * gg1.w * fsilu(bf2f(gv[p].w >> 16)));
            *(u32x4*)((bf16_t*)(F.ws + WS_YB) + tk * D + h * 256 + pc * 8) = o; }
    }
    __syncthreads();
}
__device__ __forceinline__ void comb_item(const Ctx& F, int it) {
    const bf16_t* og = (const bf16_t*)(F.ws + WS_OG); const float* lse = (const float*)(F.ws + WS_LSE); bf16_t* ya = (bf16_t*)(F.ws + WS_YA);
    for (int rr = 0; rr < 4; ++rr) { const size_t t = (size_t)it * 32 + F.wave * 4 + rr; const int hh = F.lane >> 3;
        const float l0 = lse[(0 * (size_t)S + t) * 8 + hh], l1 = lse[(1 * (size_t)S + t) * 8 + hh], l2 = lse[(2 * (size_t)S + t) * 8 + hh];
        const float m = fmaxf(l0, fmaxf(l1, l2)); float a0 = __expf(l0 - m), a1 = __expf(l1 - m), a2 = __expf(l2 - m); const float inv = 1.f / (a0 + a1 + a2); a0 *= inv; a1 *= inv; a2 *= inv;
#pragma unroll
        for (int c = 0; c < 2; ++c) { const size_t e = t * 1024 + F.lane * 16 + c * 8;
            const u32x4 v0 = *(const u32x4*)(og + e), v1 = *(const u32x4*)(og + (size_t)S * 1024 + e), v2 = *(const u32x4*)(og + 2 * (size_t)S * 1024 + e);
            u32x4 o;
            o.x = cvt_pk_bf16(a0 * bf2f(v0.x & 0xffffu) + a1 * bf2f(v1.x & 0xffffu) + a2 * bf2f(v2.x & 0xffffu), a0 * bf2f(v0.x >> 16) + a1 * bf2f(v1.x >> 16) + a2 * bf2f(v2.x >> 16));
            o.y = cvt_pk_bf16(a0 * bf2f(v0.y & 0xffffu) + a1 * bf2f(v1.y & 0xffffu) + a2 * bf2f(v2.y & 0xffffu), a0 * bf2f(v0.y >> 16) + a1 * bf2f(v1.y >> 16) + a2 * bf2f(v2.y >> 16));
            o.z = cvt_pk_bf16(a0 * bf2f(v0.z & 0xffffu) + a1 * bf2f(v1.z & 0xffffu) + a2 * bf2f(v2.z & 0xffffu), a0 * bf2f(v0.z >> 16) + a1 * bf2f(v1.z >> 16) + a2 * bf2f(v2.z >> 16));
            o.w = cvt_pk_bf16(a0 * bf2f(v0.w & 0xffffu) + a1 * bf2f(v1.w & 0xffffu) + a2 * bf2f(v2.w & 0xffffu), a0 * bf2f(v0.w >> 16) + a1 * bf2f(v1.w >> 16) + a2 * bf2f(v2.w >> 16));
            *(u32x4*)(ya + e) = o; } }
}
__device__ __forceinline__ void p4_scan_comb(const Ctx& F) {
    p4_scan(F);
    for (int it = F.bx; it < 256; it += F.G) comb_item(F, it);
}
__device__ __forceinline__ void p5_mix2(const Ctx& F) {
    for (int it = F.bx; it < 512; it += F.G) ret_unit(F, it);
    if (DUP2_MASK & 1) { __syncthreads(); for (int it = F.bx; it < 512; it += F.G) ret_unit(F, it); }
}

__device__ __forceinline__ void p8_router(const Ctx& F) {
    LAS float* gs = (LAS float*)F.lds; LAS float* sh = gs + D; LAS float* XS = sh + D; LAS float* WSm = XS + 32 * 260; LAS float* SC = WSm + 256 * 64; LAS float* SEL = SC + 32 * 64; LAS float* RSTD = SEL + 32 * 64;
    const float* modf = (const float*)(F.ws + WS_MODF);
    for (int k = F.tid; k < D; k += 512) { gs[k] = inp(F, IN_LN2)[k] * (1.f + modf[4 * D + k]); sh[k] = modf[3 * D + k]; }
    __syncthreads();
    const float* x1 = F.out; unsigned char* H2 = F.ws + WS_H;
    const float* rw = inp(F, IN_RW); const float* rb = inp(F, IN_RB);
    int* e_of = (int*)(F.ws + WS_EOF); int* pos_of = e_of + 65536; float* topw = (float*)(pos_of + 65536);
    unsigned* cnt = (unsigned*)(F.ws + WS_CTL) + CW_CNT;
    for (int it = F.bx; it < 256; it += F.G) {
        const int t0 = it * 32;
#pragma unroll 1
        for (int rr = 0; rr < 4; ++rr) { const int m = t0 + F.wave * 4 + rr;
            const GAS f32x4* xr = (const GAS f32x4*)(x1 + (size_t)m * D) + F.lane;
            f32x4 v[8]; float ss = 0.f;
#pragma unroll
            for (int j = 0; j < 8; ++j) { v[j] = xr[64 * j]; ss += (v[j].x * v[j].x + v[j].y * v[j].y) + (v[j].z * v[j].z + v[j].w * v[j].w); }
#pragma unroll
            for (int o = 1; o < 64; o <<= 1) ss += __shfl_xor(ss, o);
            const float rstd = 1.0f / sqrtf(ss * (1.f / D) + 1e-6f);
            if (F.lane == 0) RSTD[F.wave * 4 + rr] = rstd;
            GAS unsigned* o4 = (GAS unsigned*)(H2 + (size_t)m * D) + F.lane;
#pragma unroll
            for (int j = 0; j < 8; ++j) { const f32x4 g = *(const LAS f32x4*)(gs + 256 * j + 4 * F.lane), s = *(const LAS f32x4*)(sh + 256 * j + 4 * F.lane);
                const f32x4 y = v[j] * rstd * g + s; o4[64 * j] = cvt4_fp8(y.x, y.y, y.z, y.w); } }
        __syncthreads();
        const int tok = F.tid >> 4, eq = F.tid & 15;
        f32x16 ac0, ac1;
#pragma unroll
        for (int i = 0; i < 16; ++i) { ac0[i] = 0.f; ac1[i] = 0.f; }
#pragma unroll 1
        for (int kc = 0; kc < 8; ++kc) {
#pragma unroll
            for (int q = 0; q < 4; ++q) { const int idx = F.tid + 512 * q; const int row = idx >> 6, c4 = (idx & 63) * 4; const int k = kc * 256 + c4;
                const f32x4 xv = *(const f32x4*)(x1 + (size_t)(t0 + row) * D + k); const float rstd = RSTD[row];
                const f32x4 g = *(const LAS f32x4*)(gs + k), s = *(const LAS f32x4*)(sh + k);
                *(LAS f32x4*)(XS + row * 260 + c4) = xv * rstd * g + s; }
#pragma unroll
            for (int q = 0; q < 8; ++q) { const int idx = F.tid + 512 * q; const int kr = idx >> 4, c4 = (idx & 15) * 4;
                *(LAS f32x4*)(WSm + kr * 64 + c4) = *(const f32x4*)(rw + (size_t)(kc * 256 + kr) * 64 + c4); }
            __syncthreads();
            { const int i31 = F.lane & 31, kh = F.lane >> 5;
#pragma unroll 4
              for (int kp = 0; kp < 16; ++kp) { const int k = 32 * F.wave + 2 * kp + kh;
                  const float av = XS[i31 * 260 + k]; const float b0 = WSm[k * 64 + i31], b1 = WSm[k * 64 + 32 + i31];
                  ac0 = __builtin_amdgcn_mfma_f32_32x32x2f32(av, b0, ac0, 0, 0, 0); ac1 = __builtin_amdgcn_mfma_f32_32x32x2f32(av, b1, ac1, 0, 0, 0); } }
            __syncthreads();
        }
        { LAS float* RED = WSm + F.wave * 2048; const int i31 = F.lane & 31, kh = F.lane >> 5;
#pragma unroll
          for (int rg = 0; rg < 16; ++rg) { const int row = (rg & 3) + 8 * (rg >> 2) + 4 * kh; RED[row * 64 + i31] = ac0[rg]; RED[row * 64 + 32 + i31] = ac1[rg]; } }
        __syncthreads();
        f32x4 lg = (f32x4){0.f, 0.f, 0.f, 0.f};
#pragma unroll
        for (int w = 0; w < 8; ++w) lg += *(const LAS f32x4*)(WSm + w * 2048 + tok * 64 + eq * 4);
#pragma unroll
        for (int i = 0; i < 4; ++i) { const float sc = fsigm(lg[i]); SC[tok * 64 + eq * 4 + i] = sc; SEL[tok * 64 + eq * 4 + i] = sc + rb[eq * 4 + i]; }
        __syncthreads();
        if (F.tid < 32) {
            LAS float* sel = SEL + F.tid * 64; const LAS float* scp = SC + F.tid * 64;
            float gsc[8];
#pragma unroll
            for (int g = 0; g < 8; ++g) { float m1 = -3e38f, m2 = -3e38f;
#pragma unroll
                for (int j = 0; j < 8; ++j) { const float v = sel[g * 8 + j]; if (v > m1) { m2 = m1; m1 = v; } else if (v > m2) m2 = v; }
                gsc[g] = m1 + m2; }
            unsigned gmask = 0u;
#pragma unroll
            for (int r = 0; r < 4; ++r) { float best = -3e38f; int bi = 0;
#pragma unroll
                for (int g = 0; g < 8; ++g) { const bool take = !((gmask >> g) & 1u) && gsc[g] > best; best = take ? gsc[g] : best; bi = take ? g : bi; }
                gmask |= 1u << bi; }
            int idx[8]; float wv[8]; float wsum = 0.f;
#pragma unroll
            for (int r = 0; r < 8; ++r) { float best = -3e38f; int bi = 0;
                for (int e = 0; e < 64; ++e) { const float v = sel[e]; const bool take = ((gmask >> (e >> 3)) & 1u) && v > best; best = take ? v : best; bi = take ? e : bi; }
                sel[bi] = -3e38f; idx[r] = bi; wv[r] = scp[bi]; wsum += wv[r]; }
            const float sc = 2.5f / wsum; const int tk = t0 + F.tid;
#pragma unroll
            for (int r = 0; r < 8; ++r) { const unsigned pos = __hip_atomic_fetch_add(cnt + idx[r], 1u, __ATOMIC_RELAXED, __HIP_MEMORY_SCOPE_AGENT);
                e_of[tk * 8 + r] = idx[r]; pos_of[tk * 8 + r] = (int)pos; topw[tk * 8 + r] = wv[r] * sc; }
        }
        __syncthreads();
    }
}

__device__ __forceinline__ void build_moe_tab(const Ctx& F) {
    MoeTab tab = moe_tab(F.lds);
    LAS int* padstart = tab.misc + 8;
    if (F.tid < 64) {
        unsigned* cnt = (unsigned*)(F.ws + WS_CTL) + CW_CNT;
        const int c = (int)__hip_atomic_load(cnt + F.tid, __ATOMIC_RELAXED, __HIP_MEMORY_SCOPE_AGENT);
        const int nt = (c + 255) >> 8; int pre = nt;
#pragma unroll
        for (int o = 1; o < 64; o <<= 1) { const int v = __shfl_up(pre, o); if (F.tid >= o) pre += v; }
        const int excl = pre - nt;
        padstart[F.tid] = excl * 256;
        for (int r = 0; r < nt; ++r) { tab.te[excl + r] = F.tid; const int left = c - r * 256; tab.tn[excl + r] = left < 256 ? left : 256; }
        if (F.tid == 63) tab.misc[0] = pre;
    }
    __syncthreads();
}
__device__ __forceinline__ void p9_dispatch(const Ctx& F) {
    build_moe_tab(F);
    const LAS int* padstart = moe_tab(F.lds).misc + 8;
    const int* e_of = (const int*)(F.ws + WS_EOF); const int* pos_of = e_of + 65536; const float* topw = (const float*)(pos_of + 65536); int* inv = (int*)(topw + 65536);
    int* toks = (int*)(F.ws + WS_TOKS); float* wsorted = (float*)(toks + SH_ROW0);
    for (int i = F.bx * 512 + F.tid; i < 65536; i += F.G * 512) { const int e = e_of[i]; const int dest = padstart[e] + pos_of[i]; toks[dest] = i >> 3; wsorted[dest] = topw[i]; inv[i] = dest; }
}
__device__ __forceinline__ void p12_combine(const Ctx& F) {
    const unsigned char* Y = F.ws + WS_Y; const int* inv = (const int*)(F.ws + WS_EOF) + 3 * 65536; const float* g2 = (const float*)(F.ws + WS_MODF) + 5 * D;
    const int gw = F.vcu * 8 + F.wave, NGW = F.G * 8;
    for (int m = gw; m < S; m += NGW) {
        int rows[9];
#pragma unroll
        for (int s = 0; s < 8; ++s) rows[s] = inv[m * 8 + s];
        rows[8] = SH_ROW0 + m;
#pragma unroll
        for (int c = 0; c < 2; ++c) { const int col = c * 1024 + F.lane * 16;
            u32x4 v[9];
#pragma unroll
            for (int s = 0; s < 9; ++s) v[s] = *(const u32x4*)(Y + (size_t)rows[s] * D + col);
            float a[16];
#pragma unroll
            for (int e = 0; e < 16; ++e) a[e] = 0.f;
#pragma unroll
            for (int s = 0; s < 9; ++s) { const unsigned w4[4] = {v[s].x, v[s].y, v[s].z, v[s].w};
#pragma unroll
                for (int q = 0; q < 4; ++q) { const f32x2 lo = __builtin_amdgcn_cvt_pk_f32_fp8((int)w4[q], false), hi = __builtin_amdgcn_cvt_pk_f32_fp8((int)w4[q], true);
                    a[4 * q] += lo.x; a[4 * q + 1] += lo.y; a[4 * q + 2] += hi.x; a[4 * q + 3] += hi.y; } }
            float* op = F.out + (size_t)m * D + col;
#pragma unroll
            for (int q = 0; q < 4; ++q) { const f32x4 x0 = *(const f32x4*)(op + 4 * q); const f32x4 gq = *(const f32x4*)(g2 + col + 4 * q) * (1.0f / FP8_YS);
                *(f32x4*)(op + 4 * q) = x0 + gq * (f32x4){a[4 * q], a[4 * q + 1], a[4 * q + 2], a[4 * q + 3]}; } }
    }
}


__device__ __forceinline__ void ph2_proj(const Ctx& F) {
    pg8::ProjSched<false> Sa; Sa.init(F.ws + WS_H, D * 2, F.ws + WS_WINT, D * 2, F.G, F.bx);
    pg8::ProjSched<true> Sb; Sb.init(F.ws + WS_H8, D, F.ws + WS_WIN8, D, F.G, F.bx);
    EpiBf16 Ea{(bf16_t*)(F.ws + WS_PROJ), INW, 0, 1.0f}; EpiBf16 Eb{(bf16_t*)(F.ws + WS_PROJ), INW, 0, 1.0f / FP8_WIN};
    const int na = Sa.count(), nb = Sb.count(), ntot = na + nb;
    const int slot = ntot > 0 ? ((F.bx >> 3) + (F.bx & 7)) % ntot : 0;
    const int sa = slot < na ? slot : na, sb = slot < na ? 0 : slot - na;
    Sa.i_lo = 0; Sa.i_hi = sa; pg8::gemm_phase<EpiBf16, pg8::ProjSched<false>, true, false>(F.lds, D, Sa, Ea);
    if (slot < na) { __syncthreads(); convert_items(F, CV_BG_FROM, CV_ALL, F.vcu * 8 + F.wave, F.G * 8); __syncthreads(); }
    Sa.i_lo = sa; Sa.i_hi = na; pg8::gemm_phase<EpiBf16, pg8::ProjSched<false>, true, false>(F.lds, D, Sa, Ea);
    Sb.i_lo = 0; Sb.i_hi = sb; pg8::gemm_phase<EpiBf16, pg8::ProjSched<true>, true, true>(F.lds, D, Sb, Eb);
    if (slot >= na) { __syncthreads(); convert_items(F, CV_BG_FROM, CV_ALL, F.vcu * 8 + F.wave, F.G * 8); __syncthreads(); }
    Sb.i_lo = sb; Sb.i_hi = nb; pg8::gemm_phase<EpiBf16, pg8::ProjSched<true>, true, true>(F.lds, D, Sb, Eb);
}
__device__ __forceinline__ void ph6a_merge(const Ctx& F) {
    pg8::DenseSched Sd; Sd.init(F.ws + WS_YA, 1024, F.ws + WS_PA, S, D, 1024, F.G, F.bx);
    EpiGate<false> E{(bf16_t*)(F.ws + WS_MERGED), D, (const bf16_t*)(F.ws + WS_PROJ) + C_GA, INW};
    pg8::gemm_phase<EpiGate<false>, pg8::DenseSched, true>(F.lds, 1024, Sd, E);
}
__device__ __forceinline__ void ph6_merge(const Ctx& F) {
    pg8::DenseSched Sd; Sd.init(F.ws + WS_YB, D, F.ws + WS_PB, S, D, D, F.G, F.bx);
    EpiGate<true> E{(bf16_t*)(F.ws + WS_MERGED), D, (const bf16_t*)(F.ws + WS_PROJ) + C_GB, INW};
    pg8::gemm_phase<EpiGate<true>, pg8::DenseSched, true>(F.lds, D, Sd, E);
}
__device__ __forceinline__ void p5_mix2_a(const Ctx& F) { p5_mix2(F); __syncthreads(); ph6a_merge(F); }
__device__ __forceinline__ void ph7_wo(const Ctx& F) {
    pg8::DenseSched Sd; Sd.init(F.ws + WS_MERGED, D, F.ws + WS_WO, S, D, D, F.G, F.bx);
    EpiResid E{inp(F, IN_X), F.out, D, (const float*)(F.ws + WS_MODF) + 2 * D};
    pg8::gemm_phase<EpiResid, pg8::DenseSched, true>(F.lds, D, Sd, E);
}
__device__ __forceinline__ void ph10_gateup(const Ctx& F) {
    build_moe_tab(F);
    MoeSched1 S1{(const char*)(F.ws + WS_H), (const char*)(F.ws + WS_E1), (const int*)(F.ws + WS_TOKS), moe_tab(F.lds), F.G, F.vcu};
    EpiGateUp E{(unsigned char*)(F.ws + WS_ACT)};
    pg8::gemm_phase<EpiGateUp, MoeSched1, true, true>(F.lds, D, S1, E);
}
__device__ __forceinline__ void ph11_down(const Ctx& F) {
    build_moe_tab(F);
    MoeSched2 S2{(const char*)(F.ws + WS_ACT), (const char*)(F.ws + WS_E2), moe_tab(F.lds), F.G, F.vcu};
    EpiDown E{(unsigned char*)(F.ws + WS_Y), (const float*)(F.ws + WS_TOKS) + SH_ROW0};
    pg8::gemm_phase<EpiDown, MoeSched2, true, true>(F.lds, ED, S2, E);
}

struct Args { const float* in[22]; float* out; unsigned char* ws; int ph_lo, ph_hi; };
__global__ void __launch_bounds__(512, 2) fwd(Args args) {
    extern __shared__ __attribute__((aligned(16))) unsigned char lds_raw[];
    Ctx F;
    F.lds = (LAS unsigned char*)lds_raw;
    F.tid = threadIdx.x; F.lane = F.tid & 63; F.wave = __builtin_amdgcn_readfirstlane(F.tid >> 6);
    F.G = gridDim.x; F.bx = blockIdx.x; F.vcu = (F.G % 8 == 0) ? (F.bx % 8) * (F.G / 8) + F.bx / 8 : F.bx;
    F.out = args.out; F.ws = args.ws;
    if (F.tid == 0) {
#pragma unroll
        for (int i = 0; i < 22; ++i) ((LAS unsigned long long*)(F.lds + LDS_PTRS))[i] = (unsigned long long)args.in[i];
    }
    volatile LAS unsigned* MISC = (volatile LAS unsigned*)(F.lds + LDS_MISC);
    if (F.tid < 64) MISC[F.tid] = 0u;
    __syncthreads();
    unsigned* ctl = (unsigned*)(F.ws + WS_CTL);
    XcdBarrier bar; bar.bar = ctl + CW_BAR; bar.x = 0; bar.st = nullptr;
    if (!MK_PER_PHASE) bar = xcd_barrier_post(ctl + CW_BAR, MISC + 8);
    const int lo = args.ph_lo, hi = args.ph_hi;
#ifndef PHASE_MASK
#define PHASE_MASK 0x1fff
#endif
#define IN(k) (((PHASE_MASK >> (k)) & 1) && lo <= (k) && (k) < hi)
#define SEAM(k) do { if (IN(k) && IN((k) + 1)) xcd_barrier(bar); } while (0)

#ifndef DUP_MASK
#define DUP_MASK 0
#endif
#define RUN(k, fn) do { if (IN(k)) { fn(F); if ((DUP_MASK >> (k)) & 1) { xcd_barrier(bar); fn(F); } } SEAM(k); } while (0)
    RUN(0, p0_prologue);
    RUN(1, p1_norm1);
    RUN(2, ph2_proj);
    RUN(3, p3_mix1);
    RUN(4, p4_scan_comb);
    RUN(5, p5_mix2_a);
    RUN(6, ph6_merge);
    RUN(7, ph7_wo);
    RUN(8, p8_router);
    RUN(9, p9_dispatch);
    RUN(10, ph10_gateup);
    RUN(11, ph11_down);
    RUN(12, p12_combine);
#undef RUN
#undef IN
#undef SEAM
}

extern "C" void kernel_launch(void* const* d_in, const int* in_sizes, int n_in, void* d_out, int out_size, void* d_ws, size_t ws_size, hipStream_t stream) {
    static int grid = 0;
    if (grid == 0) {
        if (n_in != 22 || out_size != S * D || ws_size < WS_END) { fprintf(stderr, "kernel_launch: unexpected shapes / workspace (n_in %d out %d ws %zu need %zu)\n", n_in, out_size, ws_size, (size_t)WS_END); grid = -1; return; }
        int dev = 0, cus = 0, per_cu = 0;
        if (hipGetDevice(&dev) != hipSuccess || hipDeviceGetAttribute(&cus, hipDeviceAttributeMultiprocessorCount, dev) != hipSuccess) { grid = -1; return; }
        if (hipFuncSetAttribute((const void*)fwd, hipFuncAttributeMaxDynamicSharedMemorySize, LDS_BYTES) != hipSuccess) { fprintf(stderr, "kernel_launch: hipFuncSetAttribute failed\n"); grid = -1; return; }
        if (hipOccupancyMaxActiveBlocksPerMultiprocessor(&per_cu, (const void*)fwd, 512, LDS_BYTES) != hipSuccess || per_cu < 1) fprintf(stderr, "kernel_launch: occupancy query says %d\n", per_cu);
        (void)hipGetLastError();
        grid = cus;
    }
    if (grid < 0) return;
    (void)hipMemsetAsync((char*)d_ws + WS_CTL, 0, CTL_ZERO_BYTES, stream);
    Args a{};
    for (int i = 0; i < 22; ++i) a.in[i] = (const float*)d_in[i];
    a.out = (float*)d_out; a.ws = (unsigned char*)d_ws;
#if MK_PER_PHASE
    for (int p = 0; p < NPH; ++p) { a.ph_lo = p; a.ph_hi = p + 1; hipLaunchKernelGGL(fwd, dim3(grid), dim3(512), LDS_BYTES, stream, a); }
#else
    a.ph_lo = 0; a.ph_hi = NPH; hipLaunchKernelGGL(fwd, dim3(grid), dim3(512), LDS_BYTES, stream, a);
#endif
}
```

```cpp
#include <hip/hip_runtime.h>
#include <cstdio>
#include <cstdint>

#define LAS __attribute__((address_space(3)))
#define GAS __attribute__((address_space(1)))
typedef unsigned short bf16_t;
typedef short bf16x8 __attribute__((ext_vector_type(8)));
typedef short bf16x4 __attribute__((ext_vector_type(4)));
typedef float f32x4 __attribute__((ext_vector_type(4)));
typedef float f32x2 __attribute__((ext_vector_type(2)));
typedef float f32x16 __attribute__((ext_vector_type(16)));
typedef unsigned u32x4 __attribute__((ext_vector_type(4)));
typedef unsigned u32x2 __attribute__((ext_vector_type(2)));
typedef GAS unsigned gu32;

#ifndef DUP2_MASK
#define DUP2_MASK 0
#endif
#ifndef MK_PER_PHASE
#define MK_PER_PHASE 0
#endif

constexpr int S = 8192, D = 2048, INW = 19456;
constexpr int C_QA = 0, C_KA = 3072, C_VA = 6144, C_QR = 9216, C_KR = 10240, C_VR = 11264, C_GR = 13312, C_GA = 15360, C_GB = 17408;
constexpr int NE = 64, ED = 512, TOPK = 8;
constexpr int MAXT_R = 320;
constexpr int SH_ROW0 = MAXT_R * 256;
constexpr int NROWS_Y = SH_ROW0 + S;
constexpr int NPH = 13;

constexpr size_t MiB = 1u << 20;
constexpr size_t WS_CTL = 0, CTL_ZERO_BYTES = 1 * MiB;
constexpr size_t WS_MODP = 1 * MiB;
constexpr size_t WS_MODF = 1 * MiB + 512 * 1024;
constexpr size_t WS_LSE = 2 * MiB;
constexpr size_t WS_ROPE = 3 * MiB;
constexpr size_t WS_EOF = 7 * MiB;
constexpr size_t WS_TOKS = 8 * MiB;
constexpr size_t WS_PA = 10 * MiB, WS_PB = 14 * MiB, WS_WO = 22 * MiB;
constexpr size_t WS_H = 32 * MiB;
constexpr size_t WS_E1 = 64 * MiB;
constexpr size_t WS_H8 = 194 * MiB;
constexpr size_t WS_WIN8 = 210 * MiB;
constexpr size_t WS_E2 = 324 * MiB;
constexpr size_t WS_PREV = 454 * MiB;
constexpr size_t WS_YB = 486 * MiB;
constexpr size_t WS_MERGED = 518 * MiB;
constexpr size_t WS_R1 = 550 * MiB;
constexpr size_t WS_OG = WS_R1, WS_YA = WS_R1 + 48 * MiB, WS_UPD = WS_R1 + 64 * MiB, WS_ACT = WS_R1;
constexpr size_t WS_R2 = 678 * MiB;
constexpr size_t WS_WINT = WS_R2, WS_PROJ = WS_R2 + 76 * MiB, WS_Y = WS_R2;
constexpr size_t WS_END = 1058 * MiB;
constexpr int CW_TMO = 0, CW_CODE = 1, CW_BAR = 4096, CW_CNT = 8192;

constexpr int RING_BYTES = 131072;
constexpr int LDS_TAB = 131072;
constexpr int LDS_MISC = 163840 - 256;
constexpr int LDS_BYTES = 163840;

__device__ __forceinline__ float bf2f(unsigned b) { return __uint_as_float(b << 16); }
__device__ __forceinline__ unsigned cvt_pk_bf16(float lo, float hi) { unsigned r; asm("v_cvt_pk_bf16_f32 %0, %1, %2" : "=v"(r) : "v"(lo), "v"(hi)); return r; }
__device__ __forceinline__ float fsilu(float v) { return v / (1.f + __expf(-v)); }
__device__ __forceinline__ float fsigm(float v) { return 1.f / (1.f + __expf(-v)); }
#define TR_READ(dst, base, OFF) asm volatile("ds_read_b64_tr_b16 %0, %1 offset:%2" : "=&v"(dst) : "v"(base), "i"(OFF) : "memory")
#define TR_WAIT2(a, b) asm volatile("s_waitcnt lgkmcnt(0)" : "+v"(a), "+v"(b) :: "memory")
#define TR_WAIT4(a, b, c, d) asm volatile("s_waitcnt lgkmcnt(0)" : "+v"(a), "+v"(b), "+v"(c), "+v"(d) :: "memory")
typedef int i32x8 __attribute__((ext_vector_type(8)));
__device__ __forceinline__ unsigned cvt4_fp8(float a, float b, float c, float d) {
    a = fminf(fmaxf(a, -448.f), 448.f); b = fminf(fmaxf(b, -448.f), 448.f); c = fminf(fmaxf(c, -448.f), 448.f); d = fminf(fmaxf(d, -448.f), 448.f);
    int r = __builtin_amdgcn_cvt_pk_fp8_f32(a, b, 0, false); r = __builtin_amdgcn_cvt_pk_fp8_f32(c, d, r, true); return (unsigned)r;
}
__device__ __forceinline__ i32x8 ld32(const LAS unsigned char* p) { const u32x4 a = *(const LAS u32x4*)p, b = *(const LAS u32x4*)(p + 1024); i32x8 r; r[0] = (int)a.x; r[1] = (int)a.y; r[2] = (int)a.z; r[3] = (int)a.w; r[4] = (int)b.x; r[5] = (int)b.y; r[6] = (int)b.z; r[7] = (int)b.w; return r; }
__device__ __forceinline__ i32x8 cat8(bf16x8 lo, bf16x8 hi) { const u32x4 a = __builtin_bit_cast(u32x4, lo), b = __builtin_bit_cast(u32x4, hi); i32x8 r; r[0] = (int)a.x; r[1] = (int)a.y; r[2] = (int)a.z; r[3] = (int)a.w; r[4] = (int)b.x; r[5] = (int)b.y; r[6] = (int)b.z; r[7] = (int)b.w; return r; }
constexpr float FP8_WIN = 32.f;
#ifndef PROJ_ALL_FP8
#define PROJ_ALL_FP8 1
#endif
__host__ __device__ __forceinline__ bool proj_tile_fp8(int pn) { return PROJ_ALL_FP8 || (pn >= 24 && pn < 36) || pn >= 44; }
constexpr float FP8_WS1 = 32.f, FP8_WS2 = 16.f, FP8_AS = 4.f, FP8_YS = 32.f;
#define LDS_WAIT() asm volatile("s_waitcnt lgkmcnt(0)" ::: "memory")
#define VM_WAIT() asm volatile("s_waitcnt vmcnt(0)" ::: "memory")

namespace pg8 {
constexpr int BM = 256, BK = 64, HALF = 128, HTB = HALF * BK * 2, STAGE_BYTES = 8 * HTB, NXCD = 8, WGM = 8;
__host__ __device__ __forceinline__ int lds_byte(int r, int c) { const int st = (r >> 4) * 2 + (c >> 5), rr = r & 15, cc = c & 31, ob = rr * 64 + cc * 2; return st * 1024 + (ob ^ (((ob >> 9) & 1) << 5)); }
__host__ __device__ __forceinline__ void stage_rc(int b, int& R, int& C) { const int st = b / 1024, sb = b % 1024, swz = sb ^ (((sb >> 9) & 1) << 5); R = (st >> 1) * 16 + swz / 64; C = (st & 1) * 32 + (swz % 64) / 2; }
__host__ __device__ __forceinline__ int perm32(int rho) { const int n = rho >> 4, i = rho & 15; return 8 * (i >> 2) + 4 * n + (i & 3); }

struct Unit { int row0, pn, e, nvalid; };

struct DenseSched {
    static constexpr bool RAGGED = false;
    const char* A; const char* Bt; int lda, K; int nM, nN, nwg, G, c, i_lo, i_hi;
    __device__ __forceinline__ void init(const void* A_, int lda_, const void* Bt_, int M, int N, int K_, int G_, int c_) { A = (const char*)A_; Bt = (const char*)Bt_; lda = lda_; K = K_; nM = M / BM; nN = N / BM; nwg = nM * nN; G = G_; c = c_; i_lo = 0; i_hi = 0x7fffffff; }
    __device__ __forceinline__ bool next(int i, Unit& u) const {
        if (i_lo + i >= i_hi) return false;
        const long L = (long)(i_lo + i) * G + c; if (L >= nwg) return false;
        int wgid = (int)L; { const int q = nwg / NXCD, r = nwg % NXCD, xcd = wgid % NXCD, off = wgid / NXCD; wgid = (xcd < r ? xcd * (q + 1) : r * (q + 1) + (xcd - r) * q) + off; }
        const int nig = WGM * nN, gid = wgid / nig, fm = gid * WGM, gsz = (nM - fm) < WGM ? (nM - fm) : WGM;
        u.row0 = (fm + ((wgid % nig) % gsz)) * BM; u.pn = (wgid % nig) / gsz; u.e = 0; u.nvalid = 256; return true;
    }
    __device__ __forceinline__ const char* a_base() const { return A; }
    __device__ __forceinline__ const char* b_ptr(const Unit& u) const { return Bt + (size_t)u.pn * BM * K * 2; }
    __device__ __forceinline__ void a_off(const Unit& u, int tid, unsigned (&off)[2][2]) const {
#pragma unroll
        for (int i = 0; i < 2; ++i) { int R, C; stage_rc(tid * 16 + i * 8192, R, C);
            off[0][i] = (unsigned)((u.row0 + R) * lda + C) * 2u; off[1][i] = (unsigned)((u.row0 + HALF + R) * lda + C) * 2u; }
    }
};


template <bool FP8SET> struct ProjSched {
    static constexpr bool RAGGED = false;
    static constexpr int ntl = PROJ_ALL_FP8 ? (FP8SET ? 76 : 0) : (FP8SET ? 44 : 32), nM = 32, nwg = nM * ntl;
    const char* A; const char* Bt; int apitch, bpitch; int G, c, i_lo, i_hi;
    __device__ __forceinline__ void init(const void* A_, int apitch_, const void* Bt_, int bpitch_, int G_, int c_) { A = (const char*)A_; Bt = (const char*)Bt_; apitch = apitch_; bpitch = bpitch_; G = G_; c = c_; i_lo = 0; i_hi = 0x7fffffff; }
    __device__ __forceinline__ int count() const { return c < nwg ? (nwg - c + G - 1) / G : 0; }
    __device__ __forceinline__ bool next(int i, Unit& u) const {
        if (i_lo + i >= i_hi) return false;
        const long L = (long)(i_lo + i) * G + c; if (L >= nwg) return false;
        int wgid = (int)L; { const int q = nwg / NXCD, r = nwg % NXCD, xcd = wgid % NXCD, off = wgid / NXCD; wgid = (xcd < r ? xcd * (q + 1) : r * (q + 1) + (xcd - r) * q) + off; }
        const int nig = WGM * ntl, gid = wgid / nig, fm = gid * WGM, gsz = (nM - fm) < WGM ? (nM - fm) : WGM;
        u.row0 = (fm + ((wgid % nig) % gsz)) * BM; const int t = (wgid % nig) / gsz;
        u.pn = PROJ_ALL_FP8 ? t : (FP8SET ? (t < 12 ? 24 + t : 32 + t) : (t < 24 ? t : t + 12)); u.e = 0; u.nvalid = 256; return true;
    }
    __device__ __forceinline__ const char* a_base() const { return A; }
    __device__ __forceinline__ const char* b_ptr(const Unit& u) const { return Bt + (size_t)u.pn * BM * bpitch; }
    __device__ __forceinline__ void a_off(const Unit& u, int tid, unsigned (&off)[2][2]) const {
#pragma unroll
        for (int i = 0; i < 2; ++i) { int R, C; stage_rc(tid * 16 + i * 8192, R, C);
            off[0][i] = (unsigned)((u.row0 + R) * apitch + 2 * C); off[1][i] = (unsigned)((u.row0 + HALF + R) * apitch + 2 * C); }
    }
};

template <class Epi, class Sched, bool ALIGN_EPI, bool FP8 = false>
__device__ __forceinline__ void gemm_phase(LAS unsigned char* lds, const int K, const Sched& S, const Epi& E) {
    const int tid = threadIdx.x, wid = __builtin_amdgcn_readfirstlane(tid >> 6), lane = tid & 63, wr = wid >> 2, wc = wid & 3, fr = lane & 15, fq = lane >> 4;
    const int nt = FP8 ? K / 128 : K / BK;
    const int pitch = FP8 ? K : 2 * K;
    unsigned voffB[2];
#pragma unroll
    for (int i = 0; i < 2; ++i) { int R, C; stage_rc(tid * 16 + i * 8192, R, C); const int Rb = Epi::PERM ? ((R & ~31) + perm32(R & 31)) : R; voffB[i] = (unsigned)(Rb * pitch + 2 * C); }
    const size_t kstep = (size_t)(BK * 2);
    const size_t hstepB = (size_t)HALF * pitch;
    const unsigned ldsw = (unsigned)wid * 1024u;
    const int aoff = lds_byte(wr * 64 + fr, fq * 8), boff = lds_byte(wc * 32 + fr, fq * 8);
#define PG8_SA(b, h) (((b) * 2 + (h)) * HTB)
#define PG8_SB(b, h) ((4 + (b) * 2 + (h)) * HTB)
#define PG8_STAGE(bufoff, gbase, voff) do { _Pragma("unroll") for (int _i = 0; _i < 2; ++_i) \
        __builtin_amdgcn_global_load_lds((const unsigned*)((const char*)(gbase) + (voff)[_i]), (LAS unsigned*)(lds + (bufoff) + ldsw + _i * 8192), 16, 0, 0); } while (0)
#define PG8_LDA(dst, b, h) do { if constexpr (FP8) { _Pragma("unroll") for (int m = 0; m < 4; ++m) dst##8[m] = ld32(lds + PG8_SA(b, h) + aoff + m * 2048); } \
        else { _Pragma("unroll") for (int m = 0; m < 4; ++m) _Pragma("unroll") for (int k = 0; k < 2; ++k) dst[m][k] = *(const LAS bf16x8*)(lds + PG8_SA(b, h) + aoff + m * 2048 + k * 1024); } } while (0)
#define PG8_LDB(dst, b, h) do { if constexpr (FP8) { _Pragma("unroll") for (int n = 0; n < 2; ++n) dst##8[n] = ld32(lds + PG8_SB(b, h) + boff + n * 2048); } \
        else { _Pragma("unroll") for (int n = 0; n < 2; ++n) _Pragma("unroll") for (int k = 0; k < 2; ++k) dst[n][k] = *(const LAS bf16x8*)(lds + PG8_SB(b, h) + boff + n * 2048 + k * 1024); } } while (0)
#define PG8_MMA(ai, bj, At, Bt) do { __builtin_amdgcn_s_setprio(1); if constexpr (FP8) { _Pragma("unroll") for (int m = 0; m < 4; ++m) _Pragma("unroll") for (int n = 0; n < 2; ++n) \
        asm volatile("v_mfma_scale_f32_16x16x128_f8f6f4 %0, %1, %2, %0, %3, %3 op_sel_hi:[0,0,0]" : "+v"(acc[ai][bj][m][n]) : "v"(Bt##8[n]), "v"(At##8[m]), "v"(fp8_one)); } \
      else { _Pragma("unroll") for (int m = 0; m < 4; ++m) _Pragma("unroll") for (int n = 0; n < 2; ++n) _Pragma("unroll") for (int k = 0; k < 2; ++k) \
        acc[ai][bj][m][n] = __builtin_amdgcn_mfma_f32_16x16x32_bf16(Bt[n][k], At[m][k], acc[ai][bj][m][n], 0, 0, 0); } __builtin_amdgcn_s_setprio(0); } while (0)
#define PG8_WAIT_V(n) asm volatile("s_waitcnt vmcnt(" #n ")" ::: "memory")
#define PG8_WAIT_L(n) asm volatile("s_waitcnt lgkmcnt(" #n ")" ::: "memory")
#define PG8_BAR __builtin_amdgcn_s_barrier()
#define PG8_SCHED __builtin_amdgcn_sched_barrier(0)
    Unit cur, nxt; int ui = 0;
    if (!S.next(0, cur)) return;
    f32x4 acc[2][2][4][2];
#pragma unroll
    for (int a = 0; a < 2; ++a)
#pragma unroll
        for (int b = 0; b < 2; ++b)
#pragma unroll
            for (int m = 0; m < 4; ++m)
#pragma unroll
                for (int n = 0; n < 2; ++n) acc[a][b][m][n] = (f32x4){0.f, 0.f, 0.f, 0.f};
    bf16x8 At[4][2], B0[2][2], B1[2][2];
    i32x8 At8[4], B08[2], B18[2];
    const int fp8_one = 0x7f7f7f7f;
    unsigned coff[2][2], noff[2][2];
    S.a_off(cur, tid, coff);
    const char* const Ab = S.a_base();
    const char* cB = S.b_ptr(cur);
    PG8_STAGE(PG8_SB(0, 0), cB, voffB); PG8_STAGE(PG8_SB(0, 1), cB + hstepB, voffB); PG8_STAGE(PG8_SA(0, 0), Ab, coff[0]); PG8_STAGE(PG8_SA(0, 1), Ab, coff[1]);
    if (wr == 1) PG8_BAR;
    PG8_WAIT_V(2); PG8_BAR;
    PG8_STAGE(PG8_SB(1, 0), cB + kstep, voffB); PG8_STAGE(PG8_SA(1, 0), Ab + kstep, coff[0]); PG8_STAGE(PG8_SB(1, 1), cB + hstepB + kstep, voffB);
    PG8_WAIT_V(6); PG8_BAR;
    for (;;) {
        const bool has_next = S.next(ui + 1, nxt);
        const char* nB = has_next ? S.b_ptr(nxt) : cB;
        for (int t = 0; t < nt; t += 2) {
            const bool last = (t == nt - 2);
            const char* a1 = Ab + (size_t)(t + 1) * kstep;
            const char* a2 = last ? Ab : Ab + (size_t)(t + 2) * kstep; const char* b2 = last ? nB : cB + (size_t)(t + 2) * kstep;
            const char* a3 = a2 + kstep; const char* b3 = b2 + kstep;
            if (last && has_next) S.a_off(nxt, tid, noff);
            PG8_LDB(B0, 0, 0); PG8_LDB(B1, 0, 1); PG8_SCHED; PG8_LDA(At, 0, 0); PG8_STAGE(PG8_SA(1, 1), a1, coff[1]);
            PG8_WAIT_V(8); PG8_WAIT_L(0); PG8_BAR; PG8_MMA(0, 0, At, B0); PG8_MMA(0, 1, At, B1); PG8_BAR; PG8_SCHED;
            if (last && has_next) { coff[0][0] = noff[0][0]; coff[0][1] = noff[0][1]; coff[1][0] = noff[1][0]; coff[1][1] = noff[1][1]; }
            PG8_LDA(At, 0, 1); PG8_STAGE(PG8_SB(0, 0), b2, voffB); PG8_STAGE(PG8_SB(0, 1), b2 + hstepB, voffB); PG8_STAGE(PG8_SA(0, 0), a2, coff[0]);
            PG8_WAIT_V(8); PG8_WAIT_L(0); PG8_BAR; if (!Sched::RAGGED || cur.nvalid > HALF) { PG8_MMA(1, 0, At, B0); PG8_MMA(1, 1, At, B1); } PG8_BAR; PG8_SCHED;
            PG8_LDB(B0, 1, 0); PG8_LDB(B1, 1, 1); PG8_SCHED; PG8_LDA(At, 1, 0); PG8_STAGE(PG8_SA(0, 1), a2, coff[1]);
            PG8_WAIT_V(8); PG8_WAIT_L(0); PG8_BAR; PG8_MMA(0, 0, At, B0); PG8_MMA(0, 1, At, B1); PG8_BAR; PG8_SCHED;
            PG8_LDA(At, 1, 1); PG8_STAGE(PG8_SB(1, 0), b3, voffB); PG8_STAGE(PG8_SB(1, 1), b3 + hstepB, voffB); PG8_STAGE(PG8_SA(1, 0), a3, coff[0]);
            PG8_WAIT_V(8); PG8_WAIT_L(0); PG8_BAR; if (!Sched::RAGGED || cur.nvalid > HALF) { PG8_MMA(1, 0, At, B0); PG8_MMA(1, 1, At, B1); } PG8_BAR; PG8_SCHED;
        }
        if constexpr (ALIGN_EPI) { if (wr == 0) PG8_BAR; }
        if constexpr (FP8) asm volatile("s_nop 15\n\ts_nop 15\n\ts_nop 15" ::: "memory");
        E(acc, cur, wr, wc, fr, fq);
        if (!has_next) break;
#pragma unroll
        for (int a = 0; a < 2; ++a)
#pragma unroll
            for (int b = 0; b < 2; ++b)
#pragma unroll
                for (int m = 0; m < 4; ++m)
#pragma unroll
                    for (int n = 0; n < 2; ++n) acc[a][b][m][n] = (f32x4){0.f, 0.f, 0.f, 0.f};
        cur = nxt; cB = nB; ++ui;
        if constexpr (ALIGN_EPI) { if (wr == 1) PG8_BAR; }
    }
    PG8_WAIT_V(0);
    if constexpr (!ALIGN_EPI) { if (wr == 0) PG8_BAR; }
    PG8_BAR;
#undef PG8_SA
#undef PG8_SB
#undef PG8_STAGE
#undef PG8_LDA
#undef PG8_LDB
#undef PG8_MMA
#undef PG8_WAIT_V
#undef PG8_WAIT_L
#undef PG8_BAR
#undef PG8_SCHED
}
}
using pg8::Unit;

struct EpiBf16 {
    static constexpr bool PERM = true;
    bf16_t* O; int ldc; int nostore; float scale;
    __device__ __forceinline__ void operator()(const f32x4 (&acc)[2][2][4][2], const Unit& u, int wr, int wc, int fr, int fq) const {
        const int row0 = u.row0 + wr * 64 + fr, col0 = u.pn * 256 + wc * 32 + 8 * fq;
#pragma unroll
        for (int ai = 0; ai < 2; ++ai)
#pragma unroll
            for (int m = 0; m < 4; ++m) { bf16_t* rowp = O + (size_t)(row0 + ai * 128 + m * 16) * ldc + col0;
#pragma unroll
                for (int bj = 0; bj < 2; ++bj) { const f32x4 v0 = acc[ai][bj][m][0] * scale, v1 = acc[ai][bj][m][1] * scale;
                    u32x4 w; w.x = cvt_pk_bf16(v0[0], v0[1]); w.y = cvt_pk_bf16(v0[2], v0[3]); w.z = cvt_pk_bf16(v1[0], v1[1]); w.w = cvt_pk_bf16(v1[2], v1[3]);
                    if (!nostore) *(u32x4*)(rowp + bj * 128) = w; else asm volatile("" :: "v"(w)); } }
    }
};
template <bool ADD> struct EpiGate {
    static constexpr bool PERM = true;
    bf16_t* O; int ldc; const bf16_t* gate; int ldg;
    __device__ __forceinline__ void operator()(const f32x4 (&acc)[2][2][4][2], const Unit& u, int wr, int wc, int fr, int fq) const {
        const int row0 = u.row0 + wr * 64 + fr, col0 = u.pn * 256 + wc * 32 + 8 * fq;
#pragma unroll
        for (int ai = 0; ai < 2; ++ai)
#pragma unroll
            for (int m = 0; m < 4; ++m) { const size_t r = (size_t)(row0 + ai * 128 + m * 16); bf16_t* rowp = O + r * ldc + col0; const bf16_t* gp = gate + r * ldg + col0;
#pragma unroll
                for (int bj = 0; bj < 2; ++bj) { const f32x4 v0 = acc[ai][bj][m][0], v1 = acc[ai][bj][m][1];
                    const u32x4 g = *(const u32x4*)(gp + bj * 128);
                    float o[8];
                    o[0] = fsigm(bf2f(g.x & 0xffffu)) * v0[0]; o[1] = fsigm(bf2f(g.x >> 16)) * v0[1]; o[2] = fsigm(bf2f(g.y & 0xffffu)) * v0[2]; o[3] = fsigm(bf2f(g.y >> 16)) * v0[3];
                    o[4] = fsigm(bf2f(g.z & 0xffffu)) * v1[0]; o[5] = fsigm(bf2f(g.z >> 16)) * v1[1]; o[6] = fsigm(bf2f(g.w & 0xffffu)) * v1[2]; o[7] = fsigm(bf2f(g.w >> 16)) * v1[3];
                    if (ADD) { const u32x4 p = *(const u32x4*)(rowp + bj * 128);
                        o[0] += bf2f(p.x & 0xffffu); o[1] += bf2f(p.x >> 16); o[2] += bf2f(p.y & 0xffffu); o[3] += bf2f(p.y >> 16);
                        o[4] += bf2f(p.z & 0xffffu); o[5] += bf2f(p.z >> 16); o[6] += bf2f(p.w & 0xffffu); o[7] += bf2f(p.w >> 16); }
                    u32x4 w; w.x = cvt_pk_bf16(o[0], o[1]); w.y = cvt_pk_bf16(o[2], o[3]); w.z = cvt_pk_bf16(o[4], o[5]); w.w = cvt_pk_bf16(o[6], o[7]);
                    *(u32x4*)(rowp + bj * 128) = w; } }
    }
};
struct EpiResid {
    static constexpr bool PERM = false;
    const float* base; float* out; int ldc; const float* gvec;
    __device__ __forceinline__ void operator()(const f32x4 (&acc)[2][2][4][2], const Unit& u, int wr, int wc, int fr, int fq) const {
        const int row0 = u.row0 + wr * 64 + fr, col0 = u.pn * 256 + wc * 32 + 4 * fq;
        f32x4 gv[2][2];
#pragma unroll
        for (int bj = 0; bj < 2; ++bj)
#pragma unroll
            for (int n = 0; n < 2; ++n) gv[bj][n] = *(const f32x4*)(gvec + col0 + bj * 128 + n * 16);
#pragma unroll
        for (int ai = 0; ai < 2; ++ai)
#pragma unroll
            for (int m = 0; m < 4; ++m) { const size_t off = (size_t)(row0 + ai * 128 + m * 16) * ldc + col0;
#pragma unroll
                for (int bj = 0; bj < 2; ++bj)
#pragma unroll
                    for (int n = 0; n < 2; ++n) { const f32x4 bs = *(const f32x4*)(base + off + bj * 128 + n * 16); *(f32x4*)(out + off + bj * 128 + n * 16) = bs + gv[bj][n] * acc[ai][bj][m][n]; } }
    }
};
struct EpiGateUp {
    static constexpr bool PERM = true;
    unsigned char* ACT;
    __device__ __forceinline__ void operator()(const f32x4 (&acc)[2][2][4][2], const Unit& u, int wr, int wc, int fr, int fq) const {
        const int row0 = u.row0 + wr * 64 + fr, col0 = u.pn * 128 + wc * 32 + 8 * fq;
        constexpr float ws = 1.0f / FP8_WS1;
#pragma unroll
        for (int ai = 0; ai < 2; ++ai)
#pragma unroll
            for (int m = 0; m < 4; ++m) { unsigned char* rowp = ACT + (size_t)(row0 + ai * 128 + m * 16) * ED + col0;
                const f32x4 g0 = acc[ai][0][m][0] * ws, g1 = acc[ai][0][m][1] * ws, u0 = acc[ai][1][m][0] * (ws * FP8_AS), u1 = acc[ai][1][m][1] * (ws * FP8_AS);
                u32x2 w; w.x = cvt4_fp8(fsilu(g0[0]) * u0[0], fsilu(g0[1]) * u0[1], fsilu(g0[2]) * u0[2], fsilu(g0[3]) * u0[3]);
                w.y = cvt4_fp8(fsilu(g1[0]) * u1[0], fsilu(g1[1]) * u1[1], fsilu(g1[2]) * u1[2], fsilu(g1[3]) * u1[3]);
                *(u32x2*)rowp = w; }
    }
};
struct EpiDown {
    static constexpr bool PERM = true;
    unsigned char* Y; const float* wsorted;
    __device__ __forceinline__ void operator()(const f32x4 (&acc)[2][2][4][2], const Unit& u, int wr, int wc, int fr, int fq) const {
        const int rl0 = wr * 64 + fr, col0 = u.pn * 256 + wc * 32 + 8 * fq;
#pragma unroll
        for (int ai = 0; ai < 2; ++ai)
#pragma unroll
            for (int m = 0; m < 4; ++m) { const int rl = rl0 + ai * 128 + m * 16; const int row = u.row0 + rl;
                float wv = 1.f; if (u.e < NE) wv = (rl < u.nvalid) ? wsorted[row] : 0.f;
                wv *= FP8_YS / (FP8_WS2 * FP8_AS);
                unsigned char* rowp = Y + (size_t)row * D + col0;
#pragma unroll
                for (int bj = 0; bj < 2; ++bj) { const f32x4 v0 = acc[ai][bj][m][0] * wv, v1 = acc[ai][bj][m][1] * wv;
                    u32x2 w; w.x = cvt4_fp8(v0[0], v0[1], v0[2], v0[3]); w.y = cvt4_fp8(v1[0], v1[1], v1[2], v1[3]);
                    *(u32x2*)(rowp + bj * 128) = w; } }
    }
};

struct MoeTab { LAS int* te; LAS int* tn; LAS int* misc; };
__device__ __forceinline__ MoeTab moe_tab(LAS unsigned char* lds) { MoeTab t; t.te = (LAS int*)(lds + LDS_TAB); t.tn = t.te + 352; t.misc = t.tn + 352; return t; }
struct MoeSched1 {
    static constexpr bool RAGGED = true;
    const char* H2; const char* E1; const int* toks; MoeTab tab; int G, vcu;
    __device__ __forceinline__ bool next(int i, Unit& u) const {
        const int ntr = tab.misc[0]; const int L = i * G + vcu; if (L >= 4 * (ntr + 32)) return false;
        const int t = L >> 2; u.pn = L & 3;
        if (t < ntr) { u.row0 = t * 256; u.e = tab.te[t]; u.nvalid = tab.tn[t]; } else { u.row0 = SH_ROW0 + (t - ntr) * 256; u.e = NE; u.nvalid = 256; }
        return true;
    }
    __device__ __forceinline__ const char* a_base() const { return H2; }
    __device__ __forceinline__ const char* b_ptr(const Unit& u) const { return E1 + ((size_t)u.e * 1024 + (size_t)u.pn * 256) * D; }
    __device__ __forceinline__ void a_off(const Unit& u, int tid, unsigned (&off)[2][2]) const {
#pragma unroll
        for (int i = 0; i < 2; ++i) { int R, C; pg8::stage_rc(tid * 16 + i * 8192, R, C);
#pragma unroll
            for (int h = 0; h < 2; ++h) { const int r = h * 128 + R; int tok;
                if (u.e < NE) tok = (r < u.nvalid) ? toks[u.row0 + r] : 0; else tok = u.row0 - SH_ROW0 + r;
                off[h][i] = (unsigned)(tok * D + 2 * C); } }
    }
};
struct MoeSched2 {
    static constexpr bool RAGGED = true;
    const char* ACT; const char* E2; MoeTab tab; int G, vcu;
    __device__ __forceinline__ bool next(int i, Unit& u) const {
        const int ntr = tab.misc[0]; const int L = i * G + vcu; if (L >= 8 * (ntr + 32)) return false;
        const int t = L >> 3; u.pn = L & 7;
        if (t < ntr) { u.row0 = t * 256; u.e = tab.te[t]; u.nvalid = tab.tn[t]; } else { u.row0 = SH_ROW0 + (t - ntr) * 256; u.e = NE; u.nvalid = 256; }
        return true;
    }
    __device__ __forceinline__ const char* a_base() const { return ACT; }
    __device__ __forceinline__ const char* b_ptr(const Unit& u) const { return E2 + ((size_t)u.e * 2048 + (size_t)u.pn * 256) * ED; }
    __device__ __forceinline__ void a_off(const Unit& u, int tid, unsigned (&off)[2][2]) const {
#pragma unroll
        for (int i = 0; i < 2; ++i) { int R, C; pg8::stage_rc(tid * 16 + i * 8192, R, C);
            off[0][i] = (unsigned)((u.row0 + R) * ED + 2 * C); off[1][i] = (unsigned)((u.row0 + 128 + R) * ED + 2 * C); }
    }
};

#define XB_TMO      128
#define XB_XCNT(j)  (256  + 64 * (j))
#define XB_XSUB(j)  (1280 + 64 * (j))
#define XB_XGEN(j)  (2304 + 64 * (j))
#define XB_TOP      3328
#define XB_TOPGEN   3392
#define XCD_BAR_WORDS 3456
#define XB_SPIN_CAP (1u << 18)
__device__ __forceinline__ unsigned xb_ld(unsigned* p)              { return __hip_atomic_load(p, __ATOMIC_RELAXED, __HIP_MEMORY_SCOPE_AGENT); }
__device__ __forceinline__ unsigned xb_add(unsigned* p, unsigned v) { return __hip_atomic_fetch_add(p, v, __ATOMIC_RELAXED, __HIP_MEMORY_SCOPE_AGENT); }
__device__ __forceinline__ unsigned xb_xcc_id() { return (unsigned)__builtin_amdgcn_s_getreg((3 << 11) | 20) & 0xFu; }
#define XB_SPIN(cond, bar) do { unsigned _sp = 0; while (cond) { __builtin_amdgcn_s_sleep(1); \
    if ((++_sp & 255u) == 0u) { if (xb_ld(&(bar)[XB_TMO])) break; if (_sp > XB_SPIN_CAP) { atomicAdd(&(bar)[XB_TMO], 1u); break; } } } } while (0)
struct XcdBarrier { unsigned* bar; unsigned x; volatile LAS unsigned* st; };
__device__ __forceinline__ XcdBarrier xcd_barrier_post(unsigned* bar, volatile LAS unsigned* st) {
    XcdBarrier b; b.bar = bar; b.x = xb_xcc_id(); b.st = st;
    if (threadIdx.x == 0) (void)xb_add(&bar[XB_XCNT(b.x)], 1u);
    return b;
}
__device__ __forceinline__ void xcd_barrier_complete(unsigned* bar, unsigned x, unsigned& nloc, unsigned& nx) {
    const unsigned G = gridDim.x * gridDim.y * gridDim.z;
    unsigned sum, cnt, mine, sp = 0u;
    for (;;) {
        sum = 0u; cnt = 0u; mine = 0u;
#pragma unroll
        for (unsigned j = 0; j < 16; ++j) { const unsigned c = xb_ld(&bar[XB_XCNT(j)]); sum += c; cnt += (c > 0u) ? 1u : 0u; mine = (j == x) ? c : mine; }
        if (sum == G) break;
        __builtin_amdgcn_s_sleep(1);
        if ((++sp & 255u) == 0u) { if (xb_ld(&bar[XB_TMO])) break; if (sp > XB_SPIN_CAP) { atomicAdd(&bar[XB_TMO], 1u); break; } }
    }
    nloc = mine > 0u ? mine : 1u; nx = cnt > 0u ? cnt : 1u;
}
__device__ __forceinline__ void xcd_barrier(const XcdBarrier& b) {
    asm volatile("s_waitcnt vmcnt(0)" ::: "memory");
    __syncthreads();
    if (threadIdx.x == 0) {
        unsigned* bar = b.bar;
        __builtin_amdgcn_s_waitcnt(0);
        unsigned nloc = b.st[0], nx = b.st[1];
        if (nloc == 0u) { xcd_barrier_complete(bar, b.x, nloc, nx); b.st[0] = nloc; b.st[1] = nx; }
        const unsigned old = xb_add(&bar[XB_XSUB(b.x)], 1u);
        const unsigned gen = old / nloc;
        if (old + 1u == (gen + 1u) * nloc) {
            __builtin_amdgcn_fence(__ATOMIC_RELEASE, "agent");
            asm volatile("s_waitcnt vmcnt(0)" ::: "memory");
            const unsigned og = xb_add(&bar[XB_TOP], 1u);
            const unsigned tg = og / nx;
            if (og + 1u == (tg + 1u) * nx) xb_add(&bar[XB_TOPGEN], 1u);
            else XB_SPIN(xb_ld(&bar[XB_TOPGEN]) == tg, bar);
            __builtin_amdgcn_fence(__ATOMIC_ACQUIRE, "agent");
            xb_add(&bar[XB_XGEN(b.x)], 1u);
            asm volatile("s_waitcnt vmcnt(0)" ::: "memory");
        } else {
            XB_SPIN(xb_ld(&bar[XB_XGEN(b.x)]) == gen, bar);
            __builtin_amdgcn_fence(__ATOMIC_ACQUIRE, "agent");
            asm volatile("s_waitcnt vmcnt(0)" ::: "memory");
        }
    }
    __syncthreads();
}

struct Ctx {
    LAS unsigned char* lds;
    int tid, lane, wave, G, vcu, bx;
    float* out; unsigned char* ws;
};
constexpr int LDS_PTRS = 163840 - 512;
__device__ __forceinline__ const float* inp(const Ctx& F, int i) {
    const LAS unsigned* p = (const LAS unsigned*)(F.lds + LDS_PTRS) + 2 * i;
    const unsigned lo = __builtin_amdgcn_readfirstlane(p[0]), hi = __builtin_amdgcn_readfirstlane(p[1]);
    return (const float*)(const GAS float*)(((unsigned long long)hi << 32) | lo);
}
#define IN_X 0
#define IN_C 1
#define IN_RELB 2
#define IN_WADA 3
#define IN_BADA 4
#define IN_LN1 5
#define IN_WIN 6
#define IN_QNG 7
#define IN_KNG 8
#define IN_GNG 9
#define IN_PA 10
#define IN_PB 11
#define IN_WO 12
#define IN_LN2 13
#define IN_RW 14
#define IN_RB 15
#define IN_WG 16
#define IN_WU 17
#define IN_WD 18
#define IN_WGS 19
#define IN_WUS 20
#define IN_WDS 21

struct CvItem { const float* src; unsigned char* dst; int ldw, ldt; float scale; };
constexpr int CV_WIN = 32 * 304, CV_PA = 16 * 32, CV_PB = 32 * 32, CV_WO = 32 * 32, CV_EX = 768;
constexpr int CV_DENSE = CV_WIN + CV_PA + CV_PB + CV_WO, CV_ALL = CV_DENSE + 65 * CV_EX;
#ifndef CV_BG_FROM
#define CV_BG_FROM CV_DENSE
#endif
__device__ __forceinline__ void cv_kn(int q, int nbg_count, int& kb, int& nb) {
    const int super = q >> 3, sub = q & 7; kb = (super / nbg_count) * 4 + (sub >> 1); nb = (super % nbg_count) * 2 + (sub & 1);
}
__device__ __forceinline__ CvItem cv_decode(const Ctx& F, int it) {
    CvItem c; int r = it; int kb, nb; c.scale = 0.f;
    if (r < CV_WIN) { cv_kn(r, 152, kb, nb); c.ldw = INW; c.src = inp(F, IN_WIN) + (size_t)(64 * kb) * INW + 64 * nb;
        if (proj_tile_fp8(nb >> 2)) { c.ldt = D; c.scale = FP8_WIN; c.dst = F.ws + WS_WIN8 + (size_t)(64 * nb) * D + 64 * kb; }
        else { c.ldt = D * 2; c.dst = F.ws + WS_WINT + ((size_t)(64 * nb) * D + 64 * kb) * 2; }
        return c; } r -= CV_WIN;
    if (r < CV_PA) { cv_kn(r, 16, kb, nb); c.ldw = D; c.ldt = 1024 * 2; c.src = inp(F, IN_PA) + (size_t)(64 * kb) * D + 64 * nb; c.dst = F.ws + WS_PA + ((size_t)(64 * nb) * 1024 + 64 * kb) * 2; return c; } r -= CV_PA;
    if (r < CV_PB) { cv_kn(r, 16, kb, nb); c.ldw = D; c.ldt = D * 2; c.src = inp(F, IN_PB) + (size_t)(64 * kb) * D + 64 * nb; c.dst = F.ws + WS_PB + ((size_t)(64 * nb) * D + 64 * kb) * 2; return c; } r -= CV_PB;
    if (r < CV_WO) { cv_kn(r, 16, kb, nb); c.ldw = D; c.ldt = D * 2; c.src = inp(F, IN_WO) + (size_t)(64 * kb) * D + 64 * nb; c.dst = F.ws + WS_WO + ((size_t)(64 * nb) * D + 64 * kb) * 2; return c; } r -= CV_WO;
    const int e = r / CV_EX; int q = r % CV_EX;
    if (q < 512) {
        const int isup = q >> 8; q &= 255; cv_kn(q, 4, kb, nb); const int n0 = 64 * nb;
        const float* w = (e < NE) ? inp(F, isup ? IN_WU : IN_WG) + (size_t)e * D * ED : inp(F, isup ? IN_WUS : IN_WGS);
        c.ldw = ED; c.ldt = D; c.scale = FP8_WS1; c.src = w + (size_t)(64 * kb) * ED + n0;
        c.dst = F.ws + WS_E1 + ((size_t)e * 1024 + (size_t)((n0 >> 7) * 256 + (n0 & 127) + isup * 128)) * D + 64 * kb;
    } else {
        q -= 512; cv_kn(q, 16, kb, nb);
        const float* w = (e < NE) ? inp(F, IN_WD) + (size_t)e * ED * D : inp(F, IN_WDS);
        c.ldw = D; c.ldt = ED; c.scale = FP8_WS2; c.src = w + (size_t)(64 * kb) * D + 64 * nb;
        c.dst = F.ws + WS_E2 + ((size_t)e * D + (size_t)(64 * nb)) * ED + 64 * kb;
    }
    return c;
}
__device__ __forceinline__ void cv_load(const CvItem& c, int lane, f32x4 (&v)[16]) {
    const int r4 = lane >> 4, c16 = lane & 15;
#pragma unroll
    for (int i = 0; i < 16; ++i) v[i] = *(const f32x4*)(c.src + (size_t)(4 * i + r4) * c.ldw + 4 * c16);
}
__device__ __forceinline__ void cv_store(const CvItem& c, int lane, const f32x4 (&v)[16], LAS float* scr) {
    const int r4 = lane >> 4, c16 = lane & 15;
#pragma unroll
    for (int i = 0; i < 16; ++i) { LAS float* d = scr + (4 * i + r4) * 65 + 4 * c16; d[0] = v[i].x; d[1] = v[i].y; d[2] = v[i].z; d[3] = v[i].w; }
    LDS_WAIT(); asm volatile("" ::: "memory");
    const int cc = lane & 7;
    if (c.scale == 0.f) {
#pragma unroll
        for (int j = 0; j < 8; ++j) { const int n = (lane >> 3) + 8 * j; const LAS float* s = scr + (8 * cc) * 65 + n;
            u32x4 o; o.x = cvt_pk_bf16(s[0 * 65], s[1 * 65]); o.y = cvt_pk_bf16(s[2 * 65], s[3 * 65]); o.z = cvt_pk_bf16(s[4 * 65], s[5 * 65]); o.w = cvt_pk_bf16(s[6 * 65], s[7 * 65]);
            *(GAS u32x4*)(c.dst + (size_t)n * c.ldt + 16 * cc) = o; }
    } else { const float sc = c.scale;
#pragma unroll
        for (int j = 0; j < 8; ++j) { const int n = (lane >> 3) + 8 * j; const LAS float* s = scr + (8 * cc) * 65 + n;
            u32x2 o; o.x = cvt4_fp8(s[0 * 65] * sc, s[1 * 65] * sc, s[2 * 65] * sc, s[3 * 65] * sc); o.y = cvt4_fp8(s[4 * 65] * sc, s[5 * 65] * sc, s[6 * 65] * sc, s[7 * 65] * sc);
            *(GAS u32x2*)(c.dst + (size_t)n * c.ldt + 8 * cc) = o; }
    }
    LDS_WAIT(); asm volatile("" ::: "memory");
}
__device__ __forceinline__ void convert_items(const Ctx& F, int lo, int hi, int gw, int NGW) {
    LAS float* scr = (LAS float*)(F.lds + 16384 + F.wave * 16640);
    int it = lo + gw;
    if (it >= hi) return;
    f32x4 va[16], vb[16];
    CvItem ca = cv_decode(F, it), cb = ca;
    cv_load(ca, F.lane, va);
    for (;;) {
        int nx = it + NGW; const bool hb = nx < hi;
        if (hb) { cb = cv_decode(F, nx); cv_load(cb, F.lane, vb); }
        cv_store(ca, F.lane, va, scr);
        if (!hb) break;
        it = nx; nx = it + NGW; const bool ha = nx < hi;
        if (ha) { ca = cv_decode(F, nx); cv_load(ca, F.lane, va); }
        cv_store(cb, F.lane, vb, scr);
        if (!ha) break;
        it = nx;
    }
}
__device__ __forceinline__ void p0_prologue(const Ctx& F) {
    {
        const float* cvec = inp(F, IN_C); const float* wada = inp(F, IN_WADA); float* modp = (float*)(F.ws + WS_MODP);
        LAS float* red = (LAS float*)F.lds;
        for (int it = F.bx; it < 384; it += F.G) {
            const int cc = it % 48, ks = it / 48; const int col = cc * 256 + F.lane * 4; const int k0 = ks * 256 + F.wave * 32;
            f32x4 a = (f32x4){0.f, 0.f, 0.f, 0.f};
#pragma unroll 8
            for (int r = 0; r < 32; ++r) { const int k = k0 + r; const float s = fsilu(cvec[k]); const f32x4 w = *(const f32x4*)(wada + (size_t)k * 12288 + col); a += w * s; }
            *(LAS f32x4*)(red + F.wave * 256 + F.lane * 4) = a;
            __syncthreads();
            if (F.tid < 256) { float s = 0.f;
#pragma unroll
                for (int w = 0; w < 8; ++w) s += red[w * 256 + F.tid];
                modp[ks * 12288 + cc * 256 + F.tid] = s; }
            __syncthreads();
        }
    }
    {
        float* rc = (float*)(F.ws + WS_ROPE); float* rs = rc + S * 64;
        for (int idx = F.bx * 512 + F.tid; idx < S * 64; idx += F.G * 512) {
            const int pos = idx >> 6, i = idx & 63;
            double inv = 1.0; const double r = 0.86596432336006535;
            for (int q = 0; q < i; ++q) inv *= r;
            const double ang = (double)pos * inv;
            const double n = __builtin_rint(ang * 0.15915494309189535);
            const float red = (float)(ang - n * 6.283185307179586);
            rc[idx] = __cosf(red); rs[idx] = __sinf(red);
        }
    }
    convert_items(F, 0, CV_BG_FROM, F.vcu * 8 + F.wave, F.G * 8);
}

__device__ __forceinline__ float mod_sum(const Ctx& F, int n) {
    const float* modp = (const float*)(F.ws + WS_MODP); float s = inp(F, IN_BADA)[n];
#pragma unroll
    for (int k = 0; k < 8; ++k) s += modp[k * 12288 + n];
    return s;
}
__device__ __forceinline__ void norm_rows(const Ctx& F, const float* X, const LAS float* gs, const LAS float* sh, bf16_t* O, unsigned char* O8) {
    const int gw = F.vcu * 8 + F.wave, NGW = F.G * 8;
    for (int m = gw; m < S; m += NGW) {
        const GAS f32x4* xr = (const GAS f32x4*)(X + (size_t)m * D) + F.lane;
        f32x4 v[8]; float ss = 0.f;
#pragma unroll
        for (int j = 0; j < 8; ++j) { v[j] = xr[64 * j]; ss += (v[j].x * v[j].x + v[j].y * v[j].y) + (v[j].z * v[j].z + v[j].w * v[j].w); }
#pragma unroll
        for (int o = 1; o < 64; o <<= 1) ss += __shfl_xor(ss, o);
        const float rstd = 1.0f / sqrtf(ss * (1.f / D) + 1e-6f);
        GAS u32x2* o8 = (GAS u32x2*)(O + (size_t)m * D) + F.lane; GAS unsigned* o4 = (GAS unsigned*)(O8 + (size_t)m * D) + F.lane;
#pragma unroll
        for (int j = 0; j < 8; ++j) { const f32x4 g = *(const LAS f32x4*)(gs + 256 * j + 4 * F.lane), s = *(const LAS f32x4*)(sh + 256 * j + 4 * F.lane);
            const f32x4 y = v[j] * rstd * g + s; u32x2 w; w.x = cvt_pk_bf16(y.x, y.y); w.y = cvt_pk_bf16(y.z, y.w); if (!PROJ_ALL_FP8) o8[64 * j] = w; o4[64 * j] = cvt4_fp8(y.x, y.y, y.z, y.w); }
    }
}
__device__ __forceinline__ void p1_norm1(const Ctx& F) {
    LAS float* gs = (LAS float*)F.lds; LAS float* sh = gs + D;
    for (int k = F.tid; k < D; k += 512) { const float shv = mod_sum(F, k), scv = mod_sum(F, D + k); gs[k] = inp(F, IN_LN1)[k] * (1.f + scv); sh[k] = shv; }
    float* modf = (float*)(F.ws + WS_MODF);
    for (int n = F.bx * 512 + F.tid; n < 12288; n += F.G * 512) modf[n] = mod_sum(F, n);
    __syncthreads();
    norm_rows(F, inp(F, IN_X), gs, sh, (bf16_t*)(F.ws + WS_H), F.ws + WS_H8);
}


__device__ __forceinline__ bf16x8 pk_frag(u32x2 lo, u32x2 hi) { u32x4 v; v.x = lo.x; v.y = lo.y; v.z = hi.x; v.w = hi.y; return __builtin_bit_cast(bf16x8, v); }
__device__ __forceinline__ f32x4 mfma16(bf16x8 a, bf16x8 b, f32x4 c) { return __builtin_amdgcn_mfma_f32_16x16x32_bf16(a, b, c, 0, 0, 0); }
__device__ __forceinline__ float gamma_log2(int h) { return log2f(1.0f - exp2f(-5.0f - (float)h)); }

struct AttnU { int g, hh, d, r, nb, head; };
__device__ __forceinline__ AttnU attn_decode(int u) {
    AttnU U; U.g = u >> 9; const int rem = u & 511; U.hh = rem >> 6; const int rem2 = rem & 63;
    const int dsh = 2 * U.g; U.d = 1 << dsh; const int nblk = 64 >> dsh;
    U.r = rem2 / nblk; U.nb = rem2 % nblk; U.head = U.g * 8 + U.hh; return U;
}
__device__ __forceinline__ void attn_issue(const bf16_t* proj, const AttnU& U, int tid, int w, int lane, u32x4 (&kr)[8], u32x4 (&vr)[8], u32x4 (&qr)[4]) {
    const int rowi = tid >> 4, ch = tid & 15;
#pragma unroll
    for (int p = 0; p < 8; ++p) { const int cc = p * 32 + rowi; const int jk = (U.nb - 1) * 128 + cc;
        if (jk >= 0) { const unsigned off = (unsigned)(jk * U.d + U.r) * INW + U.head * 128 + ch * 8; kr[p] = *(const u32x4*)(proj + off + C_KA); vr[p] = *(const u32x4*)(proj + off + C_VA); }
        else { kr[p] = (u32x4){0u, 0u, 0u, 0u}; vr[p] = (u32x4){0u, 0u, 0u, 0u}; } }
    const int ql = lane & 15, g4 = lane >> 4; const unsigned tq = (unsigned)((U.nb * 128 + 16 * w + ql) * U.d + U.r);
#pragma unroll
    for (int ds = 0; ds < 4; ++ds) qr[ds] = *(const u32x4*)(proj + tq * INW + C_QA + U.head * 128 + 32 * ds + 8 * g4);
}
__device__ __forceinline__ void p3_attn(const Ctx& F) {
    const bf16_t* proj = (const bf16_t*)(F.ws + WS_PROJ);
    LAS bf16_t* KS = (LAS bf16_t*)F.lds;
    LAS bf16_t* VS = (LAS bf16_t*)(F.lds + 69632);
    LAS float* BT = (LAS float*)(F.lds + 139264);
    const int lane = F.lane, w = F.wave, ql = lane & 15, g4 = lane >> 4;
    const int rowi = F.tid >> 4, ch = F.tid & 15;
    u32x4 kr[8], vr[8], qr[4];
    int it = F.bx;
    if (it < 1536) { const AttnU U0 = attn_decode(it); attn_issue(proj, U0, F.tid, w, lane, kr, vr, qr); }
    for (; it < 1536; it += F.G) {
        const AttnU U = attn_decode(it);
        const int d = U.d, nb = U.nb;
        if (F.tid <= 128) { const int dist = F.tid * d; int b;
            if (dist < 16) b = dist; else { b = 16 + (int)floorf(log2f((float)dist * 0.0625f) * (16.0f / 7.0f)); b = b > 31 ? 31 : b; }
            BT[F.tid] = inp(F, IN_RELB)[b * 24 + U.head]; }
        {
            const float* kg = inp(F, IN_KNG) + ch * 8;
            const f32x4 kg0 = *(const f32x4*)kg, kg1 = *(const f32x4*)(kg + 4);
#pragma unroll
            for (int p = 0; p < 8; ++p) { const int cc = p * 32 + rowi;
                float f[8]; f[0] = bf2f(kr[p].x & 0xffffu); f[1] = bf2f(kr[p].x >> 16); f[2] = bf2f(kr[p].y & 0xffffu); f[3] = bf2f(kr[p].y >> 16);
                f[4] = bf2f(kr[p].z & 0xffffu); f[5] = bf2f(kr[p].z >> 16); f[6] = bf2f(kr[p].w & 0xffffu); f[7] = bf2f(kr[p].w >> 16);
                float ss = 0.f;
#pragma unroll
                for (int e = 0; e < 8; ++e) ss += f[e] * f[e];
                ss += __shfl_xor(ss, 1); ss += __shfl_xor(ss, 2); ss += __shfl_xor(ss, 4); ss += __shfl_xor(ss, 8);
                const float rstd = 1.0f / sqrtf(ss * (1.f / 128.f) + 1e-6f);
                u32x4 o; o.x = cvt_pk_bf16(f[0] * rstd * kg0.x, f[1] * rstd * kg0.y); o.y = cvt_pk_bf16(f[2] * rstd * kg0.z, f[3] * rstd * kg0.w);
                o.z = cvt_pk_bf16(f[4] * rstd * kg1.x, f[5] * rstd * kg1.y); o.w = cvt_pk_bf16(f[6] * rstd * kg1.z, f[7] * rstd * kg1.w);
                *(LAS u32x4*)(KS + cc * 136 + ch * 8) = o;
                *(LAS u32x4*)(VS + cc * 136 + ch * 8) = vr[p]; }
        }
        const int a = 16 * w + ql;
        const unsigned tq = (unsigned)((nb * 128 + a) * d + U.r);
        bf16x8 qf[4];
        {
            float f[4][8]; float ss = 0.f;
#pragma unroll
            for (int ds = 0; ds < 4; ++ds) { f[ds][0] = bf2f(qr[ds].x & 0xffffu); f[ds][1] = bf2f(qr[ds].x >> 16); f[ds][2] = bf2f(qr[ds].y & 0xffffu); f[ds][3] = bf2f(qr[ds].y >> 16);
                f[ds][4] = bf2f(qr[ds].z & 0xffffu); f[ds][5] = bf2f(qr[ds].z >> 16); f[ds][6] = bf2f(qr[ds].w & 0xffffu); f[ds][7] = bf2f(qr[ds].w >> 16);
#pragma unroll
                for (int e = 0; e < 8; ++e) ss += f[ds][e] * f[ds][e]; }
            ss += __shfl_xor(ss, 16); ss += __shfl_xor(ss, 32);
            const float rs = (1.0f / sqrtf(ss * (1.f / 128.f) + 1e-6f)) * 0.08838834764831845f;
#pragma unroll
            for (int ds = 0; ds < 4; ++ds) { const float* qg = inp(F, IN_QNG) + 32 * ds + 8 * g4; const f32x4 q0 = *(const f32x4*)qg, q1 = *(const f32x4*)(qg + 4); u32x4 o;
                o.x = cvt_pk_bf16(f[ds][0] * rs * q0.x, f[ds][1] * rs * q0.y); o.y = cvt_pk_bf16(f[ds][2] * rs * q0.z, f[ds][3] * rs * q0.w);
                o.z = cvt_pk_bf16(f[ds][4] * rs * q1.x, f[ds][5] * rs * q1.y); o.w = cvt_pk_bf16(f[ds][6] * rs * q1.z, f[ds][7] * rs * q1.w);
                qf[ds] = __builtin_bit_cast(bf16x8, o); }
        }
        __syncthreads();
        { const int nx = it + F.G; if (nx < 1536) { const AttnU Un = attn_decode(nx); attn_issue(proj, Un, F.tid, w, lane, kr, vr, qr); } }
        const int kbase = 32 * (w >> 1);
        f32x4 sc[10];
#pragma unroll
        for (int ti = 0; ti < 10; ++ti) { f32x4 acc = (f32x4){0.f, 0.f, 0.f, 0.f};
#pragma unroll
            for (int ds = 0; ds < 4; ++ds) { const bf16x8 kf = *(const LAS bf16x8*)(KS + (kbase + 16 * ti + ql) * 136 + 32 * ds + 8 * g4); acc = mfma16(kf, qf[ds], acc); }
            sc[ti] = acc; }
        float mx = -1e30f;
#pragma unroll
        for (int ti = 0; ti < 10; ++ti)
#pragma unroll
            for (int i = 0; i < 4; ++i) { const int cc = kbase + 16 * ti + 4 * g4 + i; const int delta = 128 + a - cc;
                const bool ok = (delta >= 0) && (delta <= 128) && (nb > 0 || cc >= 128);
                const float sv = ok ? sc[ti][i] + BT[ok ? delta : 0] : -1e30f; sc[ti][i] = sv; mx = fmaxf(mx, sv); }
        mx = fmaxf(mx, __shfl_xor(mx, 16)); mx = fmaxf(mx, __shfl_xor(mx, 32));
        float lsum = 0.f;
#pragma unroll
        for (int ti = 0; ti < 10; ++ti)
#pragma unroll
            for (int i = 0; i < 4; ++i) { const float p = __expf(sc[ti][i] - mx); sc[ti][i] = p; lsum += p; }
        lsum += __shfl_xor(lsum, 16); lsum += __shfl_xor(lsum, 32);
        bf16x8 pf[5];
#pragma unroll
        for (int s = 0; s < 5; ++s) { u32x4 o; o.x = cvt_pk_bf16(sc[2 * s][0], sc[2 * s][1]); o.y = cvt_pk_bf16(sc[2 * s][2], sc[2 * s][3]);
            o.z = cvt_pk_bf16(sc[2 * s + 1][0], sc[2 * s + 1][1]); o.w = cvt_pk_bf16(sc[2 * s + 1][2], sc[2 * s + 1][3]); pf[s] = __builtin_bit_cast(bf16x8, o); }
        const float rl = 1.0f / lsum;
        bf16_t* og = (bf16_t*)(F.ws + WS_OG) + ((unsigned)(U.g * S) + tq) * 1024u + U.hh * 128;
        const unsigned vbase = (unsigned)(size_t)VS + (unsigned)(((kbase + 4 * g4 + (ql >> 2)) * 136 + 4 * (ql & 3)) * 2);
#pragma unroll
        for (int dt = 0; dt < 8; ++dt) { f32x4 acc = (f32x4){0.f, 0.f, 0.f, 0.f};
            u32x2 lo[5], hi[5];
#pragma unroll
            for (int s = 0; s < 5; ++s) { TR_READ(lo[s], vbase, (32 * s * 136 + dt * 16) * 2); TR_READ(hi[s], vbase, ((32 * s + 16) * 136 + dt * 16) * 2); }
            TR_WAIT4(lo[0], hi[0], lo[1], hi[1]); TR_WAIT4(lo[2], hi[2], lo[3], hi[3]); TR_WAIT2(lo[4], hi[4]);
#pragma unroll
            for (int s = 0; s < 5; ++s) acc = mfma16(pk_frag(lo[s], hi[s]), pf[s], acc);
            u32x2 o; o.x = cvt_pk_bf16(acc[0] * rl, acc[1] * rl); o.y = cvt_pk_bf16(acc[2] * rl, acc[3] * rl);
            *(u32x2*)(og + dt * 16 + 4 * g4) = o; }
        if (g4 == 0) ((float*)(F.ws + WS_LSE))[((unsigned)(U.g * S) + tq) * 8u + U.hh] = mx + __logf(lsum);
        __syncthreads();
    }
}

__device__ __forceinline__ void rot8v(const u32x4 own, const u32x4 par, int ch, const f32x4 c0, const f32x4 c1, const f32x4 s0, const f32x4 s1, float scale, float (&o)[8]) {
    float a[8], b[8];
    a[0] = bf2f(own.x & 0xffffu); a[1] = bf2f(own.x >> 16); a[2] = bf2f(own.y & 0xffffu); a[3] = bf2f(own.y >> 16); a[4] = bf2f(own.z & 0xffffu); a[5] = bf2f(own.z >> 16); a[6] = bf2f(own.w & 0xffffu); a[7] = bf2f(own.w >> 16);
    b[0] = bf2f(par.x & 0xffffu); b[1] = bf2f(par.x >> 16); b[2] = bf2f(par.y & 0xffffu); b[3] = bf2f(par.y >> 16); b[4] = bf2f(par.z & 0xffffu); b[5] = bf2f(par.z >> 16); b[6] = bf2f(par.w & 0xffffu); b[7] = bf2f(par.w >> 16);
    const float cv[8] = {c0.x, c0.y, c0.z, c0.w, c1.x, c1.y, c1.z, c1.w}, sv[8] = {s0.x, s0.y, s0.z, s0.w, s1.x, s1.y, s1.z, s1.w};
#pragma unroll
    for (int e = 0; e < 8; ++e) o[e] = ((ch < 8) ? (a[e] * cv[e] - b[e] * sv[e]) : (b[e] * sv[e] + a[e] * cv[e])) * scale;
}

__device__ __forceinline__ void upd_unit(const Ctx& F, int u) {
    const int n = u >> 3, h = u & 7;
    const bf16_t* proj = (const bf16_t*)(F.ws + WS_PROJ);
    const float* rc = (const float*)(F.ws + WS_ROPE); const float* rsn = rc + S * 64;
    LAS bf16_t* KS = (LAS bf16_t*)F.lds;
    LAS bf16_t* VS = (LAS bf16_t*)(F.lds + 34816);
    const int lane = F.lane, w = F.wave;
    const float lg2 = gamma_log2(h);
    {
        const int rowi = F.tid >> 4, ch = F.tid & 15;
        u32x4 kown[4], kpar[4], vv[8]; f32x4 c0[4], c1[4], s0[4], s1[4];
#pragma unroll
        for (int p = 0; p < 4; ++p) { const int j = p * 32 + rowi; const unsigned tok = (unsigned)(n * 128 + j);
            const bf16_t* kp = proj + tok * INW + C_KR + h * 128;
            kown[p] = *(const u32x4*)(kp + ch * 8); kpar[p] = *(const u32x4*)(kp + (ch ^ 8) * 8);
            const float* cp = rc + tok * 64 + (ch & 7) * 8; const float* sp = rsn + tok * 64 + (ch & 7) * 8;
            c0[p] = *(const f32x4*)cp; c1[p] = *(const f32x4*)(cp + 4); s0[p] = *(const f32x4*)sp; s1[p] = *(const f32x4*)(sp + 4);
            vv[2 * p] = *(const u32x4*)(proj + tok * INW + C_VR + h * 256 + ch * 8); vv[2 * p + 1] = *(const u32x4*)(proj + tok * INW + C_VR + h * 256 + (ch + 16) * 8); }
#pragma unroll
        for (int p = 0; p < 4; ++p) { const int j = p * 32 + rowi;
            float o[8]; rot8v(kown[p], kpar[p], ch, c0[p], c1[p], s0[p], s1[p], 0.08838834764831845f, o);
            u32x4 ov; ov.x = cvt_pk_bf16(o[0], o[1]); ov.y = cvt_pk_bf16(o[2], o[3]); ov.z = cvt_pk_bf16(o[4], o[5]); ov.w = cvt_pk_bf16(o[6], o[7]);
            *(LAS u32x4*)(KS + j * 136 + ch * 8) = ov; }
#pragma unroll
        for (int p = 0; p < 4; ++p) { const int j = p * 32 + rowi; const float z = exp2f(lg2 * (float)(127 - j));
#pragma unroll
            for (int c2 = 0; c2 < 2; ++c2) { const int chv = ch + 16 * c2; const u32x4 x = vv[2 * p + c2];
                u32x4 ov; ov.x = cvt_pk_bf16(bf2f(x.x & 0xffffu) * z, bf2f(x.x >> 16) * z); ov.y = cvt_pk_bf16(bf2f(x.y & 0xffffu) * z, bf2f(x.y >> 16) * z);
                ov.z = cvt_pk_bf16(bf2f(x.z & 0xffffu) * z, bf2f(x.z >> 16) * z); ov.w = cvt_pk_bf16(bf2f(x.w & 0xffffu) * z, bf2f(x.w >> 16) * z);
                *(LAS u32x4*)(VS + j * 264 + chv * 8) = ov; } }
    }
    __syncthreads();
    const int ql = lane & 15, g4 = lane >> 4;
    const unsigned kb = (unsigned)(size_t)KS + (unsigned)(((8 * g4 + (ql >> 2)) * 136 + 4 * (ql & 3)) * 2);
    const unsigned vbw = (unsigned)(size_t)VS + (unsigned)(((8 * g4 + (ql >> 2)) * 264 + 4 * (ql & 3) + 32 * w) * 2);
    f32x4 acc[2][8];
#pragma unroll
    for (int a = 0; a < 2; ++a)
#pragma unroll
        for (int b = 0; b < 8; ++b) acc[a][b] = (f32x4){0.f, 0.f, 0.f, 0.f};
#pragma unroll
    for (int ks = 0; ks < 4; ++ks) {
        u32x2 vl[2], vh[2];
#pragma unroll
        for (int a = 0; a < 2; ++a) { TR_READ(vl[a], vbw, (32 * ks * 264 + a * 16) * 2); TR_READ(vh[a], vbw, ((32 * ks + 4) * 264 + a * 16) * 2); }
        TR_WAIT4(vl[0], vh[0], vl[1], vh[1]);
        const bf16x8 vf0 = pk_frag(vl[0], vh[0]), vf1 = pk_frag(vl[1], vh[1]);
#pragma unroll
        for (int b = 0; b < 8; b += 2) {
            u32x2 k0l, k0h, k1l, k1h;
            TR_READ(k0l, kb, (32 * ks * 136 + b * 16) * 2); TR_READ(k0h, kb, ((32 * ks + 4) * 136 + b * 16) * 2);
            TR_READ(k1l, kb, (32 * ks * 136 + (b + 1) * 16) * 2); TR_READ(k1h, kb, ((32 * ks + 4) * 136 + (b + 1) * 16) * 2);
            TR_WAIT4(k0l, k0h, k1l, k1h);
            const bf16x8 kf0 = pk_frag(k0l, k0h), kf1 = pk_frag(k1l, k1h);
            acc[0][b] = mfma16(vf0, kf0, acc[0][b]); acc[1][b] = mfma16(vf1, kf0, acc[1][b]);
            acc[0][b + 1] = mfma16(vf0, kf1, acc[0][b + 1]); acc[1][b + 1] = mfma16(vf1, kf1, acc[1][b + 1]); }
    }
    float* upd = (float*)(F.ws + WS_UPD) + (size_t)(n * 8 + h) * 32768;
#pragma unroll
    for (int a = 0; a < 2; ++a)
#pragma unroll
        for (int b = 0; b < 8; ++b)
#pragma unroll
            for (int i = 0; i < 4; ++i) upd[((2 * w + a) * 16 + 4 * g4 + i) * 128 + b * 16 + ql] = acc[a][b][i];
    __syncthreads();
}
__device__ __forceinline__ void p3_mix1(const Ctx& F) {
    p3_attn(F);
    if (DUP2_MASK & 4) { __syncthreads(); p3_attn(F); }
    for (int it = F.bx; it < 512; it += F.G) upd_unit(F, it);
    if (DUP2_MASK & 8) { __syncthreads(); for (int it = F.bx; it < 512; it += F.G) upd_unit(F, it); }
}

__device__ __forceinline__ void p4_scan(const Ctx& F) {
    const float* upd = (const float*)(F.ws + WS_UPD); unsigned* prev = (unsigned*)(F.ws + WS_PREV);
    for (int p = F.bx * 512 + F.tid; p < 131072; p += F.G * 512) {
        const int h = p >> 14;
        const float gch = exp2f(gamma_log2(h) * 128.0f);
        const int within = (p & 16383) * 2;
        float s0 = 0.f, s1 = 0.f;
#pragma unroll 8
        for (int n = 0; n < 64; ++n) { const size_t o = (size_t)(n * 8 + h) * 32768 + within;
            const f32x2 uv = *(const f32x2*)(upd + o);
            prev[o >> 1] = cvt_pk_bf16(s0, s1);
            s0 = gch * s0 + uv.x; s1 = gch * s1 + uv.y; }
    }
}

__device__ __forceinline__ void ret_unit(const Ctx& F, int u) {
    const int n = u >> 3, h = u & 7;
    const bf16_t* proj = (const bf16_t*)(F.ws + WS_PROJ);
    const float* rc = (const float*)(F.ws + WS_ROPE); const float* rsn = rc + S * 64;
    LAS bf16_t* KS = (LAS bf16_t*)F.lds;
    LAS bf16_t* VS = (LAS bf16_t*)(F.lds + 34816);
    LAS bf16_t* QS = (LAS bf16_t*)(F.lds + 102400);
    LAS float* RED = (LAS float*)(F.lds + 137216);
    LAS float* TOT = (LAS float*)(F.lds + 145408);
    const int lane = F.lane, w = F.wave;
    const float lg2 = gamma_log2(h);
    const int ql = lane & 15, g4 = lane >> 4;
    const bf16_t* prev = (const bf16_t*)(F.ws + WS_PREV) + (size_t)(n * 8 + h) * 32768;
    {
        const int rowi = F.tid >> 4, ch = F.tid & 15;
        u32x4 kown[4], kpar[4], vv[8]; f32x4 c0[4], c1[4], s0[4], s1[4];
#pragma unroll
        for (int p = 0; p < 4; ++p) { const int j = p * 32 + rowi; const unsigned tok = (unsigned)(n * 128 + j);
            const bf16_t* kp = proj + tok * INW + C_KR + h * 128;
            kown[p] = *(const u32x4*)(kp + ch * 8); kpar[p] = *(const u32x4*)(kp + (ch ^ 8) * 8);
            const float* cp = rc + tok * 64 + (ch & 7) * 8; const float* sp = rsn + tok * 64 + (ch & 7) * 8;
            c0[p] = *(const f32x4*)cp; c1[p] = *(const f32x4*)(cp + 4); s0[p] = *(const f32x4*)sp; s1[p] = *(const f32x4*)(sp + 4);
            vv[2 * p] = *(const u32x4*)(proj + tok * INW + C_VR + h * 256 + ch * 8); vv[2 * p + 1] = *(const u32x4*)(proj + tok * INW + C_VR + h * 256 + (ch + 16) * 8); }
#pragma unroll
        for (int p = 0; p < 4; ++p) { const int j = p * 32 + rowi;
            float o[8]; rot8v(kown[p], kpar[p], ch, c0[p], c1[p], s0[p], s1[p], 0.08838834764831845f, o);
            u32x4 ov; ov.x = cvt_pk_bf16(o[0], o[1]); ov.y = cvt_pk_bf16(o[2], o[3]); ov.z = cvt_pk_bf16(o[4], o[5]); ov.w = cvt_pk_bf16(o[6], o[7]);
            *(LAS u32x4*)(KS + j * 136 + ch * 8) = ov; }
#pragma unroll
        for (int p = 0; p < 4; ++p) { const int j = p * 32 + rowi;
#pragma unroll
            for (int c2 = 0; c2 < 2; ++c2) { const int chv = ch + 16 * c2; const u32x4 x = vv[2 * p + c2];
                *(LAS u32x4*)(VS + j * 264 + chv * 8) = x; } }
    }
    const int iq = 16 * w + ql; const unsigned tq = (unsigned)(n * 128 + iq);
    bf16x8 qf[4];
    {
        u32x4 qv[4]; float f[4][8];
#pragma unroll
        for (int ds = 0; ds < 4; ++ds) qv[ds] = *(const u32x4*)(proj + tq * INW + C_QR + h * 128 + 32 * ds + 8 * g4);
#pragma unroll
        for (int ds = 0; ds < 4; ++ds) { f[ds][0] = bf2f(qv[ds].x & 0xffffu); f[ds][1] = bf2f(qv[ds].x >> 16); f[ds][2] = bf2f(qv[ds].y & 0xffffu); f[ds][3] = bf2f(qv[ds].y >> 16);
            f[ds][4] = bf2f(qv[ds].z & 0xffffu); f[ds][5] = bf2f(qv[ds].z >> 16); f[ds][6] = bf2f(qv[ds].w & 0xffffu); f[ds][7] = bf2f(qv[ds].w >> 16); }
        const float xi = exp2f(lg2 * (float)(iq + 1));
#pragma unroll
        for (int ds = 0; ds < 2; ++ds) {
            const float* cp = rc + tq * 64 + 32 * ds + 8 * g4; const float* sp = rsn + tq * 64 + 32 * ds + 8 * g4;
            const f32x4 c0 = *(const f32x4*)cp, c1 = *(const f32x4*)(cp + 4), s0 = *(const f32x4*)sp, s1 = *(const f32x4*)(sp + 4);
            const float cv[8] = {c0.x, c0.y, c0.z, c0.w, c1.x, c1.y, c1.z, c1.w}, sv[8] = {s0.x, s0.y, s0.z, s0.w, s1.x, s1.y, s1.z, s1.w};
            float lo[8], hi[8];
#pragma unroll
            for (int e = 0; e < 8; ++e) { const float t1 = f[ds][e], t2 = f[ds + 2][e]; lo[e] = t1 * cv[e] - t2 * sv[e]; hi[e] = t1 * sv[e] + t2 * cv[e]; }
            u32x4 o; o.x = cvt_pk_bf16(lo[0], lo[1]); o.y = cvt_pk_bf16(lo[2], lo[3]); o.z = cvt_pk_bf16(lo[4], lo[5]); o.w = cvt_pk_bf16(lo[6], lo[7]); qf[ds] = __builtin_bit_cast(bf16x8, o);
            o.x = cvt_pk_bf16(hi[0], hi[1]); o.y = cvt_pk_bf16(hi[2], hi[3]); o.z = cvt_pk_bf16(hi[4], hi[5]); o.w = cvt_pk_bf16(hi[6], hi[7]); qf[ds + 2] = __builtin_bit_cast(bf16x8, o);
            o.x = cvt_pk_bf16(lo[0] * xi, lo[1] * xi); o.y = cvt_pk_bf16(lo[2] * xi, lo[3] * xi); o.z = cvt_pk_bf16(lo[4] * xi, lo[5] * xi); o.w = cvt_pk_bf16(lo[6] * xi, lo[7] * xi);
            *(LAS u32x4*)(QS + iq * 136 + 32 * ds + 8 * g4) = o;
            o.x = cvt_pk_bf16(hi[0] * xi, hi[1] * xi); o.y = cvt_pk_bf16(hi[2] * xi, hi[3] * xi); o.z = cvt_pk_bf16(hi[4] * xi, hi[5] * xi); o.w = cvt_pk_bf16(hi[6] * xi, hi[7] * xi);
            *(LAS u32x4*)(QS + iq * 136 + 32 * (ds + 2) + 8 * g4) = o;
        }
    }
    bf16x8 pr[2][4];
#pragma unroll
    for (int a = 0; a < 2; ++a)
#pragma unroll
        for (int ds = 0; ds < 4; ++ds) pr[a][ds] = *(const bf16x8*)(prev + ((2 * w + a) * 16 + ql) * 128 + 32 * ds + 8 * g4);
    __syncthreads();
    f32x4 sc[8];
#pragma unroll
    for (int kt = 0; kt < 8; ++kt) { f32x4 a = (f32x4){0.f, 0.f, 0.f, 0.f};
#pragma unroll
        for (int ds = 0; ds < 4; ++ds) { const bf16x8 kf = *(const LAS bf16x8*)(KS + (16 * kt + ql) * 136 + 32 * ds + 8 * g4); a = mfma16(kf, qf[ds], a); }
#pragma unroll
        for (int i = 0; i < 4; ++i) { const int j = 16 * kt + 4 * g4 + i; const int df = iq - j; a[i] = (df >= 0) ? a[i] * exp2f(lg2 * (float)df) : 0.f; }
        sc[kt] = a; }
    __syncthreads();
#pragma unroll
    for (int kt = 0; kt < 8; ++kt) { u32x2 o; o.x = cvt_pk_bf16(sc[kt][0], sc[kt][1]); o.y = cvt_pk_bf16(sc[kt][2], sc[kt][3]); *(LAS u32x2*)(KS + iq * 136 + 16 * kt + 4 * g4) = o; }
    __syncthreads();
    f32x4 acc[2][8];
#pragma unroll
    for (int a = 0; a < 2; ++a)
#pragma unroll
        for (int qt = 0; qt < 8; ++qt) acc[a][qt] = (f32x4){0.f, 0.f, 0.f, 0.f};
#pragma unroll
    for (int ds = 0; ds < 4; ++ds)
#pragma unroll
        for (int qt = 0; qt < 8; ++qt) { const bf16x8 bq = *(const LAS bf16x8*)(QS + (qt * 16 + ql) * 136 + 32 * ds + 8 * g4);
            acc[0][qt] = mfma16(pr[0][ds], bq, acc[0][qt]); acc[1][qt] = mfma16(pr[1][ds], bq, acc[1][qt]); }
    const unsigned vbw = (unsigned)(size_t)VS + (unsigned)(((8 * g4 + (ql >> 2)) * 264 + 4 * (ql & 3) + 32 * w) * 2);
#pragma unroll
    for (int s = 0; s < 4; ++s) {
        u32x2 vl[2], vh[2];
#pragma unroll
        for (int a = 0; a < 2; ++a) { TR_READ(vl[a], vbw, (32 * s * 264 + a * 16) * 2); TR_READ(vh[a], vbw, ((32 * s + 4) * 264 + a * 16) * 2); }
        TR_WAIT4(vl[0], vh[0], vl[1], vh[1]);
        const bf16x8 vf0 = pk_frag(vl[0], vh[0]), vf1 = pk_frag(vl[1], vh[1]);
#pragma unroll
        for (int qt = 0; qt < 8; ++qt) if (qt >= 2 * s) { const bf16x8 bp = *(const LAS bf16x8*)(KS + (qt * 16 + ql) * 136 + 32 * s + 8 * g4);
            acc[0][qt] = mfma16(vf0, bp, acc[0][qt]); acc[1][qt] = mfma16(vf1, bp, acc[1][qt]); }
    }
#pragma unroll
    for (int qt = 0; qt < 8; ++qt) { float s1 = 0.f, s2 = 0.f;
#pragma unroll
        for (int a = 0; a < 2; ++a)
#pragma unroll
            for (int i = 0; i < 4; ++i) { const float x = acc[a][qt][i]; s1 += x; s2 += x * x; }
        s1 += __shfl_xor(s1, 16); s1 += __shfl_xor(s1, 32); s2 += __shfl_xor(s2, 16); s2 += __shfl_xor(s2, 32);
        if (g4 == 0) *(LAS f32x2*)(RED + (w * 128 + qt * 16 + ql) * 2) = (f32x2){s1, s2}; }
    __syncthreads();
    if (F.tid < 128) { float s1 = 0.f, s2 = 0.f;
#pragma unroll
        for (int ww = 0; ww < 8; ++ww) { const f32x2 v = *(const LAS f32x2*)(RED + (ww * 128 + F.tid) * 2); s1 += v.x; s2 += v.y; }
        const float mean = s1 * (1.f / 256.f); float var = s2 * (1.f / 256.f) - mean * mean; var = var > 0.f ? var : 0.f;
        *(LAS f32x2*)(TOT + F.tid * 2) = (f32x2){mean, 1.0f / sqrtf(var + 1e-5f)}; }
    __syncthreads();
    LAS bf16_t* OT = VS;
#pragma unroll
    for (int qt = 0; qt < 8; ++qt) { const f32x2 st = *(const LAS f32x2*)(TOT + (qt * 16 + ql) * 2);
#pragma unroll
        for (int a = 0; a < 2; ++a) { u32x2 o; o.x = cvt_pk_bf16((acc[a][qt][0] - st.x) * st.y, (acc[a][qt][1] - st.x) * st.y); o.y = cvt_pk_bf16((acc[a][qt][2] - st.x) * st.y, (acc[a][qt][3] - st.x) * st.y);
            *(LAS u32x2*)(OT + (qt * 16 + ql) * 264 + (2 * w + a) * 16 + 4 * g4) = o; } }
    __syncthreads();
    const float* gng = inp(F, IN_GNG) + h * 256;
    {
        const int pc = F.tid & 31;
        const f32x4 gg0 = *(const f32x4*)(gng + pc * 8), gg1 = *(const f32x4*)(gng + pc * 8 + 4);
        u32x4 gv[8];
#pragma unroll
        for (int p = 0; p < 8; ++p) { const unsigned tk = (unsigned)(n * 128 + p * 16 + (F.tid >> 5)); gv[p] = *(const u32x4*)(proj + tk * INW + C_GR + h * 256 + pc * 8); }
#pragma unroll
        for (int p = 0; p < 8; ++p) { const int row = p * 16 + (F.tid >> 5); const unsigned tk = (unsigned)(n * 128 + row);
            const u32x4 x = *(const LAS u32x4*)(OT + row * 264 + pc * 8); u32x4 o;
            o.x = cvt_pk_bf16(bf2f(x.x & 0xffffu) * gg0.x * fsilu(bf2f(gv[p].x & 0xffffu)), bf2f(x.x >> 16) * gg0.y * fsilu(bf2f(gv[p].x >> 16)));
            o.y = cvt_pk_bf16(bf2f(x.y & 0xffffu) * gg0.z * fsilu(bf2f(gv[p].y & 0xffffu)), bf2f(x.y >> 16) * gg0.w * fsilu(bf2f(gv[p].y >> 16)));
            o.z = cvt_pk_bf16(bf2f(x.z & 0xffffu) * gg1.x * fsilu(bf2f(gv[p].z & 0xffffu)), bf2f(x.z >> 16) * gg1.y * fsilu(bf2f(gv[p].z >> 16)));
            o.w = cvt_pk_bf16(bf2f(x.w & 0xffffu) * gg1.z * fsilu(bf2f(gv[p].w & 0xffffu)), bf2f(x.w >> 16) * gg1.w * fsilu(bf2f(gv[p].w >> 16)));
            *(u32x4*)((bf16_t*)(F.ws + WS_YB) + tk * D + h * 256 + pc * 8) = o; }
    }
    __syncthreads();
}
__device__ __forceinline__ void comb_item(const Ctx& F, int it) {
    const bf16_t* og = (const bf16_t*)(F.ws + WS_OG); const float* lse = (const float*)(F.ws + WS_LSE); bf16_t* ya = (bf16_t*)(F.ws + WS_YA);
    for (int rr = 0; rr < 4; ++rr) { const size_t t = (size_t)it * 32 + F.wave * 4 + rr; const int hh = F.lane >> 3;
        const float l0 = lse[(0 * (size_t)S + t) * 8 + hh], l1 = lse[(1 * (size_t)S + t) * 8 + hh], l2 = lse[(2 * (size_t)S + t) * 8 + hh];
        const float m = fmaxf(l0, fmaxf(l1, l2)); float a0 = __expf(l0 - m), a1 = __expf(l1 - m), a2 = __expf(l2 - m); const float inv = 1.f / (a0 + a1 + a2); a0 *= inv; a1 *= inv; a2 *= inv;
#pragma unroll
        for (int c = 0; c < 2; ++c) { const size_t e = t * 1024 + F.lane * 16 + c * 8;
            const u32x4 v0 = *(const u32x4*)(og + e), v1 = *(const u32x4*)(og + (size_t)S * 1024 + e), v2 = *(const u32x4*)(og + 2 * (size_t)S * 1024 + e);
            u32x4 o;
            o.x = cvt_pk_bf16(a0 * bf2f(v0.x & 0xffffu) + a1 * bf2f(v1.x & 0xffffu) + a2 * bf2f(v2.x & 0xffffu), a0 * bf2f(v0.x >> 16) + a1 * bf2f(v1.x >> 16) + a2 * bf2f(v2.x >> 16));
            o.y = cvt_pk_bf16(a0 * bf2f(v0.y & 0xffffu) + a1 * bf2f(v1.y & 0xffffu) + a2 * bf2f(v2.y & 0xffffu), a0 * bf2f(v0.y >> 16) + a1 * bf2f(v1.y >> 16) + a2 * bf2f(v2.y >> 16));
            o.z = cvt_pk_bf16(a0 * bf2f(v0.z & 0xffffu) + a1 * bf2f(v1.z & 0xffffu) + a2 * bf2f(v2.z & 0xffffu), a0 * bf2f(v0.z >> 16) + a1 * bf2f(v1.z >> 16) + a2 * bf2f(v2.z >> 16));
            o.w = cvt_pk_bf16(a0 * bf2f(v0.w & 0xffffu) + a1 * bf2f(v1.w & 0xffffu) + a2 * bf2f(v2.w & 0xffffu), a0 * bf2f(v0.w >> 16) + a1 * bf2f(v1.w >> 16) + a2 * bf2f(v2.w >> 16));
            *(u32x4*)(ya + e) = o; } }
}
__device__ __forceinline__ void p4_scan_comb(const Ctx& F) {
    p4_scan(F);
    for (int it = F.bx; it < 256; it += F.G) comb_item(F, it);
}
__device__ __forceinline__ void p5_mix2(const Ctx& F) {
    for (int it = F.bx; it < 512; it += F.G) ret_unit(F, it);
    if (DUP2_MASK & 1) { __syncthreads(); for (int it = F.bx; it < 512; it += F.G) ret_unit(F, it); }
}

__device__ __forceinline__ void p8_router(const Ctx& F) {
    LAS float* gs = (LAS float*)F.lds; LAS float* sh = gs + D; LAS float* XS = sh + D; LAS float* WSm = XS + 32 * 260; LAS float* SC = WSm + 256 * 64; LAS float* SEL = SC + 32 * 64; LAS float* RSTD = SEL + 32 * 64;
    const float* modf = (const float*)(F.ws + WS_MODF);
    for (int k = F.tid; k < D; k += 512) { gs[k] = inp(F, IN_LN2)[k] * (1.f + modf[4 * D + k]); sh[k] = modf[3 * D + k]; }
    __syncthreads();
    const float* x1 = F.out; unsigned char* H2 = F.ws + WS_H;
    const float* rw = inp(F, IN_RW); const float* rb = inp(F, IN_RB);
    int* e_of = (int*)(F.ws + WS_EOF); int* pos_of = e_of + 65536; float* topw = (float*)(pos_of + 65536);
    unsigned* cnt = (unsigned*)(F.ws + WS_CTL) + CW_CNT;
    for (int it = F.bx; it < 256; it += F.G) {
        const int t0 = it * 32;
#pragma unroll 1
        for (int rr = 0; rr < 4; ++rr) { const int m = t0 + F.wave * 4 + rr;
            const GAS f32x4* xr = (const GAS f32x4*)(x1 + (size_t)m * D) + F.lane;
            f32x4 v[8]; float ss = 0.f;
#pragma unroll
            for (int j = 0; j < 8; ++j) { v[j] = xr[64 * j]; ss += (v[j].x * v[j].x + v[j].y * v[j].y) + (v[j].z * v[j].z + v[j].w * v[j].w); }
#pragma unroll
            for (int o = 1; o < 64; o <<= 1) ss += __shfl_xor(ss, o);
            const float rstd = 1.0f / sqrtf(ss * (1.f / D) + 1e-6f);
            if (F.lane == 0) RSTD[F.wave * 4 + rr] = rstd;
            GAS unsigned* o4 = (GAS unsigned*)(H2 + (size_t)m * D) + F.lane;
#pragma unroll
            for (int j = 0; j < 8; ++j) { const f32x4 g = *(const LAS f32x4*)(gs + 256 * j + 4 * F.lane), s = *(const LAS f32x4*)(sh + 256 * j + 4 * F.lane);
                const f32x4 y = v[j] * rstd * g + s; o4[64 * j] = cvt4_fp8(y.x, y.y, y.z, y.w); } }
        __syncthreads();
        const int tok = F.tid >> 4, eq = F.tid & 15;
        f32x16 ac0, ac1;
#pragma unroll
        for (int i = 0; i < 16; ++i) { ac0[i] = 0.f; ac1[i] = 0.f; }
#pragma unroll 1
        for (int kc = 0; kc < 8; ++kc) {
#pragma unroll
            for (int q = 0; q < 4; ++q) { const int idx = F.tid + 512 * q; const int row = idx >> 6, c4 = (idx & 63) * 4; const int k = kc * 256 + c4;
                const f32x4 xv = *(const f32x4*)(x1 + (size_t)(t0 + row) * D + k); const float rstd = RSTD[row];
                const f32x4 g = *(const LAS f32x4*)(gs + k), s = *(const LAS f32x4*)(sh + k);
                *(LAS f32x4*)(XS + row * 260 + c4) = xv * rstd * g + s; }
#pragma unroll
            for (int q = 0; q < 8; ++q) { const int idx = F.tid + 512 * q; const int kr = idx >> 4, c4 = (idx & 15) * 4;
                *(LAS f32x4*)(WSm + kr * 64 + c4) = *(const f32x4*)(rw + (size_t)(kc * 256 + kr) * 64 + c4); }
            __syncthreads();
            { const int i31 = F.lane & 31, kh = F.lane >> 5;
#pragma unroll 4
              for (int kp = 0; kp < 16; ++kp) { const int k = 32 * F.wave + 2 * kp + kh;
                  const float av = XS[i31 * 260 + k]; const float b0 = WSm[k * 64 + i31], b1 = WSm[k * 64 + 32 + i31];
                  ac0 = __builtin_amdgcn_mfma_f32_32x32x2f32(av, b0, ac0, 0, 0, 0); ac1 = __builtin_amdgcn_mfma_f32_32x32x2f32(av, b1, ac1, 0, 0, 0); } }
            __syncthreads();
        }
        { LAS float* RED = WSm + F.wave * 2048; const int i31 = F.lane & 31, kh = F.lane >> 5;
#pragma unroll
          for (int rg = 0; rg < 16; ++rg) { const int row = (rg & 3) + 8 * (rg >> 2) + 4 * kh; RED[row * 64 + i31] = ac0[rg]; RED[row * 64 + 32 + i31] = ac1[rg]; } }
        __syncthreads();
        f32x4 lg = (f32x4){0.f, 0.f, 0.f, 0.f};
#pragma unroll
        for (int w = 0; w < 8; ++w) lg += *(const LAS f32x4*)(WSm + w * 2048 + tok * 64 + eq * 4);
#pragma unroll
        for (int i = 0; i < 4; ++i) { const float sc = fsigm(lg[i]); SC[tok * 64 + eq * 4 + i] = sc; SEL[tok * 64 + eq * 4 + i] = sc + rb[eq * 4 + i]; }
        __syncthreads();
        if (F.tid < 32) {
            LAS float* sel = SEL + F.tid * 64; const LAS float* scp = SC + F.tid * 64;
            float gsc[8];
#pragma unroll
            for (int g = 0; g < 8; ++g) { float m1 = -3e38f, m2 = -3e38f;
#pragma unroll
                for (int j = 0; j < 8; ++j) { const float v = sel[g * 8 + j]; if (v > m1) { m2 = m1; m1 = v; } else if (v > m2) m2 = v; }
                gsc[g] = m1 + m2; }
            unsigned gmask = 0u;
#pragma unroll
            for (int r = 0; r < 4; ++r) { float best = -3e38f; int bi = 0;
#pragma unroll
                for (int g = 0; g < 8; ++g) { const bool take = !((gmask >> g) & 1u) && gsc[g] > best; best = take ? gsc[g] : best; bi = take ? g : bi; }
                gmask |= 1u << bi; }
            int idx[8]; float wv[8]; float wsum = 0.f;
#pragma unroll
            for (int r = 0; r < 8; ++r) { float best = -3e38f; int bi = 0;
                for (int e = 0; e < 64; ++e) { const float v = sel[e]; const bool take = ((gmask >> (e >> 3)) & 1u) && v > best; best = take ? v : best; bi = take ? e : bi; }
                sel[bi] = -3e38f; idx[r] = bi; wv[r] = scp[bi]; wsum += wv[r]; }
            const float sc = 2.5f / wsum; const int tk = t0 + F.tid;
#pragma unroll
            for (int r = 0; r < 8; ++r) { const unsigned pos = __hip_atomic_fetch_add(cnt + idx[r], 1u, __ATOMIC_RELAXED, __HIP_MEMORY_SCOPE_AGENT);
                e_of[tk * 8 + r] = idx[r]; pos_of[tk * 8 + r] = (int)pos; topw[tk * 8 + r] = wv[r] * sc; }
        }
        __syncthreads();
    }
}

__device__ __forceinline__ void build_moe_tab(const Ctx& F) {
    MoeTab tab = moe_tab(F.lds);
    LAS int* padstart = tab.misc + 8;
    if (F.tid < 64) {
        unsigned* cnt = (unsigned*)(F.ws + WS_CTL) + CW_CNT;
        const int c = (int)__hip_atomic_load(cnt + F.tid, __ATOMIC_RELAXED, __HIP_MEMORY_SCOPE_AGENT);
        const int nt = (c + 255) >> 8; int pre = nt;
#pragma unroll
        for (int o = 1; o < 64; o <<= 1) { const int v = __shfl_up(pre, o); if (F.tid >= o) pre += v; }
        const int excl = pre - nt;
        padstart[F.tid] = excl * 256;
        for (int r = 0; r < nt; ++r) { tab.te[excl + r] = F.tid; const int left = c - r * 256; tab.tn[excl + r] = left < 256 ? left : 256; }
        if (F.tid == 63) tab.misc[0] = pre;
    }
    __syncthreads();
}
__device__ __forceinline__ void p9_dispatch(const Ctx& F) {
    build_moe_tab(F);
    const LAS int* padstart = moe_tab(F.lds).misc + 8;
    const int* e_of = (const int*)(F.ws + WS_EOF); const int* pos_of = e_of + 65536; const float* topw = (const float*)(pos_of + 65536); int* inv = (int*)(topw + 65536);
    int* toks = (int*)(F.ws + WS_TOKS); float* wsorted = (float*)(toks + SH_ROW0);
    for (int i = F.bx * 512 + F.tid; i < 65536; i += F.G * 512) { const int e = e_of[i]; const int dest = padstart[e] + pos_of[i]; toks[dest] = i >> 3; wsorted[dest] = topw[i]; inv[i] = dest; }
}
__device__ __forceinline__ void p12_combine(const Ctx& F) {
    const unsigned char* Y = F.ws + WS_Y; const int* inv = (const int*)(F.ws + WS_EOF) + 3 * 65536; const float* g2 = (const float*)(F.ws + WS_MODF) + 5 * D;
    const int gw = F.vcu * 8 + F.wave, NGW = F.G * 8;
    for (int m = gw; m < S; m += NGW) {
        int rows[9];
#pragma unroll
        for (int s = 0; s < 8; ++s) rows[s] = inv[m * 8 + s];
        rows[8] = SH_ROW0 + m;
#pragma unroll
        for (int c = 0; c < 2; ++c) { const int col = c * 1024 + F.lane * 16;
            u32x4 v[9];
#pragma unroll
            for (int s = 0; s < 9; ++s) v[s] = *(const u32x4*)(Y + (size_t)rows[s] * D + col);
            float a[16];
#pragma unroll
            for (int e = 0; e < 16; ++e) a[e] = 0.f;
#pragma unroll
            for (int s = 0; s < 9; ++s) { const unsigned w4[4] = {v[s].x, v[s].y, v[s].z, v[s].w};
#pragma unroll
                for (int q = 0; q < 4; ++q) { const f32x2 lo = __builtin_amdgcn_cvt_pk_f32_fp8((int)w4[q], false), hi = __builtin_amdgcn_cvt_pk_f32_fp8((int)w4[q], true);
                    a[4 * q] += lo.x; a[4 * q + 1] += lo.y; a[4 * q + 2] += hi.x; a[4 * q + 3] += hi.y; } }
            float* op = F.out + (size_t)m * D + col;
#pragma unroll
            for (int q = 0; q < 4; ++q) { const f32x4 x0 = *(const f32x4*)(op + 4 * q); const f32x4 gq = *(const f32x4*)(g2 + col + 4 * q) * (1.0f / FP8_YS);
                *(f32x4*)(op + 4 * q) = x0 + gq * (f32x4){a[4 * q], a[4 * q + 1], a[4 * q + 2], a[4 * q + 3]}; } }
    }
}


__device__ __forceinline__ void ph2_proj(const Ctx& F) {
    pg8::ProjSched<false> Sa; Sa.init(F.ws + WS_H, D * 2, F.ws + WS_WINT, D * 2, F.G, F.bx);
    pg8::ProjSched<true> Sb; Sb.init(F.ws + WS_H8, D, F.ws + WS_WIN8, D, F.G, F.bx);
    EpiBf16 Ea{(bf16_t*)(F.ws + WS_PROJ), INW, 0, 1.0f}; EpiBf16 Eb{(bf16_t*)(F.ws + WS_PROJ), INW, 0, 1.0f / FP8_WIN};
    const int na = Sa.count(), nb = Sb.count(), ntot = na + nb;
    const int slot = ntot > 0 ? ((F.bx >> 3) + (F.bx & 7)) % ntot : 0;
    const int sa = slot < na ? slot : na, sb = slot < na ? 0 : slot - na;
    Sa.i_lo = 0; Sa.i_hi = sa; pg8::gemm_phase<EpiBf16, pg8::ProjSched<false>, true, false>(F.lds, D, Sa, Ea);
    if (slot < na) { __syncthreads(); convert_items(F, CV_BG_FROM, CV_ALL, F.vcu * 8 + F.wave, F.G * 8); __syncthreads(); }
    Sa.i_lo = sa; Sa.i_hi = na; pg8::gemm_phase<EpiBf16, pg8::ProjSched<false>, true, false>(F.lds, D, Sa, Ea);
    Sb.i_lo = 0; Sb.i_hi = sb; pg8::gemm_phase<EpiBf16, pg8::ProjSched<true>, true, true>(F.lds, D, Sb, Eb);
    if (slot >= na) { __syncthreads(); convert_items(F, CV_BG_FROM, CV_ALL, F.vcu * 8 + F.wave, F.G * 8); __syncthreads(); }
    Sb.i_lo = sb; Sb.i_hi = nb; pg8::gemm_phase<EpiBf16, pg8::ProjSched<true>, true, true>(F.lds, D, Sb, Eb);
}
__device__ __forceinline__ void ph6a_merge(const Ctx& F) {
    pg8::DenseSched Sd; Sd.init(F.ws + WS_YA, 1024, F.ws + WS_PA, S, D, 1024, F.G, F.bx);
    EpiGate<false> E{(bf16_t*)(F.ws + WS_MERGED), D, (const bf16_t*)(F.ws + WS_PROJ) + C_GA, INW};
    pg8::gemm_phase<EpiGate<false>, pg8::DenseSched, true>(F.lds, 1024, Sd, E);
}
__device__ __forceinline__ void ph6_merge(const Ctx& F) {
    pg8::DenseSched Sd; Sd.init(F.ws + WS_YB, D, F.ws + WS_PB, S, D, D, F.G, F.bx);
    EpiGate<true> E{(bf16_t*)(F.ws + WS_MERGED), D, (const bf16_t*)(F.ws + WS_PROJ) + C_GB, INW};
    pg8::gemm_phase<EpiGate<true>, pg8::DenseSched, true>(F.lds, D, Sd, E);
}
__device__ __forceinline__ void p5_mix2_a(const Ctx& F) { p5_mix2(F); __syncthreads(); ph6a_merge(F); }
__device__ __forceinline__ void ph7_wo(const Ctx& F) {
    pg8::DenseSched Sd; Sd.init(F.ws + WS_MERGED, D, F.ws + WS_WO, S, D, D, F.G, F.bx);
    EpiResid E{inp(F, IN_X), F.out, D, (const float*)(F.ws + WS_MODF) + 2 * D};
    pg8::gemm_phase<EpiResid, pg8::DenseSched, true>(F.lds, D, Sd, E);
}
__device__ __forceinline__ void ph10_gateup(const Ctx& F) {
    build_moe_tab(F);
    MoeSched1 S1{(const char*)(F.ws + WS_H), (const char*)(F.ws + WS_E1), (const int*)(F.ws + WS_TOKS), moe_tab(F.lds), F.G, F.vcu};
    EpiGateUp E{(unsigned char*)(F.ws + WS_ACT)};
    pg8::gemm_phase<EpiGateUp, MoeSched1, true, true>(F.lds, D, S1, E);
}
__device__ __forceinline__ void ph11_down(const Ctx& F) {
    build_moe_tab(F);
    MoeSched2 S2{(const char*)(F.ws + WS_ACT), (const char*)(F.ws + WS_E2), moe_tab(F.lds), F.G, F.vcu};
    EpiDown E{(unsigned char*)(F.ws + WS_Y), (const float*)(F.ws + WS_TOKS) + SH_ROW0};
    pg8::gemm_phase<EpiDown, MoeSched2, true, true>(F.lds, ED, S2, E);
}

struct Args { const float* in[22]; float* out; unsigned char* ws; int ph_lo, ph_hi; };
__global__ void __launch_bounds__(512, 2) fwd(Args args) {
    extern __shared__ __attribute__((aligned(16))) unsigned char lds_raw[];
    Ctx F;
    F.lds = (LAS unsigned char*)lds_raw;
    F.tid = threadIdx.x; F.lane = F.tid & 63; F.wave = __builtin_amdgcn_readfirstlane(F.tid >> 6);
    F.G = gridDim.x; F.bx = blockIdx.x; F.vcu = (F.G % 8 == 0) ? (F.bx % 8) * (F.G / 8) + F.bx / 8 : F.bx;
    F.out = args.out; F.ws = args.ws;
    if (F.tid == 0) {
#pragma unroll
        for (int i = 0; i < 22; ++i) ((LAS unsigned long long*)(F.lds + LDS_PTRS))[i] = (unsigned long long)args.in[i];
    }
    volatile LAS unsigned* MISC = (volatile LAS unsigned*)(F.lds + LDS_MISC);
    if (F.tid < 64) MISC[F.tid] = 0u;
    __syncthreads();
    unsigned* ctl = (unsigned*)(F.ws + WS_CTL);
    XcdBarrier bar; bar.bar = ctl + CW_BAR; bar.x = 0; bar.st = nullptr;
    if (!MK_PER_PHASE) bar = xcd_barrier_post(ctl + CW_BAR, MISC + 8);
    const int lo = args.ph_lo, hi = args.ph_hi;
#ifndef PHASE_MASK
#define PHASE_MASK 0x1fff
#endif
#define IN(k) (((PHASE_MASK >> (k)) & 1) && lo <= (k) && (k) < hi)
#define SEAM(k) do { if (IN(k) && IN((k) + 1)) xcd_barrier(bar); } while (0)

#ifndef DUP_MASK
#define DUP_MASK 0
#endif
#define RUN(k, fn) do { if (IN(k)) { fn(F); if ((DUP_MASK >> (k)) & 1) { xcd_barrier(bar); fn(F); } } SEAM(k); } while (0)
    RUN(0, p0_prologue);
    RUN(1, p1_norm1);
    RUN(2, ph2_proj);
    RUN(3, p3_mix1);
    RUN(4, p4_scan_comb);
    RUN(5, p5_mix2_a);
    RUN(6, ph6_merge);
    RUN(7, ph7_wo);
    RUN(8, p8_router);
    RUN(9, p9_dispatch);
    RUN(10, ph10_gateup);
    RUN(11, ph11_down);
    RUN(12, p12_combine);
#undef RUN
#undef IN
#undef SEAM
}

extern "C" void kernel_launch(void* const* d_in, const int* in_sizes, int n_in, void* d_out, int out_size, void* d_ws, size_t ws_size, hipStream_t stream) {
    static int grid = 0;
    if (grid == 0) {
        if (n_in != 22 || out_size != S * D || ws_size < WS_END) { fprintf(stderr, "kernel_launch: unexpected shapes / workspace (n_in %d out %d ws %zu need %zu)\n", n_in, out_size, ws_size, (size_t)WS_END); grid = -1; return; }
        int dev = 0, cus = 0, per_cu = 0;
        if (hipGetDevice(&dev) != hipSuccess || hipDeviceGetAttribute(&cus, hipDeviceAttributeMultiprocessorCount, dev) != hipSuccess) { grid = -1; return; }
        if (hipFuncSetAttribute((const void*)fwd, hipFuncAttributeMaxDynamicSharedMemorySize, LDS_BYTES) != hipSuccess) { fprintf(stderr, "kernel_launch: hipFuncSetAttribute failed\n"); grid = -1; return; }
        if (hipOccupancyMaxActiveBlocksPerMultiprocessor(&per_cu, (const void*)fwd, 512, LDS_BYTES) != hipSuccess || per_cu < 1) fprintf(stderr, "kernel_launch: occupancy query says %d\n", per_cu);
        (void)hipGetLastError();
        grid = cus;
    }
    if (grid < 0) return;
    (void)hipMemsetAsync((char*)d_ws + WS_CTL, 0, CTL_ZERO_BYTES, stream);
    Args a{};
    for (int i = 0; i < 22; ++i) a.in[i] = (const float*)d_in[i];
    a.out = (float*)d_out; a.ws = (unsigned char*)d_ws;
#if MK_PER_PHASE
    for (int p = 0; p < NPH; ++p) { a.ph_lo = p; a.ph_hi = p + 1; hipLaunchKernelGGL(fwd, dim3(grid), dim3(512), LDS_BYTES, stream, a); }
#else
    a.ph_lo = 0; a.ph_hi = NPH; hipLaunchKernelGGL(fwd, dim3(grid), dim3(512), LDS_BYTES, stream, a);
#endif
}
```

```cpp
#include <hip/hip_runtime.h>
#include <cstdio>
#include <cstdint>

#define LAS __attribute__((address_space(3)))
#define GAS __attribute__((address_space(1)))
typedef unsigned short bf16_t;
typedef short bf16x8 __attribute__((ext_vector_type(8)));
typedef short bf16x4 __attribute__((ext_vector_type(4)));
typedef float f32x4 __attribute__((ext_vector_type(4)));
typedef float f32x2 __attribute__((ext_vector_type(2)));
typedef float f32x16 __attribute__((ext_vector_type(16)));
typedef unsigned u32x4 __attribute__((ext_vector_type(4)));
typedef unsigned u32x2 __attribute__((ext_vector_type(2)));
typedef GAS unsigned gu32;

#ifndef DUP2_MASK
#define DUP2_MASK 0
#endif
#ifndef MK_PER_PHASE
#define MK_PER_PHASE 0
#endif

constexpr int S = 8192, D = 2048, INW = 19456;
constexpr int C_QA = 0, C_KA = 3072, C_VA = 6144, C_QR = 9216, C_KR = 10240, C_VR = 11264, C_GR = 13312, C_GA = 15360, C_GB = 17408;
constexpr int NE = 64, ED = 512, TOPK = 8;
constexpr int MAXT_R = 320;
constexpr int SH_ROW0 = MAXT_R * 256;
constexpr int NROWS_Y = SH_ROW0 + S;
constexpr int NPH = 13;

constexpr size_t MiB = 1u << 20;
constexpr size_t WS_CTL = 0, CTL_ZERO_BYTES = 1 * MiB;
constexpr size_t WS_MODP = 1 * MiB;
constexpr size_t WS_MODF = 1 * MiB + 512 * 1024;
constexpr size_t WS_LSE = 2 * MiB;
constexpr size_t WS_ROPE = 3 * MiB;
constexpr size_t WS_EOF = 7 * MiB;
constexpr size_t WS_TOKS = 8 * MiB;
constexpr size_t WS_HIST = 8 * MiB + 720896;
constexpr size_t WS_PA = 10 * MiB, WS_PB = 14 * MiB, WS_WO = 22 * MiB;
constexpr size_t WS_H = 32 * MiB;
constexpr size_t WS_E1 = 64 * MiB;
constexpr size_t WS_H8 = 194 * MiB;
constexpr size_t WS_WIN8 = 210 * MiB;
constexpr size_t WS_E2 = 324 * MiB;
constexpr size_t WS_PREV = 454 * MiB;
constexpr size_t WS_YB = 486 * MiB;
constexpr size_t WS_MERGED = 518 * MiB;
constexpr size_t WS_R1 = 550 * MiB;
constexpr size_t WS_OG = WS_R1, WS_YA = WS_R1 + 48 * MiB, WS_UPD = WS_R1 + 64 * MiB, WS_ACT = WS_R1;
constexpr size_t WS_R2 = 678 * MiB;
constexpr size_t WS_WINT = WS_R2, WS_PROJ = WS_R2 + 76 * MiB, WS_Y = WS_R2;
constexpr size_t WS_END = 1058 * MiB;
constexpr int CW_TMO = 0, CW_CODE = 1, CW_BAR = 4096, CW_CNT = 8192;

constexpr int RING_BYTES = 131072;
constexpr int LDS_TAB = 131072;
constexpr int LDS_MISC = 163840 - 256;
constexpr int LDS_BYTES = 163840;

__device__ __forceinline__ float bf2f(unsigned b) { return __uint_as_float(b << 16); }
__device__ __forceinline__ unsigned cvt_pk_bf16(float lo, float hi) { unsigned r; asm("v_cvt_pk_bf16_f32 %0, %1, %2" : "=v"(r) : "v"(lo), "v"(hi)); return r; }
__device__ __forceinline__ float fsilu(float v) { return v / (1.f + __expf(-v)); }
__device__ __forceinline__ float fsigm(float v) { return 1.f / (1.f + __expf(-v)); }
#define TR_READ(dst, base, OFF) asm volatile("ds_read_b64_tr_b16 %0, %1 offset:%2" : "=&v"(dst) : "v"(base), "i"(OFF) : "memory")
#define TR_WAIT2(a, b) asm volatile("s_waitcnt lgkmcnt(0)" : "+v"(a), "+v"(b) :: "memory")
#define TR_WAIT4(a, b, c, d) asm volatile("s_waitcnt lgkmcnt(0)" : "+v"(a), "+v"(b), "+v"(c), "+v"(d) :: "memory")
typedef int i32x8 __attribute__((ext_vector_type(8)));
__device__ __forceinline__ unsigned cvt4_fp8(float a, float b, float c, float d) {
    a = fminf(fmaxf(a, -448.f), 448.f); b = fminf(fmaxf(b, -448.f), 448.f); c = fminf(fmaxf(c, -448.f), 448.f); d = fminf(fmaxf(d, -448.f), 448.f);
    int r = __builtin_amdgcn_cvt_pk_fp8_f32(a, b, 0, false); r = __builtin_amdgcn_cvt_pk_fp8_f32(c, d, r, true); return (unsigned)r;
}
__device__ __forceinline__ i32x8 ld32(const LAS unsigned char* p) { const u32x4 a = *(const LAS u32x4*)p, b = *(const LAS u32x4*)(p + 1024); i32x8 r; r[0] = (int)a.x; r[1] = (int)a.y; r[2] = (int)a.z; r[3] = (int)a.w; r[4] = (int)b.x; r[5] = (int)b.y; r[6] = (int)b.z; r[7] = (int)b.w; return r; }
__device__ __forceinline__ i32x8 cat8(bf16x8 lo, bf16x8 hi) { const u32x4 a = __builtin_bit_cast(u32x4, lo), b = __builtin_bit_cast(u32x4, hi); i32x8 r; r[0] = (int)a.x; r[1] = (int)a.y; r[2] = (int)a.z; r[3] = (int)a.w; r[4] = (int)b.x; r[5] = (int)b.y; r[6] = (int)b.z; r[7] = (int)b.w; return r; }
constexpr float FP8_WIN = 32.f;
#ifndef PROJ_ALL_FP8
#define PROJ_ALL_FP8 1
#endif
__host__ __device__ __forceinline__ bool proj_tile_fp8(int pn) { return PROJ_ALL_FP8 || (pn >= 24 && pn < 36) || pn >= 44; }
constexpr float FP8_WS1 = 32.f, FP8_WS2 = 16.f, FP8_AS = 4.f, FP8_YS = 32.f;
#define LDS_WAIT() asm volatile("s_waitcnt lgkmcnt(0)" ::: "memory")
#define VM_WAIT() asm volatile("s_waitcnt vmcnt(0)" ::: "memory")

namespace pg8 {
constexpr int BM = 256, BK = 64, HALF = 128, HTB = HALF * BK * 2, STAGE_BYTES = 8 * HTB, NXCD = 8, WGM = 8;
__host__ __device__ __forceinline__ int lds_byte(int r, int c) { const int st = (r >> 4) * 2 + (c >> 5), rr = r & 15, cc = c & 31, ob = rr * 64 + cc * 2; return st * 1024 + (ob ^ (((ob >> 9) & 1) << 5)); }
__host__ __device__ __forceinline__ void stage_rc(int b, int& R, int& C) { const int st = b / 1024, sb = b % 1024, swz = sb ^ (((sb >> 9) & 1) << 5); R = (st >> 1) * 16 + swz / 64; C = (st & 1) * 32 + (swz % 64) / 2; }
__host__ __device__ __forceinline__ int perm32(int rho) { const int n = rho >> 4, i = rho & 15; return 8 * (i >> 2) + 4 * n + (i & 3); }

struct Unit { int row0, pn, e, nvalid; };

struct DenseSched {
    static constexpr bool RAGGED = false;
    const char* A; const char* Bt; int lda, K; int nM, nN, nwg, G, c, i_lo, i_hi;
    __device__ __forceinline__ void init(const void* A_, int lda_, const void* Bt_, int M, int N, int K_, int G_, int c_) { A = (const char*)A_; Bt = (const char*)Bt_; lda = lda_; K = K_; nM = M / BM; nN = N / BM; nwg = nM * nN; G = G_; c = c_; i_lo = 0; i_hi = 0x7fffffff; }
    __device__ __forceinline__ bool next(int i, Unit& u) const {
        if (i_lo + i >= i_hi) return false;
        const long L = (long)(i_lo + i) * G + c; if (L >= nwg) return false;
        int wgid = (int)L; { const int q = nwg / NXCD, r = nwg % NXCD, xcd = wgid % NXCD, off = wgid / NXCD; wgid = (xcd < r ? xcd * (q + 1) : r * (q + 1) + (xcd - r) * q) + off; }
        const int nig = WGM * nN, gid = wgid / nig, fm = gid * WGM, gsz = (nM - fm) < WGM ? (nM - fm) : WGM;
        u.row0 = (fm + ((wgid % nig) % gsz)) * BM; u.pn = (wgid % nig) / gsz; u.e = 0; u.nvalid = 256; return true;
    }
    __device__ __forceinline__ const char* a_base() const { return A; }
    __device__ __forceinline__ const char* b_ptr(const Unit& u) const { return Bt + (size_t)u.pn * BM * K * 2; }
    __device__ __forceinline__ void a_off(const Unit& u, int tid, unsigned (&off)[2][2]) const {
#pragma unroll
        for (int i = 0; i < 2; ++i) { int R, C; stage_rc(tid * 16 + i * 8192, R, C);
            off[0][i] = (unsigned)((u.row0 + R) * lda + C) * 2u; off[1][i] = (unsigned)((u.row0 + HALF + R) * lda + C) * 2u; }
    }
};


template <bool FP8SET> struct ProjSched {
    static constexpr bool RAGGED = false;
    static constexpr int ntl = PROJ_ALL_FP8 ? (FP8SET ? 76 : 0) : (FP8SET ? 44 : 32), nM = 32, nwg = nM * ntl;
    const char* A; const char* Bt; int apitch, bpitch; int G, c, i_lo, i_hi;
    __device__ __forceinline__ void init(const void* A_, int apitch_, const void* Bt_, int bpitch_, int G_, int c_) { A = (const char*)A_; Bt = (const char*)Bt_; apitch = apitch_; bpitch = bpitch_; G = G_; c = c_; i_lo = 0; i_hi = 0x7fffffff; }
    __device__ __forceinline__ int count() const { return c < nwg ? (nwg - c + G - 1) / G : 0; }
    __device__ __forceinline__ bool next(int i, Unit& u) const {
        if (i_lo + i >= i_hi) return false;
        const long L = (long)(i_lo + i) * G + c; if (L >= nwg) return false;
        int wgid = (int)L; { const int q = nwg / NXCD, r = nwg % NXCD, xcd = wgid % NXCD, off = wgid / NXCD; wgid = (xcd < r ? xcd * (q + 1) : r * (q + 1) + (xcd - r) * q) + off; }
        const int nig = WGM * ntl, gid = wgid / nig, fm = gid * WGM, gsz = (nM - fm) < WGM ? (nM - fm) : WGM;
        u.row0 = (fm + ((wgid % nig) % gsz)) * BM; const int t = (wgid % nig) / gsz;
        u.pn = PROJ_ALL_FP8 ? t : (FP8SET ? (t < 12 ? 24 + t : 32 + t) : (t < 24 ? t : t + 12)); u.e = 0; u.nvalid = 256; return true;
    }
    __device__ __forceinline__ const char* a_base() const { return A; }
    __device__ __forceinline__ const char* b_ptr(const Unit& u) const { return Bt + (size_t)u.pn * BM * bpitch; }
    __device__ __forceinline__ void a_off(const Unit& u, int tid, unsigned (&off)[2][2]) const {
#pragma unroll
        for (int i = 0; i < 2; ++i) { int R, C; stage_rc(tid * 16 + i * 8192, R, C);
            off[0][i] = (unsigned)((u.row0 + R) * apitch + 2 * C); off[1][i] = (unsigned)((u.row0 + HALF + R) * apitch + 2 * C); }
    }
};

template <class Epi, class Sched, bool ALIGN_EPI, bool FP8 = false>
__device__ __forceinline__ void gemm_phase(LAS unsigned char* lds, const int K, const Sched& S, const Epi& E) {
    const int tid = threadIdx.x, wid = __builtin_amdgcn_readfirstlane(tid >> 6), lane = tid & 63, wr = wid >> 2, wc = wid & 3, fr = lane & 15, fq = lane >> 4;
    const int nt = FP8 ? K / 128 : K / BK;
    const int pitch = FP8 ? K : 2 * K;
    unsigned voffB[2];
#pragma unroll
    for (int i = 0; i < 2; ++i) { int R, C; stage_rc(tid * 16 + i * 8192, R, C); const int Rb = Epi::PERM ? ((R & ~31) + perm32(R & 31)) : R; voffB[i] = (unsigned)(Rb * pitch + 2 * C); }
    const size_t kstep = (size_t)(BK * 2);
    const size_t hstepB = (size_t)HALF * pitch;
    const unsigned ldsw = (unsigned)wid * 1024u;
    const int aoff = lds_byte(wr * 64 + fr, fq * 8), boff = lds_byte(wc * 32 + fr, fq * 8);
#define PG8_SA(b, h) (((b) * 2 + (h)) * HTB)
#define PG8_SB(b, h) ((4 + (b) * 2 + (h)) * HTB)
#define PG8_STAGE(bufoff, gbase, voff) do { _Pragma("unroll") for (int _i = 0; _i < 2; ++_i) \
        __builtin_amdgcn_global_load_lds((const unsigned*)((const char*)(gbase) + (voff)[_i]), (LAS unsigned*)(lds + (bufoff) + ldsw + _i * 8192), 16, 0, 0); } while (0)
#define PG8_LDA(dst, b, h) do { if constexpr (FP8) { _Pragma("unroll") for (int m = 0; m < 4; ++m) dst##8[m] = ld32(lds + PG8_SA(b, h) + aoff + m * 2048); } \
        else { _Pragma("unroll") for (int m = 0; m < 4; ++m) _Pragma("unroll") for (int k = 0; k < 2; ++k) dst[m][k] = *(const LAS bf16x8*)(lds + PG8_SA(b, h) + aoff + m * 2048 + k * 1024); } } while (0)
#define PG8_LDB(dst, b, h) do { if constexpr (FP8) { _Pragma("unroll") for (int n = 0; n < 2; ++n) dst##8[n] = ld32(lds + PG8_SB(b, h) + boff + n * 2048); } \
        else { _Pragma("unroll") for (int n = 0; n < 2; ++n) _Pragma("unroll") for (int k = 0; k < 2; ++k) dst[n][k] = *(const LAS bf16x8*)(lds + PG8_SB(b, h) + boff + n * 2048 + k * 1024); } } while (0)
#define PG8_MMA(ai, bj, At, Bt) do { __builtin_amdgcn_s_setprio(1); if constexpr (FP8) { _Pragma("unroll") for (int m = 0; m < 4; ++m) _Pragma("unroll") for (int n = 0; n < 2; ++n) \
        asm volatile("v_mfma_scale_f32_16x16x128_f8f6f4 %0, %1, %2, %0, %3, %3 op_sel_hi:[0,0,0]" : "+v"(acc[ai][bj][m][n]) : "v"(Bt##8[n]), "v"(At##8[m]), "v"(fp8_one)); } \
      else { _Pragma("unroll") for (int m = 0; m < 4; ++m) _Pragma("unroll") for (int n = 0; n < 2; ++n) _Pragma("unroll") for (int k = 0; k < 2; ++k) \
        acc[ai][bj][m][n] = __builtin_amdgcn_mfma_f32_16x16x32_bf16(Bt[n][k], At[m][k], acc[ai][bj][m][n], 0, 0, 0); } __builtin_amdgcn_s_setprio(0); } while (0)
#define PG8_WAIT_V(n) asm volatile("s_waitcnt vmcnt(" #n ")" ::: "memory")
#define PG8_WAIT_L(n) asm volatile("s_waitcnt lgkmcnt(" #n ")" ::: "memory")
#define PG8_BAR __builtin_amdgcn_s_barrier()
#define PG8_SCHED __builtin_amdgcn_sched_barrier(0)
    Unit cur, nxt; int ui = 0;
    if (!S.next(0, cur)) return;
    f32x4 acc[2][2][4][2];
#pragma unroll
    for (int a = 0; a < 2; ++a)
#pragma unroll
        for (int b = 0; b < 2; ++b)
#pragma unroll
            for (int m = 0; m < 4; ++m)
#pragma unroll
                for (int n = 0; n < 2; ++n) acc[a][b][m][n] = (f32x4){0.f, 0.f, 0.f, 0.f};
    bf16x8 At[4][2], B0[2][2], B1[2][2];
    i32x8 At8[4], B08[2], B18[2];
    const int fp8_one = 0x7f7f7f7f;
    unsigned coff[2][2], noff[2][2];
    S.a_off(cur, tid, coff);
    const char* const Ab = S.a_base();
    const char* cB = S.b_ptr(cur);
    PG8_STAGE(PG8_SB(0, 0), cB, voffB); PG8_STAGE(PG8_SB(0, 1), cB + hstepB, voffB); PG8_STAGE(PG8_SA(0, 0), Ab, coff[0]); PG8_STAGE(PG8_SA(0, 1), Ab, coff[1]);
    if (wr == 1) PG8_BAR;
    PG8_WAIT_V(2); PG8_BAR;
    PG8_STAGE(PG8_SB(1, 0), cB + kstep, voffB); PG8_STAGE(PG8_SA(1, 0), Ab + kstep, coff[0]); PG8_STAGE(PG8_SB(1, 1), cB + hstepB + kstep, voffB);
    PG8_WAIT_V(6); PG8_BAR;
    for (;;) {
        const bool has_next = S.next(ui + 1, nxt);
        const char* nB = has_next ? S.b_ptr(nxt) : cB;
        for (int t = 0; t < nt; t += 2) {
            const bool last = (t == nt - 2);
            const char* a1 = Ab + (size_t)(t + 1) * kstep;
            const char* a2 = last ? Ab : Ab + (size_t)(t + 2) * kstep; const char* b2 = last ? nB : cB + (size_t)(t + 2) * kstep;
            const char* a3 = a2 + kstep; const char* b3 = b2 + kstep;
            if (last && has_next) S.a_off(nxt, tid, noff);
            PG8_LDB(B0, 0, 0); PG8_LDB(B1, 0, 1); PG8_SCHED; PG8_LDA(At, 0, 0); PG8_STAGE(PG8_SA(1, 1), a1, coff[1]);
            PG8_WAIT_V(8); PG8_WAIT_L(0); PG8_BAR; PG8_MMA(0, 0, At, B0); PG8_MMA(0, 1, At, B1); PG8_BAR; PG8_SCHED;
            if (last && has_next) { coff[0][0] = noff[0][0]; coff[0][1] = noff[0][1]; coff[1][0] = noff[1][0]; coff[1][1] = noff[1][1]; }
            PG8_LDA(At, 0, 1); PG8_STAGE(PG8_SB(0, 0), b2, voffB); PG8_STAGE(PG8_SB(0, 1), b2 + hstepB, voffB); PG8_STAGE(PG8_SA(0, 0), a2, coff[0]);
            PG8_WAIT_V(8); PG8_WAIT_L(0); PG8_BAR; if (!Sched::RAGGED || cur.nvalid > HALF) { PG8_MMA(1, 0, At, B0); PG8_MMA(1, 1, At, B1); } PG8_BAR; PG8_SCHED;
            PG8_LDB(B0, 1, 0); PG8_LDB(B1, 1, 1); PG8_SCHED; PG8_LDA(At, 1, 0); PG8_STAGE(PG8_SA(0, 1), a2, coff[1]);
            PG8_WAIT_V(8); PG8_WAIT_L(0); PG8_BAR; PG8_MMA(0, 0, At, B0); PG8_MMA(0, 1, At, B1); PG8_BAR; PG8_SCHED;
            PG8_LDA(At, 1, 1); PG8_STAGE(PG8_SB(1, 0), b3, voffB); PG8_STAGE(PG8_SB(1, 1), b3 + hstepB, voffB); PG8_STAGE(PG8_SA(1, 0), a3, coff[0]);
            PG8_WAIT_V(8); PG8_WAIT_L(0); PG8_BAR; if (!Sched::RAGGED || cur.nvalid > HALF) { PG8_MMA(1, 0, At, B0); PG8_MMA(1, 1, At, B1); } PG8_BAR; PG8_SCHED;
        }
        if constexpr (ALIGN_EPI) { if (wr == 0) PG8_BAR; }
        if constexpr (FP8) asm volatile("s_nop 15\n\ts_nop 15\n\ts_nop 15" ::: "memory");
        E(acc, cur, wr, wc, fr, fq);
        if (!has_next) break;
#pragma unroll
        for (int a = 0; a < 2; ++a)
#pragma unroll
            for (int b = 0; b < 2; ++b)
#pragma unroll
                for (int m = 0; m < 4; ++m)
#pragma unroll
                    for (int n = 0; n < 2; ++n) acc[a][b][m][n] = (f32x4){0.f, 0.f, 0.f, 0.f};
        cur = nxt; cB = nB; ++ui;
        if constexpr (ALIGN_EPI) { if (wr == 1) PG8_BAR; }
    }
    PG8_WAIT_V(0);
    if constexpr (!ALIGN_EPI) { if (wr == 0) PG8_BAR; }
    PG8_BAR;
#undef PG8_SA
#undef PG8_SB
#undef PG8_STAGE
#undef PG8_LDA
#undef PG8_LDB
#undef PG8_MMA
#undef PG8_WAIT_V
#undef PG8_WAIT_L
#undef PG8_BAR
#undef PG8_SCHED
}
}
using pg8::Unit;

struct EpiBf16 {
    static constexpr bool PERM = true;
    bf16_t* O; int ldc; int nostore; float scale;
    __device__ __forceinline__ void operator()(const f32x4 (&acc)[2][2][4][2], const Unit& u, int wr, int wc, int fr, int fq) const {
        const int row0 = u.row0 + wr * 64 + fr, col0 = u.pn * 256 + wc * 32 + 8 * fq;
#pragma unroll
        for (int ai = 0; ai < 2; ++ai)
#pragma unroll
            for (int m = 0; m < 4; ++m) { bf16_t* rowp = O + (size_t)(row0 + ai * 128 + m * 16) * ldc + col0;
#pragma unroll
                for (int bj = 0; bj < 2; ++bj) { const f32x4 v0 = acc[ai][bj][m][0] * scale, v1 = acc[ai][bj][m][1] * scale;
                    u32x4 w; w.x = cvt_pk_bf16(v0[0], v0[1]); w.y = cvt_pk_bf16(v0[2], v0[3]); w.z = cvt_pk_bf16(v1[0], v1[1]); w.w = cvt_pk_bf16(v1[2], v1[3]);
                    if (!nostore) *(u32x4*)(rowp + bj * 128) = w; else asm volatile("" :: "v"(w)); } }
    }
};
template <bool ADD> struct EpiGate {
    static constexpr bool PERM = true;
    bf16_t* O; int ldc; const bf16_t* gate; int ldg;
    __device__ __forceinline__ void operator()(const f32x4 (&acc)[2][2][4][2], const Unit& u, int wr, int wc, int fr, int fq) const {
        const int row0 = u.row0 + wr * 64 + fr, col0 = u.pn * 256 + wc * 32 + 8 * fq;
#pragma unroll
        for (int ai = 0; ai < 2; ++ai)
#pragma unroll
            for (int m = 0; m < 4; ++m) { const size_t r = (size_t)(row0 + ai * 128 + m * 16); bf16_t* rowp = O + r * ldc + col0; const bf16_t* gp = gate + r * ldg + col0;
#pragma unroll
                for (int bj = 0; bj < 2; ++bj) { const f32x4 v0 = acc[ai][bj][m][0], v1 = acc[ai][bj][m][1];
                    const u32x4 g = *(const u32x4*)(gp + bj * 128);
                    float o[8];
                    o[0] = fsigm(bf2f(g.x & 0xffffu)) * v0[0]; o[1] = fsigm(bf2f(g.x >> 16)) * v0[1]; o[2] = fsigm(bf2f(g.y & 0xffffu)) * v0[2]; o[3] = fsigm(bf2f(g.y >> 16)) * v0[3];
                    o[4] = fsigm(bf2f(g.z & 0xffffu)) * v1[0]; o[5] = fsigm(bf2f(g.z >> 16)) * v1[1]; o[6] = fsigm(bf2f(g.w & 0xffffu)) * v1[2]; o[7] = fsigm(bf2f(g.w >> 16)) * v1[3];
                    if (ADD) { const u32x4 p = *(const u32x4*)(rowp + bj * 128);
                        o[0] += bf2f(p.x & 0xffffu); o[1] += bf2f(p.x >> 16); o[2] += bf2f(p.y & 0xffffu); o[3] += bf2f(p.y >> 16);
                        o[4] += bf2f(p.z & 0xffffu); o[5] += bf2f(p.z >> 16); o[6] += bf2f(p.w & 0xffffu); o[7] += bf2f(p.w >> 16); }
                    u32x4 w; w.x = cvt_pk_bf16(o[0], o[1]); w.y = cvt_pk_bf16(o[2], o[3]); w.z = cvt_pk_bf16(o[4], o[5]); w.w = cvt_pk_bf16(o[6], o[7]);
                    *(u32x4*)(rowp + bj * 128) = w; } }
    }
};
struct EpiResid {
    static constexpr bool PERM = false;
    const float* base; float* out; int ldc; const float* gvec;
    __device__ __forceinline__ void operator()(const f32x4 (&acc)[2][2][4][2], const Unit& u, int wr, int wc, int fr, int fq) const {
        const int row0 = u.row0 + wr * 64 + fr, col0 = u.pn * 256 + wc * 32 + 4 * fq;
        f32x4 gv[2][2];
#pragma unroll
        for (int bj = 0; bj < 2; ++bj)
#pragma unroll
            for (int n = 0; n < 2; ++n) gv[bj][n] = *(const f32x4*)(gvec + col0 + bj * 128 + n * 16);
#pragma unroll
        for (int ai = 0; ai < 2; ++ai)
#pragma unroll
            for (int m = 0; m < 4; ++m) { const size_t off = (size_t)(row0 + ai * 128 + m * 16) * ldc + col0;
#pragma unroll
                for (int bj = 0; bj < 2; ++bj)
#pragma unroll
                    for (int n = 0; n < 2; ++n) { const f32x4 bs = *(const f32x4*)(base + off + bj * 128 + n * 16); *(f32x4*)(out + off + bj * 128 + n * 16) = bs + gv[bj][n] * acc[ai][bj][m][n]; } }
    }
};
struct EpiGateUp {
    static constexpr bool PERM = true;
    unsigned char* ACT;
    __device__ __forceinline__ void operator()(const f32x4 (&acc)[2][2][4][2], const Unit& u, int wr, int wc, int fr, int fq) const {
        const int row0 = u.row0 + wr * 64 + fr, col0 = u.pn * 128 + wc * 32 + 8 * fq;
        constexpr float ws = 1.0f / FP8_WS1;
#pragma unroll
        for (int ai = 0; ai < 2; ++ai)
#pragma unroll
            for (int m = 0; m < 4; ++m) { unsigned char* rowp = ACT + (size_t)(row0 + ai * 128 + m * 16) * ED + col0;
                const f32x4 g0 = acc[ai][0][m][0] * ws, g1 = acc[ai][0][m][1] * ws, u0 = acc[ai][1][m][0] * (ws * FP8_AS), u1 = acc[ai][1][m][1] * (ws * FP8_AS);
                u32x2 w; w.x = cvt4_fp8(fsilu(g0[0]) * u0[0], fsilu(g0[1]) * u0[1], fsilu(g0[2]) * u0[2], fsilu(g0[3]) * u0[3]);
                w.y = cvt4_fp8(fsilu(g1[0]) * u1[0], fsilu(g1[1]) * u1[1], fsilu(g1[2]) * u1[2], fsilu(g1[3]) * u1[3]);
                *(u32x2*)rowp = w; }
    }
};
struct EpiDown {
    static constexpr bool PERM = true;
    unsigned char* Y; const float* wsorted;
    __device__ __forceinline__ void operator()(const f32x4 (&acc)[2][2][4][2], const Unit& u, int wr, int wc, int fr, int fq) const {
        const int rl0 = wr * 64 + fr, col0 = u.pn * 256 + wc * 32 + 8 * fq;
#pragma unroll
        for (int ai = 0; ai < 2; ++ai)
#pragma unroll
            for (int m = 0; m < 4; ++m) { const int rl = rl0 + ai * 128 + m * 16; const int row = u.row0 + rl;
                float wv = 1.f; if (u.e < NE) wv = (rl < u.nvalid) ? wsorted[row] : 0.f;
                wv *= FP8_YS / (FP8_WS2 * FP8_AS);
                unsigned char* rowp = Y + (size_t)row * D + col0;
#pragma unroll
                for (int bj = 0; bj < 2; ++bj) { const f32x4 v0 = acc[ai][bj][m][0] * wv, v1 = acc[ai][bj][m][1] * wv;
                    u32x2 w; w.x = cvt4_fp8(v0[0], v0[1], v0[2], v0[3]); w.y = cvt4_fp8(v1[0], v1[1], v1[2], v1[3]);
                    *(u32x2*)(rowp + bj * 128) = w; } }
    }
};

struct MoeTab { LAS int* te; LAS int* tn; LAS int* misc; };
__device__ __forceinline__ MoeTab moe_tab(LAS unsigned char* lds) { MoeTab t; t.te = (LAS int*)(lds + LDS_TAB); t.tn = t.te + 352; t.misc = t.tn + 352; return t; }
struct MoeSched1 {
    static constexpr bool RAGGED = true;
    const char* H2; const char* E1; const int* toks; MoeTab tab; int G, vcu;
    __device__ __forceinline__ bool next(int i, Unit& u) const {
        const int ntr = tab.misc[0]; const int L = i * G + vcu; if (L >= 4 * (ntr + 32)) return false;
        const int t = L >> 2; u.pn = L & 3;
        if (t < ntr) { u.row0 = t * 256; u.e = tab.te[t]; u.nvalid = tab.tn[t]; } else { u.row0 = SH_ROW0 + (t - ntr) * 256; u.e = NE; u.nvalid = 256; }
        return true;
    }
    __device__ __forceinline__ const char* a_base() const { return H2; }
    __device__ __forceinline__ const char* b_ptr(const Unit& u) const { return E1 + ((size_t)u.e * 1024 + (size_t)u.pn * 256) * D; }
    __device__ __forceinline__ void a_off(const Unit& u, int tid, unsigned (&off)[2][2]) const {
#pragma unroll
        for (int i = 0; i < 2; ++i) { int R, C; pg8::stage_rc(tid * 16 + i * 8192, R, C);
#pragma unroll
            for (int h = 0; h < 2; ++h) { const int r = h * 128 + R; int tok;
                if (u.e < NE) tok = (r < u.nvalid) ? toks[u.row0 + r] : 0; else tok = u.row0 - SH_ROW0 + r;
                off[h][i] = (unsigned)(tok * D + 2 * C); } }
    }
};
struct MoeSched2 {
    static constexpr bool RAGGED = true;
    const char* ACT; const char* E2; MoeTab tab; int G, vcu;
    __device__ __forceinline__ bool next(int i, Unit& u) const {
        const int ntr = tab.misc[0]; const int L = i * G + vcu; if (L >= 8 * (ntr + 32)) return false;
        const int t = L >> 3; u.pn = L & 7;
        if (t < ntr) { u.row0 = t * 256; u.e = tab.te[t]; u.nvalid = tab.tn[t]; } else { u.row0 = SH_ROW0 + (t - ntr) * 256; u.e = NE; u.nvalid = 256; }
        return true;
    }
    __device__ __forceinline__ const char* a_base() const { return ACT; }
    __device__ __forceinline__ const char* b_ptr(const Unit& u) const { return E2 + ((size_t)u.e * 2048 + (size_t)u.pn * 256) * ED; }
    __device__ __forceinline__ void a_off(const Unit& u, int tid, unsigned (&off)[2][2]) const {
#pragma unroll
        for (int i = 0; i < 2; ++i) { int R, C; pg8::stage_rc(tid * 16 + i * 8192, R, C);
            off[0][i] = (unsigned)((u.row0 + R) * ED + 2 * C); off[1][i] = (unsigned)((u.row0 + 128 + R) * ED + 2 * C); }
    }
};

#define XB_TMO      128
#define XB_XCNT(j)  (256  + 64 * (j))
#define XB_XSUB(j)  (1280 + 64 * (j))
#define XB_XGEN(j)  (2304 + 64 * (j))
#define XB_TOP      3328
#define XB_TOPGEN   3392
#define XCD_BAR_WORDS 3456
#define XB_SPIN_CAP (1u << 18)
__device__ __forceinline__ unsigned xb_ld(unsigned* p)              { return __hip_atomic_load(p, __ATOMIC_RELAXED, __HIP_MEMORY_SCOPE_AGENT); }
__device__ __forceinline__ unsigned xb_add(unsigned* p, unsigned v) { return __hip_atomic_fetch_add(p, v, __ATOMIC_RELAXED, __HIP_MEMORY_SCOPE_AGENT); }
__device__ __forceinline__ unsigned xb_xcc_id() { return (unsigned)__builtin_amdgcn_s_getreg((3 << 11) | 20) & 0xFu; }
#define XB_SPIN(cond, bar) do { unsigned _sp = 0; while (cond) { __builtin_amdgcn_s_sleep(1); \
    if ((++_sp & 255u) == 0u) { if (xb_ld(&(bar)[XB_TMO])) break; if (_sp > XB_SPIN_CAP) { atomicAdd(&(bar)[XB_TMO], 1u); break; } } } } while (0)
struct XcdBarrier { unsigned* bar; unsigned x; volatile LAS unsigned* st; };
__device__ __forceinline__ XcdBarrier xcd_barrier_post(unsigned* bar, volatile LAS unsigned* st) {
    XcdBarrier b; b.bar = bar; b.x = xb_xcc_id(); b.st = st;
    if (threadIdx.x == 0) (void)xb_add(&bar[XB_XCNT(b.x)], 1u);
    return b;
}
__device__ __forceinline__ void xcd_barrier_complete(unsigned* bar, unsigned x, unsigned& nloc, unsigned& nx) {
    const unsigned G = gridDim.x * gridDim.y * gridDim.z;
    unsigned sum, cnt, mine, sp = 0u;
    for (;;) {
        sum = 0u; cnt = 0u; mine = 0u;
#pragma unroll
        for (unsigned j = 0; j < 16; ++j) { const unsigned c = xb_ld(&bar[XB_XCNT(j)]); sum += c; cnt += (c > 0u) ? 1u : 0u; mine = (j == x) ? c : mine; }
        if (sum == G) break;
        __builtin_amdgcn_s_sleep(1);
        if ((++sp & 255u) == 0u) { if (xb_ld(&bar[XB_TMO])) break; if (sp > XB_SPIN_CAP) { atomicAdd(&bar[XB_TMO], 1u); break; } }
    }
    nloc = mine > 0u ? mine : 1u; nx = cnt > 0u ? cnt : 1u;
}
__device__ __forceinline__ void xcd_barrier(const XcdBarrier& b) {
    asm volatile("s_waitcnt vmcnt(0)" ::: "memory");
    __syncthreads();
    if (threadIdx.x == 0) {
        unsigned* bar = b.bar;
        __builtin_amdgcn_s_waitcnt(0);
        unsigned nloc = b.st[0], nx = b.st[1];
        if (nloc == 0u) { xcd_barrier_complete(bar, b.x, nloc, nx); b.st[0] = nloc; b.st[1] = nx; }
        const unsigned old = xb_add(&bar[XB_XSUB(b.x)], 1u);
        const unsigned gen = old / nloc;
        if (old + 1u == (gen + 1u) * nloc) {
            __builtin_amdgcn_fence(__ATOMIC_RELEASE, "agent");
            asm volatile("s_waitcnt vmcnt(0)" ::: "memory");
            const unsigned og = xb_add(&bar[XB_TOP], 1u);
            const unsigned tg = og / nx;
            if (og + 1u == (tg + 1u) * nx) xb_add(&bar[XB_TOPGEN], 1u);
            else XB_SPIN(xb_ld(&bar[XB_TOPGEN]) == tg, bar);
            __builtin_amdgcn_fence(__ATOMIC_ACQUIRE, "agent");
            xb_add(&bar[XB_XGEN(b.x)], 1u);
            asm volatile("s_waitcnt vmcnt(0)" ::: "memory");
        } else {
            XB_SPIN(xb_ld(&bar[XB_XGEN(b.x)]) == gen, bar);
            __builtin_amdgcn_fence(__ATOMIC_ACQUIRE, "agent");
            asm volatile("s_waitcnt vmcnt(0)" ::: "memory");
        }
    }
    __syncthreads();
}

struct Ctx {
    LAS unsigned char* lds;
    int tid, lane, wave, G, vcu, bx;
    float* out; unsigned char* ws;
};
constexpr int LDS_PTRS = 163840 - 512;
__device__ __forceinline__ const float* inp(const Ctx& F, int i) {
    const LAS unsigned* p = (const LAS unsigned*)(F.lds + LDS_PTRS) + 2 * i;
    const unsigned lo = __builtin_amdgcn_readfirstlane(p[0]), hi = __builtin_amdgcn_readfirstlane(p[1]);
    return (const float*)(const GAS float*)(((unsigned long long)hi << 32) | lo);
}
#define IN_X 0
#define IN_C 1
#define IN_RELB 2
#define IN_WADA 3
#define IN_BADA 4
#define IN_LN1 5
#define IN_WIN 6
#define IN_QNG 7
#define IN_KNG 8
#define IN_GNG 9
#define IN_PA 10
#define IN_PB 11
#define IN_WO 12
#define IN_LN2 13
#define IN_RW 14
#define IN_RB 15
#define IN_WG 16
#define IN_WU 17
#define IN_WD 18
#define IN_WGS 19
#define IN_WUS 20
#define IN_WDS 21

struct CvItem { const float* src; unsigned char* dst; int ldw, ldt; float scale; };
constexpr int CV_WIN = 32 * 304, CV_PA = 16 * 32, CV_PB = 32 * 32, CV_WO = 32 * 32, CV_EX = 768;
constexpr int CV_DENSE = CV_WIN + CV_PA + CV_PB + CV_WO, CV_ALL = CV_DENSE + 65 * CV_EX;
#ifndef CV_BG_FROM
#define CV_BG_FROM CV_DENSE
#endif
__device__ __forceinline__ void cv_kn(int q, int nbg_count, int& kb, int& nb) {
    const int super = q >> 3, sub = q & 7; kb = (super / nbg_count) * 4 + (sub >> 1); nb = (super % nbg_count) * 2 + (sub & 1);
}
__device__ __forceinline__ CvItem cv_decode(const Ctx& F, int it) {
    CvItem c; int r = it; int kb, nb; c.scale = 0.f;
    if (r < CV_WIN) { cv_kn(r, 152, kb, nb); c.ldw = INW; c.src = inp(F, IN_WIN) + (size_t)(64 * kb) * INW + 64 * nb;
        if (proj_tile_fp8(nb >> 2)) { c.ldt = D; c.scale = FP8_WIN; c.dst = F.ws + WS_WIN8 + (size_t)(64 * nb) * D + 64 * kb; }
        else { c.ldt = D * 2; c.dst = F.ws + WS_WINT + ((size_t)(64 * nb) * D + 64 * kb) * 2; }
        return c; } r -= CV_WIN;
    if (r < CV_PA) { cv_kn(r, 16, kb, nb); c.ldw = D; c.ldt = 1024 * 2; c.src = inp(F, IN_PA) + (size_t)(64 * kb) * D + 64 * nb; c.dst = F.ws + WS_PA + ((size_t)(64 * nb) * 1024 + 64 * kb) * 2; return c; } r -= CV_PA;
    if (r < CV_PB) { cv_kn(r, 16, kb, nb); c.ldw = D; c.ldt = D * 2; c.src = inp(F, IN_PB) + (size_t)(64 * kb) * D + 64 * nb; c.dst = F.ws + WS_PB + ((size_t)(64 * nb) * D + 64 * kb) * 2; return c; } r -= CV_PB;
    if (r < CV_WO) { cv_kn(r, 16, kb, nb); c.ldw = D; c.ldt = D * 2; c.src = inp(F, IN_WO) + (size_t)(64 * kb) * D + 64 * nb; c.dst = F.ws + WS_WO + ((size_t)(64 * nb) * D + 64 * kb) * 2; return c; } r -= CV_WO;
    const int e = r / CV_EX; int q = r % CV_EX;
    if (q < 512) {
        const int isup = q >> 8; q &= 255; cv_kn(q, 4, kb, nb); const int n0 = 64 * nb;
        const float* w = (e < NE) ? inp(F, isup ? IN_WU : IN_WG) + (size_t)e * D * ED : inp(F, isup ? IN_WUS : IN_WGS);
        c.ldw = ED; c.ldt = D; c.scale = FP8_WS1; c.src = w + (size_t)(64 * kb) * ED + n0;
        c.dst = F.ws + WS_E1 + ((size_t)e * 1024 + (size_t)((n0 >> 7) * 256 + (n0 & 127) + isup * 128)) * D + 64 * kb;
    } else {
        q -= 512; cv_kn(q, 16, kb, nb);
        const float* w = (e < NE) ? inp(F, IN_WD) + (size_t)e * ED * D : inp(F, IN_WDS);
        c.ldw = D; c.ldt = ED; c.scale = FP8_WS2; c.src = w + (size_t)(64 * kb) * D + 64 * nb;
        c.dst = F.ws + WS_E2 + ((size_t)e * D + (size_t)(64 * nb)) * ED + 64 * kb;
    }
    return c;
}
__device__ __forceinline__ void cv_load(const CvItem& c, int lane, f32x4 (&v)[16]) {
    const int r4 = lane >> 4, c16 = lane & 15;
#pragma unroll
    for (int i = 0; i < 16; ++i) v[i] = *(const f32x4*)(c.src + (size_t)(4 * i + r4) * c.ldw + 4 * c16);
}
__device__ __forceinline__ void cv_store(const CvItem& c, int lane, const f32x4 (&v)[16], LAS float* scr) {
    const int r4 = lane >> 4, c16 = lane & 15;
#pragma unroll
    for (int i = 0; i < 16; ++i) { LAS float* d = scr + (4 * i + r4) * 65 + 4 * c16; d[0] = v[i].x; d[1] = v[i].y; d[2] = v[i].z; d[3] = v[i].w; }
    LDS_WAIT(); asm volatile("" ::: "memory");
    const int cc = lane & 7;
    if (c.scale == 0.f) {
#pragma unroll
        for (int j = 0; j < 8; ++j) { const int n = (lane >> 3) + 8 * j; const LAS float* s = scr + (8 * cc) * 65 + n;
            u32x4 o; o.x = cvt_pk_bf16(s[0 * 65], s[1 * 65]); o.y = cvt_pk_bf16(s[2 * 65], s[3 * 65]); o.z = cvt_pk_bf16(s[4 * 65], s[5 * 65]); o.w = cvt_pk_bf16(s[6 * 65], s[7 * 65]);
            *(GAS u32x4*)(c.dst + (size_t)n * c.ldt + 16 * cc) = o; }
    } else { const float sc = c.scale;
#pragma unroll
        for (int j = 0; j < 8; ++j) { const int n = (lane >> 3) + 8 * j; const LAS float* s = scr + (8 * cc) * 65 + n;
            u32x2 o; o.x = cvt4_fp8(s[0 * 65] * sc, s[1 * 65] * sc, s[2 * 65] * sc, s[3 * 65] * sc); o.y = cvt4_fp8(s[4 * 65] * sc, s[5 * 65] * sc, s[6 * 65] * sc, s[7 * 65] * sc);
            *(GAS u32x2*)(c.dst + (size_t)n * c.ldt + 8 * cc) = o; }
    }
    LDS_WAIT(); asm volatile("" ::: "memory");
}
__device__ __forceinline__ void convert_items(const Ctx& F, int lo, int hi, int gw, int NGW) {
    LAS float* scr = (LAS float*)(F.lds + 16384 + F.wave * 16640);
    int it = lo + gw;
    if (it >= hi) return;
    f32x4 va[16], vb[16];
    CvItem ca = cv_decode(F, it), cb = ca;
    cv_load(ca, F.lane, va);
    for (;;) {
        int nx = it + NGW; const bool hb = nx < hi;
        if (hb) { cb = cv_decode(F, nx); cv_load(cb, F.lane, vb); }
        cv_store(ca, F.lane, va, scr);
        if (!hb) break;
        it = nx; nx = it + NGW; const bool ha = nx < hi;
        if (ha) { ca = cv_decode(F, nx); cv_load(ca, F.lane, va); }
        cv_store(cb, F.lane, vb, scr);
        if (!ha) break;
        it = nx;
    }
}
__device__ __forceinline__ void p0_prologue(const Ctx& F) {
    {
        const float* cvec = inp(F, IN_C); const float* wada = inp(F, IN_WADA); float* modp = (float*)(F.ws + WS_MODP);
        LAS float* red = (LAS float*)F.lds;
        for (int it = F.bx; it < 384; it += F.G) {
            const int cc = it % 48, ks = it / 48; const int col = cc * 256 + F.lane * 4; const int k0 = ks * 256 + F.wave * 32;
            f32x4 a = (f32x4){0.f, 0.f, 0.f, 0.f};
#pragma unroll 8
            for (int r = 0; r < 32; ++r) { const int k = k0 + r; const float s = fsilu(cvec[k]); const f32x4 w = *(const f32x4*)(wada + (size_t)k * 12288 + col); a += w * s; }
            *(LAS f32x4*)(red + F.wave * 256 + F.lane * 4) = a;
            __syncthreads();
            if (F.tid < 256) { float s = 0.f;
#pragma unroll
                for (int w = 0; w < 8; ++w) s += red[w * 256 + F.tid];
                modp[ks * 12288 + cc * 256 + F.tid] = s; }
            __syncthreads();
        }
    }
    {
        float* rc = (float*)(F.ws + WS_ROPE); float* rs = rc + S * 64;
        for (int idx = F.bx * 512 + F.tid; idx < S * 64; idx += F.G * 512) {
            const int pos = idx >> 6, i = idx & 63;
            double inv = 1.0; const double r = 0.86596432336006535;
            for (int q = 0; q < i; ++q) inv *= r;
            const double ang = (double)pos * inv;
            const double n = __builtin_rint(ang * 0.15915494309189535);
            const float red = (float)(ang - n * 6.283185307179586);
            rc[idx] = __cosf(red); rs[idx] = __sinf(red);
        }
    }
    convert_items(F, 0, CV_BG_FROM, F.vcu * 8 + F.wave, F.G * 8);
}

__device__ __forceinline__ float mod_sum(const Ctx& F, int n) {
    const float* modp = (const float*)(F.ws + WS_MODP); float s = inp(F, IN_BADA)[n];
#pragma unroll
    for (int k = 0; k < 8; ++k) s += modp[k * 12288 + n];
    return s;
}
__device__ __forceinline__ void norm_rows(const Ctx& F, const float* X, const LAS float* gs, const LAS float* sh, bf16_t* O, unsigned char* O8) {
    const int gw = F.vcu * 8 + F.wave, NGW = F.G * 8;
    for (int m = gw; m < S; m += NGW) {
        const GAS f32x4* xr = (const GAS f32x4*)(X + (size_t)m * D) + F.lane;
        f32x4 v[8]; float ss = 0.f;
#pragma unroll
        for (int j = 0; j < 8; ++j) { v[j] = xr[64 * j]; ss += (v[j].x * v[j].x + v[j].y * v[j].y) + (v[j].z * v[j].z + v[j].w * v[j].w); }
#pragma unroll
        for (int o = 1; o < 64; o <<= 1) ss += __shfl_xor(ss, o);
        const float rstd = 1.0f / sqrtf(ss * (1.f / D) + 1e-6f);
        GAS u32x2* o8 = (GAS u32x2*)(O + (size_t)m * D) + F.lane; GAS unsigned* o4 = (GAS unsigned*)(O8 + (size_t)m * D) + F.lane;
#pragma unroll
        for (int j = 0; j < 8; ++j) { const f32x4 g = *(const LAS f32x4*)(gs + 256 * j + 4 * F.lane), s = *(const LAS f32x4*)(sh + 256 * j + 4 * F.lane);
            const f32x4 y = v[j] * rstd * g + s; u32x2 w; w.x = cvt_pk_bf16(y.x, y.y); w.y = cvt_pk_bf16(y.z, y.w); if (!PROJ_ALL_FP8) o8[64 * j] = w; o4[64 * j] = cvt4_fp8(y.x, y.y, y.z, y.w); }
    }
}
__device__ __forceinline__ void p1_norm1(const Ctx& F) {
    LAS float* gs = (LAS float*)F.lds; LAS float* sh = gs + D;
    for (int k = F.tid; k < D; k += 512) { const float shv = mod_sum(F, k), scv = mod_sum(F, D + k); gs[k] = inp(F, IN_LN1)[k] * (1.f + scv); sh[k] = shv; }
    float* modf = (float*)(F.ws + WS_MODF);
    for (int n = F.bx * 512 + F.tid; n < 12288; n += F.G * 512) modf[n] = mod_sum(F, n);
    __syncthreads();
    norm_rows(F, inp(F, IN_X), gs, sh, (bf16_t*)(F.ws + WS_H), F.ws + WS_H8);
}


__device__ __forceinline__ bf16x8 pk_frag(u32x2 lo, u32x2 hi) { u32x4 v; v.x = lo.x; v.y = lo.y; v.z = hi.x; v.w = hi.y; return __builtin_bit_cast(bf16x8, v); }
__device__ __forceinline__ f32x4 mfma16(bf16x8 a, bf16x8 b, f32x4 c) { return __builtin_amdgcn_mfma_f32_16x16x32_bf16(a, b, c, 0, 0, 0); }
__device__ __forceinline__ float gamma_log2(int h) { return log2f(1.0f - exp2f(-5.0f - (float)h)); }

struct AttnU { int g, hh, d, r, nb, head; };
__device__ __forceinline__ AttnU attn_decode(int u) {
    AttnU U; U.g = u >> 9; const int rem = u & 511; U.hh = rem >> 6; const int rem2 = rem & 63;
    const int dsh = 2 * U.g; U.d = 1 << dsh; const int nblk = 64 >> dsh;
    U.r = rem2 / nblk; U.nb = rem2 % nblk; U.head = U.g * 8 + U.hh; return U;
}
__device__ __forceinline__ void attn_issue(const bf16_t* proj, const AttnU& U, int tid, int w, int lane, u32x4 (&kr)[8], u32x4 (&vr)[8], u32x4 (&qr)[4]) {
    const int rowi = tid >> 4, ch = tid & 15;
#pragma unroll
    for (int p = 0; p < 8; ++p) { const int cc = p * 32 + rowi; const int jk = (U.nb - 1) * 128 + cc;
        if (jk >= 0) { const unsigned off = (unsigned)(jk * U.d + U.r) * INW + U.head * 128 + ch * 8; kr[p] = *(const u32x4*)(proj + off + C_KA); vr[p] = *(const u32x4*)(proj + off + C_VA); }
        else { kr[p] = (u32x4){0u, 0u, 0u, 0u}; vr[p] = (u32x4){0u, 0u, 0u, 0u}; } }
    const int ql = lane & 15, g4 = lane >> 4; const unsigned tq = (unsigned)((U.nb * 128 + 16 * w + ql) * U.d + U.r);
#pragma unroll
    for (int ds = 0; ds < 4; ++ds) qr[ds] = *(const u32x4*)(proj + tq * INW + C_QA + U.head * 128 + 32 * ds + 8 * g4);
}
__device__ __forceinline__ void p3_attn(const Ctx& F) {
    const bf16_t* proj = (const bf16_t*)(F.ws + WS_PROJ);
    LAS bf16_t* KS = (LAS bf16_t*)F.lds;
    LAS bf16_t* VS = (LAS bf16_t*)(F.lds + 69632);
    LAS float* BT = (LAS float*)(F.lds + 139264);
    const int lane = F.lane, w = F.wave, ql = lane & 15, g4 = lane >> 4;
    const int rowi = F.tid >> 4, ch = F.tid & 15;
    u32x4 kr[8], vr[8], qr[4];
    int it = F.bx;
    if (it < 1536) { const AttnU U0 = attn_decode(it); attn_issue(proj, U0, F.tid, w, lane, kr, vr, qr); }
    for (; it < 1536; it += F.G) {
        const AttnU U = attn_decode(it);
        const int d = U.d, nb = U.nb;
        if (F.tid <= 128) { const int dist = F.tid * d; int b;
            if (dist < 16) b = dist; else { b = 16 + (int)floorf(log2f((float)dist * 0.0625f) * (16.0f / 7.0f)); b = b > 31 ? 31 : b; }
            BT[F.tid] = inp(F, IN_RELB)[b * 24 + U.head]; }
        {
            const float* kg = inp(F, IN_KNG) + ch * 8;
            const f32x4 kg0 = *(const f32x4*)kg, kg1 = *(const f32x4*)(kg + 4);
#pragma unroll
            for (int p = 0; p < 8; ++p) { const int cc = p * 32 + rowi;
                float f[8]; f[0] = bf2f(kr[p].x & 0xffffu); f[1] = bf2f(kr[p].x >> 16); f[2] = bf2f(kr[p].y & 0xffffu); f[3] = bf2f(kr[p].y >> 16);
                f[4] = bf2f(kr[p].z & 0xffffu); f[5] = bf2f(kr[p].z >> 16); f[6] = bf2f(kr[p].w & 0xffffu); f[7] = bf2f(kr[p].w >> 16);
                float ss = 0.f;
#pragma unroll
                for (int e = 0; e < 8; ++e) ss += f[e] * f[e];
                ss += __shfl_xor(ss, 1); ss += __shfl_xor(ss, 2); ss += __shfl_xor(ss, 4); ss += __shfl_xor(ss, 8);
                const float rstd = 1.0f / sqrtf(ss * (1.f / 128.f) + 1e-6f);
                u32x4 o; o.x = cvt_pk_bf16(f[0] * rstd * kg0.x, f[1] * rstd * kg0.y); o.y = cvt_pk_bf16(f[2] * rstd * kg0.z, f[3] * rstd * kg0.w);
                o.z = cvt_pk_bf16(f[4] * rstd * kg1.x, f[5] * rstd * kg1.y); o.w = cvt_pk_bf16(f[6] * rstd * kg1.z, f[7] * rstd * kg1.w);
                *(LAS u32x4*)(KS + cc * 136 + ch * 8) = o;
                *(LAS u32x4*)(VS + cc * 136 + ch * 8) = vr[p]; }
        }
        const int a = 16 * w + ql;
        const unsigned tq = (unsigned)((nb * 128 + a) * d + U.r);
        bf16x8 qf[4];
        {
            float f[4][8]; float ss = 0.f;
#pragma unroll
            for (int ds = 0; ds < 4; ++ds) { f[ds][0] = bf2f(qr[ds].x & 0xffffu); f[ds][1] = bf2f(qr[ds].x >> 16); f[ds][2] = bf2f(qr[ds].y & 0xffffu); f[ds][3] = bf2f(qr[ds].y >> 16);
                f[ds][4] = bf2f(qr[ds].z & 0xffffu); f[ds][5] = bf2f(qr[ds].z >> 16); f[ds][6] = bf2f(qr[ds].w & 0xffffu); f[ds][7] = bf2f(qr[ds].w >> 16);
#pragma unroll
                for (int e = 0; e < 8; ++e) ss += f[ds][e] * f[ds][e]; }
            ss += __shfl_xor(ss, 16); ss += __shfl_xor(ss, 32);
            const float rs = (1.0f / sqrtf(ss * (1.f / 128.f) + 1e-6f)) * 0.08838834764831845f;
#pragma unroll
            for (int ds = 0; ds < 4; ++ds) { const float* qg = inp(F, IN_QNG) + 32 * ds + 8 * g4; const f32x4 q0 = *(const f32x4*)qg, q1 = *(const f32x4*)(qg + 4); u32x4 o;
                o.x = cvt_pk_bf16(f[ds][0] * rs * q0.x, f[ds][1] * rs * q0.y); o.y = cvt_pk_bf16(f[ds][2] * rs * q0.z, f[ds][3] * rs * q0.w);
                o.z = cvt_pk_bf16(f[ds][4] * rs * q1.x, f[ds][5] * rs * q1.y); o.w = cvt_pk_bf16(f[ds][6] * rs * q1.z, f[ds][7] * rs * q1.w);
                qf[ds] = __builtin_bit_cast(bf16x8, o); }
        }
        __syncthreads();
        { const int nx = it + F.G; if (nx < 1536) { const AttnU Un = attn_decode(nx); attn_issue(proj, Un, F.tid, w, lane, kr, vr, qr); } }
        const int kbase = 32 * (w >> 1);
        f32x4 sc[10];
#pragma unroll
        for (int ti = 0; ti < 10; ++ti) { f32x4 acc = (f32x4){0.f, 0.f, 0.f, 0.f};
#pragma unroll
            for (int ds = 0; ds < 4; ++ds) { const bf16x8 kf = *(const LAS bf16x8*)(KS + (kbase + 16 * ti + ql) * 136 + 32 * ds + 8 * g4); acc = mfma16(kf, qf[ds], acc); }
            sc[ti] = acc; }
        float mx = -1e30f;
#pragma unroll
        for (int ti = 0; ti < 10; ++ti)
#pragma unroll
            for (int i = 0; i < 4; ++i) { const int cc = kbase + 16 * ti + 4 * g4 + i; const int delta = 128 + a - cc;
                const bool ok = (delta >= 0) && (delta <= 128) && (nb > 0 || cc >= 128);
                const float sv = ok ? sc[ti][i] + BT[ok ? delta : 0] : -1e30f; sc[ti][i] = sv; mx = fmaxf(mx, sv); }
        mx = fmaxf(mx, __shfl_xor(mx, 16)); mx = fmaxf(mx, __shfl_xor(mx, 32));
        float lsum = 0.f;
#pragma unroll
        for (int ti = 0; ti < 10; ++ti)
#pragma unroll
            for (int i = 0; i < 4; ++i) { const float p = __expf(sc[ti][i] - mx); sc[ti][i] = p; lsum += p; }
        lsum += __shfl_xor(lsum, 16); lsum += __shfl_xor(lsum, 32);
        bf16x8 pf[5];
#pragma unroll
        for (int s = 0; s < 5; ++s) { u32x4 o; o.x = cvt_pk_bf16(sc[2 * s][0], sc[2 * s][1]); o.y = cvt_pk_bf16(sc[2 * s][2], sc[2 * s][3]);
            o.z = cvt_pk_bf16(sc[2 * s + 1][0], sc[2 * s + 1][1]); o.w = cvt_pk_bf16(sc[2 * s + 1][2], sc[2 * s + 1][3]); pf[s] = __builtin_bit_cast(bf16x8, o); }
        const float rl = 1.0f / lsum;
        bf16_t* og = (bf16_t*)(F.ws + WS_OG) + ((unsigned)(U.g * S) + tq) * 1024u + U.hh * 128;
        const unsigned vbase = (unsigned)(size_t)VS + (unsigned)(((kbase + 4 * g4 + (ql >> 2)) * 136 + 4 * (ql & 3)) * 2);
#pragma unroll
        for (int dt = 0; dt < 8; ++dt) { f32x4 acc = (f32x4){0.f, 0.f, 0.f, 0.f};
            u32x2 lo[5], hi[5];
#pragma unroll
            for (int s = 0; s < 5; ++s) { TR_READ(lo[s], vbase, (32 * s * 136 + dt * 16) * 2); TR_READ(hi[s], vbase, ((32 * s + 16) * 136 + dt * 16) * 2); }
            TR_WAIT4(lo[0], hi[0], lo[1], hi[1]); TR_WAIT4(lo[2], hi[2], lo[3], hi[3]); TR_WAIT2(lo[4], hi[4]);
#pragma unroll
            for (int s = 0; s < 5; ++s) acc = mfma16(pk_frag(lo[s], hi[s]), pf[s], acc);
            u32x2 o; o.x = cvt_pk_bf16(acc[0] * rl, acc[1] * rl); o.y = cvt_pk_bf16(acc[2] * rl, acc[3] * rl);
            *(u32x2*)(og + dt * 16 + 4 * g4) = o; }
        if (g4 == 0) ((float*)(F.ws + WS_LSE))[((unsigned)(U.g * S) + tq) * 8u + U.hh] = mx + __logf(lsum);
        __syncthreads();
    }
}

__device__ __forceinline__ void rot8v(const u32x4 own, const u32x4 par, int ch, const f32x4 c0, const f32x4 c1, const f32x4 s0, const f32x4 s1, float scale, float (&o)[8]) {
    float a[8], b[8];
    a[0] = bf2f(own.x & 0xffffu); a[1] = bf2f(own.x >> 16); a[2] = bf2f(own.y & 0xffffu); a[3] = bf2f(own.y >> 16); a[4] = bf2f(own.z & 0xffffu); a[5] = bf2f(own.z >> 16); a[6] = bf2f(own.w & 0xffffu); a[7] = bf2f(own.w >> 16);
    b[0] = bf2f(par.x & 0xffffu); b[1] = bf2f(par.x >> 16); b[2] = bf2f(par.y & 0xffffu); b[3] = bf2f(par.y >> 16); b[4] = bf2f(par.z & 0xffffu); b[5] = bf2f(par.z >> 16); b[6] = bf2f(par.w & 0xffffu); b[7] = bf2f(par.w >> 16);
    const float cv[8] = {c0.x, c0.y, c0.z, c0.w, c1.x, c1.y, c1.z, c1.w}, sv[8] = {s0.x, s0.y, s0.z, s0.w, s1.x, s1.y, s1.z, s1.w};
#pragma unroll
    for (int e = 0; e < 8; ++e) o[e] = ((ch < 8) ? (a[e] * cv[e] - b[e] * sv[e]) : (b[e] * sv[e] + a[e] * cv[e])) * scale;
}

__device__ __forceinline__ void upd_unit(const Ctx& F, int u) {
    const int n = u >> 3, h = u & 7;
    const bf16_t* proj = (const bf16_t*)(F.ws + WS_PROJ);
    const float* rc = (const float*)(F.ws + WS_ROPE); const float* rsn = rc + S * 64;
    LAS bf16_t* KS = (LAS bf16_t*)F.lds;
    LAS bf16_t* VS = (LAS bf16_t*)(F.lds + 34816);
    const int lane = F.lane, w = F.wave;
    const float lg2 = gamma_log2(h);
    {
        const int rowi = F.tid >> 4, ch = F.tid & 15;
        u32x4 kown[4], kpar[4], vv[8]; f32x4 c0[4], c1[4], s0[4], s1[4];
#pragma unroll
        for (int p = 0; p < 4; ++p) { const int j = p * 32 + rowi; const unsigned tok = (unsigned)(n * 128 + j);
            const bf16_t* kp = proj + tok * INW + C_KR + h * 128;
            kown[p] = *(const u32x4*)(kp + ch * 8); kpar[p] = *(const u32x4*)(kp + (ch ^ 8) * 8);
            const float* cp = rc + tok * 64 + (ch & 7) * 8; const float* sp = rsn + tok * 64 + (ch & 7) * 8;
            c0[p] = *(const f32x4*)cp; c1[p] = *(const f32x4*)(cp + 4); s0[p] = *(const f32x4*)sp; s1[p] = *(const f32x4*)(sp + 4);
            vv[2 * p] = *(const u32x4*)(proj + tok * INW + C_VR + h * 256 + ch * 8); vv[2 * p + 1] = *(const u32x4*)(proj + tok * INW + C_VR + h * 256 + (ch + 16) * 8); }
#pragma unroll
        for (int p = 0; p < 4; ++p) { const int j = p * 32 + rowi;
            float o[8]; rot8v(kown[p], kpar[p], ch, c0[p], c1[p], s0[p], s1[p], 0.08838834764831845f, o);
            u32x4 ov; ov.x = cvt_pk_bf16(o[0], o[1]); ov.y = cvt_pk_bf16(o[2], o[3]); ov.z = cvt_pk_bf16(o[4], o[5]); ov.w = cvt_pk_bf16(o[6], o[7]);
            *(LAS u32x4*)(KS + j * 136 + ch * 8) = ov; }
#pragma unroll
        for (int p = 0; p < 4; ++p) { const int j = p * 32 + rowi; const float z = exp2f(lg2 * (float)(127 - j));
#pragma unroll
            for (int c2 = 0; c2 < 2; ++c2) { const int chv = ch + 16 * c2; const u32x4 x = vv[2 * p + c2];
                u32x4 ov; ov.x = cvt_pk_bf16(bf2f(x.x & 0xffffu) * z, bf2f(x.x >> 16) * z); ov.y = cvt_pk_bf16(bf2f(x.y & 0xffffu) * z, bf2f(x.y >> 16) * z);
                ov.z = cvt_pk_bf16(bf2f(x.z & 0xffffu) * z, bf2f(x.z >> 16) * z); ov.w = cvt_pk_bf16(bf2f(x.w & 0xffffu) * z, bf2f(x.w >> 16) * z);
                *(LAS u32x4*)(VS + j * 264 + chv * 8) = ov; } }
    }
    __syncthreads();
    const int ql = lane & 15, g4 = lane >> 4;
    const unsigned kb = (unsigned)(size_t)KS + (unsigned)(((8 * g4 + (ql >> 2)) * 136 + 4 * (ql & 3)) * 2);
    const unsigned vbw = (unsigned)(size_t)VS + (unsigned)(((8 * g4 + (ql >> 2)) * 264 + 4 * (ql & 3) + 32 * w) * 2);
    f32x4 acc[2][8];
#pragma unroll
    for (int a = 0; a < 2; ++a)
#pragma unroll
        for (int b = 0; b < 8; ++b) acc[a][b] = (f32x4){0.f, 0.f, 0.f, 0.f};
#pragma unroll
    for (int ks = 0; ks < 4; ++ks) {
        u32x2 vl[2], vh[2];
#pragma unroll
        for (int a = 0; a < 2; ++a) { TR_READ(vl[a], vbw, (32 * ks * 264 + a * 16) * 2); TR_READ(vh[a], vbw, ((32 * ks + 4) * 264 + a * 16) * 2); }
        TR_WAIT4(vl[0], vh[0], vl[1], vh[1]);
        const bf16x8 vf0 = pk_frag(vl[0], vh[0]), vf1 = pk_frag(vl[1], vh[1]);
#pragma unroll
        for (int b = 0; b < 8; b += 2) {
            u32x2 k0l, k0h, k1l, k1h;
            TR_READ(k0l, kb, (32 * ks * 136 + b * 16) * 2); TR_READ(k0h, kb, ((32 * ks + 4) * 136 + b * 16) * 2);
            TR_READ(k1l, kb, (32 * ks * 136 + (b + 1) * 16) * 2); TR_READ(k1h, kb, ((32 * ks + 4) * 136 + (b + 1) * 16) * 2);
            TR_WAIT4(k0l, k0h, k1l, k1h);
            const bf16x8 kf0 = pk_frag(k0l, k0h), kf1 = pk_frag(k1l, k1h);
            acc[0][b] = mfma16(vf0, kf0, acc[0][b]); acc[1][b] = mfma16(vf1, kf0, acc[1][b]);
            acc[0][b + 1] = mfma16(vf0, kf1, acc[0][b + 1]); acc[1][b + 1] = mfma16(vf1, kf1, acc[1][b + 1]); }
    }
    float* upd = (float*)(F.ws + WS_UPD) + (size_t)(n * 8 + h) * 32768;
#pragma unroll
    for (int a = 0; a < 2; ++a)
#pragma unroll
        for (int b = 0; b < 8; ++b)
#pragma unroll
            for (int i = 0; i < 4; ++i) upd[((2 * w + a) * 16 + 4 * g4 + i) * 128 + b * 16 + ql] = acc[a][b][i];
    __syncthreads();
}
__device__ __forceinline__ void p3_mix1(const Ctx& F) {
    p3_attn(F);
    if (DUP2_MASK & 4) { __syncthreads(); p3_attn(F); }
    for (int it = F.bx; it < 512; it += F.G) upd_unit(F, it);
    if (DUP2_MASK & 8) { __syncthreads(); for (int it = F.bx; it < 512; it += F.G) upd_unit(F, it); }
}

__device__ __forceinline__ void p4_scan(const Ctx& F) {
    const float* upd = (const float*)(F.ws + WS_UPD); unsigned* prev = (unsigned*)(F.ws + WS_PREV);
    for (int p = F.bx * 512 + F.tid; p < 131072; p += F.G * 512) {
        const int h = p >> 14;
        const float gch = exp2f(gamma_log2(h) * 128.0f);
        const int within = (p & 16383) * 2;
        float s0 = 0.f, s1 = 0.f;
#pragma unroll 8
        for (int n = 0; n < 64; ++n) { const size_t o = (size_t)(n * 8 + h) * 32768 + within;
            const f32x2 uv = *(const f32x2*)(upd + o);
            prev[o >> 1] = cvt_pk_bf16(s0, s1);
            s0 = gch * s0 + uv.x; s1 = gch * s1 + uv.y; }
    }
}

__device__ __forceinline__ void ret_unit(const Ctx& F, int u) {
    const int n = u >> 3, h = u & 7;
    const bf16_t* proj = (const bf16_t*)(F.ws + WS_PROJ);
    const float* rc = (const float*)(F.ws + WS_ROPE); const float* rsn = rc + S * 64;
    LAS bf16_t* KS = (LAS bf16_t*)F.lds;
    LAS bf16_t* VS = (LAS bf16_t*)(F.lds + 34816);
    LAS bf16_t* QS = (LAS bf16_t*)(F.lds + 102400);
    LAS float* RED = (LAS float*)(F.lds + 137216);
    LAS float* TOT = (LAS float*)(F.lds + 145408);
    const int lane = F.lane, w = F.wave;
    const float lg2 = gamma_log2(h);
    const int ql = lane & 15, g4 = lane >> 4;
    const bf16_t* prev = (const bf16_t*)(F.ws + WS_PREV) + (size_t)(n * 8 + h) * 32768;
    {
        const int rowi = F.tid >> 4, ch = F.tid & 15;
        u32x4 kown[4], kpar[4], vv[8]; f32x4 c0[4], c1[4], s0[4], s1[4];
#pragma unroll
        for (int p = 0; p < 4; ++p) { const int j = p * 32 + rowi; const unsigned tok = (unsigned)(n * 128 + j);
            const bf16_t* kp = proj + tok * INW + C_KR + h * 128;
            kown[p] = *(const u32x4*)(kp + ch * 8); kpar[p] = *(const u32x4*)(kp + (ch ^ 8) * 8);
            const float* cp = rc + tok * 64 + (ch & 7) * 8; const float* sp = rsn + tok * 64 + (ch & 7) * 8;
            c0[p] = *(const f32x4*)cp; c1[p] = *(const f32x4*)(cp + 4); s0[p] = *(const f32x4*)sp; s1[p] = *(const f32x4*)(sp + 4);
            vv[2 * p] = *(const u32x4*)(proj + tok * INW + C_VR + h * 256 + ch * 8); vv[2 * p + 1] = *(const u32x4*)(proj + tok * INW + C_VR + h * 256 + (ch + 16) * 8); }
#pragma unroll
        for (int p = 0; p < 4; ++p) { const int j = p * 32 + rowi;
            float o[8]; rot8v(kown[p], kpar[p], ch, c0[p], c1[p], s0[p], s1[p], 0.08838834764831845f, o);
            u32x4 ov; ov.x = cvt_pk_bf16(o[0], o[1]); ov.y = cvt_pk_bf16(o[2], o[3]); ov.z = cvt_pk_bf16(o[4], o[5]); ov.w = cvt_pk_bf16(o[6], o[7]);
            *(LAS u32x4*)(KS + j * 136 + ch * 8) = ov; }
#pragma unroll
        for (int p = 0; p < 4; ++p) { const int j = p * 32 + rowi;
#pragma unroll
            for (int c2 = 0; c2 < 2; ++c2) { const int chv = ch + 16 * c2; const u32x4 x = vv[2 * p + c2];
                *(LAS u32x4*)(VS + j * 264 + chv * 8) = x; } }
    }
    const int iq = 16 * w + ql; const unsigned tq = (unsigned)(n * 128 + iq);
    bf16x8 qf[4];
    {
        u32x4 qv[4]; float f[4][8];
#pragma unroll
        for (int ds = 0; ds < 4; ++ds) qv[ds] = *(const u32x4*)(proj + tq * INW + C_QR + h * 128 + 32 * ds + 8 * g4);
#pragma unroll
        for (int ds = 0; ds < 4; ++ds) { f[ds][0] = bf2f(qv[ds].x & 0xffffu); f[ds][1] = bf2f(qv[ds].x >> 16); f[ds][2] = bf2f(qv[ds].y & 0xffffu); f[ds][3] = bf2f(qv[ds].y >> 16);
            f[ds][4] = bf2f(qv[ds].z & 0xffffu); f[ds][5] = bf2f(qv[ds].z >> 16); f[ds][6] = bf2f(qv[ds].w & 0xffffu); f[ds][7] = bf2f(qv[ds].w >> 16); }
        const float xi = exp2f(lg2 * (float)(iq + 1));
#pragma unroll
        for (int ds = 0; ds < 2; ++ds) {
            const float* cp = rc + tq * 64 + 32 * ds + 8 * g4; const float* sp = rsn + tq * 64 + 32 * ds + 8 * g4;
            const f32x4 c0 = *(const f32x4*)cp, c1 = *(const f32x4*)(cp + 4), s0 = *(const f32x4*)sp, s1 = *(const f32x4*)(sp + 4);
            const float cv[8] = {c0.x, c0.y, c0.z, c0.w, c1.x, c1.y, c1.z, c1.w}, sv[8] = {s0.x, s0.y, s0.z, s0.w, s1.x, s1.y, s1.z, s1.w};
            float lo[8], hi[8];
#pragma unroll
            for (int e = 0; e < 8; ++e) { const float t1 = f[ds][e], t2 = f[ds + 2][e]; lo[e] = t1 * cv[e] - t2 * sv[e]; hi[e] = t1 * sv[e] + t2 * cv[e]; }
            u32x4 o; o.x = cvt_pk_bf16(lo[0], lo[1]); o.y = cvt_pk_bf16(lo[2], lo[3]); o.z = cvt_pk_bf16(lo[4], lo[5]); o.w = cvt_pk_bf16(lo[6], lo[7]); qf[ds] = __builtin_bit_cast(bf16x8, o);
            o.x = cvt_pk_bf16(hi[0], hi[1]); o.y = cvt_pk_bf16(hi[2], hi[3]); o.z = cvt_pk_bf16(hi[4], hi[5]); o.w = cvt_pk_bf16(hi[6], hi[7]); qf[ds + 2] = __builtin_bit_cast(bf16x8, o);
            o.x = cvt_pk_bf16(lo[0] * xi, lo[1] * xi); o.y = cvt_pk_bf16(lo[2] * xi, lo[3] * xi); o.z = cvt_pk_bf16(lo[4] * xi, lo[5] * xi); o.w = cvt_pk_bf16(lo[6] * xi, lo[7] * xi);
            *(LAS u32x4*)(QS + iq * 136 + 32 * ds + 8 * g4) = o;
            o.x = cvt_pk_bf16(hi[0] * xi, hi[1] * xi); o.y = cvt_pk_bf16(hi[2] * xi, hi[3] * xi); o.z = cvt_pk_bf16(hi[4] * xi, hi[5] * xi); o.w = cvt_pk_bf16(hi[6] * xi, hi[7] * xi);
            *(LAS u32x4*)(QS + iq * 136 + 32 * (ds + 2) + 8 * g4) = o;
        }
    }
    bf16x8 pr[2][4];
#pragma unroll
    for (int a = 0; a < 2; ++a)
#pragma unroll
        for (int ds = 0; ds < 4; ++ds) pr[a][ds] = *(const bf16x8*)(prev + ((2 * w + a) * 16 + ql) * 128 + 32 * ds + 8 * g4);
    __syncthreads();
    f32x4 sc[8];
#pragma unroll
    for (int kt = 0; kt < 8; ++kt) { f32x4 a = (f32x4){0.f, 0.f, 0.f, 0.f};
#pragma unroll
        for (int ds = 0; ds < 4; ++ds) { const bf16x8 kf = *(const LAS bf16x8*)(KS + (16 * kt + ql) * 136 + 32 * ds + 8 * g4); a = mfma16(kf, qf[ds], a); }
#pragma unroll
        for (int i = 0; i < 4; ++i) { const int j = 16 * kt + 4 * g4 + i; const int df = iq - j; a[i] = (df >= 0) ? a[i] * exp2f(lg2 * (float)df) : 0.f; }
        sc[kt] = a; }
    __syncthreads();
#pragma unroll
    for (int kt = 0; kt < 8; ++kt) { u32x2 o; o.x = cvt_pk_bf16(sc[kt][0], sc[kt][1]); o.y = cvt_pk_bf16(sc[kt][2], sc[kt][3]); *(LAS u32x2*)(KS + iq * 136 + 16 * kt + 4 * g4) = o; }
    __syncthreads();
    f32x4 acc[2][8];
#pragma unroll
    for (int a = 0; a < 2; ++a)
#pragma unroll
        for (int qt = 0; qt < 8; ++qt) acc[a][qt] = (f32x4){0.f, 0.f, 0.f, 0.f};
#pragma unroll
    for (int ds = 0; ds < 4; ++ds)
#pragma unroll
        for (int qt = 0; qt < 8; ++qt) { const bf16x8 bq = *(const LAS bf16x8*)(QS + (qt * 16 + ql) * 136 + 32 * ds + 8 * g4);
            acc[0][qt] = mfma16(pr[0][ds], bq, acc[0][qt]); acc[1][qt] = mfma16(pr[1][ds], bq, acc[1][qt]); }
    const unsigned vbw = (unsigned)(size_t)VS + (unsigned)(((8 * g4 + (ql >> 2)) * 264 + 4 * (ql & 3) + 32 * w) * 2);
#pragma unroll
    for (int s = 0; s < 4; ++s) {
        u32x2 vl[2], vh[2];
#pragma unroll
        for (int a = 0; a < 2; ++a) { TR_READ(vl[a], vbw, (32 * s * 264 + a * 16) * 2); TR_READ(vh[a], vbw, ((32 * s + 4) * 264 + a * 16) * 2); }
        TR_WAIT4(vl[0], vh[0], vl[1], vh[1]);
        const bf16x8 vf0 = pk_frag(vl[0], vh[0]), vf1 = pk_frag(vl[1], vh[1]);
#pragma unroll
        for (int qt = 0; qt < 8; ++qt) if (qt >= 2 * s) { const bf16x8 bp = *(const LAS bf16x8*)(KS + (qt * 16 + ql) * 136 + 32 * s + 8 * g4);
            acc[0][qt] = mfma16(vf0, bp, acc[0][qt]); acc[1][qt] = mfma16(vf1, bp, acc[1][qt]); }
    }
#pragma unroll
    for (int qt = 0; qt < 8; ++qt) { float s1 = 0.f, s2 = 0.f;
#pragma unroll
        for (int a = 0; a < 2; ++a)
#pragma unroll
            for (int i = 0; i < 4; ++i) { const float x = acc[a][qt][i]; s1 += x; s2 += x * x; }
        s1 += __shfl_xor(s1, 16); s1 += __shfl_xor(s1, 32); s2 += __shfl_xor(s2, 16); s2 += __shfl_xor(s2, 32);
        if (g4 == 0) *(LAS f32x2*)(RED + (w * 128 + qt * 16 + ql) * 2) = (f32x2){s1, s2}; }
    __syncthreads();
    if (F.tid < 128) { float s1 = 0.f, s2 = 0.f;
#pragma unroll
        for (int ww = 0; ww < 8; ++ww) { const f32x2 v = *(const LAS f32x2*)(RED + (ww * 128 + F.tid) * 2); s1 += v.x; s2 += v.y; }
        const float mean = s1 * (1.f / 256.f); float var = s2 * (1.f / 256.f) - mean * mean; var = var > 0.f ? var : 0.f;
        *(LAS f32x2*)(TOT + F.tid * 2) = (f32x2){mean, 1.0f / sqrtf(var + 1e-5f)}; }
    __syncthreads();
    LAS bf16_t* OT = VS;
#pragma unroll
    for (int qt = 0; qt < 8; ++qt) { const f32x2 st = *(const LAS f32x2*)(TOT + (qt * 16 + ql) * 2);
#pragma unroll
        for (int a = 0; a < 2; ++a) { u32x2 o; o.x = cvt_pk_bf16((acc[a][qt][0] - st.x) * st.y, (acc[a][qt][1] - st.x) * st.y); o.y = cvt_pk_bf16((acc[a][qt][2] - st.x) * st.y, (acc[a][qt][3] - st.x) * st.y);
            *(LAS u32x2*)(OT + (qt * 16 + ql) * 264 + (2 * w + a) * 16 + 4 * g4) = o; } }
    __syncthreads();
    const float* gng = inp(F, IN_GNG) + h * 256;
    {
        const int pc = F.tid & 31;
        const f32x4 gg0 = *(const f32x4*)(gng + pc * 8), gg1 = *(const f32x4*)(gng + pc * 8 + 4);
        u32x4 gv[8];
#pragma unroll
        for (int p = 0; p < 8; ++p) { const unsigned tk = (unsigned)(n * 128 + p * 16 + (F.tid >> 5)); gv[p] = *(const u32x4*)(proj + tk * INW + C_GR + h * 256 + pc * 8); }
#pragma unroll
        for (int p = 0; p < 8; ++p) { const int row = p * 16 + (F.tid >> 5); const unsigned tk = (unsigned)(n * 128 + row);
            const u32x4 x = *(const LAS u32x4*)(OT + row * 264 + pc * 8); u32x4 o;
            o.x = cvt_pk_bf16(bf2f(x.x & 0xffffu) * gg0.x * fsilu(bf2f(gv[p].x & 0xffffu)), bf2f(x.x >> 16) * gg0.y * fsilu(bf2f(gv[p].x >> 16)));
            o.y = cvt_pk_bf16(bf2f(x.y & 0xffffu) * gg0.z * fsilu(bf2f(gv[p].y & 0xffffu)), bf2f(x.y >> 16) * gg0.w * fsilu(bf2f(gv[p].y >> 16)));
            o.z = cvt_pk_bf16(bf2f(x.z & 0xffffu) * gg1.x * fsilu(bf2f(gv[p].z & 0xffffu)), bf2f(x.z >> 16) * gg1.y * fsilu(bf2f(gv[p].z >> 16)));
            o.w = cvt_pk_bf16(bf2f(x.w & 0xffffu) * gg1.z * fsilu(bf2f(gv[p].w & 0xffffu)), bf2f(x.w >> 16) * gg1.w * fsilu(bf2f(gv[p].w >> 16)));
            *(u32x4*)((bf16_t*)(F.ws + WS_YB) + tk * D + h * 256 + pc * 8) = o; }
    }
    __syncthreads();
}
__device__ __forceinline__ void comb_item(const Ctx& F, int it) {
    const bf16_t* og = (const bf16_t*)(F.ws + WS_OG); const float* lse = (const float*)(F.ws + WS_LSE); bf16_t* ya = (bf16_t*)(F.ws + WS_YA);
    for (int rr = 0; rr < 4; ++rr) { const size_t t = (size_t)it * 32 + F.wave * 4 + rr; const int hh = F.lane >> 3;
        const float l0 = lse[(0 * (size_t)S + t) * 8 + hh], l1 = lse[(1 * (size_t)S + t) * 8 + hh], l2 = lse[(2 * (size_t)S + t) * 8 + hh];
        const float m = fmaxf(l0, fmaxf(l1, l2)); float a0 = __expf(l0 - m), a1 = __expf(l1 - m), a2 = __expf(l2 - m); const float inv = 1.f / (a0 + a1 + a2); a0 *= inv; a1 *= inv; a2 *= inv;
#pragma unroll
        for (int c = 0; c < 2; ++c) { const size_t e = t * 1024 + F.lane * 16 + c * 8;
            const u32x4 v0 = *(const u32x4*)(og + e), v1 = *(const u32x4*)(og + (size_t)S * 1024 + e), v2 = *(const u32x4*)(og + 2 * (size_t)S * 1024 + e);
            u32x4 o;
            o.x = cvt_pk_bf16(a0 * bf2f(v0.x & 0xffffu) + a1 * bf2f(v1.x & 0xffffu) + a2 * bf2f(v2.x & 0xffffu), a0 * bf2f(v0.x >> 16) + a1 * bf2f(v1.x >> 16) + a2 * bf2f(v2.x >> 16));
            o.y = cvt_pk_bf16(a0 * bf2f(v0.y & 0xffffu) + a1 * bf2f(v1.y & 0xffffu) + a2 * bf2f(v2.y & 0xffffu), a0 * bf2f(v0.y >> 16) + a1 * bf2f(v1.y >> 16) + a2 * bf2f(v2.y >> 16));
            o.z = cvt_pk_bf16(a0 * bf2f(v0.z & 0xffffu) + a1 * bf2f(v1.z & 0xffffu) + a2 * bf2f(v2.z & 0xffffu), a0 * bf2f(v0.z >> 16) + a1 * bf2f(v1.z >> 16) + a2 * bf2f(v2.z >> 16));
            o.w = cvt_pk_bf16(a0 * bf2f(v0.w & 0xffffu) + a1 * bf2f(v1.w & 0xffffu) + a2 * bf2f(v2.w & 0xffffu), a0 * bf2f(v0.w >> 16) + a1 * bf2f(v1.w >> 16) + a2 * bf2f(v2.w >> 16));
            *(u32x4*)(ya + e) = o; } }
}
__device__ __forceinline__ void p4_scan_comb(const Ctx& F) {
    p4_scan(F);
    for (int it = F.bx; it < 256; it += F.G) comb_item(F, it);
}
__device__ __forceinline__ void p5_mix2(const Ctx& F) {
    for (int it = F.bx; it < 512; it += F.G) ret_unit(F, it);
    if (DUP2_MASK & 1) { __syncthreads(); for (int it = F.bx; it < 512; it += F.G) ret_unit(F, it); }
}

__device__ __forceinline__ void p8_router(const Ctx& F) {
    LAS float* gs = (LAS float*)F.lds; LAS float* sh = gs + D; LAS float* XS = sh + D; LAS float* WSm = XS + 32 * 260; LAS float* SC = WSm + 256 * 64; LAS float* SEL = SC + 32 * 64; LAS float* RSTD = SEL + 32 * 64;
    const float* modf = (const float*)(F.ws + WS_MODF);
    for (int k = F.tid; k < D; k += 512) { gs[k] = inp(F, IN_LN2)[k] * (1.f + modf[4 * D + k]); sh[k] = modf[3 * D + k]; }
    __syncthreads();
    const float* x1 = F.out; unsigned char* H2 = F.ws + WS_H;
    const float* rw = inp(F, IN_RW); const float* rb = inp(F, IN_RB);
    int* e_of = (int*)(F.ws + WS_EOF); int* pos_of = e_of + 65536; float* topw = (float*)(pos_of + 65536);
    LAS int* HL = (LAS int*)(RSTD + 32);
    int* hist = (int*)(F.ws + WS_HIST);
    for (int it = F.bx; it < 256; it += F.G) {
        const int t0 = it * 32;
        if (F.tid < 64) HL[F.tid] = 0;
#pragma unroll 1
        for (int rr = 0; rr < 4; ++rr) { const int m = t0 + F.wave * 4 + rr;
            const GAS f32x4* xr = (const GAS f32x4*)(x1 + (size_t)m * D) + F.lane;
            f32x4 v[8]; float ss = 0.f;
#pragma unroll
            for (int j = 0; j < 8; ++j) { v[j] = xr[64 * j]; ss += (v[j].x * v[j].x + v[j].y * v[j].y) + (v[j].z * v[j].z + v[j].w * v[j].w); }
#pragma unroll
            for (int o = 1; o < 64; o <<= 1) ss += __shfl_xor(ss, o);
            const float rstd = 1.0f / sqrtf(ss * (1.f / D) + 1e-6f);
            if (F.lane == 0) RSTD[F.wave * 4 + rr] = rstd;
            GAS unsigned* o4 = (GAS unsigned*)(H2 + (size_t)m * D) + F.lane;
#pragma unroll
            for (int j = 0; j < 8; ++j) { const f32x4 g = *(const LAS f32x4*)(gs + 256 * j + 4 * F.lane), s = *(const LAS f32x4*)(sh + 256 * j + 4 * F.lane);
                const f32x4 y = v[j] * rstd * g + s; o4[64 * j] = cvt4_fp8(y.x, y.y, y.z, y.w); } }
        __syncthreads();
        const int tok = F.tid >> 4, eq = F.tid & 15;
        f32x16 ac0, ac1;
#pragma unroll
        for (int i = 0; i < 16; ++i) { ac0[i] = 0.f; ac1[i] = 0.f; }
#pragma unroll 1
        for (int kc = 0; kc < 8; ++kc) {
#pragma unroll
            for (int q = 0; q < 4; ++q) { const int idx = F.tid + 512 * q; const int row = idx >> 6, c4 = (idx & 63) * 4; const int k = kc * 256 + c4;
                const f32x4 xv = *(const f32x4*)(x1 + (size_t)(t0 + row) * D + k); const float rstd = RSTD[row];
                const f32x4 g = *(const LAS f32x4*)(gs + k), s = *(const LAS f32x4*)(sh + k);
                *(LAS f32x4*)(XS + row * 260 + c4) = xv * rstd * g + s; }
#pragma unroll
            for (int q = 0; q < 8; ++q) { const int idx = F.tid + 512 * q; const int kr = idx >> 4, c4 = (idx & 15) * 4;
                *(LAS f32x4*)(WSm + kr * 64 + c4) = *(const f32x4*)(rw + (size_t)(kc * 256 + kr) * 64 + c4); }
            __syncthreads();
            { const int i31 = F.lane & 31, kh = F.lane >> 5;
#pragma unroll 4
              for (int kp = 0; kp < 16; ++kp) { const int k = 32 * F.wave + 2 * kp + kh;
                  const float av = XS[i31 * 260 + k]; const float b0 = WSm[k * 64 + i31], b1 = WSm[k * 64 + 32 + i31];
                  ac0 = __builtin_amdgcn_mfma_f32_32x32x2f32(av, b0, ac0, 0, 0, 0); ac1 = __builtin_amdgcn_mfma_f32_32x32x2f32(av, b1, ac1, 0, 0, 0); } }
            __syncthreads();
        }
        { LAS float* RED = WSm + F.wave * 2048; const int i31 = F.lane & 31, kh = F.lane >> 5;
#pragma unroll
          for (int rg = 0; rg < 16; ++rg) { const int row = (rg & 3) + 8 * (rg >> 2) + 4 * kh; RED[row * 64 + i31] = ac0[rg]; RED[row * 64 + 32 + i31] = ac1[rg]; } }
        __syncthreads();
        f32x4 lg = (f32x4){0.f, 0.f, 0.f, 0.f};
#pragma unroll
        for (int w = 0; w < 8; ++w) lg += *(const LAS f32x4*)(WSm + w * 2048 + tok * 64 + eq * 4);
#pragma unroll
        for (int i = 0; i < 4; ++i) { const float sc = fsigm(lg[i]); SC[tok * 64 + eq * 4 + i] = sc; SEL[tok * 64 + eq * 4 + i] = sc + rb[eq * 4 + i]; }
        __syncthreads();
        if (F.tid < 32) {
            LAS float* sel = SEL + F.tid * 64; const LAS float* scp = SC + F.tid * 64;
            float gsc[8];
#pragma unroll
            for (int g = 0; g < 8; ++g) { float m1 = -3e38f, m2 = -3e38f;
#pragma unroll
                for (int j = 0; j < 8; ++j) { const float v = sel[g * 8 + j]; if (v > m1) { m2 = m1; m1 = v; } else if (v > m2) m2 = v; }
                gsc[g] = m1 + m2; }
            unsigned gmask = 0u;
#pragma unroll
            for (int r = 0; r < 4; ++r) { float best = -3e38f; int bi = 0;
#pragma unroll
                for (int g = 0; g < 8; ++g) { const bool take = !((gmask >> g) & 1u) && gsc[g] > best; best = take ? gsc[g] : best; bi = take ? g : bi; }
                gmask |= 1u << bi; }
            int idx[8]; float wv[8]; float wsum = 0.f;
#pragma unroll
            for (int r = 0; r < 8; ++r) { float best = -3e38f; int bi = 0;
                for (int e = 0; e < 64; ++e) { const float v = sel[e]; const bool take = ((gmask >> (e >> 3)) & 1u) && v > best; best = take ? v : best; bi = take ? e : bi; }
                sel[bi] = -3e38f; idx[r] = bi; wv[r] = scp[bi]; wsum += wv[r]; }
            const float sc = 2.5f / wsum; const int tk = t0 + F.tid;
#pragma unroll
            for (int r = 0; r < 8; ++r) { const int pos = __hip_atomic_fetch_add(HL + idx[r], 1, __ATOMIC_RELAXED, __HIP_MEMORY_SCOPE_WORKGROUP);
                e_of[tk * 8 + r] = idx[r]; pos_of[tk * 8 + r] = pos; topw[tk * 8 + r] = wv[r] * sc; }
        }
        __syncthreads();
        if (F.tid < 64) hist[it * 64 + F.tid] = HL[F.tid];
        __syncthreads();
    }
}

__device__ __forceinline__ void build_moe_tab_c(const Ctx& F, int c) {
    MoeTab tab = moe_tab(F.lds);
    LAS int* padstart = tab.misc + 8;
    if (F.tid < 64) {
        const int nt = (c + 255) >> 8; int pre = nt;
#pragma unroll
        for (int o = 1; o < 64; o <<= 1) { const int v = __shfl_up(pre, o); if (F.tid >= o) pre += v; }
        const int excl = pre - nt;
        padstart[F.tid] = excl * 256;
        for (int r = 0; r < nt; ++r) { tab.te[excl + r] = F.tid; const int left = c - r * 256; tab.tn[excl + r] = left < 256 ? left : 256; }
        if (F.tid == 63) tab.misc[0] = pre;
    }
    __syncthreads();
}
__device__ __forceinline__ void build_moe_tab(const Ctx& F) {
    int c = 0;
    if (F.tid < 64) c = (int)__hip_atomic_load((unsigned*)(F.ws + WS_CTL) + CW_CNT + F.tid, __ATOMIC_RELAXED, __HIP_MEMORY_SCOPE_AGENT);
    build_moe_tab_c(F, c);
}
__device__ __forceinline__ void p9_dispatch(const Ctx& F) {
    const int* hist = (const int*)(F.ws + WS_HIST);
    LAS int* PL = (LAS int*)F.lds;
    LAS int* TL = PL + 512;
    LAS int* PRE = TL + 512;
    const int* e_of = (const int*)(F.ws + WS_EOF); const int* pos_of = e_of + 65536; const float* topw = (const float*)(pos_of + 65536); int* inv = (int*)(topw + 65536);
    int* toks = (int*)(F.ws + WS_TOKS); float* wsorted = (float*)(toks + SH_ROW0);
    for (int it = F.bx; it < 256; it += F.G) {
        { const int e = F.tid & 63, seg = F.tid >> 6; int slt = 0, sall = 0;
#pragma unroll 8
          for (int q = 0; q < 32; ++q) { const int j = seg * 32 + q; const int v = hist[j * 64 + e]; sall += v; slt += (j < it) ? v : 0; }
          PL[seg * 64 + e] = slt; TL[seg * 64 + e] = sall; }
        __syncthreads();
        int c = 0;
        if (F.tid < 64) { int p = 0;
#pragma unroll
            for (int sg = 0; sg < 8; ++sg) { p += PL[sg * 64 + F.tid]; c += TL[sg * 64 + F.tid]; }
            PRE[F.tid] = p;
            if (it == 0) ((unsigned*)(F.ws + WS_CTL))[CW_CNT + F.tid] = (unsigned)c; }
        build_moe_tab_c(F, c);
        const LAS int* padstart = moe_tab(F.lds).misc + 8;
        if (F.tid < 256) { const int i = it * 256 + F.tid; const int e = e_of[i]; const int dest = padstart[e] + PRE[e] + pos_of[i]; toks[dest] = i >> 3; wsorted[dest] = topw[i]; inv[i] = dest; }
        __syncthreads();
    }
}
__device__ __forceinline__ void p12_combine(const Ctx& F) {
    const unsigned char* Y = F.ws + WS_Y; const int* inv = (const int*)(F.ws + WS_EOF) + 3 * 65536; const float* g2 = (const float*)(F.ws + WS_MODF) + 5 * D;
    const int gw = F.vcu * 8 + F.wave, NGW = F.G * 8;
    for (int m = gw; m < S; m += NGW) {
        int rows[9];
#pragma unroll
        for (int s = 0; s < 8; ++s) rows[s] = inv[m * 8 + s];
        rows[8] = SH_ROW0 + m;
#pragma unroll
        for (int c = 0; c < 2; ++c) { const int col = c * 1024 + F.lane * 16;
            u32x4 v[9];
#pragma unroll
            for (int s = 0; s < 9; ++s) v[s] = *(const u32x4*)(Y + (size_t)rows[s] * D + col);
            float a[16];
#pragma unroll
            for (int e = 0; e < 16; ++e) a[e] = 0.f;
#pragma unroll
            for (int s = 0; s < 9; ++s) { const unsigned w4[4] = {v[s].x, v[s].y, v[s].z, v[s].w};
#pragma unroll
                for (int q = 0; q < 4; ++q) { const f32x2 lo = __builtin_amdgcn_cvt_pk_f32_fp8((int)w4[q], false), hi = __builtin_amdgcn_cvt_pk_f32_fp8((int)w4[q], true);
                    a[4 * q] += lo.x; a[4 * q + 1] += lo.y; a[4 * q + 2] += hi.x; a[4 * q + 3] += hi.y; } }
            float* op = F.out + (size_t)m * D + col;
#pragma unroll
            for (int q = 0; q < 4; ++q) { const f32x4 x0 = *(const f32x4*)(op + 4 * q); const f32x4 gq = *(const f32x4*)(g2 + col + 4 * q) * (1.0f / FP8_YS);
                *(f32x4*)(op + 4 * q) = x0 + gq * (f32x4){a[4 * q], a[4 * q + 1], a[4 * q + 2], a[4 * q + 3]}; } }
    }
}


__device__ __forceinline__ void ph2_proj(const Ctx& F) {
    pg8::ProjSched<false> Sa; Sa.init(F.ws + WS_H, D * 2, F.ws + WS_WINT, D * 2, F.G, F.bx);
    pg8::ProjSched<true> Sb; Sb.init(F.ws + WS_H8, D, F.ws + WS_WIN8, D, F.G, F.bx);
    EpiBf16 Ea{(bf16_t*)(F.ws + WS_PROJ), INW, 0, 1.0f}; EpiBf16 Eb{(bf16_t*)(F.ws + WS_PROJ), INW, 0, 1.0f / FP8_WIN};
    const int na = Sa.count(), nb = Sb.count(), ntot = na + nb;
    const int slot = ntot > 0 ? ((F.bx >> 3) + (F.bx & 7)) % ntot : 0;
    const int sa = slot < na ? slot : na, sb = slot < na ? 0 : slot - na;
    Sa.i_lo = 0; Sa.i_hi = sa; pg8::gemm_phase<EpiBf16, pg8::ProjSched<false>, true, false>(F.lds, D, Sa, Ea);
    if (slot < na) { __syncthreads(); convert_items(F, CV_BG_FROM, CV_ALL, F.vcu * 8 + F.wave, F.G * 8); __syncthreads(); }
    Sa.i_lo = sa; Sa.i_hi = na; pg8::gemm_phase<EpiBf16, pg8::ProjSched<false>, true, false>(F.lds, D, Sa, Ea);
    Sb.i_lo = 0; Sb.i_hi = sb; pg8::gemm_phase<EpiBf16, pg8::ProjSched<true>, true, true>(F.lds, D, Sb, Eb);
    if (slot >= na) { __syncthreads(); convert_items(F, CV_BG_FROM, CV_ALL, F.vcu * 8 + F.wave, F.G * 8); __syncthreads(); }
    Sb.i_lo = sb; Sb.i_hi = nb; pg8::gemm_phase<EpiBf16, pg8::ProjSched<true>, true, true>(F.lds, D, Sb, Eb);
}
__device__ __forceinline__ void ph6a_merge(const Ctx& F) {
    pg8::DenseSched Sd; Sd.init(F.ws + WS_YA, 1024, F.ws + WS_PA, S, D, 1024, F.G, F.bx);
    EpiGate<false> E{(bf16_t*)(F.ws + WS_MERGED), D, (const bf16_t*)(F.ws + WS_PROJ) + C_GA, INW};
    pg8::gemm_phase<EpiGate<false>, pg8::DenseSched, true>(F.lds, 1024, Sd, E);
}
__device__ __forceinline__ void ph6_merge(const Ctx& F) {
    pg8::DenseSched Sd; Sd.init(F.ws + WS_YB, D, F.ws + WS_PB, S, D, D, F.G, F.bx);
    EpiGate<true> E{(bf16_t*)(F.ws + WS_MERGED), D, (const bf16_t*)(F.ws + WS_PROJ) + C_GB, INW};
    pg8::gemm_phase<EpiGate<true>, pg8::DenseSched, true>(F.lds, D, Sd, E);
}
__device__ __forceinline__ void p5_mix2_a(const Ctx& F) { p5_mix2(F); __syncthreads(); ph6a_merge(F); }
__device__ __forceinline__ void ph7_wo(const Ctx& F) {
    pg8::DenseSched Sd; Sd.init(F.ws + WS_MERGED, D, F.ws + WS_WO, S, D, D, F.G, F.bx);
    EpiResid E{inp(F, IN_X), F.out, D, (const float*)(F.ws + WS_MODF) + 2 * D};
    pg8::gemm_phase<EpiResid, pg8::DenseSched, true>(F.lds, D, Sd, E);
}
__device__ __forceinline__ void ph10_gateup(const Ctx& F) {
    build_moe_tab(F);
    MoeSched1 S1{(const char*)(F.ws + WS_H), (const char*)(F.ws + WS_E1), (const int*)(F.ws + WS_TOKS), moe_tab(F.lds), F.G, F.vcu};
    EpiGateUp E{(unsigned char*)(F.ws + WS_ACT)};
    pg8::gemm_phase<EpiGateUp, MoeSched1, true, true>(F.lds, D, S1, E);
}
__device__ __forceinline__ void ph11_down(const Ctx& F) {
    build_moe_tab(F);
    MoeSched2 S2{(const char*)(F.ws + WS_ACT), (const char*)(F.ws + WS_E2), moe_tab(F.lds), F.G, F.vcu};
    EpiDown E{(unsigned char*)(F.ws + WS_Y), (const float*)(F.ws + WS_TOKS) + SH_ROW0};
    pg8::gemm_phase<EpiDown, MoeSched2, true, true>(F.lds, ED, S2, E);
}

struct Args { const float* in[22]; float* out; unsigned char* ws; int ph_lo, ph_hi; };
__global__ void __launch_bounds__(512, 2) fwd(Args args) {
    extern __shared__ __attribute__((aligned(16))) unsigned char lds_raw[];
    Ctx F;
    F.lds = (LAS unsigned char*)lds_raw;
    F.tid = threadIdx.x; F.lane = F.tid & 63; F.wave = __builtin_amdgcn_readfirstlane(F.tid >> 6);
    F.G = gridDim.x; F.bx = blockIdx.x; F.vcu = (F.G % 8 == 0) ? (F.bx % 8) * (F.G / 8) + F.bx / 8 : F.bx;
    F.out = args.out; F.ws = args.ws;
    if (F.tid == 0) {
#pragma unroll
        for (int i = 0; i < 22; ++i) ((LAS unsigned long long*)(F.lds + LDS_PTRS))[i] = (unsigned long long)args.in[i];
    }
    volatile LAS unsigned* MISC = (volatile LAS unsigned*)(F.lds + LDS_MISC);
    if (F.tid < 64) MISC[F.tid] = 0u;
    __syncthreads();
    unsigned* ctl = (unsigned*)(F.ws + WS_CTL);
    XcdBarrier bar; bar.bar = ctl + CW_BAR; bar.x = 0; bar.st = nullptr;
    if (!MK_PER_PHASE) bar = xcd_barrier_post(ctl + CW_BAR, MISC + 8);
    const int lo = args.ph_lo, hi = args.ph_hi;
#ifndef PHASE_MASK
#define PHASE_MASK 0x1fff
#endif
#define IN(k) (((PHASE_MASK >> (k)) & 1) && lo <= (k) && (k) < hi)
#define SEAM(k) do { if (IN(k) && IN((k) + 1)) xcd_barrier(bar); } while (0)

#ifndef DUP_MASK
#define DUP_MASK 0
#endif
#define RUN(k, fn) do { if (IN(k)) { fn(F); if ((DUP_MASK >> (k)) & 1) { xcd_barrier(bar); fn(F); } } SEAM(k); } while (0)
    RUN(0, p0_prologue);
    RUN(1, p1_norm1);
    RUN(2, ph2_proj);
    RUN(3, p3_mix1);
    RUN(4, p4_scan_comb);
    RUN(5, p5_mix2_a);
    RUN(6, ph6_merge);
    RUN(7, ph7_wo);
    RUN(8, p8_router);
    RUN(9, p9_dispatch);
    RUN(10, ph10_gateup);
    RUN(11, ph11_down);
    RUN(12, p12_combine);
#undef RUN
#undef IN
#undef SEAM
}

extern "C" void kernel_launch(void* const* d_in, const int* in_sizes, int n_in, void* d_out, int out_size, void* d_ws, size_t ws_size, hipStream_t stream) {
    static int grid = 0;
    if (grid == 0) {
        if (n_in != 22 || out_size != S * D || ws_size < WS_END) { fprintf(stderr, "kernel_launch: unexpected shapes / workspace (n_in %d out %d ws %zu need %zu)\n", n_in, out_size, ws_size, (size_t)WS_END); grid = -1; return; }
        int dev = 0, cus = 0, per_cu = 0;
        if (hipGetDevice(&dev) != hipSuccess || hipDeviceGetAttribute(&cus, hipDeviceAttributeMultiprocessorCount, dev) != hipSuccess) { grid = -1; return; }
        if (hipFuncSetAttribute((const void*)fwd, hipFuncAttributeMaxDynamicSharedMemorySize, LDS_BYTES) != hipSuccess) { fprintf(stderr, "kernel_launch: hipFuncSetAttribute failed\n"); grid = -1; return; }
        if (hipOccupancyMaxActiveBlocksPerMultiprocessor(&per_cu, (const void*)fwd, 512, LDS_BYTES) != hipSuccess || per_cu < 1) fprintf(stderr, "kernel_launch: occupancy query says %d\n", per_cu);
        (void)hipGetLastError();
        grid = cus;
    }
    if (grid < 0) return;
    (void)hipMemsetAsync((char*)d_ws + WS_CTL, 0, CTL_ZERO_BYTES, stream);
    Args a{};
    for (int i = 0; i < 22; ++i) a.in[i] = (const float*)d_in[i];
    a.out = (float*)d_out; a.ws = (unsigned char*)d_ws;
#if MK_PER_PHASE
    for (int p = 0; p < NPH; ++p) { a.ph_lo = p; a.ph_hi = p + 1; hipLaunchKernelGGL(fwd, dim3(grid), dim3(512), LDS_BYTES, stream, a); }
#else
    a.ph_lo = 0; a.ph_hi = NPH; hipLaunchKernelGGL(fwd, dim3(grid), dim3(512), LDS_BYTES, stream, a);
#endif
}
```

```cpp
#ifndef P10_SLOTS
#define P10_SLOTS 5
#endif
#include <hip/hip_runtime.h>
#include <cstdio>
#include <cstdint>

#define LAS __attribute__((address_space(3)))
#define GAS __attribute__((address_space(1)))
typedef unsigned short bf16_t;
typedef short bf16x8 __attribute__((ext_vector_type(8)));
typedef short bf16x4 __attribute__((ext_vector_type(4)));
typedef float f32x4 __attribute__((ext_vector_type(4)));
typedef float f32x2 __attribute__((ext_vector_type(2)));
typedef float f32x16 __attribute__((ext_vector_type(16)));
typedef unsigned u32x4 __attribute__((ext_vector_type(4)));
typedef unsigned u32x2 __attribute__((ext_vector_type(2)));
typedef GAS unsigned gu32;

#ifndef DUP2_MASK
#define DUP2_MASK 0
#endif
#ifndef MK_PER_PHASE
#define MK_PER_PHASE 0
#endif

constexpr int S = 8192, D = 2048, INW = 19456;
constexpr int C_QA = 0, C_KA = 3072, C_VA = 6144, C_QR = 9216, C_KR = 10240, C_VR = 11264, C_GR = 13312, C_GA = 15360, C_GB = 17408;
constexpr int NE = 64, ED = 512, TOPK = 8;
constexpr int MAXT_R = 320;
constexpr int SH_ROW0 = MAXT_R * 256;
constexpr int NROWS_Y = SH_ROW0 + S;
constexpr int NPH = 13;

constexpr size_t MiB = 1u << 20;
constexpr size_t WS_CTL = 0, CTL_ZERO_BYTES = 1 * MiB;
constexpr size_t WS_MODP = 1 * MiB;
constexpr size_t WS_MODF = 1 * MiB + 512 * 1024;
constexpr size_t WS_LSE = 2 * MiB;
constexpr size_t WS_ROPE = 3 * MiB;
constexpr size_t WS_EOF = 7 * MiB;
constexpr size_t WS_RWH = 9 * MiB, WS_RWL = 9 * MiB + 256 * 1024;
constexpr size_t WS_TOKS = 8 * MiB;
constexpr size_t WS_HIST = 8 * MiB + 720896;
constexpr size_t WS_PA = 10 * MiB, WS_PB = 14 * MiB, WS_WO = 22 * MiB;
constexpr size_t WS_H = 32 * MiB;
constexpr size_t WS_E1 = 64 * MiB;
constexpr size_t WS_H8 = 194 * MiB;
constexpr size_t WS_WIN8 = 210 * MiB;
constexpr size_t WS_E2 = 324 * MiB;
constexpr size_t WS_PREV = 454 * MiB;
constexpr size_t WS_YB = 486 * MiB;
constexpr size_t WS_MERGED = 518 * MiB;
constexpr size_t WS_R1 = 550 * MiB;
constexpr size_t WS_OG = WS_R1, WS_YA = WS_R1 + 48 * MiB, WS_UPD = WS_R1 + 64 * MiB, WS_ACT = WS_R1;
constexpr size_t WS_R2 = 678 * MiB;
constexpr size_t WS_WINT = WS_R2, WS_PROJ = WS_R2 + 76 * MiB, WS_Y = WS_R2;
constexpr size_t WS_END = 1058 * MiB;
constexpr int CW_TMO = 0, CW_CODE = 1, CW_BAR = 4096, CW_CNT = 8192;

constexpr int RING_BYTES = 131072;
constexpr int LDS_TAB = 131072;
constexpr int LDS_EPI = 131072 + 8192;
constexpr int LDS_MISC = 163840 - 256;
constexpr int LDS_BYTES = 163840;

__device__ __forceinline__ float bf2f(unsigned b) { return __uint_as_float(b << 16); }
__device__ __forceinline__ unsigned cvt_pk_bf16(float lo, float hi) { unsigned r; asm("v_cvt_pk_bf16_f32 %0, %1, %2" : "=v"(r) : "v"(lo), "v"(hi)); return r; }
__device__ __forceinline__ float fsilu(float v) { return v / (1.f + __expf(-v)); }
__device__ __forceinline__ float fsigm(float v) { return 1.f / (1.f + __expf(-v)); }
#define TR_READ(dst, base, OFF) asm volatile("ds_read_b64_tr_b16 %0, %1 offset:%2" : "=&v"(dst) : "v"(base), "i"(OFF) : "memory")
#define TR_WAIT2(a, b) asm volatile("s_waitcnt lgkmcnt(0)" : "+v"(a), "+v"(b) :: "memory")
#define TR_WAIT4(a, b, c, d) asm volatile("s_waitcnt lgkmcnt(0)" : "+v"(a), "+v"(b), "+v"(c), "+v"(d) :: "memory")
typedef int i32x8 __attribute__((ext_vector_type(8)));
__device__ __forceinline__ unsigned cvt4_fp8(float a, float b, float c, float d) {
    a = fminf(fmaxf(a, -448.f), 448.f); b = fminf(fmaxf(b, -448.f), 448.f); c = fminf(fmaxf(c, -448.f), 448.f); d = fminf(fmaxf(d, -448.f), 448.f);
    int r = __builtin_amdgcn_cvt_pk_fp8_f32(a, b, 0, false); r = __builtin_amdgcn_cvt_pk_fp8_f32(c, d, r, true); return (unsigned)r;
}
__device__ __forceinline__ i32x8 ld32(const LAS unsigned char* p) { const u32x4 a = *(const LAS u32x4*)p, b = *(const LAS u32x4*)(p + 1024); i32x8 r; r[0] = (int)a.x; r[1] = (int)a.y; r[2] = (int)a.z; r[3] = (int)a.w; r[4] = (int)b.x; r[5] = (int)b.y; r[6] = (int)b.z; r[7] = (int)b.w; return r; }
__device__ __forceinline__ i32x8 cat8(bf16x8 lo, bf16x8 hi) { const u32x4 a = __builtin_bit_cast(u32x4, lo), b = __builtin_bit_cast(u32x4, hi); i32x8 r; r[0] = (int)a.x; r[1] = (int)a.y; r[2] = (int)a.z; r[3] = (int)a.w; r[4] = (int)b.x; r[5] = (int)b.y; r[6] = (int)b.z; r[7] = (int)b.w; return r; }
constexpr float FP8_WIN = 32.f;
#ifndef PROJ_ALL_FP8
#define PROJ_ALL_FP8 1
#endif
__host__ __device__ __forceinline__ bool proj_tile_fp8(int pn) { return PROJ_ALL_FP8 || (pn >= 24 && pn < 36) || pn >= 44; }
constexpr float FP8_PW = 32.f, FP8_YAS = 32.f, FP8_YBS = 16.f;
constexpr float FP8_WO = 32.f, FP8_MS = 16.f;
constexpr float FP8_WS1 = 32.f, FP8_WS2 = 16.f, FP8_AS = 4.f, FP8_YS = 32.f;
#define LDS_WAIT() asm volatile("s_waitcnt lgkmcnt(0)" ::: "memory")
#define VM_WAIT() asm volatile("s_waitcnt vmcnt(0)" ::: "memory")

namespace pg8 {
constexpr int BM = 256, BK = 64, HALF = 128, HTB = HALF * BK * 2, STAGE_BYTES = 8 * HTB, NXCD = 8, WGM = 8;
__host__ __device__ __forceinline__ int lds_byte(int r, int c) { const int st = (r >> 4) * 2 + (c >> 5), rr = r & 15, cc = c & 31, ob = rr * 64 + cc * 2; return st * 1024 + (ob ^ (((ob >> 9) & 1) << 5)); }
__host__ __device__ __forceinline__ void stage_rc(int b, int& R, int& C) { const int st = b / 1024, sb = b % 1024, swz = sb ^ (((sb >> 9) & 1) << 5); R = (st >> 1) * 16 + swz / 64; C = (st & 1) * 32 + (swz % 64) / 2; }
__host__ __device__ __forceinline__ int perm32(int rho) { const int n = rho >> 4, i = rho & 15; return 8 * (i >> 2) + 4 * n + (i & 3); }

struct Unit { int row0, pn, e, nvalid; };

struct DenseSched {
    static constexpr bool RAGGED = false;
    const char* A; const char* Bt; int lda, K; int nM, nN, nwg, G, c, i_lo, i_hi;
    __device__ __forceinline__ void init(const void* A_, int lda_, const void* Bt_, int M, int N, int K_, int G_, int c_) { A = (const char*)A_; Bt = (const char*)Bt_; lda = lda_; K = K_; nM = M / BM; nN = N / BM; nwg = nM * nN; G = G_; c = c_; i_lo = 0; i_hi = 0x7fffffff; }
    __device__ __forceinline__ bool next(int i, Unit& u) const {
        if (i_lo + i >= i_hi) return false;
        const long L = (long)(i_lo + i) * G + c; if (L >= nwg) return false;
        int wgid = (int)L; { const int q = nwg / NXCD, r = nwg % NXCD, xcd = wgid % NXCD, off = wgid / NXCD; wgid = (xcd < r ? xcd * (q + 1) : r * (q + 1) + (xcd - r) * q) + off; }
        const int nig = WGM * nN, gid = wgid / nig, fm = gid * WGM, gsz = (nM - fm) < WGM ? (nM - fm) : WGM;
        u.row0 = (fm + ((wgid % nig) % gsz)) * BM; u.pn = (wgid % nig) / gsz; u.e = 0; u.nvalid = 256; return true;
    }
    __device__ __forceinline__ const char* a_base() const { return A; }
    __device__ __forceinline__ const char* b_ptr(const Unit& u) const { return Bt + (size_t)u.pn * BM * K * 2; }
    __device__ __forceinline__ void a_off(const Unit& u, int tid, unsigned (&off)[2][2]) const {
#pragma unroll
        for (int i = 0; i < 2; ++i) { int R, C; stage_rc(tid * 16 + i * 8192, R, C);
            off[0][i] = (unsigned)((u.row0 + R) * lda + C) * 2u; off[1][i] = (unsigned)((u.row0 + HALF + R) * lda + C) * 2u; }
    }
};


struct DenseSched8 {
    static constexpr bool RAGGED = false;
    const char* A; const char* Bt; int apitch, bpitch; int nM, nN, nwg, G, c;
    __device__ __forceinline__ void init(const void* A_, int apitch_, const void* Bt_, int bpitch_, int M, int N, int G_, int c_) { A = (const char*)A_; Bt = (const char*)Bt_; apitch = apitch_; bpitch = bpitch_; nM = M / BM; nN = N / BM; nwg = nM * nN; G = G_; c = c_; }
    __device__ __forceinline__ bool next(int i, Unit& u) const {
        const long L = (long)i * G + c; if (L >= nwg) return false;
        int wgid = (int)L; { const int q = nwg / NXCD, r = nwg % NXCD, xcd = wgid % NXCD, off = wgid / NXCD; wgid = (xcd < r ? xcd * (q + 1) : r * (q + 1) + (xcd - r) * q) + off; }
        const int nig = WGM * nN, gid = wgid / nig, fm = gid * WGM, gsz = (nM - fm) < WGM ? (nM - fm) : WGM;
        u.row0 = (fm + ((wgid % nig) % gsz)) * BM; u.pn = (wgid % nig) / gsz; u.e = 0; u.nvalid = 256; return true;
    }
    __device__ __forceinline__ const char* a_base() const { return A; }
    __device__ __forceinline__ const char* b_ptr(const Unit& u) const { return Bt + (size_t)u.pn * BM * bpitch; }
    __device__ __forceinline__ void a_off(const Unit& u, int tid, unsigned (&off)[2][2]) const {
#pragma unroll
        for (int i = 0; i < 2; ++i) { int R, C; stage_rc(tid * 16 + i * 8192, R, C);
            off[0][i] = (unsigned)((u.row0 + R) * apitch + 2 * C); off[1][i] = (unsigned)((u.row0 + HALF + R) * apitch + 2 * C); }
    }
};

template <bool FP8SET> struct ProjSched {
    static constexpr bool RAGGED = false;
    static constexpr int ntl = PROJ_ALL_FP8 ? (FP8SET ? 76 : 0) : (FP8SET ? 44 : 32), nM = 32, nwg = nM * ntl;
    const char* A; const char* Bt; int apitch, bpitch; int G, c, i_lo, i_hi;
    __device__ __forceinline__ void init(const void* A_, int apitch_, const void* Bt_, int bpitch_, int G_, int c_) { A = (const char*)A_; Bt = (const char*)Bt_; apitch = apitch_; bpitch = bpitch_; G = G_; c = c_; i_lo = 0; i_hi = 0x7fffffff; }
    __device__ __forceinline__ int count() const { return c < nwg ? (nwg - c + G - 1) / G : 0; }
    __device__ __forceinline__ bool next(int i, Unit& u) const {
        if (i_lo + i >= i_hi) return false;
        const long L = (long)(i_lo + i) * G + c; if (L >= nwg) return false;
        int wgid = (int)L; { const int q = nwg / NXCD, r = nwg % NXCD, xcd = wgid % NXCD, off = wgid / NXCD; wgid = (xcd < r ? xcd * (q + 1) : r * (q + 1) + (xcd - r) * q) + off; }
        const int nig = WGM * ntl, gid = wgid / nig, fm = gid * WGM, gsz = (nM - fm) < WGM ? (nM - fm) : WGM;
        u.row0 = (fm + ((wgid % nig) % gsz)) * BM; const int t = (wgid % nig) / gsz;
        u.pn = PROJ_ALL_FP8 ? t : (FP8SET ? (t < 12 ? 24 + t : 32 + t) : (t < 24 ? t : t + 12)); u.e = 0; u.nvalid = 256; return true;
    }
    __device__ __forceinline__ const char* a_base() const { return A; }
    __device__ __forceinline__ const char* b_ptr(const Unit& u) const { return Bt + (size_t)u.pn * BM * bpitch; }
    __device__ __forceinline__ void a_off(const Unit& u, int tid, unsigned (&off)[2][2]) const {
#pragma unroll
        for (int i = 0; i < 2; ++i) { int R, C; stage_rc(tid * 16 + i * 8192, R, C);
            off[0][i] = (unsigned)((u.row0 + R) * apitch + 2 * C); off[1][i] = (unsigned)((u.row0 + HALF + R) * apitch + 2 * C); }
    }
};

template <class Epi, class Sched, bool ALIGN_EPI, bool FP8 = false>
__device__ __forceinline__ void gemm_phase(LAS unsigned char* lds, const int K, const Sched& S, const Epi& E) {
    const int tid = threadIdx.x, wid = __builtin_amdgcn_readfirstlane(tid >> 6), lane = tid & 63, wr = wid >> 2, wc = wid & 3, fr = lane & 15, fq = lane >> 4;
    const int nt = FP8 ? K / 128 : K / BK;
    const int pitch = FP8 ? K : 2 * K;
    unsigned voffB[2], voffB1[2];
#pragma unroll
    for (int i = 0; i < 2; ++i) { int R, C; stage_rc(tid * 16 + i * 8192, R, C);
        if constexpr (Epi::PERM2) { const int rb = 64 * (R >> 5) + 16 * ((R & 15) >> 2) + 4 * ((R >> 4) & 1) + (R & 3); voffB[i] = (unsigned)(rb * pitch + 2 * C); voffB1[i] = (unsigned)((rb + 8) * pitch + 2 * C); }
        else { const int Rb = Epi::PERM ? ((R & ~31) + perm32(R & 31)) : R; voffB[i] = (unsigned)(Rb * pitch + 2 * C); voffB1[i] = voffB[i]; } }
    const size_t kstep = (size_t)(BK * 2);
    const size_t hstepB = Epi::PERM2 ? (size_t)0 : (size_t)HALF * pitch;
    const unsigned ldsw = (unsigned)wid * 1024u;
    const int aoff = lds_byte(wr * 64 + fr, fq * 8), boff = lds_byte(wc * 32 + fr, fq * 8);
#define PG8_SA(b, h) (((b) * 2 + (h)) * HTB)
#define PG8_SB(b, h) ((4 + (b) * 2 + (h)) * HTB)
#define PG8_STAGE(bufoff, gbase, voff) do { _Pragma("unroll") for (int _i = 0; _i < 2; ++_i) \
        __builtin_amdgcn_global_load_lds((const unsigned*)((const char*)(gbase) + (voff)[_i]), (LAS unsigned*)(lds + (bufoff) + ldsw + _i * 8192), 16, 0, 0); } while (0)
#define PG8_LDA(dst, b, h) do { if constexpr (FP8) { _Pragma("unroll") for (int m = 0; m < 4; ++m) dst##8[m] = ld32(lds + PG8_SA(b, h) + aoff + m * 2048); } \
        else { _Pragma("unroll") for (int m = 0; m < 4; ++m) _Pragma("unroll") for (int k = 0; k < 2; ++k) dst[m][k] = *(const LAS bf16x8*)(lds + PG8_SA(b, h) + aoff + m * 2048 + k * 1024); } } while (0)
#define PG8_LDB(dst, b, h) do { if constexpr (FP8) { _Pragma("unroll") for (int n = 0; n < 2; ++n) dst##8[n] = ld32(lds + PG8_SB(b, h) + boff + n * 2048); } \
        else { _Pragma("unroll") for (int n = 0; n < 2; ++n) _Pragma("unroll") for (int k = 0; k < 2; ++k) dst[n][k] = *(const LAS bf16x8*)(lds + PG8_SB(b, h) + boff + n * 2048 + k * 1024); } } while (0)
#define PG8_MMA(ai, bj, At, Bt) do { __builtin_amdgcn_s_setprio(1); if constexpr (FP8) { _Pragma("unroll") for (int m = 0; m < 4; ++m) _Pragma("unroll") for (int n = 0; n < 2; ++n) \
        asm volatile("v_mfma_scale_f32_16x16x128_f8f6f4 %0, %1, %2, %0, %3, %3 op_sel_hi:[0,0,0]" : "+v"(acc[ai][bj][m][n]) : "v"(Bt##8[n]), "v"(At##8[m]), "v"(fp8_one)); } \
      else { _Pragma("unroll") for (int m = 0; m < 4; ++m) _Pragma("unroll") for (int n = 0; n < 2; ++n) _Pragma("unroll") for (int k = 0; k < 2; ++k) \
        acc[ai][bj][m][n] = __builtin_amdgcn_mfma_f32_16x16x32_bf16(Bt[n][k], At[m][k], acc[ai][bj][m][n], 0, 0, 0); } __builtin_amdgcn_s_setprio(0); } while (0)
#define PG8_WAIT_V(n) asm volatile("s_waitcnt vmcnt(" #n ")" ::: "memory")
#define PG8_WAIT_VX(fresh, extra) asm volatile("v_cmp_ne_u32_e32 vcc, 0, %0\n\ts_nop 0\n\ts_cbranch_vccnz .Lwx%=a\n\ts_waitcnt vmcnt(8)\n\ts_branch .Lwx%=b\n.Lwx%=a:\n\ts_waitcnt vmcnt(%1)\n.Lwx%=b:" :: "v"(fresh), "n"(8 + (extra) + Epi::NST) : "memory", "vcc")
#define PG8_WAIT_L(n) asm volatile("s_waitcnt lgkmcnt(" #n ")" ::: "memory")
#define PG8_BAR __builtin_amdgcn_s_barrier()
#define PG8_SCHED __builtin_amdgcn_sched_barrier(0)
    Unit cur, nxt; int ui = 0;
    if (!S.next(0, cur)) return;
    f32x4 acc[2][2][4][2];
#pragma unroll
    for (int a = 0; a < 2; ++a)
#pragma unroll
        for (int b = 0; b < 2; ++b)
#pragma unroll
            for (int m = 0; m < 4; ++m)
#pragma unroll
                for (int n = 0; n < 2; ++n) acc[a][b][m][n] = (f32x4){0.f, 0.f, 0.f, 0.f};
    bf16x8 At[4][2], B0[2][2], B1[2][2];
    i32x8 At8[4], B08[2], B18[2];
    const int fp8_one = 0x7f7f7f7f;
    unsigned coff[2][2], noff[2][2];
    S.a_off(cur, tid, coff);
    const char* const Ab = S.a_base();
    const char* cB = S.b_ptr(cur);
    PG8_STAGE(PG8_SB(0, 0), cB, voffB); PG8_STAGE(PG8_SB(0, 1), cB + hstepB, voffB1); PG8_STAGE(PG8_SA(0, 0), Ab, coff[0]); PG8_STAGE(PG8_SA(0, 1), Ab, coff[1]);
    if (wr == 1) PG8_BAR;
    PG8_WAIT_V(2); PG8_BAR;
    PG8_STAGE(PG8_SB(1, 0), cB + kstep, voffB); PG8_STAGE(PG8_SA(1, 0), Ab + kstep, coff[0]); PG8_STAGE(PG8_SB(1, 1), cB + hstepB + kstep, voffB1);
    PG8_WAIT_V(6); PG8_BAR;
    for (;;) {
        const bool has_next = S.next(ui + 1, nxt);
        const char* nB = has_next ? S.b_ptr(nxt) : cB;
        for (int t = 0; t < nt; t += 2) {
            const bool last = (t == nt - 2);
            const int fresh = ((t == 0) && (ui > 0)) ? 1 : 0;
            const char* a1 = Ab + (size_t)(t + 1) * kstep;
            const char* a2 = last ? Ab : Ab + (size_t)(t + 2) * kstep; const char* b2 = last ? nB : cB + (size_t)(t + 2) * kstep;
            const char* a3 = a2 + kstep; const char* b3 = b2 + kstep;
            if (last && has_next) S.a_off(nxt, tid, noff);
            PG8_LDB(B0, 0, 0); PG8_LDB(B1, 0, 1); PG8_SCHED; PG8_LDA(At, 0, 0); PG8_STAGE(PG8_SA(1, 1), a1, coff[1]);
            PG8_WAIT_VX(fresh, 0); PG8_WAIT_L(0); PG8_BAR; PG8_MMA(0, 0, At, B0); PG8_MMA(0, 1, At, B1); PG8_BAR; PG8_SCHED;
            if (last && has_next) { coff[0][0] = noff[0][0]; coff[0][1] = noff[0][1]; coff[1][0] = noff[1][0]; coff[1][1] = noff[1][1]; }
            PG8_LDA(At, 0, 1); PG8_STAGE(PG8_SB(0, 0), b2, voffB); PG8_STAGE(PG8_SB(0, 1), b2 + hstepB, voffB1); PG8_STAGE(PG8_SA(0, 0), a2, coff[0]);
            PG8_WAIT_VX(fresh, 0); PG8_WAIT_L(0); PG8_BAR; if (!Sched::RAGGED || cur.nvalid > HALF) { PG8_MMA(1, 0, At, B0); PG8_MMA(1, 1, At, B1); } PG8_BAR; PG8_SCHED;
            PG8_LDB(B0, 1, 0); PG8_LDB(B1, 1, 1); PG8_SCHED; PG8_LDA(At, 1, 0); PG8_STAGE(PG8_SA(0, 1), a2, coff[1]);
            PG8_WAIT_VX(fresh, 2); PG8_WAIT_L(0); PG8_BAR; PG8_MMA(0, 0, At, B0); PG8_MMA(0, 1, At, B1); PG8_BAR; PG8_SCHED;
            PG8_LDA(At, 1, 1); PG8_STAGE(PG8_SB(1, 0), b3, voffB); PG8_STAGE(PG8_SB(1, 1), b3 + hstepB, voffB1); PG8_STAGE(PG8_SA(1, 0), a3, coff[0]);
            PG8_WAIT_V(8); PG8_WAIT_L(0); PG8_BAR; if (!Sched::RAGGED || cur.nvalid > HALF) { PG8_MMA(1, 0, At, B0); PG8_MMA(1, 1, At, B1); } PG8_BAR; PG8_SCHED;
        }
        if constexpr (ALIGN_EPI) { if (wr == 0) PG8_BAR; }
        if constexpr (FP8) asm volatile("s_nop 15\n\ts_nop 15\n\ts_nop 15" ::: "memory");
        E(acc, cur, wr, wc, fr, fq);
        if (!has_next) break;
#pragma unroll
        for (int a = 0; a < 2; ++a)
#pragma unroll
            for (int b = 0; b < 2; ++b)
#pragma unroll
                for (int m = 0; m < 4; ++m)
#pragma unroll
                    for (int n = 0; n < 2; ++n) acc[a][b][m][n] = (f32x4){0.f, 0.f, 0.f, 0.f};
        cur = nxt; cB = nB; ++ui;
        if constexpr (ALIGN_EPI) { if (wr == 1) PG8_BAR; }
    }
    PG8_WAIT_V(0);
    if constexpr (!ALIGN_EPI) { if (wr == 0) PG8_BAR; }
    PG8_BAR;
#undef PG8_SA
#undef PG8_SB
#undef PG8_STAGE
#undef PG8_LDA
#undef PG8_LDB
#undef PG8_MMA
#undef PG8_WAIT_V
#undef PG8_WAIT_VX
#undef PG8_WAIT_L
#undef PG8_BAR
#undef PG8_SCHED
}
}
using pg8::Unit;

struct EpiBf16 {
    static constexpr bool PERM = true, PERM2 = true; static constexpr int NST = 16;
    bf16_t* O; int ldc; int nostore; float scale; LAS unsigned char* ebuf;
    __device__ __forceinline__ void operator()(const f32x4 (&acc)[2][2][4][2], const Unit& u, int wr, int wc, int fr, int fq) const {
        int lane = __builtin_amdgcn_mbcnt_hi(~0u, __builtin_amdgcn_mbcnt_lo(~0u, 0u)); asm volatile("" : "+v"(lane));
        const int fr_ = lane & 15, fq_ = lane >> 4, rr = lane >> 3, pc = lane & 7;
        LAS unsigned char* wp = ebuf + fr_ * 128; const int x0 = ((2 * fq_) ^ (fr_ & 7)) << 4, x1 = x0 ^ 16;
        const LAS unsigned char* rp = ebuf + rr * 128 + ((pc ^ rr) << 4);
        const unsigned goff = (unsigned)((u.row0 + wr * 64 + rr) * INW + u.pn * 256 + wc * 64 + 8 * pc) * 2u;
#pragma unroll
        for (int ai = 0; ai < 2; ++ai)
#pragma unroll
            for (int m = 0; m < 4; ++m) {
#pragma unroll
                for (int bj = 0; bj < 2; ++bj) { const f32x4 v0 = acc[ai][bj][m][0] * scale, v1 = acc[ai][bj][m][1] * scale;
                    u32x4 w; w.x = cvt_pk_bf16(v0[0], v0[1]); w.y = cvt_pk_bf16(v0[2], v0[3]); w.z = cvt_pk_bf16(v1[0], v1[1]); w.w = cvt_pk_bf16(v1[2], v1[3]);
                    *(LAS u32x4*)(wp + (bj ? x1 : x0)) = w; }
                const u32x4 r0 = *(const LAS u32x4*)rp, r1 = *(const LAS u32x4*)(rp + 1024);
                unsigned char* g = (unsigned char*)O + (goff + (unsigned)((ai * 128 + m * 16) * INW * 2));
                *(u32x4*)g = r0; *(u32x4*)(g + 8 * INW * 2) = r1; }
    }
};
template <bool ADD> struct EpiGate {
    static constexpr bool PERM = true, PERM2 = false; static constexpr int NST = 16;
    bf16_t* O; int ldc; const bf16_t* gate; int ldg; unsigned char* O8; float scale;
    __device__ __forceinline__ void operator()(const f32x4 (&acc)[2][2][4][2], const Unit& u, int wr, int wc, int fr, int fq) const {
        const int row0 = u.row0 + wr * 64 + fr, col0 = u.pn * 256 + wc * 32 + 8 * fq;
#pragma unroll
        for (int ai = 0; ai < 2; ++ai)
#pragma unroll
            for (int m = 0; m < 4; ++m) { const size_t r = (size_t)(row0 + ai * 128 + m * 16); bf16_t* rowp = O + r * ldc + col0; const bf16_t* gp = gate + r * ldg + col0;
#pragma unroll
                for (int bj = 0; bj < 2; ++bj) { const f32x4 v0 = acc[ai][bj][m][0] * scale, v1 = acc[ai][bj][m][1] * scale;
                    const u32x4 g = *(const u32x4*)(gp + bj * 128);
                    float o[8];
                    o[0] = fsigm(bf2f(g.x & 0xffffu)) * v0[0]; o[1] = fsigm(bf2f(g.x >> 16)) * v0[1]; o[2] = fsigm(bf2f(g.y & 0xffffu)) * v0[2]; o[3] = fsigm(bf2f(g.y >> 16)) * v0[3];
                    o[4] = fsigm(bf2f(g.z & 0xffffu)) * v1[0]; o[5] = fsigm(bf2f(g.z >> 16)) * v1[1]; o[6] = fsigm(bf2f(g.w & 0xffffu)) * v1[2]; o[7] = fsigm(bf2f(g.w >> 16)) * v1[3];
                    unsigned char* tp = (unsigned char*)O + r * (size_t)D + col0 + bj * 128;
                    if (ADD) { const u32x2 p = *(const u32x2*)tp; constexpr float is = 1.0f / FP8_MS;
                        const f32x2 p0 = __builtin_amdgcn_cvt_pk_f32_fp8((int)p.x, false), p1 = __builtin_amdgcn_cvt_pk_f32_fp8((int)p.x, true), p2 = __builtin_amdgcn_cvt_pk_f32_fp8((int)p.y, false), p3 = __builtin_amdgcn_cvt_pk_f32_fp8((int)p.y, true);
                        o[0] += p0.x * is; o[1] += p0.y * is; o[2] += p1.x * is; o[3] += p1.y * is; o[4] += p2.x * is; o[5] += p2.y * is; o[6] += p3.x * is; o[7] += p3.y * is; }
                    if (ADD) { u32x2 w8; w8.x = cvt4_fp8(o[0] * FP8_MS, o[1] * FP8_MS, o[2] * FP8_MS, o[3] * FP8_MS); w8.y = cvt4_fp8(o[4] * FP8_MS, o[5] * FP8_MS, o[6] * FP8_MS, o[7] * FP8_MS);
                        *(u32x2*)(O8 + r * (size_t)D + col0 + bj * 128) = w8; }
                    else { u32x2 w8; w8.x = cvt4_fp8(o[0] * FP8_MS, o[1] * FP8_MS, o[2] * FP8_MS, o[3] * FP8_MS); w8.y = cvt4_fp8(o[4] * FP8_MS, o[5] * FP8_MS, o[6] * FP8_MS, o[7] * FP8_MS);
                        *(u32x2*)tp = w8; } } }
    }
};
struct EpiResid {
    static constexpr bool PERM = false, PERM2 = false; static constexpr int NST = 32;
    const float* base; float* out; int ldc; const float* gvec; float scale;
    __device__ __forceinline__ void operator()(const f32x4 (&acc)[2][2][4][2], const Unit& u, int wr, int wc, int fr, int fq) const {
        const int row0 = u.row0 + wr * 64 + fr, col0 = u.pn * 256 + wc * 32 + 4 * fq;
        f32x4 gv[2][2];
#pragma unroll
        for (int bj = 0; bj < 2; ++bj)
#pragma unroll
            for (int n = 0; n < 2; ++n) gv[bj][n] = *(const f32x4*)(gvec + col0 + bj * 128 + n * 16) * scale;
#pragma unroll
        for (int ai = 0; ai < 2; ++ai)
#pragma unroll
            for (int m = 0; m < 4; ++m) { const size_t off = (size_t)(row0 + ai * 128 + m * 16) * ldc + col0;
#pragma unroll
                for (int bj = 0; bj < 2; ++bj)
#pragma unroll
                    for (int n = 0; n < 2; ++n) { const f32x4 bs = *(const f32x4*)(base + off + bj * 128 + n * 16); *(f32x4*)(out + off + bj * 128 + n * 16) = bs + gv[bj][n] * acc[ai][bj][m][n]; } }
    }
};
struct EpiGateUp {
    static constexpr bool PERM = true, PERM2 = false; static constexpr int NST = 4;
    unsigned char* ACT; LAS unsigned char* ebuf;
    __device__ __forceinline__ void operator()(const f32x4 (&acc)[2][2][4][2], const Unit& u, int wr, int wc, int fr, int fq) const {
        int lane = __builtin_amdgcn_mbcnt_hi(~0u, __builtin_amdgcn_mbcnt_lo(~0u, 0u)); asm volatile("" : "+v"(lane));
        LAS unsigned char* wp = ebuf + (lane & 15) * 32 + (lane >> 4) * 8; const LAS unsigned char* rp = ebuf + lane * 16;
        const unsigned goff = (unsigned)((u.row0 + wr * 64 + (lane >> 1)) * ED + u.pn * 128 + wc * 32 + 16 * (lane & 1));
        constexpr float ws = 1.0f / FP8_WS1;
#pragma unroll
        for (int ai = 0; ai < 2; ++ai)
#pragma unroll
            for (int mp = 0; mp < 2; ++mp) {
#pragma unroll
                for (int mh = 0; mh < 2; ++mh) { const int m = 2 * mp + mh;
                    const f32x4 g0 = acc[ai][0][m][0] * ws, g1 = acc[ai][0][m][1] * ws, u0 = acc[ai][1][m][0] * (ws * FP8_AS), u1 = acc[ai][1][m][1] * (ws * FP8_AS);
                    u32x2 w; w.x = cvt4_fp8(fsilu(g0[0]) * u0[0], fsilu(g0[1]) * u0[1], fsilu(g0[2]) * u0[2], fsilu(g0[3]) * u0[3]);
                    w.y = cvt4_fp8(fsilu(g1[0]) * u1[0], fsilu(g1[1]) * u1[1], fsilu(g1[2]) * u1[2], fsilu(g1[3]) * u1[3]);
                    *(LAS u32x2*)(wp + mp * 1024 + mh * 512) = w; }
                const u32x4 r = *(const LAS u32x4*)(rp + mp * 1024);
                *(u32x4*)(ACT + (goff + (unsigned)((ai * 128 + mp * 32) * ED))) = r; }
    }
};
struct EpiDown {
    static constexpr bool PERM = true, PERM2 = true; static constexpr int NST = 8;
    unsigned char* Y; const float* wsorted; LAS unsigned char* ebuf;
    __device__ __forceinline__ void operator()(const f32x4 (&acc)[2][2][4][2], const Unit& u, int wr, int wc, int fr, int fq) const {
        const int rl0 = wr * 64 + fr, col0 = u.pn * 256 + wc * 64 + 16 * fq;
#pragma unroll
        for (int ai = 0; ai < 2; ++ai)
#pragma unroll
            for (int m = 0; m < 4; ++m) { const int rl = rl0 + ai * 128 + m * 16; const int row = u.row0 + rl;
                float wv = 1.f; if (u.e < NE) wv = (rl < u.nvalid) ? wsorted[row] : 0.f;
                wv *= FP8_YS / (FP8_WS2 * FP8_AS);
                const f32x4 v0 = acc[ai][0][m][0] * wv, v1 = acc[ai][0][m][1] * wv, v2 = acc[ai][1][m][0] * wv, v3 = acc[ai][1][m][1] * wv;
                u32x4 w; w.x = cvt4_fp8(v0[0], v0[1], v0[2], v0[3]); w.y = cvt4_fp8(v1[0], v1[1], v1[2], v1[3]); w.z = cvt4_fp8(v2[0], v2[1], v2[2], v2[3]); w.w = cvt4_fp8(v3[0], v3[1], v3[2], v3[3]);
                const int lane = fq * 16 + fr, rr = lane >> 2;
                LAS unsigned char* eb = ebuf + (m & 1) * 1024;
                *(LAS u32x4*)(eb + fr * 64 + ((fq ^ ((fr >> 2) & 3)) << 4)) = w;
                const u32x4 r = *(const LAS u32x4*)(eb + rr * 64 + (((lane & 3) ^ ((rr >> 2) & 3)) << 4));
                *(u32x4*)(Y + (size_t)(u.row0 + wr * 64 + ai * 128 + m * 16 + rr) * D + u.pn * 256 + wc * 64 + 16 * (lane & 3)) = r; }
    }
};

struct MoeTab { LAS int* te; LAS int* tn; LAS int* misc; };
__device__ __forceinline__ MoeTab moe_tab(LAS unsigned char* lds) { MoeTab t; t.te = (LAS int*)(lds + LDS_TAB); t.tn = t.te + 352; t.misc = t.tn + 352; return t; }
struct MoeSched1 {
    static constexpr bool RAGGED = true;
    const char* H2; const char* E1; const int* toks; MoeTab tab; int G, vcu, i_lo, i_hi;
    __device__ __forceinline__ bool next(int i_, Unit& u) const {
        const int i = i_lo + i_; if (i >= i_hi) return false;
        const int ntr = tab.misc[0]; const int L = i * G + vcu; if (L >= 4 * (ntr + 32)) return false;
        const int t = L >> 2; u.pn = L & 3;
        if (t < ntr) { u.row0 = t * 256; u.e = tab.te[t]; u.nvalid = tab.tn[t]; } else { u.row0 = SH_ROW0 + (t - ntr) * 256; u.e = NE; u.nvalid = 256; }
        return true;
    }
    __device__ __forceinline__ const char* a_base() const { return H2; }
    __device__ __forceinline__ const char* b_ptr(const Unit& u) const { return E1 + ((size_t)u.e * 1024 + (size_t)u.pn * 256) * D; }
    __device__ __forceinline__ void a_off(const Unit& u, int tid, unsigned (&off)[2][2]) const {
#pragma unroll
        for (int i = 0; i < 2; ++i) { int R, C; pg8::stage_rc(tid * 16 + i * 8192, R, C);
#pragma unroll
            for (int h = 0; h < 2; ++h) { const int r = h * 128 + R; int tok;
                if (u.e < NE) tok = (r < u.nvalid) ? toks[u.row0 + r] : 0; else tok = u.row0 - SH_ROW0 + r;
                off[h][i] = (unsigned)(tok * D + 2 * C); } }
    }
};
struct MoeSched2 {
    static constexpr bool RAGGED = true;
    const char* ACT; const char* E2; MoeTab tab; int G, vcu;
    __device__ __forceinline__ bool next(int i, Unit& u) const {
        const int ntr = tab.misc[0]; const int NI = 4 * (ntr + 32), Jf = NI / G; int M, sub;
        if (i < 2 * Jf) { M = (i >> 1) * G + vcu; sub = i & 1; }
        else { const int U = (i - 2 * Jf) * G + vcu; if (U >= 2 * (NI - Jf * G)) return false; M = Jf * G + (U >> 1); sub = U & 1; }
        const int t = M >> 2; u.pn = 2 * (M & 3) + (sub ^ (t & 1));
        if (t < ntr) { u.row0 = t * 256; u.e = tab.te[t]; u.nvalid = tab.tn[t]; } else { u.row0 = SH_ROW0 + (t - ntr) * 256; u.e = NE; u.nvalid = 256; }
        return true;
    }
    __device__ __forceinline__ const char* a_base() const { return ACT; }
    __device__ __forceinline__ const char* b_ptr(const Unit& u) const { return E2 + ((size_t)u.e * 2048 + (size_t)u.pn * 256) * ED; }
    __device__ __forceinline__ void a_off(const Unit& u, int tid, unsigned (&off)[2][2]) const {
#pragma unroll
        for (int i = 0; i < 2; ++i) { int R, C; pg8::stage_rc(tid * 16 + i * 8192, R, C);
            off[0][i] = (unsigned)((u.row0 + R) * ED + 2 * C); off[1][i] = (unsigned)((u.row0 + 128 + R) * ED + 2 * C); }
    }
};

#define XB_TMO      128
#define XB_XCNT(j)  (256  + 64 * (j))
#define XB_XSUB(j)  (1280 + 64 * (j))
#define XB_XGEN(j)  (2304 + 64 * (j))
#define XB_TOP      3328
#define XB_TOPGEN   3392
#define XCD_BAR_WORDS 3456
#define XB_SPIN_CAP (1u << 18)
__device__ __forceinline__ unsigned xb_ld(unsigned* p)              { return __hip_atomic_load(p, __ATOMIC_RELAXED, __HIP_MEMORY_SCOPE_AGENT); }
__device__ __forceinline__ unsigned xb_add(unsigned* p, unsigned v) { return __hip_atomic_fetch_add(p, v, __ATOMIC_RELAXED, __HIP_MEMORY_SCOPE_AGENT); }
__device__ __forceinline__ unsigned xb_xcc_id() { return (unsigned)__builtin_amdgcn_s_getreg((3 << 11) | 20) & 0xFu; }
#define XB_SPIN(cond, bar) do { unsigned _sp = 0; while (cond) { __builtin_amdgcn_s_sleep(1); \
    if ((++_sp & 255u) == 0u) { if (xb_ld(&(bar)[XB_TMO])) break; if (_sp > XB_SPIN_CAP) { atomicAdd(&(bar)[XB_TMO], 1u); break; } } } } while (0)
struct XcdBarrier { unsigned* bar; unsigned x; volatile LAS unsigned* st; };
__device__ __forceinline__ XcdBarrier xcd_barrier_post(unsigned* bar, volatile LAS unsigned* st) {
    XcdBarrier b; b.bar = bar; b.x = xb_xcc_id(); b.st = st;
    if (threadIdx.x == 0) (void)xb_add(&bar[XB_XCNT(b.x)], 1u);
    return b;
}
__device__ __forceinline__ void xcd_barrier_complete(unsigned* bar, unsigned x, unsigned& nloc, unsigned& nx) {
    const unsigned G = gridDim.x * gridDim.y * gridDim.z;
    unsigned sum, cnt, mine, sp = 0u;
    for (;;) {
        sum = 0u; cnt = 0u; mine = 0u;
#pragma unroll
        for (unsigned j = 0; j < 16; ++j) { const unsigned c = xb_ld(&bar[XB_XCNT(j)]); sum += c; cnt += (c > 0u) ? 1u : 0u; mine = (j == x) ? c : mine; }
        if (sum == G) break;
        __builtin_amdgcn_s_sleep(1);
        if ((++sp & 255u) == 0u) { if (xb_ld(&bar[XB_TMO])) break; if (sp > XB_SPIN_CAP) { atomicAdd(&bar[XB_TMO], 1u); break; } }
    }
    nloc = mine > 0u ? mine : 1u; nx = cnt > 0u ? cnt : 1u;
}
__device__ __forceinline__ void xcd_barrier(const XcdBarrier& b) {
    asm volatile("s_waitcnt vmcnt(0)" ::: "memory");
    __syncthreads();
    if (threadIdx.x == 0) {
        unsigned* bar = b.bar;
        __builtin_amdgcn_s_waitcnt(0);
        unsigned nloc = b.st[0], nx = b.st[1];
        if (nloc == 0u) { xcd_barrier_complete(bar, b.x, nloc, nx); b.st[0] = nloc; b.st[1] = nx; }
        const unsigned old = xb_add(&bar[XB_XSUB(b.x)], 1u);
        const unsigned gen = old / nloc;
        if (old + 1u == (gen + 1u) * nloc) {
            __builtin_amdgcn_fence(__ATOMIC_RELEASE, "agent");
            asm volatile("s_waitcnt vmcnt(0)" ::: "memory");
            const unsigned og = xb_add(&bar[XB_TOP], 1u);
            const unsigned tg = og / nx;
            if (og + 1u == (tg + 1u) * nx) xb_add(&bar[XB_TOPGEN], 1u);
            else XB_SPIN(xb_ld(&bar[XB_TOPGEN]) == tg, bar);
            __builtin_amdgcn_fence(__ATOMIC_ACQUIRE, "agent");
            xb_add(&bar[XB_XGEN(b.x)], 1u);
            asm volatile("s_waitcnt vmcnt(0)" ::: "memory");
        } else {
            XB_SPIN(xb_ld(&bar[XB_XGEN(b.x)]) == gen, bar);
            __builtin_amdgcn_fence(__ATOMIC_ACQUIRE, "agent");
            asm volatile("s_waitcnt vmcnt(0)" ::: "memory");
        }
    }
    __syncthreads();
}

struct Ctx {
    LAS unsigned char* lds;
    int tid, lane, wave, G, vcu, bx;
    float* out; unsigned char* ws;
};
constexpr int LDS_PTRS = 163840 - 512;
__device__ __forceinline__ const float* inp(const Ctx& F, int i) {
    const LAS unsigned* p = (const LAS unsigned*)(F.lds + LDS_PTRS) + 2 * i;
    const unsigned lo = __builtin_amdgcn_readfirstlane(p[0]), hi = __builtin_amdgcn_readfirstlane(p[1]);
    return (const float*)(const GAS float*)(((unsigned long long)hi << 32) | lo);
}
#define IN_X 0
#define IN_C 1
#define IN_RELB 2
#define IN_WADA 3
#define IN_BADA 4
#define IN_LN1 5
#define IN_WIN 6
#define IN_QNG 7
#define IN_KNG 8
#define IN_GNG 9
#define IN_PA 10
#define IN_PB 11
#define IN_WO 12
#define IN_LN2 13
#define IN_RW 14
#define IN_RB 15
#define IN_WG 16
#define IN_WU 17
#define IN_WD 18
#define IN_WGS 19
#define IN_WUS 20
#define IN_WDS 21

struct CvItem { const float* src; unsigned char* dst; int ldw, ldt; float scale; };
constexpr int CV_WIN = 32 * 304, CV_PA = 16 * 32, CV_PB = 32 * 32, CV_WO = 32 * 32, CV_EX = 768;
constexpr int CV_DENSE = CV_WIN + CV_PA + CV_PB + CV_WO, CV_ALL = CV_DENSE + 65 * CV_EX;
#ifndef CV_BG_FROM
#define CV_BG_FROM CV_DENSE
#endif
__device__ __forceinline__ void cv_kn(int q, int nbg_count, int& kb, int& nb) {
    const int super = q >> 3, sub = q & 7; kb = (super / nbg_count) * 4 + (sub >> 1); nb = (super % nbg_count) * 2 + (sub & 1);
}
__device__ __forceinline__ CvItem cv_decode(const Ctx& F, int it) {
    CvItem c; int r = it; int kb, nb; c.scale = 0.f;
    if (r < CV_WIN) { cv_kn(r, 152, kb, nb); c.ldw = INW; c.src = inp(F, IN_WIN) + (size_t)(64 * kb) * INW + 64 * nb;
        if (proj_tile_fp8(nb >> 2)) { c.ldt = D; c.scale = FP8_WIN; c.dst = F.ws + WS_WIN8 + (size_t)(64 * nb) * D + 64 * kb; }
        else { c.ldt = D * 2; c.dst = F.ws + WS_WINT + ((size_t)(64 * nb) * D + 64 * kb) * 2; }
        return c; } r -= CV_WIN;
    if (r < CV_PA) { cv_kn(r, 16, kb, nb); c.ldw = D; c.ldt = 1024; c.scale = FP8_PW; c.src = inp(F, IN_PA) + (size_t)(64 * kb) * D + 64 * nb; c.dst = F.ws + WS_PA + (size_t)(64 * nb) * 1024 + 64 * kb; return c; } r -= CV_PA;
    if (r < CV_PB) { cv_kn(r, 16, kb, nb); c.ldw = D; c.ldt = D; c.scale = FP8_PW; c.src = inp(F, IN_PB) + (size_t)(64 * kb) * D + 64 * nb; c.dst = F.ws + WS_PB + (size_t)(64 * nb) * D + 64 * kb; return c; } r -= CV_PB;
    if (r < CV_WO) { cv_kn(r, 16, kb, nb); c.ldw = D; c.ldt = D; c.scale = FP8_WO; c.src = inp(F, IN_WO) + (size_t)(64 * kb) * D + 64 * nb; c.dst = F.ws + WS_WO + (size_t)(64 * nb) * D + 64 * kb; return c; } r -= CV_WO;
    const int e = r / CV_EX; int q = r % CV_EX;
    if (q < 512) {
        const int isup = q >> 8; q &= 255; cv_kn(q, 4, kb, nb); const int n0 = 64 * nb;
        const float* w = (e < NE) ? inp(F, isup ? IN_WU : IN_WG) + (size_t)e * D * ED : inp(F, isup ? IN_WUS : IN_WGS);
        c.ldw = ED; c.ldt = D; c.scale = FP8_WS1; c.src = w + (size_t)(64 * kb) * ED + n0;
        c.dst = F.ws + WS_E1 + ((size_t)e * 1024 + (size_t)((n0 >> 7) * 256 + (n0 & 127) + isup * 128)) * D + 64 * kb;
    } else {
        q -= 512; cv_kn(q, 16, kb, nb);
        const float* w = (e < NE) ? inp(F, IN_WD) + (size_t)e * ED * D : inp(F, IN_WDS);
        c.ldw = D; c.ldt = ED; c.scale = FP8_WS2; c.src = w + (size_t)(64 * kb) * D + 64 * nb;
        c.dst = F.ws + WS_E2 + ((size_t)e * D + (size_t)(64 * nb)) * ED + 64 * kb;
    }
    return c;
}
__device__ __forceinline__ void cv_load(const CvItem& c, int lane, f32x4 (&v)[16]) {
    const int r4 = lane >> 4, c16 = lane & 15;
#pragma unroll
    for (int i = 0; i < 16; ++i) v[i] = *(const f32x4*)(c.src + (size_t)(4 * i + r4) * c.ldw + 4 * c16);
}
__device__ __forceinline__ void cv_store(const CvItem& c, int lane, const f32x4 (&v)[16], LAS float* scr) {
    const int r4 = lane >> 4, c16 = lane & 15;
#pragma unroll
    for (int i = 0; i < 16; ++i) { LAS float* d = scr + (4 * i + r4) * 65 + 4 * c16; d[0] = v[i].x; d[1] = v[i].y; d[2] = v[i].z; d[3] = v[i].w; }
    LDS_WAIT(); asm volatile("" ::: "memory");
    const int cc = lane & 7;
    if (c.scale == 0.f) {
#pragma unroll
        for (int j = 0; j < 8; ++j) { const int n = (lane >> 3) + 8 * j; const LAS float* s = scr + (8 * cc) * 65 + n;
            u32x4 o; o.x = cvt_pk_bf16(s[0 * 65], s[1 * 65]); o.y = cvt_pk_bf16(s[2 * 65], s[3 * 65]); o.z = cvt_pk_bf16(s[4 * 65], s[5 * 65]); o.w = cvt_pk_bf16(s[6 * 65], s[7 * 65]);
            *(GAS u32x4*)(c.dst + (size_t)n * c.ldt + 16 * cc) = o; }
    } else { const float sc = c.scale;
#pragma unroll
        for (int j = 0; j < 8; ++j) { const int n = (lane >> 3) + 8 * j; const LAS float* s = scr + (8 * cc) * 65 + n;
            u32x2 o; o.x = cvt4_fp8(s[0 * 65] * sc, s[1 * 65] * sc, s[2 * 65] * sc, s[3 * 65] * sc); o.y = cvt4_fp8(s[4 * 65] * sc, s[5 * 65] * sc, s[6 * 65] * sc, s[7 * 65] * sc);
            *(GAS u32x2*)(c.dst + (size_t)n * c.ldt + 8 * cc) = o; }
    }
    LDS_WAIT(); asm volatile("" ::: "memory");
}
constexpr int CV_N1 = 65 * 512, CV_N2 = 65 * 256;
template <int MODE> __device__ __forceinline__ int cv_map(int j) { return MODE == 0 ? j : MODE == 1 ? CV_DENSE + (j >> 9) * CV_EX + (j & 511) : CV_DENSE + (j >> 8) * CV_EX + 512 + (j & 255); }
template <int MODE = 0> __device__ __forceinline__ void convert_items(const Ctx& F, int lo, int hi, int gw, int NGW) {
    LAS float* scr = (LAS float*)(F.lds + 16384 + F.wave * 16640);
    int it = lo + gw;
    if (it >= hi) return;
    f32x4 va[16], vb[16];
    CvItem ca = cv_decode(F, cv_map<MODE>(it)), cb = ca;
    cv_load(ca, F.lane, va);
    for (;;) {
        int nx = it + NGW; const bool hb = nx < hi;
        if (hb) { cb = cv_decode(F, cv_map<MODE>(nx)); cv_load(cb, F.lane, vb); }
        cv_store(ca, F.lane, va, scr);
        if (!hb) break;
        it = nx; nx = it + NGW; const bool ha = nx < hi;
        if (ha) { ca = cv_decode(F, cv_map<MODE>(nx)); cv_load(ca, F.lane, va); }
        cv_store(cb, F.lane, vb, scr);
        if (!ha) break;
        it = nx;
    }
}
__device__ __forceinline__ void p0_prologue(const Ctx& F) {
    {
        const float* cvec = inp(F, IN_C); const float* wada = inp(F, IN_WADA); float* modp = (float*)(F.ws + WS_MODP);
        LAS float* red = (LAS float*)F.lds;
        for (int it = F.bx; it < 384; it += F.G) {
            const int cc = it % 48, ks = it / 48; const int col = cc * 256 + F.lane * 4; const int k0 = ks * 256 + F.wave * 32;
            f32x4 a = (f32x4){0.f, 0.f, 0.f, 0.f};
#pragma unroll 8
            for (int r = 0; r < 32; ++r) { const int k = k0 + r; const float s = fsilu(cvec[k]); const f32x4 w = *(const f32x4*)(wada + (size_t)k * 12288 + col); a += w * s; }
            *(LAS f32x4*)(red + F.wave * 256 + F.lane * 4) = a;
            __syncthreads();
            if (F.tid < 256) { float s = 0.f;
#pragma unroll
                for (int w = 0; w < 8; ++w) s += red[w * 256 + F.tid];
                modp[ks * 12288 + cc * 256 + F.tid] = s; }
            __syncthreads();
        }
    }
    {
        float* rc = (float*)(F.ws + WS_ROPE); float* rs = rc + S * 64;
        for (int idx = F.bx * 512 + F.tid; idx < S * 64; idx += F.G * 512) {
            const int pos = idx >> 6, i = idx & 63;
            double inv = 1.0; const double r = 0.86596432336006535;
            for (int q = 0; q < i; ++q) inv *= r;
            const double ang = (double)pos * inv;
            const double n = __builtin_rint(ang * 0.15915494309189535);
            const float red = (float)(ang - n * 6.283185307179586);
            rc[idx] = __cosf(red); rs[idx] = __sinf(red);
        }
    }
    {
        const float* rw = inp(F, IN_RW); unsigned* rwh = (unsigned*)(F.ws + WS_RWH); unsigned* rwl = (unsigned*)(F.ws + WS_RWL);
        for (int idx = F.bx * 512 + F.tid; idx < 64 * 1024; idx += F.G * 512) { const int e = idx & 63, kp = idx >> 6;
            const float a = rw[(size_t)(2 * kp) * 64 + e], b = rw[(size_t)(2 * kp + 1) * 64 + e];
            const unsigned h = cvt_pk_bf16(a, b); const unsigned l = cvt_pk_bf16(a - bf2f(h & 0xffffu), b - bf2f(h >> 16));
            rwh[e * 1024 + kp] = h; rwl[e * 1024 + kp] = l; }
    }
    convert_items(F, 0, CV_BG_FROM, F.vcu * 8 + F.wave, F.G * 8);
}

__device__ __forceinline__ float mod_sum(const Ctx& F, int n) {
    const float* modp = (const float*)(F.ws + WS_MODP); float s = inp(F, IN_BADA)[n];
#pragma unroll
    for (int k = 0; k < 8; ++k) s += modp[k * 12288 + n];
    return s;
}
__device__ __forceinline__ void norm_rows(const Ctx& F, const float* X, const LAS float* gs, const LAS float* sh, bf16_t* O, unsigned char* O8) {
    const int gw = F.vcu * 8 + F.wave, NGW = F.G * 8;
    for (int m = gw; m < S; m += NGW) {
        const GAS f32x4* xr = (const GAS f32x4*)(X + (size_t)m * D) + F.lane;
        f32x4 v[8]; float ss = 0.f;
#pragma unroll
        for (int j = 0; j < 8; ++j) { v[j] = xr[64 * j]; ss += (v[j].x * v[j].x + v[j].y * v[j].y) + (v[j].z * v[j].z + v[j].w * v[j].w); }
#pragma unroll
        for (int o = 1; o < 64; o <<= 1) ss += __shfl_xor(ss, o);
        const float rstd = 1.0f / sqrtf(ss * (1.f / D) + 1e-6f);
        GAS u32x2* o8 = (GAS u32x2*)(O + (size_t)m * D) + F.lane; GAS unsigned* o4 = (GAS unsigned*)(O8 + (size_t)m * D) + F.lane;
#pragma unroll
        for (int j = 0; j < 8; ++j) { const f32x4 g = *(const LAS f32x4*)(gs + 256 * j + 4 * F.lane), s = *(const LAS f32x4*)(sh + 256 * j + 4 * F.lane);
            const f32x4 y = v[j] * rstd * g + s; u32x2 w; w.x = cvt_pk_bf16(y.x, y.y); w.y = cvt_pk_bf16(y.z, y.w); if (!PROJ_ALL_FP8) o8[64 * j] = w; o4[64 * j] = cvt4_fp8(y.x, y.y, y.z, y.w); }
    }
}
__device__ __forceinline__ void p1_norm1(const Ctx& F) {
    LAS float* gs = (LAS float*)F.lds; LAS float* sh = gs + D;
    for (int k = F.tid; k < D; k += 512) { const float shv = mod_sum(F, k), scv = mod_sum(F, D + k); gs[k] = inp(F, IN_LN1)[k] * (1.f + scv); sh[k] = shv; }
    float* modf = (float*)(F.ws + WS_MODF);
    for (int n = F.bx * 512 + F.tid; n < 12288; n += F.G * 512) modf[n] = mod_sum(F, n);
    __syncthreads();
    norm_rows(F, inp(F, IN_X), gs, sh, (bf16_t*)(F.ws + WS_H), F.ws + WS_H8);
}


__device__ __forceinline__ bf16x8 pk_frag(u32x2 lo, u32x2 hi) { u32x4 v; v.x = lo.x; v.y = lo.y; v.z = hi.x; v.w = hi.y; return __builtin_bit_cast(bf16x8, v); }
__device__ __forceinline__ f32x4 mfma16(bf16x8 a, bf16x8 b, f32x4 c) { return __builtin_amdgcn_mfma_f32_16x16x32_bf16(a, b, c, 0, 0, 0); }
__device__ __forceinline__ float gamma_log2(int h) { return log2f(1.0f - exp2f(-5.0f - (float)h)); }

struct AttnU { int g, hh, d, r, nb, head; };
__device__ __forceinline__ AttnU attn_decode(int u) {
    AttnU U; U.g = u >> 9; const int rem = u & 511; U.hh = rem >> 6; const int rem2 = rem & 63;
    const int dsh = 2 * U.g; U.d = 1 << dsh; const int nblk = 64 >> dsh;
    U.r = rem2 / nblk; U.nb = rem2 % nblk; U.head = U.g * 8 + U.hh; return U;
}
__device__ __forceinline__ void attn_issue(const bf16_t* proj, const AttnU& U, int tid, int w, int lane, u32x4 (&kr)[8], u32x4 (&vr)[8], u32x4 (&qr)[4]) {
    const int rowi = tid >> 4, ch = tid & 15;
#pragma unroll
    for (int p = 0; p < 8; ++p) { const int cc = p * 32 + rowi; const int jk = (U.nb - 1) * 128 + cc;
        if (jk >= 0) { const unsigned off = (unsigned)(jk * U.d + U.r) * INW + U.head * 128 + ch * 8; kr[p] = *(const u32x4*)(proj + off + C_KA); vr[p] = *(const u32x4*)(proj + off + C_VA); }
        else { kr[p] = (u32x4){0u, 0u, 0u, 0u}; vr[p] = (u32x4){0u, 0u, 0u, 0u}; } }
    const int ql = lane & 15, g4 = lane >> 4; const unsigned tq = (unsigned)((U.nb * 128 + 16 * w + ql) * U.d + U.r);
#pragma unroll
    for (int ds = 0; ds < 4; ++ds) qr[ds] = *(const u32x4*)(proj + tq * INW + C_QA + U.head * 128 + 32 * ds + 8 * g4);
}
__device__ __forceinline__ void p3_attn(const Ctx& F) {
    const bf16_t* proj = (const bf16_t*)(F.ws + WS_PROJ);
    LAS bf16_t* KS = (LAS bf16_t*)F.lds;
    LAS bf16_t* VS = (LAS bf16_t*)(F.lds + 69632);
    LAS float* BT = (LAS float*)(F.lds + 139264);
    LAS float* RB = (LAS float*)(F.lds + 140288);
    const int lane = F.lane, w = F.wave, ql = lane & 15, g4 = lane >> 4;
    const int rowi = F.tid >> 4, ch = F.tid & 15;
    u32x4 kr[8], vr[8], qr[4];
    int it = F.bx;
    if (it < 1536) { const AttnU U0 = attn_decode(it); attn_issue(proj, U0, F.tid, w, lane, kr, vr, qr); }
    LAS float* KGL = RB + 768; LAS float* QGL = KGL + 128;
    { const float* relb = inp(F, IN_RELB); for (int i = F.tid; i < 768; i += 512) RB[i] = relb[i];
      if (F.tid < 128) KGL[F.tid] = inp(F, IN_KNG)[F.tid]; else if (F.tid < 256) QGL[F.tid - 128] = inp(F, IN_QNG)[F.tid - 128]; }
    __syncthreads();
    for (; it < 1536; it += F.G) {
        const AttnU U = attn_decode(it);
        const int d = U.d, nb = U.nb;
        if (F.tid <= 128) { const int dist = F.tid * d; int b;
            if (dist < 16) b = dist; else { b = 16 + (int)floorf(log2f((float)dist * 0.0625f) * (16.0f / 7.0f)); b = b > 31 ? 31 : b; }
            BT[F.tid] = RB[b * 24 + U.head]; }
        {
            const LAS float* kg = KGL + ch * 8;
            const f32x4 kg0 = *(const LAS f32x4*)kg, kg1 = *(const LAS f32x4*)(kg + 4);
#pragma unroll
            for (int p = 0; p < 8; ++p) { const int cc = p * 32 + rowi;
                float f[8]; f[0] = bf2f(kr[p].x & 0xffffu); f[1] = bf2f(kr[p].x >> 16); f[2] = bf2f(kr[p].y & 0xffffu); f[3] = bf2f(kr[p].y >> 16);
                f[4] = bf2f(kr[p].z & 0xffffu); f[5] = bf2f(kr[p].z >> 16); f[6] = bf2f(kr[p].w & 0xffffu); f[7] = bf2f(kr[p].w >> 16);
                float ss = 0.f;
#pragma unroll
                for (int e = 0; e < 8; ++e) ss += f[e] * f[e];
                ss += __shfl_xor(ss, 1); ss += __shfl_xor(ss, 2); ss += __shfl_xor(ss, 4); ss += __shfl_xor(ss, 8);
                const float rstd = 1.0f / sqrtf(ss * (1.f / 128.f) + 1e-6f);
                u32x4 o; o.x = cvt_pk_bf16(f[0] * rstd * kg0.x, f[1] * rstd * kg0.y); o.y = cvt_pk_bf16(f[2] * rstd * kg0.z, f[3] * rstd * kg0.w);
                o.z = cvt_pk_bf16(f[4] * rstd * kg1.x, f[5] * rstd * kg1.y); o.w = cvt_pk_bf16(f[6] * rstd * kg1.z, f[7] * rstd * kg1.w);
                *(LAS u32x4*)(KS + cc * 136 + ch * 8) = o;
                *(LAS u32x4*)(VS + cc * 136 + ch * 8) = vr[p]; }
        }
        const int a = 16 * w + ql;
        const unsigned tq = (unsigned)((nb * 128 + a) * d + U.r);
        bf16x8 qf[4];
        {
            float f[4][8]; float ss = 0.f;
#pragma unroll
            for (int ds = 0; ds < 4; ++ds) { f[ds][0] = bf2f(qr[ds].x & 0xffffu); f[ds][1] = bf2f(qr[ds].x >> 16); f[ds][2] = bf2f(qr[ds].y & 0xffffu); f[ds][3] = bf2f(qr[ds].y >> 16);
                f[ds][4] = bf2f(qr[ds].z & 0xffffu); f[ds][5] = bf2f(qr[ds].z >> 16); f[ds][6] = bf2f(qr[ds].w & 0xffffu); f[ds][7] = bf2f(qr[ds].w >> 16);
#pragma unroll
                for (int e = 0; e < 8; ++e) ss += f[ds][e] * f[ds][e]; }
            ss += __shfl_xor(ss, 16); ss += __shfl_xor(ss, 32);
            const float rs = (1.0f / sqrtf(ss * (1.f / 128.f) + 1e-6f)) * 0.08838834764831845f;
#pragma unroll
            for (int ds = 0; ds < 4; ++ds) { const LAS float* qg = QGL + 32 * ds + 8 * g4; const f32x4 q0 = *(const LAS f32x4*)qg, q1 = *(const LAS f32x4*)(qg + 4); u32x4 o;
                o.x = cvt_pk_bf16(f[ds][0] * rs * q0.x, f[ds][1] * rs * q0.y); o.y = cvt_pk_bf16(f[ds][2] * rs * q0.z, f[ds][3] * rs * q0.w);
                o.z = cvt_pk_bf16(f[ds][4] * rs * q1.x, f[ds][5] * rs * q1.y); o.w = cvt_pk_bf16(f[ds][6] * rs * q1.z, f[ds][7] * rs * q1.w);
                qf[ds] = __builtin_bit_cast(bf16x8, o); }
        }
        __syncthreads();
        { const int nx = it + F.G; if (nx < 1536) { const AttnU Un = attn_decode(nx); attn_issue(proj, Un, F.tid, w, lane, kr, vr, qr); } }
        const int kbase = 32 * (w >> 1);
        f32x4 sc[10];
#pragma unroll
        for (int ti = 0; ti < 10; ++ti) { f32x4 acc = (f32x4){0.f, 0.f, 0.f, 0.f};
#pragma unroll
            for (int ds = 0; ds < 4; ++ds) { const bf16x8 kf = *(const LAS bf16x8*)(KS + (kbase + 16 * ti + ql) * 136 + 32 * ds + 8 * g4); acc = mfma16(kf, qf[ds], acc); }
            sc[ti] = acc; }
        float mx = -1e30f;
#pragma unroll
        for (int ti = 0; ti < 10; ++ti)
#pragma unroll
            for (int i = 0; i < 4; ++i) { const int cc = kbase + 16 * ti + 4 * g4 + i; const int delta = 128 + a - cc;
                const bool ok = (delta >= 0) && (delta <= 128) && (nb > 0 || cc >= 128);
                const float sv = ok ? sc[ti][i] + BT[ok ? delta : 0] : -1e30f; sc[ti][i] = sv; mx = fmaxf(mx, sv); }
        mx = fmaxf(mx, __shfl_xor(mx, 16)); mx = fmaxf(mx, __shfl_xor(mx, 32));
        float lsum = 0.f;
#pragma unroll
        for (int ti = 0; ti < 10; ++ti)
#pragma unroll
            for (int i = 0; i < 4; ++i) { const float p = __expf(sc[ti][i] - mx); sc[ti][i] = p; lsum += p; }
        lsum += __shfl_xor(lsum, 16); lsum += __shfl_xor(lsum, 32);
        bf16x8 pf[5];
#pragma unroll
        for (int s = 0; s < 5; ++s) { u32x4 o; o.x = cvt_pk_bf16(sc[2 * s][0], sc[2 * s][1]); o.y = cvt_pk_bf16(sc[2 * s][2], sc[2 * s][3]);
            o.z = cvt_pk_bf16(sc[2 * s + 1][0], sc[2 * s + 1][1]); o.w = cvt_pk_bf16(sc[2 * s + 1][2], sc[2 * s + 1][3]); pf[s] = __builtin_bit_cast(bf16x8, o); }
        const float rl = 1.0f / lsum;
        unsigned char* og = (F.ws + WS_OG) + ((unsigned)(U.g * S) + tq) * 1024u + U.hh * 128;
        const unsigned vbase = (unsigned)(size_t)VS + (unsigned)(((kbase + 4 * g4 + (ql >> 2)) * 136 + 4 * (ql & 3)) * 2);
#pragma unroll
        for (int dt = 0; dt < 8; ++dt) { f32x4 acc = (f32x4){0.f, 0.f, 0.f, 0.f};
            u32x2 lo[5], hi[5];
#pragma unroll
            for (int s = 0; s < 5; ++s) { TR_READ(lo[s], vbase, (32 * s * 136 + dt * 16) * 2); TR_READ(hi[s], vbase, ((32 * s + 16) * 136 + dt * 16) * 2); }
            TR_WAIT4(lo[0], hi[0], lo[1], hi[1]); TR_WAIT4(lo[2], hi[2], lo[3], hi[3]); TR_WAIT2(lo[4], hi[4]);
#pragma unroll
            for (int s = 0; s < 5; ++s) acc = mfma16(pk_frag(lo[s], hi[s]), pf[s], acc);
            const float rs = rl * FP8_YAS;
            *(unsigned*)(og + dt * 16 + 4 * g4) = cvt4_fp8(acc[0] * rs, acc[1] * rs, acc[2] * rs, acc[3] * rs); }
        if (g4 == 0) ((float*)(F.ws + WS_LSE))[((unsigned)(U.g * S) + tq) * 8u + U.hh] = mx + __logf(lsum);
        __syncthreads();
    }
}

__device__ __forceinline__ void rot8v(const u32x4 own, const u32x4 par, int ch, const f32x4 c0, const f32x4 c1, const f32x4 s0, const f32x4 s1, float scale, float (&o)[8]) {
    float a[8], b[8];
    a[0] = bf2f(own.x & 0xffffu); a[1] = bf2f(own.x >> 16); a[2] = bf2f(own.y & 0xffffu); a[3] = bf2f(own.y >> 16); a[4] = bf2f(own.z & 0xffffu); a[5] = bf2f(own.z >> 16); a[6] = bf2f(own.w & 0xffffu); a[7] = bf2f(own.w >> 16);
    b[0] = bf2f(par.x & 0xffffu); b[1] = bf2f(par.x >> 16); b[2] = bf2f(par.y & 0xffffu); b[3] = bf2f(par.y >> 16); b[4] = bf2f(par.z & 0xffffu); b[5] = bf2f(par.z >> 16); b[6] = bf2f(par.w & 0xffffu); b[7] = bf2f(par.w >> 16);
    const float cv[8] = {c0.x, c0.y, c0.z, c0.w, c1.x, c1.y, c1.z, c1.w}, sv[8] = {s0.x, s0.y, s0.z, s0.w, s1.x, s1.y, s1.z, s1.w};
#pragma unroll
    for (int e = 0; e < 8; ++e) o[e] = ((ch < 8) ? (a[e] * cv[e] - b[e] * sv[e]) : (b[e] * sv[e] + a[e] * cv[e])) * scale;
}

__device__ __forceinline__ void upd_unit(const Ctx& F, int u) {
    const int n = u >> 3, h = u & 7;
    const bf16_t* proj = (const bf16_t*)(F.ws + WS_PROJ);
    const float* rc = (const float*)(F.ws + WS_ROPE); const float* rsn = rc + S * 64;
    LAS bf16_t* KS = (LAS bf16_t*)F.lds;
    LAS bf16_t* VS = (LAS bf16_t*)(F.lds + 34816);
    const int lane = F.lane, w = F.wave;
    const float lg2 = gamma_log2(h);
    {
        const int rowi = F.tid >> 4, ch = F.tid & 15;
        u32x4 kown[4], kpar[4], vv[8]; f32x4 c0[4], c1[4], s0[4], s1[4];
#pragma unroll
        for (int p = 0; p < 4; ++p) { const int j = p * 32 + rowi; const unsigned tok = (unsigned)(n * 128 + j);
            const bf16_t* kp = proj + tok * INW + C_KR + h * 128;
            kown[p] = *(const u32x4*)(kp + ch * 8); kpar[p] = *(const u32x4*)(kp + (ch ^ 8) * 8);
            const float* cp = rc + tok * 64 + (ch & 7) * 8; const float* sp = rsn + tok * 64 + (ch & 7) * 8;
            c0[p] = *(const f32x4*)cp; c1[p] = *(const f32x4*)(cp + 4); s0[p] = *(const f32x4*)sp; s1[p] = *(const f32x4*)(sp + 4);
            vv[2 * p] = *(const u32x4*)(proj + tok * INW + C_VR + h * 256 + ch * 8); vv[2 * p + 1] = *(const u32x4*)(proj + tok * INW + C_VR + h * 256 + (ch + 16) * 8); }
#pragma unroll
        for (int p = 0; p < 4; ++p) { const int j = p * 32 + rowi;
            float o[8]; rot8v(kown[p], kpar[p], ch, c0[p], c1[p], s0[p], s1[p], 0.08838834764831845f, o);
            u32x4 ov; ov.x = cvt_pk_bf16(o[0], o[1]); ov.y = cvt_pk_bf16(o[2], o[3]); ov.z = cvt_pk_bf16(o[4], o[5]); ov.w = cvt_pk_bf16(o[6], o[7]);
            *(LAS u32x4*)(KS + j * 136 + ch * 8) = ov; }
#pragma unroll
        for (int p = 0; p < 4; ++p) { const int j = p * 32 + rowi; const float z = exp2f(lg2 * (float)(127 - j));
#pragma unroll
            for (int c2 = 0; c2 < 2; ++c2) { const int chv = ch + 16 * c2; const u32x4 x = vv[2 * p + c2];
                u32x4 ov; ov.x = cvt_pk_bf16(bf2f(x.x & 0xffffu) * z, bf2f(x.x >> 16) * z); ov.y = cvt_pk_bf16(bf2f(x.y & 0xffffu) * z, bf2f(x.y >> 16) * z);
                ov.z = cvt_pk_bf16(bf2f(x.z & 0xffffu) * z, bf2f(x.z >> 16) * z); ov.w = cvt_pk_bf16(bf2f(x.w & 0xffffu) * z, bf2f(x.w >> 16) * z);
                *(LAS u32x4*)(VS + j * 264 + chv * 8) = ov; } }
    }
    __syncthreads();
    const int ql = lane & 15, g4 = lane >> 4;
    const unsigned kb = (unsigned)(size_t)KS + (unsigned)(((8 * g4 + (ql >> 2)) * 136 + 4 * (ql & 3)) * 2);
    const unsigned vbw = (unsigned)(size_t)VS + (unsigned)(((8 * g4 + (ql >> 2)) * 264 + 4 * (ql & 3) + 32 * w) * 2);
    f32x4 acc[2][8];
#pragma unroll
    for (int a = 0; a < 2; ++a)
#pragma unroll
        for (int b = 0; b < 8; ++b) acc[a][b] = (f32x4){0.f, 0.f, 0.f, 0.f};
#pragma unroll
    for (int ks = 0; ks < 4; ++ks) {
        u32x2 vl[2], vh[2];
#pragma unroll
        for (int a = 0; a < 2; ++a) { TR_READ(vl[a], vbw, (32 * ks * 264 + a * 16) * 2); TR_READ(vh[a], vbw, ((32 * ks + 4) * 264 + a * 16) * 2); }
        TR_WAIT4(vl[0], vh[0], vl[1], vh[1]);
        const bf16x8 vf0 = pk_frag(vl[0], vh[0]), vf1 = pk_frag(vl[1], vh[1]);
#pragma unroll
        for (int b = 0; b < 8; b += 2) {
            u32x2 k0l, k0h, k1l, k1h;
            TR_READ(k0l, kb, (32 * ks * 136 + b * 16) * 2); TR_READ(k0h, kb, ((32 * ks + 4) * 136 + b * 16) * 2);
            TR_READ(k1l, kb, (32 * ks * 136 + (b + 1) * 16) * 2); TR_READ(k1h, kb, ((32 * ks + 4) * 136 + (b + 1) * 16) * 2);
            TR_WAIT4(k0l, k0h, k1l, k1h);
            const bf16x8 kf0 = pk_frag(k0l, k0h), kf1 = pk_frag(k1l, k1h);
            acc[0][b] = mfma16(vf0, kf0, acc[0][b]); acc[1][b] = mfma16(vf1, kf0, acc[1][b]);
            acc[0][b + 1] = mfma16(vf0, kf1, acc[0][b + 1]); acc[1][b + 1] = mfma16(vf1, kf1, acc[1][b + 1]); }
    }
    float* upd = (float*)(F.ws + WS_UPD) + (size_t)(n * 8 + h) * 32768;
#pragma unroll
    for (int a = 0; a < 2; ++a)
#pragma unroll
        for (int b = 0; b < 8; ++b)
#pragma unroll
            for (int i = 0; i < 4; ++i) upd[((2 * w + a) * 16 + 4 * g4 + i) * 128 + b * 16 + ql] = acc[a][b][i];
    __syncthreads();
}
__device__ __forceinline__ void p3_mix1(const Ctx& F) {
    p3_attn(F);
    if (DUP2_MASK & 4) { __syncthreads(); p3_attn(F); }
    for (int it = F.bx; it < 512; it += F.G) upd_unit(F, it);
    if (DUP2_MASK & 8) { __syncthreads(); for (int it = F.bx; it < 512; it += F.G) upd_unit(F, it); }
}

__device__ __forceinline__ void p4_scan(const Ctx& F) {
    const float* upd = (const float*)(F.ws + WS_UPD); unsigned* prev = (unsigned*)(F.ws + WS_PREV);
    for (int p = F.bx * 512 + F.tid; p < 131072; p += F.G * 512) {
        const int h = p >> 14;
        const float gch = exp2f(gamma_log2(h) * 128.0f);
        const int within = (p & 16383) * 2;
        float s0 = 0.f, s1 = 0.f;
#pragma unroll 8
        for (int n = 0; n < 64; ++n) { const size_t o = (size_t)(n * 8 + h) * 32768 + within;
            const f32x2 uv = *(const f32x2*)(upd + o);
            prev[o >> 1] = cvt_pk_bf16(s0, s1);
            s0 = gch * s0 + uv.x; s1 = gch * s1 + uv.y; }
    }
}

__device__ __forceinline__ void ret_unit(const Ctx& F, int u) {
    const int n = u >> 3, h = u & 7;
    const bf16_t* proj = (const bf16_t*)(F.ws + WS_PROJ);
    const float* rc = (const float*)(F.ws + WS_ROPE); const float* rsn = rc + S * 64;
    LAS bf16_t* KS = (LAS bf16_t*)F.lds;
    LAS bf16_t* VS = (LAS bf16_t*)(F.lds + 34816);
    LAS bf16_t* QS = (LAS bf16_t*)(F.lds + 102400);
    LAS float* RED = (LAS float*)(F.lds + 137216);
    LAS float* TOT = (LAS float*)(F.lds + 145408);
    const int lane = F.lane, w = F.wave;
    const float lg2 = gamma_log2(h);
    const int ql = lane & 15, g4 = lane >> 4;
    const bf16_t* prev = (const bf16_t*)(F.ws + WS_PREV) + (size_t)(n * 8 + h) * 32768;
    {
        const int rowi = F.tid >> 4, ch = F.tid & 15;
        u32x4 kown[4], kpar[4], vv[8]; f32x4 c0[4], c1[4], s0[4], s1[4];
#pragma unroll
        for (int p = 0; p < 4; ++p) { const int j = p * 32 + rowi; const unsigned tok = (unsigned)(n * 128 + j);
            const bf16_t* kp = proj + tok * INW + C_KR + h * 128;
            kown[p] = *(const u32x4*)(kp + ch * 8); kpar[p] = *(const u32x4*)(kp + (ch ^ 8) * 8);
            const float* cp = rc + tok * 64 + (ch & 7) * 8; const float* sp = rsn + tok * 64 + (ch & 7) * 8;
            c0[p] = *(const f32x4*)cp; c1[p] = *(const f32x4*)(cp + 4); s0[p] = *(const f32x4*)sp; s1[p] = *(const f32x4*)(sp + 4);
            vv[2 * p] = *(const u32x4*)(proj + tok * INW + C_VR + h * 256 + ch * 8); vv[2 * p + 1] = *(const u32x4*)(proj + tok * INW + C_VR + h * 256 + (ch + 16) * 8); }
#pragma unroll
        for (int p = 0; p < 4; ++p) { const int j = p * 32 + rowi;
            float o[8]; rot8v(kown[p], kpar[p], ch, c0[p], c1[p], s0[p], s1[p], 0.08838834764831845f, o);
            u32x4 ov; ov.x = cvt_pk_bf16(o[0], o[1]); ov.y = cvt_pk_bf16(o[2], o[3]); ov.z = cvt_pk_bf16(o[4], o[5]); ov.w = cvt_pk_bf16(o[6], o[7]);
            *(LAS u32x4*)(KS + j * 136 + ch * 8) = ov; }
#pragma unroll
        for (int p = 0; p < 4; ++p) { const int j = p * 32 + rowi;
#pragma unroll
            for (int c2 = 0; c2 < 2; ++c2) { const int chv = ch + 16 * c2; const u32x4 x = vv[2 * p + c2];
                *(LAS u32x4*)(VS + j * 264 + chv * 8) = x; } }
    }
    const int iq = 16 * w + ql; const unsigned tq = (unsigned)(n * 128 + iq);
    bf16x8 qf[4];
    {
        u32x4 qv[4]; float f[4][8];
#pragma unroll
        for (int ds = 0; ds < 4; ++ds) qv[ds] = *(const u32x4*)(proj + tq * INW + C_QR + h * 128 + 32 * ds + 8 * g4);
#pragma unroll
        for (int ds = 0; ds < 4; ++ds) { f[ds][0] = bf2f(qv[ds].x & 0xffffu); f[ds][1] = bf2f(qv[ds].x >> 16); f[ds][2] = bf2f(qv[ds].y & 0xffffu); f[ds][3] = bf2f(qv[ds].y >> 16);
            f[ds][4] = bf2f(qv[ds].z & 0xffffu); f[ds][5] = bf2f(qv[ds].z >> 16); f[ds][6] = bf2f(qv[ds].w & 0xffffu); f[ds][7] = bf2f(qv[ds].w >> 16); }
        const float xi = exp2f(lg2 * (float)(iq + 1));
#pragma unroll
        for (int ds = 0; ds < 2; ++ds) {
            const float* cp = rc + tq * 64 + 32 * ds + 8 * g4; const float* sp = rsn + tq * 64 + 32 * ds + 8 * g4;
            const f32x4 c0 = *(const f32x4*)cp, c1 = *(const f32x4*)(cp + 4), s0 = *(const f32x4*)sp, s1 = *(const f32x4*)(sp + 4);
            const float cv[8] = {c0.x, c0.y, c0.z, c0.w, c1.x, c1.y, c1.z, c1.w}, sv[8] = {s0.x, s0.y, s0.z, s0.w, s1.x, s1.y, s1.z, s1.w};
            float lo[8], hi[8];
#pragma unroll
            for (int e = 0; e < 8; ++e) { const float t1 = f[ds][e], t2 = f[ds + 2][e]; lo[e] = t1 * cv[e] - t2 * sv[e]; hi[e] = t1 * sv[e] + t2 * cv[e]; }
            u32x4 o; o.x = cvt_pk_bf16(lo[0], lo[1]); o.y = cvt_pk_bf16(lo[2], lo[3]); o.z = cvt_pk_bf16(lo[4], lo[5]); o.w = cvt_pk_bf16(lo[6], lo[7]); qf[ds] = __builtin_bit_cast(bf16x8, o);
            o.x = cvt_pk_bf16(hi[0], hi[1]); o.y = cvt_pk_bf16(hi[2], hi[3]); o.z = cvt_pk_bf16(hi[4], hi[5]); o.w = cvt_pk_bf16(hi[6], hi[7]); qf[ds + 2] = __builtin_bit_cast(bf16x8, o);
            o.x = cvt_pk_bf16(lo[0] * xi, lo[1] * xi); o.y = cvt_pk_bf16(lo[2] * xi, lo[3] * xi); o.z = cvt_pk_bf16(lo[4] * xi, lo[5] * xi); o.w = cvt_pk_bf16(lo[6] * xi, lo[7] * xi);
            *(LAS u32x4*)(QS + iq * 136 + 32 * ds + 8 * g4) = o;
            o.x = cvt_pk_bf16(hi[0] * xi, hi[1] * xi); o.y = cvt_pk_bf16(hi[2] * xi, hi[3] * xi); o.z = cvt_pk_bf16(hi[4] * xi, hi[5] * xi); o.w = cvt_pk_bf16(hi[6] * xi, hi[7] * xi);
            *(LAS u32x4*)(QS + iq * 136 + 32 * (ds + 2) + 8 * g4) = o;
        }
    }
    bf16x8 pr[2][4];
#pragma unroll
    for (int a = 0; a < 2; ++a)
#pragma unroll
        for (int ds = 0; ds < 4; ++ds) pr[a][ds] = *(const bf16x8*)(prev + ((2 * w + a) * 16 + ql) * 128 + 32 * ds + 8 * g4);
    __syncthreads();
    f32x4 sc[8];
#pragma unroll
    for (int kt = 0; kt < 8; ++kt) { f32x4 a = (f32x4){0.f, 0.f, 0.f, 0.f};
#pragma unroll
        for (int ds = 0; ds < 4; ++ds) { const bf16x8 kf = *(const LAS bf16x8*)(KS + (16 * kt + ql) * 136 + 32 * ds + 8 * g4); a = mfma16(kf, qf[ds], a); }
#pragma unroll
        for (int i = 0; i < 4; ++i) { const int j = 16 * kt + 4 * g4 + i; const int df = iq - j; a[i] = (df >= 0) ? a[i] * exp2f(lg2 * (float)df) : 0.f; }
        sc[kt] = a; }
    __syncthreads();
#pragma unroll
    for (int kt = 0; kt < 8; ++kt) { u32x2 o; o.x = cvt_pk_bf16(sc[kt][0], sc[kt][1]); o.y = cvt_pk_bf16(sc[kt][2], sc[kt][3]); *(LAS u32x2*)(KS + iq * 136 + 16 * kt + 4 * g4) = o; }
    __syncthreads();
    f32x4 acc[2][8];
#pragma unroll
    for (int a = 0; a < 2; ++a)
#pragma unroll
        for (int qt = 0; qt < 8; ++qt) acc[a][qt] = (f32x4){0.f, 0.f, 0.f, 0.f};
#pragma unroll
    for (int ds = 0; ds < 4; ++ds)
#pragma unroll
        for (int qt = 0; qt < 8; ++qt) { const bf16x8 bq = *(const LAS bf16x8*)(QS + (qt * 16 + ql) * 136 + 32 * ds + 8 * g4);
            acc[0][qt] = mfma16(pr[0][ds], bq, acc[0][qt]); acc[1][qt] = mfma16(pr[1][ds], bq, acc[1][qt]); }
    const unsigned vbw = (unsigned)(size_t)VS + (unsigned)(((8 * g4 + (ql >> 2)) * 264 + 4 * (ql & 3) + 32 * w) * 2);
#pragma unroll
    for (int s = 0; s < 4; ++s) {
        u32x2 vl[2], vh[2];
#pragma unroll
        for (int a = 0; a < 2; ++a) { TR_READ(vl[a], vbw, (32 * s * 264 + a * 16) * 2); TR_READ(vh[a], vbw, ((32 * s + 4) * 264 + a * 16) * 2); }
        TR_WAIT4(vl[0], vh[0], vl[1], vh[1]);
        const bf16x8 vf0 = pk_frag(vl[0], vh[0]), vf1 = pk_frag(vl[1], vh[1]);
#pragma unroll
        for (int qt = 0; qt < 8; ++qt) if (qt >= 2 * s) { const bf16x8 bp = *(const LAS bf16x8*)(KS + (qt * 16 + ql) * 136 + 32 * s + 8 * g4);
            acc[0][qt] = mfma16(vf0, bp, acc[0][qt]); acc[1][qt] = mfma16(vf1, bp, acc[1][qt]); }
    }
#pragma unroll
    for (int qt = 0; qt < 8; ++qt) { float s1 = 0.f, s2 = 0.f;
#pragma unroll
        for (int a = 0; a < 2; ++a)
#pragma unroll
            for (int i = 0; i < 4; ++i) { const float x = acc[a][qt][i]; s1 += x; s2 += x * x; }
        s1 += __shfl_xor(s1, 16); s1 += __shfl_xor(s1, 32); s2 += __shfl_xor(s2, 16); s2 += __shfl_xor(s2, 32);
        if (g4 == 0) *(LAS f32x2*)(RED + (w * 128 + qt * 16 + ql) * 2) = (f32x2){s1, s2}; }
    __syncthreads();
    if (F.tid < 128) { float s1 = 0.f, s2 = 0.f;
#pragma unroll
        for (int ww = 0; ww < 8; ++ww) { const f32x2 v = *(const LAS f32x2*)(RED + (ww * 128 + F.tid) * 2); s1 += v.x; s2 += v.y; }
        const float mean = s1 * (1.f / 256.f); float var = s2 * (1.f / 256.f) - mean * mean; var = var > 0.f ? var : 0.f;
        *(LAS f32x2*)(TOT + F.tid * 2) = (f32x2){mean, 1.0f / sqrtf(var + 1e-5f)}; }
    __syncthreads();
    LAS bf16_t* OT = VS;
#pragma unroll
    for (int qt = 0; qt < 8; ++qt) { const f32x2 st = *(const LAS f32x2*)(TOT + (qt * 16 + ql) * 2);
#pragma unroll
        for (int a = 0; a < 2; ++a) { u32x2 o; o.x = cvt_pk_bf16((acc[a][qt][0] - st.x) * st.y, (acc[a][qt][1] - st.x) * st.y); o.y = cvt_pk_bf16((acc[a][qt][2] - st.x) * st.y, (acc[a][qt][3] - st.x) * st.y);
            *(LAS u32x2*)(OT + (qt * 16 + ql) * 264 + (2 * w + a) * 16 + 4 * g4) = o; } }
    __syncthreads();
    const float* gng = inp(F, IN_GNG) + h * 256;
    {
        const int pc = F.tid & 31;
        const f32x4 gg0 = *(const f32x4*)(gng + pc * 8), gg1 = *(const f32x4*)(gng + pc * 8 + 4);
        u32x4 gv[8];
#pragma unroll
        for (int p = 0; p < 8; ++p) { const unsigned tk = (unsigned)(n * 128 + p * 16 + (F.tid >> 5)); gv[p] = *(const u32x4*)(proj + tk * INW + C_GR + h * 256 + pc * 8); }
#pragma unroll
        for (int p = 0; p < 8; ++p) { const int row = p * 16 + (F.tid >> 5); const unsigned tk = (unsigned)(n * 128 + row);
            const u32x4 x = *(const LAS u32x4*)(OT + row * 264 + pc * 8); u32x2 o;
            o.x = cvt4_fp8(bf2f(x.x & 0xffffu) * (gg0.x * FP8_YBS) * fsilu(bf2f(gv[p].x & 0xffffu)), bf2f(x.x >> 16) * (gg0.y * FP8_YBS) * fsilu(bf2f(gv[p].x >> 16)),
                           bf2f(x.y & 0xffffu) * (gg0.z * FP8_YBS) * fsilu(bf2f(gv[p].y & 0xffffu)), bf2f(x.y >> 16) * (gg0.w * FP8_YBS) * fsilu(bf2f(gv[p].y >> 16)));
            o.y = cvt4_fp8(bf2f(x.z & 0xffffu) * (gg1.x * FP8_YBS) * fsilu(bf2f(gv[p].z & 0xffffu)), bf2f(x.z >> 16) * (gg1.y * FP8_YBS) * fsilu(bf2f(gv[p].z >> 16)),
                           bf2f(x.w & 0xffffu) * (gg1.z * FP8_YBS) * fsilu(bf2f(gv[p].w & 0xffffu)), bf2f(x.w >> 16) * (gg1.w * FP8_YBS) * fsilu(bf2f(gv[p].w >> 16)));
            *(u32x2*)(F.ws + WS_YB + (size_t)tk * D + h * 256 + pc * 8) = o; }
    }
    __syncthreads();
}
__device__ __forceinline__ void comb_item(const Ctx& F, int it) {
    const unsigned char* og = F.ws + WS_OG; const float* lse = (const float*)(F.ws + WS_LSE); bf16_t* ya = (bf16_t*)(F.ws + WS_YA);
    for (int rr = 0; rr < 4; ++rr) { const size_t t = (size_t)it * 32 + F.wave * 4 + rr; const int hh = F.lane >> 3;
        const float l0 = lse[(0 * (size_t)S + t) * 8 + hh], l1 = lse[(1 * (size_t)S + t) * 8 + hh], l2 = lse[(2 * (size_t)S + t) * 8 + hh];
        const float m = fmaxf(l0, fmaxf(l1, l2)); float a0 = __expf(l0 - m), a1 = __expf(l1 - m), a2 = __expf(l2 - m); const float inv = 1.f / (a0 + a1 + a2); a0 *= inv; a1 *= inv; a2 *= inv;
#pragma unroll
        for (int c = 0; c < 2; ++c) { const size_t e = t * 1024 + F.lane * 16 + c * 8;
            const u32x2 v0 = *(const u32x2*)(og + e), v1 = *(const u32x2*)(og + (size_t)S * 1024 + e), v2 = *(const u32x2*)(og + 2 * (size_t)S * 1024 + e);
            float y[8];
#pragma unroll
            for (int hq = 0; hq < 2; ++hq) { const int w0 = hq ? (int)v0.y : (int)v0.x, w1 = hq ? (int)v1.y : (int)v1.x, w2 = hq ? (int)v2.y : (int)v2.x;
                const f32x2 p0 = __builtin_amdgcn_cvt_pk_f32_fp8(w0, false), q0 = __builtin_amdgcn_cvt_pk_f32_fp8(w0, true);
                const f32x2 p1 = __builtin_amdgcn_cvt_pk_f32_fp8(w1, false), q1 = __builtin_amdgcn_cvt_pk_f32_fp8(w1, true);
                const f32x2 p2 = __builtin_amdgcn_cvt_pk_f32_fp8(w2, false), q2 = __builtin_amdgcn_cvt_pk_f32_fp8(w2, true);
                y[4 * hq + 0] = a0 * p0.x + a1 * p1.x + a2 * p2.x; y[4 * hq + 1] = a0 * p0.y + a1 * p1.y + a2 * p2.y;
                y[4 * hq + 2] = a0 * q0.x + a1 * q1.x + a2 * q2.x; y[4 * hq + 3] = a0 * q0.y + a1 * q1.y + a2 * q2.y; }
            u32x2 o; o.x = cvt4_fp8(y[0], y[1], y[2], y[3]); o.y = cvt4_fp8(y[4], y[5], y[6], y[7]);
            *(u32x2*)((unsigned char*)ya + e) = o; } }
}
__device__ __forceinline__ void p4_scan_comb(const Ctx& F) {
    p4_scan(F);
    for (int it = F.bx; it < 256; it += F.G) comb_item(F, it);
}
__device__ __forceinline__ void p5_mix2(const Ctx& F) {
    for (int it = F.bx; it < 512; it += F.G) ret_unit(F, it);
    if (DUP2_MASK & 1) { __syncthreads(); for (int it = F.bx; it < 512; it += F.G) ret_unit(F, it); }
}

__device__ __forceinline__ void p8_router(const Ctx& F) {
    LAS float* gs = (LAS float*)F.lds; LAS float* sh = gs + D; LAS bf16_t* XH = (LAS bf16_t*)(F.lds + 16384); LAS bf16_t* XL = XH + 32 * 264; LAS bf16_t* WH = XL + 32 * 264; LAS bf16_t* WL = WH + 64 * 264;
    LAS float* WSm = (LAS float*)WH; LAS float* SC = (LAS float*)(WL + 64 * 264); LAS float* SEL = SC + 32 * 64; LAS float* RSTD = SEL + 32 * 64;
    const float* modf = (const float*)(F.ws + WS_MODF);
    for (int k = F.tid; k < D; k += 512) { gs[k] = inp(F, IN_LN2)[k] * (1.f + modf[4 * D + k]); sh[k] = modf[3 * D + k]; }
    __syncthreads();
    const float* x1 = F.out; unsigned char* H2 = F.ws + WS_H;
    const float* rw = inp(F, IN_RW); const float* rb = inp(F, IN_RB);
    int* e_of = (int*)(F.ws + WS_EOF); int* pos_of = e_of + 65536; float* topw = (float*)(pos_of + 65536);
    LAS int* HL = (LAS int*)(RSTD + 32);
    int* hist = (int*)(F.ws + WS_HIST);
    for (int it = F.bx; it < 256; it += F.G) {
        const int t0 = it * 32;
        if (F.tid < 64) HL[F.tid] = 0;
        {
            f32x4 v[4][8];
#pragma unroll
            for (int rr = 0; rr < 4; ++rr) { const GAS f32x4* xr = (const GAS f32x4*)(x1 + (size_t)(t0 + F.wave * 4 + rr) * D) + F.lane;
#pragma unroll
                for (int j = 0; j < 8; ++j) v[rr][j] = xr[64 * j]; }
#pragma unroll
            for (int rr = 0; rr < 4; ++rr) { const int m = t0 + F.wave * 4 + rr; float ss = 0.f;
#pragma unroll
                for (int j = 0; j < 8; ++j) ss += (v[rr][j].x * v[rr][j].x + v[rr][j].y * v[rr][j].y) + (v[rr][j].z * v[rr][j].z + v[rr][j].w * v[rr][j].w);
#pragma unroll
                for (int o = 1; o < 64; o <<= 1) ss += __shfl_xor(ss, o);
                const float rstd = 1.0f / sqrtf(ss * (1.f / D) + 1e-6f);
                if (F.lane == 0) RSTD[F.wave * 4 + rr] = rstd;
                GAS unsigned* o4 = (GAS unsigned*)(H2 + (size_t)m * D) + F.lane;
#pragma unroll
                for (int j = 0; j < 8; ++j) { const f32x4 g = *(const LAS f32x4*)(gs + 256 * j + 4 * F.lane), s2 = *(const LAS f32x4*)(sh + 256 * j + 4 * F.lane);
                    const f32x4 y = v[rr][j] * rstd * g + s2; o4[64 * j] = cvt4_fp8(y.x, y.y, y.z, y.w); } }
        }
        __syncthreads();
        const int tok = F.tid >> 4, eq = F.tid & 15;
        f32x4 ac[2][4];
#pragma unroll
        for (int a = 0; a < 2; ++a)
#pragma unroll
            for (int b = 0; b < 4; ++b) ac[a][b] = (f32x4){0.f, 0.f, 0.f, 0.f};
        const unsigned char* rwh = F.ws + WS_RWH; const unsigned char* rwl = F.ws + WS_RWL;
        f32x4 xg0[4], xg1[4]; u32x4 whg0[4], whg1[4], wlg0[4], wlg1[4];
        int tl = F.tid; asm volatile("" : "+v"(tl));
        const unsigned xo = (unsigned)((t0 + (tl >> 6)) * D + (tl & 63) * 4) * 4u, wo0 = (unsigned)((tl >> 5) * 2048 + (tl & 31) * 8) * 2u;
        auto ld = [&](f32x4 (&xg)[4], u32x4 (&whg)[4], u32x4 (&wlg)[4], int kc) __attribute__((always_inline)) {
#pragma unroll
            for (int q = 0; q < 4; ++q) { xg[q] = *(const f32x4*)((const unsigned char*)x1 + (xo + (unsigned)(q * 8 * D * 4 + kc * 1024)));
                const unsigned wo = wo0 + (unsigned)(q * 16 * 2048 * 2 + kc * 512); whg[q] = *(const u32x4*)(rwh + wo); wlg[q] = *(const u32x4*)(rwl + wo); } };
        auto step = [&](f32x4 (&xg)[4], u32x4 (&whg)[4], u32x4 (&wlg)[4], int kc) __attribute__((always_inline)) {
#pragma unroll
            for (int q = 0; q < 4; ++q) { const int idx = F.tid + 512 * q; const int row = idx >> 6, c4 = (idx & 63) * 4; const int k = kc * 256 + c4;
                const float rstd = RSTD[row];
                const f32x4 g = *(const LAS f32x4*)(gs + k), s2 = *(const LAS f32x4*)(sh + k);
                const f32x4 y = xg[q] * rstd * g + s2;
                u32x2 hh, ll; hh.x = cvt_pk_bf16(y.x, y.y); hh.y = cvt_pk_bf16(y.z, y.w);
                ll.x = cvt_pk_bf16(y.x - bf2f(hh.x & 0xffffu), y.y - bf2f(hh.x >> 16)); ll.y = cvt_pk_bf16(y.z - bf2f(hh.y & 0xffffu), y.w - bf2f(hh.y >> 16));
                *(LAS u32x2*)(XH + row * 264 + c4) = hh; *(LAS u32x2*)(XL + row * 264 + c4) = ll; }
#pragma unroll
            for (int q = 0; q < 4; ++q) { const int idx = F.tid + 512 * q; const int e = idx >> 5, k8 = (idx & 31) * 8; *(LAS u32x4*)(WH + e * 264 + k8) = whg[q]; *(LAS u32x4*)(WL + e * 264 + k8) = wlg[q]; }
            __syncthreads();
            if (kc + 2 < 8) ld(xg, whg, wlg, kc + 2);
            { const int i16 = F.lane & 15, kof = 32 * F.wave + 8 * (F.lane >> 4);
              bf16x8 ah[2], al[2];
#pragma unroll
              for (int tt = 0; tt < 2; ++tt) { ah[tt] = *(const LAS bf16x8*)(XH + (16 * tt + i16) * 264 + kof); al[tt] = *(const LAS bf16x8*)(XL + (16 * tt + i16) * 264 + kof); }
#pragma unroll
              for (int et = 0; et < 4; ++et) { const bf16x8 bh = *(const LAS bf16x8*)(WH + (16 * et + i16) * 264 + kof), bl = *(const LAS bf16x8*)(WL + (16 * et + i16) * 264 + kof);
#pragma unroll
                  for (int tt = 0; tt < 2; ++tt) { ac[tt][et] = mfma16(ah[tt], bh, ac[tt][et]); ac[tt][et] = mfma16(ah[tt], bl, ac[tt][et]); ac[tt][et] = mfma16(al[tt], bh, ac[tt][et]); } } }
            __syncthreads(); };
        ld(xg0, whg0, wlg0, 0); ld(xg1, whg1, wlg1, 1);
#pragma unroll 1
        for (int kc = 0; kc < 8; kc += 2) { step(xg0, whg0, wlg0, kc); step(xg1, whg1, wlg1, kc + 1); }
        { LAS float* RED = WSm + F.wave * 2048; const int i16 = F.lane & 15, rq = F.lane >> 4;
#pragma unroll
          for (int tt = 0; tt < 2; ++tt)
#pragma unroll
              for (int et = 0; et < 4; ++et)
#pragma unroll
                  for (int r = 0; r < 4; ++r) RED[(16 * tt + 4 * rq + r) * 64 + 16 * et + i16] = ac[tt][et][r]; }
        __syncthreads();
        f32x4 lg = (f32x4){0.f, 0.f, 0.f, 0.f};
#pragma unroll
        for (int w = 0; w < 8; ++w) lg += *(const LAS f32x4*)(WSm + w * 2048 + tok * 64 + eq * 4);
#pragma unroll
        for (int i = 0; i < 4; ++i) { const float sc = fsigm(lg[i]); SC[tok * 64 + eq * 4 + i] = sc; SEL[tok * 64 + eq * 4 + i] = sc + rb[eq * 4 + i]; }
        __syncthreads();
        if (F.tid < 32) {
            LAS float* sel = SEL + F.tid * 64; const LAS float* scp = SC + F.tid * 64;
            float gsc[8];
#pragma unroll
            for (int g = 0; g < 8; ++g) { float m1 = -3e38f, m2 = -3e38f;
#pragma unroll
                for (int j = 0; j < 8; ++j) { const float v = sel[g * 8 + j]; if (v > m1) { m2 = m1; m1 = v; } else if (v > m2) m2 = v; }
                gsc[g] = m1 + m2; }
            unsigned gmask = 0u;
#pragma unroll
            for (int r = 0; r < 4; ++r) { float best = -3e38f; int bi = 0;
#pragma unroll
                for (int g = 0; g < 8; ++g) { const bool take = !((gmask >> g) & 1u) && gsc[g] > best; best = take ? gsc[g] : best; bi = take ? g : bi; }
                gmask |= 1u << bi; }
            int idx[8]; float wv[8]; float wsum = 0.f;
#pragma unroll
            for (int r = 0; r < 8; ++r) { float best = -3e38f; int bi = 0;
                for (int e = 0; e < 64; ++e) { const float v = sel[e]; const bool take = ((gmask >> (e >> 3)) & 1u) && v > best; best = take ? v : best; bi = take ? e : bi; }
                sel[bi] = -3e38f; idx[r] = bi; wv[r] = scp[bi]; wsum += wv[r]; }
            const float sc = 2.5f / wsum; const int tk = t0 + F.tid;
#pragma unroll
            for (int r = 0; r < 8; ++r) { const int pos = __hip_atomic_fetch_add(HL + idx[r], 1, __ATOMIC_RELAXED, __HIP_MEMORY_SCOPE_WORKGROUP);
                e_of[tk * 8 + r] = idx[r]; pos_of[tk * 8 + r] = pos; topw[tk * 8 + r] = wv[r] * sc; }
        }
        __syncthreads();
        if (F.tid < 64) hist[it * 64 + F.tid] = HL[F.tid];
        __syncthreads();
    }
}

__device__ __forceinline__ void build_moe_tab_c(const Ctx& F, int c) {
    MoeTab tab = moe_tab(F.lds);
    LAS int* padstart = tab.misc + 8;
    if (F.tid < 64) {
        const int nt = (c + 255) >> 8; int pre = nt;
#pragma unroll
        for (int o = 1; o < 64; o <<= 1) { const int v = __shfl_up(pre, o); if (F.tid >= o) pre += v; }
        const int excl = pre - nt;
        padstart[F.tid] = excl * 256;
        for (int r = 0; r < nt; ++r) { tab.te[excl + r] = F.tid; const int left = c - r * 256; tab.tn[excl + r] = left < 256 ? left : 256; }
        if (F.tid == 63) tab.misc[0] = pre;
    }
    __syncthreads();
}
__device__ __forceinline__ void build_moe_tab(const Ctx& F) {
    int c = 0;
    if (F.tid < 64) c = (int)__hip_atomic_load((unsigned*)(F.ws + WS_CTL) + CW_CNT + F.tid, __ATOMIC_RELAXED, __HIP_MEMORY_SCOPE_AGENT);
    build_moe_tab_c(F, c);
}
__device__ __forceinline__ void p9_dispatch(const Ctx& F) {
    const int* hist = (const int*)(F.ws + WS_HIST);
    LAS int* PL = (LAS int*)F.lds;
    LAS int* TL = PL + 512;
    LAS int* PRE = TL + 512;
    const int* e_of = (const int*)(F.ws + WS_EOF); const int* pos_of = e_of + 65536; const float* topw = (const float*)(pos_of + 65536); int* inv = (int*)(topw + 65536);
    int* toks = (int*)(F.ws + WS_TOKS); float* wsorted = (float*)(toks + SH_ROW0);
    for (int it = F.bx; it < 256; it += F.G) {
        { const int e = F.tid & 63, seg = F.tid >> 6; int slt = 0, sall = 0;
#pragma unroll 8
          for (int q = 0; q < 32; ++q) { const int j = seg * 32 + q; const int v = hist[j * 64 + e]; sall += v; slt += (j < it) ? v : 0; }
          PL[seg * 64 + e] = slt; TL[seg * 64 + e] = sall; }
        __syncthreads();
        int c = 0;
        if (F.tid < 64) { int p = 0;
#pragma unroll
            for (int sg = 0; sg < 8; ++sg) { p += PL[sg * 64 + F.tid]; c += TL[sg * 64 + F.tid]; }
            PRE[F.tid] = p;
            if (it == 0) ((unsigned*)(F.ws + WS_CTL))[CW_CNT + F.tid] = (unsigned)c; }
        build_moe_tab_c(F, c);
        const LAS int* padstart = moe_tab(F.lds).misc + 8;
        if (F.tid < 256) { const int i = it * 256 + F.tid; const int e = e_of[i]; const int dest = padstart[e] + PRE[e] + pos_of[i]; toks[dest] = i >> 3; wsorted[dest] = topw[i]; inv[i] = dest; }
        __syncthreads();
    }
}
__device__ __forceinline__ void p12_combine(const Ctx& F) {
    const unsigned char* Y = F.ws + WS_Y; const int* inv = (const int*)(F.ws + WS_EOF) + 3 * 65536; const float* g2 = (const float*)(F.ws + WS_MODF) + 5 * D;
    const int gw = F.vcu * 8 + F.wave, NGW = F.G * 8;
    for (int m = gw; m < S; m += NGW) {
        int rows[9];
#pragma unroll
        for (int s = 0; s < 8; ++s) rows[s] = inv[m * 8 + s];
        rows[8] = SH_ROW0 + m;
#pragma unroll
        for (int c = 0; c < 2; ++c) { const int col = c * 1024 + F.lane * 16;
            u32x4 v[9];
#pragma unroll
            for (int s = 0; s < 9; ++s) v[s] = *(const u32x4*)(Y + (size_t)rows[s] * D + col);
            float a[16];
#pragma unroll
            for (int e = 0; e < 16; ++e) a[e] = 0.f;
#pragma unroll
            for (int s = 0; s < 9; ++s) { const unsigned w4[4] = {v[s].x, v[s].y, v[s].z, v[s].w};
#pragma unroll
                for (int q = 0; q < 4; ++q) { const f32x2 lo = __builtin_amdgcn_cvt_pk_f32_fp8((int)w4[q], false), hi = __builtin_amdgcn_cvt_pk_f32_fp8((int)w4[q], true);
                    a[4 * q] += lo.x; a[4 * q + 1] += lo.y; a[4 * q + 2] += hi.x; a[4 * q + 3] += hi.y; } }
            float* op = F.out + (size_t)m * D + col;
#pragma unroll
            for (int q = 0; q < 4; ++q) { const f32x4 x0 = *(const f32x4*)(op + 4 * q); const f32x4 gq = *(const f32x4*)(g2 + col + 4 * q) * (1.0f / FP8_YS);
                *(f32x4*)(op + 4 * q) = x0 + gq * (f32x4){a[4 * q], a[4 * q + 1], a[4 * q + 2], a[4 * q + 3]}; } }
    }
}


__device__ __forceinline__ void ph2_proj(const Ctx& F) {
    pg8::ProjSched<false> Sa; Sa.init(F.ws + WS_H, D * 2, F.ws + WS_WINT, D * 2, F.G, F.bx);
    pg8::ProjSched<true> Sb; Sb.init(F.ws + WS_H8, D, F.ws + WS_WIN8, D, F.G, F.bx);
    EpiBf16 Ea{(bf16_t*)(F.ws + WS_PROJ), INW, 0, 1.0f, F.lds + LDS_EPI + F.wave * 2048}; EpiBf16 Eb{(bf16_t*)(F.ws + WS_PROJ), INW, 0, 1.0f / FP8_WIN, F.lds + LDS_EPI + F.wave * 2048};
    const int na = Sa.count(), nb = Sb.count(), ntot = na + nb;
    const int slot = ntot > 0 ? ((((F.bx >> 7) * 8 + (F.bx & 7)) * ntot) / 16) : 0;
    const int sa = slot < na ? slot : na, sb = slot < na ? 0 : slot - na;
    Sa.i_lo = 0; Sa.i_hi = sa; pg8::gemm_phase<EpiBf16, pg8::ProjSched<false>, true, false>(F.lds, D, Sa, Ea);
    if (slot < na) { __syncthreads(); convert_items<1>(F, 0, CV_N1, F.vcu * 8 + F.wave, F.G * 8); __syncthreads(); }
    Sa.i_lo = sa; Sa.i_hi = na; pg8::gemm_phase<EpiBf16, pg8::ProjSched<false>, true, false>(F.lds, D, Sa, Ea);
    Sb.i_lo = 0; Sb.i_hi = sb; pg8::gemm_phase<EpiBf16, pg8::ProjSched<true>, true, true>(F.lds, D, Sb, Eb);
    if (slot >= na) { __syncthreads();
        const int cvA = (F.G == 256) ? 15 * 2048 : CV_N1;
        convert_items<1>(F, 0, cvA, F.vcu * 8 + F.wave, F.G * 8);
        if (F.G == 256 && F.bx >= 128) convert_items<1>(F, cvA, CV_N1, (F.bx - 128) * 8 + F.wave, 128 * 8);
        __syncthreads(); }
    Sb.i_lo = sb; Sb.i_hi = nb; pg8::gemm_phase<EpiBf16, pg8::ProjSched<true>, true, true>(F.lds, D, Sb, Eb);
}
__device__ __forceinline__ void ph6a_merge(const Ctx& F) {
    pg8::DenseSched8 Sd; Sd.init(F.ws + WS_YA, 1024, F.ws + WS_PA, 1024, S, D, F.G, F.bx);
    EpiGate<false> E{(bf16_t*)(F.ws + WS_MERGED), D, (const bf16_t*)(F.ws + WS_PROJ) + C_GA, INW, nullptr, 1.0f / (FP8_YAS * FP8_PW)};
    pg8::gemm_phase<EpiGate<false>, pg8::DenseSched8, true, true>(F.lds, 1024, Sd, E);
}
__device__ __forceinline__ void ph6_merge(const Ctx& F) {
    pg8::DenseSched8 Sd; Sd.init(F.ws + WS_YB, D, F.ws + WS_PB, D, S, D, F.G, F.bx);
    EpiGate<true> E{(bf16_t*)(F.ws + WS_MERGED), D, (const bf16_t*)(F.ws + WS_PROJ) + C_GB, INW, F.ws + WS_H8, 1.0f / (FP8_YBS * FP8_PW)};
    pg8::gemm_phase<EpiGate<true>, pg8::DenseSched8, true, true>(F.lds, D, Sd, E);
}
__device__ __forceinline__ void p5_mix2_a(const Ctx& F) { p5_mix2(F); __syncthreads(); ph6a_merge(F); }
__device__ __forceinline__ void ph7_wo(const Ctx& F) {
    pg8::DenseSched8 Sd; Sd.init(F.ws + WS_H8, D, F.ws + WS_WO, D, S, D, F.G, F.bx);
    EpiResid E{inp(F, IN_X), F.out, D, (const float*)(F.ws + WS_MODF) + 2 * D, 1.0f / (FP8_MS * FP8_WO)};
    pg8::gemm_phase<EpiResid, pg8::DenseSched8, true, true>(F.lds, D, Sd, E);
}
__device__ __forceinline__ void ph10_gateup(const Ctx& F) {
    build_moe_tab(F);
    MoeSched1 S1{(const char*)(F.ws + WS_H), (const char*)(F.ws + WS_E1), (const int*)(F.ws + WS_TOKS), moe_tab(F.lds), F.G, F.vcu, 0, 0};
    EpiGateUp E{(unsigned char*)(F.ws + WS_ACT), F.lds + LDS_EPI + F.wave * 2048};
    const int slot = (((F.bx >> 7) * 8 + (F.bx & 7)) * P10_SLOTS) / 16;
    S1.i_lo = 0; S1.i_hi = slot; pg8::gemm_phase<EpiGateUp, MoeSched1, true, true>(F.lds, D, S1, E);
    int n6; { const int tot = 4 * (moe_tab(F.lds).misc[0] + 32), rounds = (tot + F.G - 1) / F.G; n6 = tot - (rounds - 1) * F.G; if (n6 >= F.G || n6 < 0) n6 = 0; if (n6 > F.G / 2) n6 = 0; }
    n6 = __builtin_amdgcn_readfirstlane(n6);
    __syncthreads(); if (F.vcu >= n6) convert_items<2>(F, 0, CV_N2, (F.vcu - n6) * 8 + F.wave, (F.G - n6) * 8); __syncthreads();
    build_moe_tab(F);
    S1.i_lo = slot; S1.i_hi = 0x7fffffff; pg8::gemm_phase<EpiGateUp, MoeSched1, true, true>(F.lds, D, S1, E);
}
__device__ __forceinline__ void ph11_down(const Ctx& F) {
    build_moe_tab(F);
    MoeSched2 S2{(const char*)(F.ws + WS_ACT), (const char*)(F.ws + WS_E2), moe_tab(F.lds), F.G, F.vcu};
    EpiDown E{(unsigned char*)(F.ws + WS_Y), (const float*)(F.ws + WS_TOKS) + SH_ROW0, F.lds + LDS_EPI + F.wave * 2048};
    pg8::gemm_phase<EpiDown, MoeSched2, true, true>(F.lds, ED, S2, E);
}

struct Args { const float* in[22]; float* out; unsigned char* ws; int ph_lo, ph_hi; };
__global__ void __launch_bounds__(512, 2) fwd(Args args) {
    extern __shared__ __attribute__((aligned(16))) unsigned char lds_raw[];
    Ctx F;
    F.lds = (LAS unsigned char*)lds_raw;
    F.tid = threadIdx.x; F.lane = F.tid & 63; F.wave = __builtin_amdgcn_readfirstlane(F.tid >> 6);
    F.G = gridDim.x; F.bx = blockIdx.x; F.vcu = (F.G % 8 == 0) ? (F.bx % 8) * (F.G / 8) + F.bx / 8 : F.bx;
    F.out = args.out; F.ws = args.ws;
    if (F.tid == 0) {
#pragma unroll
        for (int i = 0; i < 22; ++i) ((LAS unsigned long long*)(F.lds + LDS_PTRS))[i] = (unsigned long long)args.in[i];
    }
    volatile LAS unsigned* MISC = (volatile LAS unsigned*)(F.lds + LDS_MISC);
    if (F.tid < 64) MISC[F.tid] = 0u;
    __syncthreads();
    unsigned* ctl = (unsigned*)(F.ws + WS_CTL);
    XcdBarrier bar; bar.bar = ctl + CW_BAR; bar.x = 0; bar.st = nullptr;
    if (!MK_PER_PHASE) bar = xcd_barrier_post(ctl + CW_BAR, MISC + 8);
    const int lo = args.ph_lo, hi = args.ph_hi;
#ifndef PHASE_MASK
#define PHASE_MASK 0x1fff
#endif
#define IN(k) (((PHASE_MASK >> (k)) & 1) && lo <= (k) && (k) < hi)
#define SEAM(k) do { if (IN(k) && IN((k) + 1)) xcd_barrier(bar); } while (0)

#ifndef DUP_MASK
#define DUP_MASK 0
#endif
#define RUN(k, fn) do { if (IN(k)) { fn(F); if ((DUP_MASK >> (k)) & 1) { xcd_barrier(bar); fn(F); } } SEAM(k); } while (0)
    RUN(0, p0_prologue);
    RUN(1, p1_norm1);
    RUN(2, ph2_proj);
    RUN(3, p3_mix1);
    RUN(4, p4_scan_comb);
    RUN(5, p5_mix2_a);
    RUN(6, ph6_merge);
    RUN(7, ph7_wo);
    RUN(8, p8_router);
    RUN(9, p9_dispatch);
    RUN(10, ph10_gateup);
    RUN(11, ph11_down);
    RUN(12, p12_combine);
#undef RUN
#undef IN
#undef SEAM
}

extern "C" void kernel_launch(void* const* d_in, const int* in_sizes, int n_in, void* d_out, int out_size, void* d_ws, size_t ws_size, hipStream_t stream) {
    static int grid = 0;
    if (grid == 0) {
        if (n_in != 22 || out_size != S * D || ws_size < WS_END) { fprintf(stderr, "kernel_launch: unexpected shapes / workspace (n_in %d out %d ws %zu need %zu)\n", n_in, out_size, ws_size, (size_t)WS_END); grid = -1; return; }
        int dev = 0, cus = 0, per_cu = 0;
        if (hipGetDevice(&dev) != hipSuccess || hipDeviceGetAttribute(&cus, hipDeviceAttributeMultiprocessorCount, dev) != hipSuccess) { grid = -1; return; }
        if (hipFuncSetAttribute((const void*)fwd, hipFuncAttributeMaxDynamicSharedMemorySize, LDS_BYTES) != hipSuccess) { fprintf(stderr, "kernel_launch: hipFuncSetAttribute failed\n"); grid = -1; return; }
        if (hipOccupancyMaxActiveBlocksPerMultiprocessor(&per_cu, (const void*)fwd, 512, LDS_BYTES) != hipSuccess || per_cu < 1) fprintf(stderr, "kernel_launch: occupancy query says %d\n", per_cu);
        (void)hipGetLastError();
        grid = cus;
    }
    if (grid < 0) return;
    (void)hipMemsetAsync((char*)d_ws + WS_CTL, 0, CTL_ZERO_BYTES, stream);
    Args a{};
    for (int i = 0; i < 22; ++i) a.in[i] = (const float*)d_in[i];
    a.out = (float*)d_out; a.ws = (unsigned char*)d_ws;
#if MK_PER_PHASE
    for (int p = 0; p < NPH; ++p) { a.ph_lo = p; a.ph_hi = p + 1; hipLaunchKernelGGL(fwd, dim3(grid), dim3(512), LDS_BYTES, stream, a); }
#else
    a.ph_lo = 0; a.ph_hi = NPH; hipLaunchKernelGGL(fwd, dim3(grid), dim3(512), LDS_BYTES, stream, a);
#endif
}
```
